# Optimizing an MI355X kernel written in HIP

```python
import math
import jax
import jax.numpy as jnp
from jax import lax
import numpy as np

D_MODEL = 2048
BATCH = 32
SEQ = 256
DEPTH = 2
DEC_BATCH = 2
DEC_SEQ = 1024
PAST_LEN = 512

GRID_W = 64
D_MIX = D_MODEL
W_A = D_MIX // 4
HD_A = 64
H_A = W_A // HD_A
W_LORA = 64
A_LORA = 64
W_B = D_MIX // 4
H_B = 4
HD_B = W_B // H_B
CHUNK = 64
W_C = D_MIX // 2
H_C = 8
DV_C = W_C // H_C
DK_C = DV_C // 2
Q_BLOCK = 128
ROPE_BASE = 10000.0
CONV_W = 3
N_DIR = 2
LN_EPS = 1e-5
GN_EPS_A = 64e-5
GN_EPS = 1e-5
RMS_EPS = 1e-5
DEEPNORM_ALPHA = (2 * DEPTH) ** 0.25
DEEPNORM_BETA = (8 * DEPTH) ** -0.25
PROJ_SPLITS = (
    3 * W_A, W_LORA, W_LORA, A_LORA, A_LORA, W_A,
    2 * W_B, W_B, W_B, N_DIR * H_B, N_DIR * H_B, W_B,
    2 * H_C * DK_C, 2 * H_C * DK_C, H_C * DV_C, H_C * DV_C,
)
P_IN = sum(PROJ_SPLITS)

kernel_name = 'hybrid_rwkv7_mlstm_diffattn_prefix_dit_step'


def layer_norm(x, g, b):
    xf = x.astype(jnp.float32)
    mu = jnp.mean(xf, axis=-1, keepdims=True)
    var = jnp.mean(jnp.square(xf - mu), axis=-1, keepdims=True)
    return ((xf - mu) * lax.rsqrt(var + LN_EPS) * g + b).astype(x.dtype)


def head_layer_norm(y, g, b, eps):
    mu = jnp.mean(y, axis=-1, keepdims=True)
    var = jnp.mean(jnp.square(y - mu), axis=-1, keepdims=True)
    yn = (y - mu) * lax.rsqrt(var + eps)
    return yn.reshape(y.shape[0], y.shape[1], -1) * g + b


def centred_conv(x, w, b):
    xp = jnp.pad(x, ((0, 0), (1, 1), (0, 0)))
    return xp[:, :-2] * w[0] + xp[:, 1:-1] * w[1] + xp[:, 2:] * w[2] + b


def axial_rope(x):
    n_tok = x.shape[1]
    rows = n_tok // GRID_W
    row = jnp.repeat(jnp.arange(rows, dtype=jnp.float32), GRID_W)
    col = jnp.tile(jnp.arange(GRID_W, dtype=jnp.float32), rows)
    half = DK_C // 2
    inv = 1.0 / (ROPE_BASE ** (jnp.arange(0, half, 2, dtype=jnp.float32) / half))

    def rot(xa, pos):
        ang = pos[:, None] * inv
        cos = jnp.cos(ang)[None, :, None, :]
        sin = jnp.sin(ang)[None, :, None, :]
        x1, x2 = jnp.split(xa, 2, axis=-1)
        return jnp.concatenate([x1 * cos - x2 * sin, x2 * cos + x1 * sin], axis=-1)

    xr, xc = jnp.split(x, 2, axis=-1)
    return jnp.concatenate([rot(xr, row), rot(xc, col)], axis=-1)


def rwkv_scan(s0, r, w, k, v, kk, a, reverse):
    def step(S, inp):
        r_t, w_t, k_t, v_t, kk_t, a_t = inp
        sk = jnp.einsum('bhvk,bhk->bhv', S, kk_t)
        S = (S * w_t[:, :, None, :] - sk[..., None] * (kk_t * a_t)[:, :, None, :]
             + v_t[..., None] * k_t[:, :, None, :])
        return S, jnp.einsum('bhvk,bhk->bhv', S, r_t)

    xs = tuple(jnp.swapaxes(t, 0, 1) for t in (r, w, k, v, kk, a))
    s_fin, ys = lax.scan(step, s0.astype(jnp.float32), xs, reverse=reverse)
    return jnp.swapaxes(ys, 0, 1), s_fin


def rwkv_mixer(u_rkv, wds, ads, u_gate, lp, s0):
    B, T, _ = u_rkv.shape

    def heads(t):
        return t.reshape(B, T, H_A, HD_A)

    r, k, v = (heads(t) for t in jnp.split(centred_conv(u_rkv, lp['conv_a_w'], lp['conv_a_b']), 3, axis=-1))
    kk = k * lp['rwkv_k_k'].reshape(H_A, HD_A)
    kk = kk * lax.rsqrt(jnp.sum(kk * kk, axis=-1, keepdims=True) + 1e-12)
    k_a = lp['rwkv_k_a'].reshape(H_A, HD_A)
    y = 0.0
    bonus = 0.0
    states = []
    for d in range(N_DIR):
        z = lp['rwkv_w0'][d] + jnp.tanh(wds[d]) @ lp['rwkv_w_up'][d]
        decay = heads(jnp.exp(-jnp.exp(-jax.nn.softplus(-z) - 0.5)))
        a = heads(jax.nn.sigmoid(lp['rwkv_a0'][d] + ads[d] @ lp['rwkv_a_up'][d]))
        kt = k * (1.0 + (a - 1.0) * k_a)
        yd, sd = rwkv_scan(s0[:, d], r, decay, kt, v, kk, a, reverse=(d == 1))
        y = y + yd
        bonus = bonus + jnp.sum(r * kt * lp['rwkv_r_k'], axis=-1, keepdims=True) * v
        states.append(sd)
    y = head_layer_norm(y, lp['rwkv_gn_g'], lp['rwkv_gn_b'], GN_EPS_A) + bonus.reshape(B, T, W_A)
    return y * jax.nn.silu(u_gate), jnp.stack(states, axis=1)


def mlstm_chunkwise(q, k, v, li, lf, C0, n0, m0):
    B, H, T, d = q.shape
    nc = T // CHUNK

    def to_chunks(t):
        t = t.reshape(B, H, nc, CHUNK, *t.shape[3:])
        return jnp.moveaxis(t, 2, 0)

    xs = tuple(to_chunks(t) for t in (q, k, v, li, lf))
    tri = jnp.tril(jnp.ones((CHUNK, CHUNK), dtype=bool))

    def step(carry, inp):
        C, n, m = carry
        qc, kc, vc, ic, fc = inp
        b = jnp.cumsum(fc, axis=-1)
        inter = b + m[..., None]
        D = b[..., :, None] - b[..., None, :] + ic[..., None, :]
        D = jnp.where(tri, D, -jnp.inf)
        mt = jnp.maximum(inter, jnp.max(D, axis=-1))
        wi = jnp.exp(inter - mt)
        P = jnp.exp(D - mt[..., None]) * jnp.einsum('bhtd,bhsd->bhts', qc, kc)
        num = wi[..., None] * jnp.einsum('bhvk,bhtk->bhtv', C, qc) + jnp.einsum('bhts,bhsv->bhtv', P, vc)
        den = wi * jnp.einsum('bhk,bhtk->bht', n, qc) + jnp.sum(P, axis=-1)
        h = num / jnp.maximum(jnp.abs(den), jnp.exp(-mt))[..., None]
        bL = b[..., -1]
        g = bL[..., None] - b + ic
        m_new = jnp.maximum(bL + m, jnp.max(g, axis=-1))
        sc = jnp.exp(bL + m - m_new)
        wg = jnp.exp(g - m_new[..., None])
        C = sc[..., None, None] * C + jnp.einsum('bhs,bhsv,bhsk->bhvk', wg, vc, kc)
        n = sc[..., None] * n + jnp.einsum('bhs,bhsk->bhk', wg, kc)
        return (C, n, m_new), h

    init = (C0.astype(jnp.float32), n0.astype(jnp.float32), m0.astype(jnp.float32))
    (C, n, m), hs = lax.scan(step, init, xs)
    h = jnp.moveaxis(hs, 0, 2).reshape(B, H, T, d)
    return h, C, n, m


def mlstm_mixer(u_qk, u_v, u_o, u_i, u_f, u_gate, lp, state0):
    B, T, _ = u_qk.shape
    C0, n0, m0 = state0
    qk = jax.nn.silu(centred_conv(u_qk, lp['conv_b_w'], lp['conv_b_b']))
    q, k = jnp.split(qk, 2, axis=-1)

    def heads(t):
        return t.reshape(B, T, H_B, HD_B).transpose(0, 2, 1, 3)

    q, k, v = heads(q), heads(k) * (HD_B ** -0.5), heads(u_v)
    ig = (u_i.reshape(B, T, N_DIR, H_B) + lp['mlstm_b_i']).transpose(2, 0, 3, 1)
    lf = jax.nn.log_sigmoid(u_f.reshape(B, T, N_DIR, H_B) + lp['mlstm_b_f']).transpose(2, 0, 3, 1)
    h = 0.0
    Cs, ns, ms = [], [], []
    for d in range(N_DIR):
        if d == 0:
            flip = lambda t: t
        else:
            flip = lambda t: jnp.flip(t, axis=2)
        hd, Cd, nd, md = mlstm_chunkwise(flip(q), flip(k), flip(v), flip(ig[d]), flip(lf[d]),
                                         C0[:, d], n0[:, d], m0[:, d])
        h = h + flip(hd)
        Cs.append(Cd)
        ns.append(nd)
        ms.append(md)
    o = jax.nn.sigmoid(u_o).reshape(B, T, H_B, HD_B)
    h = h.transpose(0, 2, 1, 3) * o
    y = head_layer_norm(h, lp['mlstm_gn_g'], lp['mlstm_gn_b'], GN_EPS) * jax.nn.silu(u_gate)
    return y, (jnp.stack(Cs, axis=1), jnp.stack(ns, axis=1), jnp.stack(ms, axis=1))


def diff_softmax_attention(q1, q2, k1, k2, v, lam):
    B, H, T, _ = q1.shape
    nb = T // Q_BLOCK
    scale = DK_C ** -0.5

    def blocks(t):
        return jnp.moveaxis(t.reshape(B, H, nb, Q_BLOCK, t.shape[-1]), 2, 0)

    def one_block(qs):
        qb1, qb2 = qs
        p1 = jax.nn.softmax(jnp.einsum('bhqd,bhkd->bhqk', qb1, k1) * scale, axis=-1)
        p2 = jax.nn.softmax(jnp.einsum('bhqd,bhkd->bhqk', qb2, k2) * scale, axis=-1)
        return jnp.einsum('bhqk,bhkd->bhqd', p1 - lam * p2, v)

    out = lax.map(one_block, (blocks(q1), blocks(q2)))
    return jnp.moveaxis(out, 0, 2).reshape(B, H, T, v.shape[-1])


def diff_attn_mixer(u_q, u_k, u_v, u_gate, lp, lam_init, ctx_kv):
    B, T, _ = u_q.shape
    q = u_q.reshape(B, T, 2 * H_C, DK_C)
    k = u_k.reshape(B, T, 2 * H_C, DK_C)
    if ctx_kv is not None:
        q, k = axial_rope(q), axial_rope(k)
    q = q.reshape(B, T, H_C, 2, DK_C).transpose(3, 0, 2, 1, 4)
    k_own = k.reshape(B, T, H_C, 2 * DK_C).transpose(0, 2, 1, 3)
    v_own = u_v.reshape(B, T, H_C, DV_C).transpose(0, 2, 1, 3)
    if ctx_kv is None:
        k_all, v_all = k_own, v_own
    else:
        k_all = jnp.concatenate([ctx_kv[0].astype(jnp.float32), k_own], axis=2)
        v_all = jnp.concatenate([ctx_kv[1].astype(jnp.float32), v_own], axis=2)
    k1, k2 = jnp.split(k_all, 2, axis=-1)
    lam = (jnp.exp(jnp.sum(lp['diff_lq1'] * lp['diff_lk1'])) - jnp.exp(jnp.sum(lp['diff_lq2'] * lp['diff_lk2']))
           + lam_init).astype(jnp.float32)
    o = diff_softmax_attention(q[0], q[1], k1, k2, v_all, lam)
    o = o * lax.rsqrt(jnp.mean(jnp.square(o), axis=-1, keepdims=True) + RMS_EPS) * lp['diff_subln_g'] * (1.0 - lam_init)
    o = o.transpose(0, 2, 1, 3).reshape(B, T, W_C)
    return o * jax.nn.silu(u_gate), (k_own, v_own)


def trunk_layer(x, mod, lp, lam_init, cached):
    B, T, _ = x.shape
    f32 = jnp.float32
    shift, scale, gate = jnp.split(mod, 3, axis=-1)
    u = x * (1.0 + scale[:, None]) + shift[:, None]
    proj = jnp.matmul(u, lp['w_in']).astype(f32)
    cuts = [int(i) for i in np.cumsum(PROJ_SPLITS)[:-1]]
    (a_rkv, a_wdf, a_wdb, a_adf, a_adb, a_gate,
     b_qk, b_v, b_o, b_i, b_f, b_gate,
     c_q, c_k, c_v, c_gate) = jnp.split(proj, cuts, axis=-1)
    if cached is None:
        ctx_kv = None
        s_rwkv0 = jnp.zeros((B, N_DIR, H_A, HD_A, HD_A), f32)
        mstate0 = (jnp.zeros((B, N_DIR, H_B, HD_B, HD_B), f32),
                   jnp.zeros((B, N_DIR, H_B, HD_B), f32),
                   jnp.zeros((B, N_DIR, H_B), f32))
    else:
        ctx_kv = (cached[0], cached[1])
        s_rwkv0 = cached[2]
        mstate0 = (cached[3], cached[4], cached[5])
    y_a, s_rwkv = rwkv_mixer(a_rkv, (a_wdf, a_wdb), (a_adf, a_adb), a_gate, lp, s_rwkv0)
    y_b, mstate = mlstm_mixer(b_qk, b_v, b_o, b_i, b_f, b_gate, lp, mstate0)
    y_c, kv_own = diff_attn_mixer(c_q, c_k, c_v, c_gate, lp, lam_init, ctx_kv)
    mixed = jnp.concatenate([y_a, y_b, y_c], axis=-1).astype(x.dtype)
    out = jnp.matmul(mixed, lp['w_out'])
    x_new = layer_norm(DEEPNORM_ALPHA * x + gate[:, None] * out, lp['ln_g'], lp['ln_b'])
    return x_new, (kv_own[0], kv_own[1], s_rwkv, mstate[0], mstate[1], mstate[2])


def setup_inputs(seed: int = 0) -> dict:
    key = jax.random.key(seed)
    keys = iter(jax.random.split(key, 48))

    def nrm(shape, s=1.0):
        return jax.random.normal(next(keys), shape, jnp.float32) * s

    L = DEPTH
    return {
        'x_prompt': nrm((BATCH, SEQ, D_MODEL)),
        'x_sample': nrm((DEC_BATCH, DEC_SEQ, D_MODEL)),
        'cache_attn_k': nrm((DEC_BATCH, L, H_C, PAST_LEN, 2 * DK_C)),
        'cache_attn_v': nrm((DEC_BATCH, L, H_C, PAST_LEN, DV_C)),
        'state_rwkv': nrm((DEC_BATCH, L, N_DIR, H_A, HD_A, HD_A), 0.5),
        'state_mlstm_c': nrm((DEC_BATCH, L, N_DIR, H_B, HD_B, HD_B), 0.1),
        'state_mlstm_n': nrm((DEC_BATCH, L, N_DIR, H_B, HD_B), 0.3),
        'state_mlstm_m': nrm((DEC_BATCH, L, N_DIR, H_B), 0.5),
        'c': nrm((DEC_BATCH, D_MODEL)),
        'c_ctx': nrm((D_MODEL,)),
        'w_ada': nrm((L, D_MODEL, 3 * D_MODEL), 0.5 * D_MODEL ** -0.5),
        'b_ada': nrm((L, 3 * D_MODEL), 0.01),
        'w_in': nrm((L, D_MODEL, P_IN), D_MODEL ** -0.5),
        'conv_a_w': nrm((L, CONV_W, 3 * W_A), 0.2).at[:, 1].add(1.0),
        'conv_a_b': nrm((L, 3 * W_A), 0.01),
        'rwkv_w0': nrm((L, N_DIR, W_A), 0.5) - 1.0,
        'rwkv_w_up': nrm((L, N_DIR, W_LORA, W_A), 0.5 * W_LORA ** -0.5),
        'rwkv_a0': nrm((L, N_DIR, W_A), 0.3),
        'rwkv_a_up': nrm((L, N_DIR, A_LORA, W_A), 0.5 * A_LORA ** -0.5),
        'rwkv_k_k': 0.85 + nrm((L, W_A), 0.05),
        'rwkv_k_a': 1.0 + nrm((L, W_A), 0.05),
        'rwkv_r_k': nrm((L, H_A, HD_A), 0.1),
        'rwkv_gn_g': 1.0 + nrm((L, W_A), 0.05),
        'rwkv_gn_b': nrm((L, W_A), 0.01),
        'conv_b_w': nrm((L, CONV_W, 2 * W_B), 0.2).at[:, 1].add(1.0),
        'conv_b_b': nrm((L, 2 * W_B), 0.01),
        'mlstm_b_i': nrm((L, N_DIR, H_B), 0.1),
        'mlstm_b_f': jax.random.uniform(next(keys), (L, N_DIR, H_B), jnp.float32, 3.0, 6.0),
        'mlstm_gn_g': 1.0 + nrm((L, W_B), 0.05),
        'mlstm_gn_b': nrm((L, W_B), 0.01),
        'diff_lq1': nrm((L, DK_C), 0.1),
        'diff_lk1': nrm((L, DK_C), 0.1),
        'diff_lq2': nrm((L, DK_C), 0.1),
        'diff_lk2': nrm((L, DK_C), 0.1),
        'diff_subln_g': 1.0 + nrm((L, DV_C), 0.05),
        'w_out': nrm((L, D_MIX, D_MODEL), DEEPNORM_BETA * D_MIX ** -0.5),
        'ln_g': 1.0 + nrm((L, D_MODEL), 0.05),
        'ln_b': nrm((L, D_MODEL), 0.01),
    }


def reference(x_prompt, x_sample, cache_attn_k, cache_attn_v, state_rwkv, state_mlstm_c, state_mlstm_n,
              state_mlstm_m, c, c_ctx, w_ada, b_ada, w_in, conv_a_w, conv_a_b, rwkv_w0, rwkv_w_up, rwkv_a0,
              rwkv_a_up, rwkv_k_k, rwkv_k_a, rwkv_r_k, rwkv_gn_g, rwkv_gn_b, conv_b_w, conv_b_b, mlstm_b_i,
              mlstm_b_f, mlstm_gn_g, mlstm_gn_b, diff_lq1, diff_lk1, diff_lq2, diff_lk2, diff_subln_g, w_out,
              ln_g, ln_b):
    silu_ctx = jax.nn.silu(c_ctx)[None, :]
    silu_c = jax.nn.silu(c)
    y_prompt = x_prompt
    y_sample = x_sample
    ctx_layers = []
    for l in range(DEPTH):
        lp = {
            'w_in': w_in[l], 'conv_a_w': conv_a_w[l], 'conv_a_b': conv_a_b[l],
            'rwkv_w0': rwkv_w0[l], 'rwkv_w_up': rwkv_w_up[l], 'rwkv_a0': rwkv_a0[l], 'rwkv_a_up': rwkv_a_up[l],
            'rwkv_k_k': rwkv_k_k[l], 'rwkv_k_a': rwkv_k_a[l], 'rwkv_r_k': rwkv_r_k[l],
            'rwkv_gn_g': rwkv_gn_g[l], 'rwkv_gn_b': rwkv_gn_b[l],
            'conv_b_w': conv_b_w[l], 'conv_b_b': conv_b_b[l], 'mlstm_b_i': mlstm_b_i[l], 'mlstm_b_f': mlstm_b_f[l],
            'mlstm_gn_g': mlstm_gn_g[l], 'mlstm_gn_b': mlstm_gn_b[l],
            'diff_lq1': diff_lq1[l], 'diff_lk1': diff_lk1[l], 'diff_lq2': diff_lq2[l], 'diff_lk2': diff_lk2[l],
            'diff_subln_g': diff_subln_g[l], 'w_out': w_out[l], 'ln_g': ln_g[l], 'ln_b': ln_b[l],
        }
        lam_init = 0.8 - 0.6 * math.exp(-0.3 * l)
        mod_ctx = jnp.matmul(silu_ctx, w_ada[l]) + b_ada[l]
        y_prompt, ctx_t = trunk_layer(y_prompt, mod_ctx, lp, lam_init, None)
        ctx_layers.append(ctx_t)
        mod_lat = jnp.matmul(silu_c, w_ada[l]) + b_ada[l]
        cached = (cache_attn_k[:, l], cache_attn_v[:, l], state_rwkv[:, l],
                  state_mlstm_c[:, l], state_mlstm_n[:, l], state_mlstm_m[:, l])
        y_sample, _ = trunk_layer(y_sample, mod_lat, lp, lam_init, cached)
    new_k, new_v, new_rwkv, new_c, new_n, new_m = (jnp.stack([t[i] for t in ctx_layers], axis=1) for i in range(6))
    return (y_prompt, y_sample, new_k, new_v, new_rwkv, new_c, new_n, new_m)
```

```cpp
#include <hip/hip_runtime.h>
#include <hip/hip_cooperative_groups.h>
#include <cstdio>
#include <cstdint>
namespace cg = cooperative_groups;
namespace pg8 {
#define PG8_LAS __attribute__((address_space(3)))
typedef unsigned short bf16_t;
typedef short bf16x8 __attribute__((ext_vector_type(8)));
typedef float f32x4 __attribute__((ext_vector_type(4)));
typedef unsigned u32x4 __attribute__((ext_vector_type(4)));
constexpr int BM = 256, BK = 64, HALF = 128, HTB = HALF * BK * 2  , STAGE_BYTES = 8 * HTB, NXCD = 8, WGM = 8;

__host__ __device__ __forceinline__ int lds_byte(int r, int c) { const int st = (r >> 4) * 2 + (c >> 5), rr = r & 15, cc = c & 31, ob = rr * 64 + cc * 2; return st * 1024 + (ob ^ (((ob >> 9) & 1) << 5)); }
__host__ __device__ __forceinline__ void stage_rc(int b, int& R, int& C) { const int st = b / 1024, sb = b % 1024, swz = sb ^ (((sb >> 9) & 1) << 5); R = (st >> 1) * 16 + swz / 64; C = (st & 1) * 32 + (swz % 64) / 2; }
__host__ __device__ __forceinline__ int perm32(int rho) { const int n = rho >> 4, i = rho & 15; return 8 * (i >> 2) + 4 * n + (i & 3); }

struct Unit { int pm, pn; };
struct Gemm { const bf16_t* A; const bf16_t* Bt; int M, N, K; };

struct StaticOrder {
    int nM, nN, nwg, G, c;
    __host__ __device__ void init(int M, int N, int G_, int c_) { nM = M / BM; nN = N / BM; nwg = nM * nN; G = G_; c = c_; }
    __host__ __device__ bool next(int i, Unit& u) const {
        const long L = (long)i * G + c; if (L >= nwg) return false;
        int wgid = (int)L; { const int q = nwg / NXCD, r = nwg % NXCD, xcd = wgid % NXCD, off = wgid / NXCD; wgid = (xcd < r ? xcd * (q + 1) : r * (q + 1) + (xcd - r) * q) + off; }
        const int nig = WGM * nN, gid = wgid / nig, fm = gid * WGM, gsz = (nM - fm) < WGM ? (nM - fm) : WGM;
        u.pm = fm + ((wgid % nig) % gsz); u.pn = (wgid % nig) / gsz; return true;
    }
    __device__ __forceinline__ void a_ready(const Unit&) const {}
    __device__ __forceinline__ void done(const Unit&) const {}
};
__device__ __forceinline__ unsigned cvt_pk_bf16(float lo, float hi) { unsigned r; asm volatile("v_cvt_pk_bf16_f32 %0, %1, %2" : "=v"(r) : "v"(lo), "v"(hi)); return r; }
template <class Epi, class Sched, bool STAMP = false>
__device__ __forceinline__ void gemm_phase(PG8_LAS unsigned char* lds, const Gemm g, const Sched& S, const Epi& E, unsigned long long* stamps) {
    int tid = threadIdx.x; asm volatile("" : "+v"(tid)); const int wid = __builtin_amdgcn_readfirstlane(tid >> 6), lane = tid & 63, wr = wid >> 2, wc = wid & 3, fr = lane & 15, fq = lane >> 4;
    const int K = g.K, nt = K / BK;
    int ts_lo = 0, ts_hi = 0, nts = 0; const unsigned long long rt_entry = STAMP ? (unsigned long long)wall_clock64() : 0ull;
#define PG8_STAMP() do { if (STAMP && wid == 0 && nts < 64) { const unsigned long long _c = (unsigned long long)clock64(); \
        ts_lo = (lane == nts) ? (int)(unsigned)_c : ts_lo; ts_hi = (lane == nts) ? (int)(unsigned)(_c >> 32) : ts_hi; ++nts; } } while (0)
    PG8_STAMP();
    unsigned voffA[2], voffB[2];
#pragma unroll
    for (int i = 0; i < 2; ++i) { int R, C; stage_rc(tid * 16 + i * 8192, R, C); const int Rb = Epi::PERM ? ((R & ~31) + perm32(R & 31)) : R;
        voffA[i] = (unsigned)(R * K + C) * 2u; voffB[i] = (unsigned)(Rb * K + C) * 2u; }
    const size_t kstep = (size_t)(BK * 2);
    const size_t hstep = (size_t)HALF * K * 2;
    const size_t tstep = 2 * hstep;
    const unsigned ldsw = (unsigned)wid * 1024u;
    const int aoff = lds_byte(wr * 64 + fr, fq * 8), boff = lds_byte(wc * 32 + fr, fq * 8);
#define PG8_SA(b, h) (((b) * 2 + (h)) * HTB)
#define PG8_SB(b, h) ((4 + (b) * 2 + (h)) * HTB)
#define PG8_STAGE(bufoff, gbase, voff) do { _Pragma("unroll") for (int _i = 0; _i < 2; ++_i) \
        __builtin_amdgcn_global_load_lds((const unsigned*)((const char*)(gbase) + (voff)[_i]), (PG8_LAS unsigned*)(lds + (bufoff) + ldsw + _i * 8192), 16, 0, 0); } while (0)
#define PG8_LDA(dst, b, h) do { _Pragma("unroll") for (int m = 0; m < 4; ++m) _Pragma("unroll") for (int k = 0; k < 2; ++k) dst[m][k] = *(const PG8_LAS bf16x8*)(lds + PG8_SA(b, h) + aoff + m * 2048 + k * 1024); } while (0)
#define PG8_LDB(dst, b, h) do { _Pragma("unroll") for (int n = 0; n < 2; ++n) _Pragma("unroll") for (int k = 0; k < 2; ++k) dst[n][k] = *(const PG8_LAS bf16x8*)(lds + PG8_SB(b, h) + boff + n * 2048 + k * 1024); } while (0)
#define PG8_MMA(ai, bj, At, Bt) do { __builtin_amdgcn_s_setprio(1); _Pragma("unroll") for (int m = 0; m < 4; ++m) _Pragma("unroll") for (int n = 0; n < 2; ++n) _Pragma("unroll") for (int k = 0; k < 2; ++k) \
        acc[ai][bj][m][n] = __builtin_amdgcn_mfma_f32_16x16x32_bf16(Bt[n][k], At[m][k], acc[ai][bj][m][n], 0, 0, 0); __builtin_amdgcn_s_setprio(0); } while (0)
#define PG8_WAIT_V(n) asm volatile("s_waitcnt vmcnt(" #n ")" ::: "memory")
#define PG8_WAIT_L(n) asm volatile("s_waitcnt lgkmcnt(" #n ")" ::: "memory")
#define PG8_BAR __builtin_amdgcn_s_barrier()
#define PG8_SCHED __builtin_amdgcn_sched_barrier(0)
    Unit cur, nxt; int ui = 0;
    if (!S.next(0, cur)) return;
    f32x4 acc[2][2][4][2];
#pragma unroll
    for (int a = 0; a < 2; ++a)
#pragma unroll
        for (int b = 0; b < 2; ++b)
#pragma unroll
            for (int m = 0; m < 4; ++m)
#pragma unroll
                for (int n = 0; n < 2; ++n) acc[a][b][m][n] = (f32x4){0.f, 0.f, 0.f, 0.f};
    bf16x8 At[4][2], B0[2][2], B1[2][2];
    const char* cA = (const char*)g.A + (size_t)cur.pm * tstep; const char* cB = (const char*)g.Bt + (size_t)cur.pn * tstep;
    S.a_ready(cur);
    PG8_STAGE(PG8_SB(0, 0), cB, voffB); PG8_STAGE(PG8_SA(0, 0), cA, voffA); PG8_STAGE(PG8_SB(0, 1), cB + hstep, voffB); PG8_STAGE(PG8_SA(0, 1), cA + hstep, voffA);
    if (wr == 1) PG8_BAR;
    PG8_WAIT_V(4); PG8_BAR;
    PG8_STAGE(PG8_SB(1, 0), cB + kstep, voffB); PG8_STAGE(PG8_SA(1, 0), cA + kstep, voffA); PG8_STAGE(PG8_SB(1, 1), cB + hstep + kstep, voffB);
    PG8_WAIT_V(6); PG8_BAR;
    PG8_STAMP();
    for (;;) {
        const bool has_next = S.next(ui + 1, nxt);
        const char* nA = has_next ? (const char*)g.A + (size_t)nxt.pm * tstep : cA; const char* nB = has_next ? (const char*)g.Bt + (size_t)nxt.pn * tstep : cB;
        for (int t = 0; t < nt; t += 2) {
            const bool last = (t == nt - 2);
            const char* a1 = cA + (size_t)(t + 1) * kstep;
            const char* a2 = last ? nA : cA + (size_t)(t + 2) * kstep; const char* b2 = last ? nB : cB + (size_t)(t + 2) * kstep;
            const char* a3 = a2 + kstep; const char* b3 = b2 + kstep;
            if (last && has_next) S.a_ready(nxt);
            PG8_LDB(B0, 0, 0); PG8_SCHED; PG8_LDA(At, 0, 0); PG8_STAGE(PG8_SA(1, 1), a1 + hstep, voffA);
            PG8_WAIT_L(8); PG8_BAR; PG8_WAIT_L(0); PG8_MMA(0, 0, At, B0); PG8_BAR; PG8_SCHED;
            PG8_LDB(B1, 0, 1); PG8_STAGE(PG8_SB(0, 0), b2, voffB);
            PG8_BAR; PG8_WAIT_L(0); PG8_MMA(0, 1, At, B1); PG8_BAR;
            PG8_LDA(At, 0, 1); PG8_STAGE(PG8_SA(0, 0), a2, voffA);
            PG8_BAR; PG8_WAIT_L(0); PG8_MMA(1, 0, At, B0); PG8_BAR; PG8_SCHED;
            PG8_STAGE(PG8_SB(0, 1), b2 + hstep, voffB);
            PG8_WAIT_V(6); PG8_BAR; PG8_MMA(1, 1, At, B1); PG8_BAR;
            PG8_LDB(B0, 1, 0); PG8_SCHED; PG8_LDA(At, 1, 0); PG8_STAGE(PG8_SA(0, 1), a2 + hstep, voffA);
            PG8_WAIT_L(8); PG8_BAR; PG8_WAIT_L(0); PG8_MMA(0, 0, At, B0); PG8_BAR; PG8_SCHED;
            PG8_LDB(B1, 1, 1); PG8_STAGE(PG8_SB(1, 0), b3, voffB);
            PG8_BAR; PG8_WAIT_L(0); PG8_MMA(0, 1, At, B1); PG8_BAR;
            PG8_LDA(At, 1, 1); PG8_STAGE(PG8_SA(1, 0), a3, voffA);
            PG8_BAR; PG8_WAIT_L(0); PG8_MMA(1, 0, At, B0); PG8_BAR; PG8_SCHED;
            PG8_STAGE(PG8_SB(1, 1), b3 + hstep, voffB);
            PG8_WAIT_V(6); PG8_BAR; PG8_MMA(1, 1, At, B1); PG8_BAR;
        }
        PG8_STAMP();
        if constexpr (!Epi::AFTER_DRAIN) { E(acc, cur, wr, wc, fr, fq); S.done(cur); }
        PG8_STAMP();
        if (!has_next) break;
#pragma unroll
        for (int a = 0; a < 2; ++a)
#pragma unroll
            for (int b = 0; b < 2; ++b)
#pragma unroll
                for (int m = 0; m < 4; ++m)
#pragma unroll
                    for (int n = 0; n < 2; ++n) acc[a][b][m][n] = (f32x4){0.f, 0.f, 0.f, 0.f};
        cur = nxt; cA = nA; cB = nB; ++ui;
    }
    PG8_WAIT_V(0);
    if (wr == 0) PG8_BAR;
    PG8_BAR;
    if constexpr (Epi::AFTER_DRAIN) { E.fused(acc, cur, wr, wc, fr, fq, lds, wid, lane); S.done(cur); }
    PG8_STAMP();
    if (STAMP && wid == 0) { stamps[lane] = lane < nts ? (((unsigned long long)(unsigned)ts_hi << 32) | (unsigned)ts_lo) : 0ull;
        if (lane == 62) stamps[62] = rt_entry; if (lane == 63) stamps[63] = (unsigned long long)wall_clock64(); }
#undef PG8_STAMP
#undef PG8_SA
#undef PG8_SB
#undef PG8_STAGE
#undef PG8_LDA
#undef PG8_LDB
#undef PG8_MMA
#undef PG8_WAIT_V
#undef PG8_WAIT_L
#undef PG8_BAR
#undef PG8_SCHED
}
}

#define LAS __attribute__((address_space(3)))
typedef unsigned short bf16_t;
typedef short bf16x8 __attribute__((ext_vector_type(8)));
typedef float f32x4 __attribute__((ext_vector_type(4)));
typedef unsigned u32x4v __attribute__((ext_vector_type(4)));

constexpr int NTOK = 10240, NPT = 8192, DM = 2048, NP = 9216, PIN = 8976;
constexpr int C_Q = 4864, C_K = 5888, C_V = 6912, C_G = 7936, C_IF = 8960;
constexpr int A_WD = 1536, A_AD = 1664, A_GATE = 1792;
constexpr int B_Q = 2304, B_V = 3328, B_O = 3840, B_GATE = 4352;
constexpr int NTHREADS = 512;
constexpr int LDS_SLOT = 131072, LDS_BYTES = 131072 + 1024;

constexpr size_t WS_CTL = 0;
constexpr size_t WS_MOD = 4096;
constexpr size_t WS_ROPE = WS_MOD + 147456;
constexpr size_t WS_LAM = WS_ROPE + 8192;
constexpr size_t WS_WIN = WS_LAM + 256;
constexpr size_t WS_WOUT = WS_WIN + 2ull * NP * DM * 2;
constexpr size_t WS_UM = WS_WOUT + 2ull * DM * DM * 2;
constexpr size_t WS_PROJ = WS_UM + (size_t)NTOK * DM * 2;
constexpr size_t WS_GATES = WS_PROJ + (size_t)NTOK * NP * 2;
constexpr size_t SZ16 = (size_t)NTOK * 512 * 2, SZ32 = (size_t)NTOK * 512 * 4;
constexpr size_t WS_SCR = WS_GATES + (size_t)NTOK * 16 * 4;
constexpr size_t WS_SCKK = WS_SCR + SZ16;
constexpr size_t WS_SCV = WS_SCKK + SZ16;
constexpr size_t WS_SCBON = WS_SCV + SZ16;
constexpr size_t WS_SCKT = WS_SCBON + SZ16;
constexpr size_t WS_SCKA = WS_SCKT + 2 * SZ16;
constexpr size_t WS_SCW = WS_SCKA + 2 * SZ16;
constexpr size_t WS_YD = WS_SCW + 2 * SZ32;
constexpr size_t WS_HD = WS_YD + 2 * SZ32;
constexpr size_t WS_END = WS_HD + 2 * SZ32;

constexpr size_t O_Y = 0, O_NK = 20971520, O_NV = 37748736, O_RW = 54525952, O_MC = 58720256, O_MN = 67108864, O_MM = 67174400;

struct Params { const float* in[38]; float* out; unsigned char* ws; };
enum { I_XP = 0, I_XS, I_CK, I_CV, I_SRW, I_SMC, I_SMN, I_SMM, I_C, I_CCTX, I_WADA, I_BADA, I_WIN, I_CAW, I_CAB, I_W0, I_WUP, I_A0, I_AUP, I_KK, I_KA, I_RK,
       I_RGG, I_RGB, I_CBW, I_CBB, I_BI, I_BF, I_MGG, I_MGB, I_LQ1, I_LK1, I_LQ2, I_LK2, I_SUBG, I_WOUT, I_LNG, I_LNB };

__device__ __forceinline__ float bf2f(bf16_t v) { return __uint_as_float(((unsigned)v) << 16); }
__device__ __forceinline__ float bflo(unsigned w) { return __uint_as_float(w << 16); }
__device__ __forceinline__ float bfhi(unsigned w) { return __uint_as_float(w & 0xffff0000u); }
__device__ __forceinline__ unsigned pk2(float lo, float hi) { return pg8::cvt_pk_bf16(lo, hi); }
__device__ __forceinline__ bf16_t f2bf(float f) { return (bf16_t)(pk2(f, 0.f) & 0xffffu); }
__device__ __forceinline__ void unpack8(const u32x4v w, float (&o)[8]) { o[0] = bflo(w.x); o[1] = bfhi(w.x); o[2] = bflo(w.y); o[3] = bfhi(w.y); o[4] = bflo(w.z); o[5] = bfhi(w.z); o[6] = bflo(w.w); o[7] = bfhi(w.w); }
__device__ __forceinline__ u32x4v pack8(const float (&o)[8]) { u32x4v w; w.x = pk2(o[0], o[1]); w.y = pk2(o[2], o[3]); w.z = pk2(o[4], o[5]); w.w = pk2(o[6], o[7]); return w; }
__device__ __forceinline__ void ld8f(const float* p, float (&o)[8]) { const float4 a = *(const float4*)p, b = *(const float4*)(p + 4); o[0] = a.x; o[1] = a.y; o[2] = a.z; o[3] = a.w; o[4] = b.x; o[5] = b.y; o[6] = b.z; o[7] = b.w; }
__device__ __forceinline__ float sigmoidf_(float x) { return 1.0f / (1.0f + __expf(-x)); }
__device__ __forceinline__ float siluf_(float x) { return x / (1.0f + __expf(-x)); }
__device__ __forceinline__ bf16x8 frag(const LAS bf16_t* base, int row0, int ld, int k0, int lane) { return *(const LAS bf16x8*)(base + (row0 + (lane & 15)) * ld + k0 + (lane >> 4) * 8); }
#define MFMA16(a, b, c) __builtin_amdgcn_mfma_f32_16x16x32_bf16((a), (b), (c), 0, 0, 0)
#define LDS_FENCE() asm volatile("s_waitcnt lgkmcnt(0)" ::: "memory")
template <int CTRL> __device__ __forceinline__ float dppf(float x) { return __builtin_bit_cast(float, __builtin_amdgcn_mov_dpp(__builtin_bit_cast(int, x), CTRL, 0xf, 0xf, true)); }
__device__ __forceinline__ float red16_sum(float x) { x += dppf<0xB1>(x); x += dppf<0x4E>(x); x += dppf<0x124>(x); x += dppf<0x128>(x); return x; }
__device__ __forceinline__ float red4_sum(float x) { x += dppf<0xB1>(x); x += dppf<0x4E>(x); return x; }
__device__ __forceinline__ float red16_max(float x) { x = fmaxf(x, dppf<0xB1>(x)); x = fmaxf(x, dppf<0x4E>(x)); x = fmaxf(x, dppf<0x124>(x)); x = fmaxf(x, dppf<0x128>(x)); return x; }

__device__ __forceinline__ int opaque_tid() { int t = threadIdx.x; asm volatile("" : "+v"(t)); return t; }
__device__ __forceinline__ int next_task(unsigned* ctr, LAS int* slot) {
    __syncthreads();
    if (threadIdx.x == 0) *slot = (int)atomicAdd(ctr, 1u);
    __syncthreads();
    return *slot;
}
__device__ __forceinline__ int win_src_col(int n) { return n < 4352 ? n : (n < 8960 ? n + 16 : (n < 8976 ? n - 8960 + 4352 : -1)); }
__device__ __forceinline__ int mod_row(int tok) { return tok < NPT ? 0 : 1 + ((tok - NPT) >> 10); }

__device__ __forceinline__ void p0_mod_item(const Params& p, int item, LAS unsigned char* lds) {
    const int tid = opaque_tid(), lane = tid & 63, wave = tid >> 6, kq = lane >> 4, cq = lane & 15;
    const int l = item / 96, cb = item % 96;
    LAS float* sS = (LAS float*)lds;
    LAS float* sRed = sS + 3 * 2048;
    for (int e = tid; e < 3 * 2048; e += NTHREADS) { const int r = e >> 11, k = e & 2047; const float cv = r == 0 ? p.in[I_CCTX][k] : p.in[I_C][(r - 1) * 2048 + k]; sS[e] = siluf_(cv); }
    __syncthreads();
    const float* W = p.in[I_WADA] + (size_t)l * 2048 * 6144 + cb * 64 + 4 * cq;
    float4 a0 = {0, 0, 0, 0}, a1 = a0, a2 = a0;
#pragma unroll 4
    for (int i = 0; i < 64; ++i) { const int k = wave * 256 + i * 4 + kq; const float4 w = *(const float4*)(W + (size_t)k * 6144);
        const float s0 = sS[k], s1 = sS[2048 + k], s2 = sS[4096 + k];
        a0.x += s0 * w.x; a0.y += s0 * w.y; a0.z += s0 * w.z; a0.w += s0 * w.w;
        a1.x += s1 * w.x; a1.y += s1 * w.y; a1.z += s1 * w.z; a1.w += s1 * w.w;
        a2.x += s2 * w.x; a2.y += s2 * w.y; a2.z += s2 * w.z; a2.w += s2 * w.w; }
    float v[12] = {a0.x, a0.y, a0.z, a0.w, a1.x, a1.y, a1.z, a1.w, a2.x, a2.y, a2.z, a2.w};
#pragma unroll
    for (int i = 0; i < 12; ++i) { v[i] += __shfl_xor(v[i], 16); v[i] += __shfl_xor(v[i], 32); }
    if (kq == 0) {
#pragma unroll
        for (int r = 0; r < 3; ++r)
#pragma unroll
            for (int e = 0; e < 4; ++e) sRed[(wave * 3 + r) * 64 + 4 * cq + e] = v[r * 4 + e];
    }
    __syncthreads();
    if (tid < 192) { const int r = tid >> 6, c = tid & 63; float s = 0.f;
#pragma unroll
        for (int w = 0; w < 8; ++w) s += sRed[(w * 3 + r) * 64 + c];
        ((float*)(p.ws + WS_MOD))[(l * 3 + r) * 6144 + cb * 64 + c] = s + p.in[I_BADA][l * 6144 + cb * 64 + c]; }
}
template <bool MAPCOL> __device__ __forceinline__ void p0_transpose_item(const float* W, int N, int nblk, bf16_t* WT, LAS float* scr, int item, int lane) {
    const int kb = item / nblk, nb = item % nblk, k0 = 64 * kb, n0 = 32 * nb;
    const int n = n0 + (lane & 31); const int oc = MAPCOL ? win_src_col(n) : n;
#pragma unroll 8
    for (int i = 0; i < 32; ++i) { const int kk = 2 * i + (lane >> 5); scr[kk * 33 + (lane & 31)] = oc >= 0 ? W[(size_t)(k0 + kk) * N + oc] : 0.f; }
    LDS_FENCE();
    const int c = lane & 7;
#pragma unroll
    for (int j = 0; j < 4; ++j) { const int nn = (lane >> 3) + 8 * j; const LAS float* s = scr + (8 * c) * 33 + nn;
        u32x4v o; o.x = pk2(s[0 * 33], s[1 * 33]); o.y = pk2(s[2 * 33], s[3 * 33]); o.z = pk2(s[4 * 33], s[5 * 33]); o.w = pk2(s[6 * 33], s[7 * 33]);
        *(u32x4v*)(WT + (size_t)(n0 + nn) * 2048 + k0 + 8 * c) = o; }
    LDS_FENCE();
}
__device__ __forceinline__ void p0_phase(const Params& p, LAS unsigned char* lds) {
    const int tid = opaque_tid(), lane = tid & 63, wave = tid >> 6;
    unsigned* ctr = (unsigned*)(p.ws + WS_CTL);
    LAS int* slot = (LAS int*)(lds + LDS_SLOT);
    constexpr int NT_MOD = 192, NT_TR = 2816, NT = NT_MOD + 1 + NT_TR;
    for (;;) {
        const int t = next_task(ctr, slot);
        if (t >= NT) break;
        if (t < NT_MOD) { p0_mod_item(p, t, lds); continue; }
        if (t == NT_MOD) {
            float* rope = (float*)(p.ws + WS_ROPE);
            for (int e = tid; e < 1024; e += NTHREADS) { const int pos = e >> 4, i = e & 15; const float inv = 1.0f / powf(10000.0f, (float)(2 * i) / 32.0f); const float ang = (float)pos * inv;
                rope[pos * 32 + i] = cosf(ang); rope[pos * 32 + 16 + i] = sinf(ang); }
            if (tid < 2) { const int l = tid; float d1 = 0.f, d2 = 0.f;
                for (int i = 0; i < 64; ++i) { d1 += p.in[I_LQ1][l * 64 + i] * p.in[I_LK1][l * 64 + i]; d2 += p.in[I_LQ2][l * 64 + i] * p.in[I_LK2][l * 64 + i]; }
                const float lam_init = 0.8f - 0.6f * expf(-0.3f * (float)l);
                ((float*)(p.ws + WS_LAM))[l] = expf(d1) - expf(d2) + lam_init; }
            continue;
        }
        int it = (t - NT_MOD - 1) * 8 + wave;
        LAS float* scr = (LAS float*)(lds + wave * 8704);
        const int l = it / 11264; it -= l * 11264;
        if (it < 9216) p0_transpose_item<true>(p.in[I_WIN] + (size_t)l * 2048 * PIN, PIN, 288, (bf16_t*)(p.ws + WS_WIN) + (size_t)l * NP * 2048, scr, it, lane);
        else p0_transpose_item<false>(p.in[I_WOUT] + (size_t)l * 2048 * 2048, 2048, 64, (bf16_t*)(p.ws + WS_WOUT) + (size_t)l * 2048 * 2048, scr, it - 9216, lane);
    }
}
__device__ __forceinline__ void modulate_row(const float* xrow, const float* mod, bf16_t* urow, int lane) {
#pragma unroll
    for (int j = 0; j < 4; ++j) { const int c = j * 512 + lane * 8; float x[8], sh[8], sc[8], o[8]; ld8f(xrow + c, x); ld8f(mod + c, sh); ld8f(mod + 2048 + c, sc);
#pragma unroll
        for (int e = 0; e < 8; ++e) o[e] = x[e] * (1.0f + sc[e]) + sh[e];
        *(u32x4v*)(urow + c) = pack8(o); }
}
__device__ __forceinline__ void p0b_phase(const Params& p) {
    const int tid_ = opaque_tid(); const int lane = tid_ & 63, gw = blockIdx.x * 8 + (tid_ >> 6), NGW = gridDim.x * 8;
    for (int tok = gw; tok < NTOK; tok += NGW) {
        const float* xrow = tok < NPT ? p.in[I_XP] + (size_t)tok * DM : p.in[I_XS] + (size_t)(tok - NPT) * DM;
        modulate_row(xrow, (const float*)(p.ws + WS_MOD) + mod_row(tok) * 6144, (bf16_t*)(p.ws + WS_UM) + (size_t)tok * DM, lane);
    }
}

struct EpiIn {
    static constexpr bool PERM = true, AFTER_DRAIN = false;
    bf16_t* proj; float* gates; float* newk; float* newv; const float* rope; int layer;
    __device__ __forceinline__ void operator()(const f32x4 (&acc)[2][2][4][2], const pg8::Unit& u, int wr, int wc, int fr, int fq) const {
        const int row0 = u.pm * 256 + wr * 64 + fr, col0 = u.pn * 256 + wc * 32 + 8 * fq;
        const bool samp = u.pm >= 32;
        const bool is_rope = samp && u.pn >= 19 && u.pn < 27;
        const bool is_k = !samp && u.pn >= 23 && u.pn < 27, is_v = !samp && u.pn >= 27 && u.pn < 31, is_g = u.pn == 35;
#pragma unroll
        for (int ai = 0; ai < 2; ++ai)
#pragma unroll
            for (int m = 0; m < 4; ++m) {
                const int row = row0 + ai * 128 + m * 16;
                float cs[8], sn[8];
                if (is_rope) { const int pos = (row - NPT) & 1023; const int pp = (wc & 1) ? (pos & 63) : (pos >> 6); const float* rp = rope + pp * 32 + 8 * (fq & 1); ld8f(rp, cs); ld8f(rp + 16, sn); }
#pragma unroll
                for (int bj = 0; bj < 2; ++bj) {
                    f32x4 v0 = acc[ai][bj][m][0], v1 = acc[ai][bj][m][1];
                    if (is_rope) {
                        const float sg = (fq & 2) ? 1.0f : -1.0f;
#pragma unroll
                        for (int e = 0; e < 4; ++e) { const float p0 = __shfl_xor(v0[e], 32), p1 = __shfl_xor(v1[e], 32);
                            v0[e] = v0[e] * cs[e] + sg * p0 * sn[e]; v1[e] = v1[e] * cs[4 + e] + sg * p1 * sn[4 + e]; }
                    }
                    const int col = col0 + bj * 128;
                    u32x4v w; w.x = pk2(v0[0], v0[1]); w.y = pk2(v0[2], v0[3]); w.z = pk2(v1[0], v1[1]); w.w = pk2(v1[2], v1[3]);
                    *(u32x4v*)(proj + (size_t)row * NP + col) = w;
                    if (is_k || is_v) { const int ck = col - (is_k ? C_K : C_V), h = ck >> 7, j = ck & 127, b = row >> 8, t = row & 255;
                        float* dst = (is_k ? newk : newv) + ((((size_t)(b * 2 + layer) * 8 + h) * 256 + t) * 128 + j);
                        *(f32x4*)dst = v0; *(f32x4*)(dst + 4) = v1; }
                    if (is_g && bj == 0 && wc == 0 && fq < 2) { float* dst = gates + (size_t)row * 16 + 8 * fq; *(f32x4*)dst = v0; *(f32x4*)(dst + 4) = v1; }
                }
            }
    }
};
struct EpiOut {
    static constexpr bool PERM = false, AFTER_DRAIN = false;
    const float* xp; const float* xs; const float* mod; float* y; int layer;
    __device__ __forceinline__ void operator()(const f32x4 (&acc)[2][2][4][2], const pg8::Unit& u, int wr, int wc, int fr, int fq) const {
        const int row0 = u.pm * 256 + wr * 64 + fr, col0 = u.pn * 256 + wc * 32 + 4 * fq;
#pragma unroll
        for (int ai = 0; ai < 2; ++ai)
#pragma unroll
            for (int m = 0; m < 4; ++m) {
                const int row = row0 + ai * 128 + m * 16;
                const float* xrow = layer == 0 ? (row < NPT ? xp + (size_t)row * DM : xs + (size_t)(row - NPT) * DM) : y + (size_t)row * DM;
                const float* g = mod + mod_row(row) * 6144 + 4096;
#pragma unroll
                for (int bj = 0; bj < 2; ++bj)
#pragma unroll
                    for (int n = 0; n < 2; ++n) { const int c = col0 + bj * 128 + n * 16;
                        const f32x4 xv = *(const f32x4*)(xrow + c), gv = *(const f32x4*)(g + c);
                        *(f32x4*)(y + (size_t)row * DM + c) = 1.41421356237f * xv + gv * acc[ai][bj][m][n]; }
            }
    }
};

__device__ __forceinline__ void mlstm_task(const Params& p, int l, int s, int d, int h, LAS unsigned char* lds) {
    const int tid = opaque_tid(), lane = tid & 63, wave = tid >> 6, quad = lane >> 4, l15 = lane & 15;
    const int T = s < 32 ? 256 : 1024, tok0 = s < 32 ? s * 256 : NPT + (s - 32) * 1024, nch = T / 64;
    LAS bf16_t* sQ = (LAS bf16_t*)lds;
    LAS bf16_t* sK = sQ + 64 * 136;
    LAS bf16_t* sKt = sK + 64 * 136;
    LAS bf16_t* sVt = sKt + 128 * 72;
    LAS bf16_t* sP = sVt + 128 * 72;
    LAS bf16_t* sC = sP + 64 * 72;
    LAS float* sf = (LAS float*)(sC + 128 * 136);
    LAS float *sA = sf, *sB = sf + 64, *sPm = sf + 128, *sN = sf + 192, *sNq = sf + 320, *sPs = sf + 384;
    const bf16_t* proj = (const bf16_t*)(p.ws + WS_PROJ);
    const float* gates = (const float*)(p.ws + WS_GATES);
    float* hd = (float*)(p.ws + WS_HD) + (size_t)d * NTOK * 512;
    const float bi = p.in[I_BI][l * 8 + d * 4 + h], bfb = p.in[I_BF][l * 8 + d * 4 + h];
    f32x4 cacc[8];
    float m;
    __syncthreads();
    if (s >= 32) {
        const size_t sb = (((size_t)((s - 32) * 2 + l) * 2 + d) * 4 + h);
        const float* C0 = p.in[I_SMC] + sb * 128 * 128;
#pragma unroll
        for (int tn = 0; tn < 8; ++tn)
#pragma unroll
            for (int j = 0; j < 4; ++j) cacc[tn][j] = C0[(16 * wave + quad * 4 + j) * 128 + 16 * tn + l15];
        if (tid < 128) sN[tid] = p.in[I_SMN][sb * 128 + tid];
        m = p.in[I_SMM][sb];
    } else {
#pragma unroll
        for (int tn = 0; tn < 8; ++tn) cacc[tn] = (f32x4){0.f, 0.f, 0.f, 0.f};
        if (tid < 128) sN[tid] = 0.f;
        m = 0.f;
    }
#pragma unroll
    for (int tn = 0; tn < 8; ++tn)
#pragma unroll
        for (int j = 0; j < 4; ++j) sC[(16 * wave + quad * 4 + j) * 136 + 16 * tn + l15] = f2bf(cacc[tn][j]);

    for (int c = 0; c < nch; ++c) {
        __syncthreads();
        if (wave == 0) {
            const int ii = 64 * c + lane; const int tk = d == 0 ? tok0 + ii : tok0 + T - 1 - ii;
            const float gi = gates[(size_t)tk * 16 + d * 4 + h] + bi, gf = gates[(size_t)tk * 16 + 8 + d * 4 + h] + bfb;
            const float lf = fminf(gf, 0.f) - log1pf(__expf(-fabsf(gf)));
            float b = lf;
#pragma unroll
            for (int off = 1; off < 64; off <<= 1) { const float t = __shfl_up(b, off); if (lane >= off) b += t; }
            const float a = gi - b; float pm = a;
#pragma unroll
            for (int off = 1; off < 64; off <<= 1) { const float t = __shfl_up(pm, off); if (lane >= off) pm = fmaxf(pm, t); }
            sB[lane] = b; sA[lane] = a; sPm[lane] = pm;
        }
        __syncthreads();
        const float mx = fmaxf(m, sPm[63]), bL = sB[63];
#pragma unroll
        for (int it = 0; it < 4; ++it) {
            const int idx = tid + 512 * it, i = idx >> 5, g = idx & 31, isK = g >> 4, j0 = (g & 15) * 8, ch = (isK ? 512 : 0) + h * 128 + j0;
            const int ii = 64 * c + i, pos = d == 0 ? ii : T - 1 - ii, tk = tok0 + pos;
            const bf16_t* src = proj + (size_t)tk * NP + B_Q + ch;
            float x0[8], x1[8], x2[8], w0[8], w1[8], w2[8], bb[8], y[8];
            unpack8(*(const u32x4v*)src, x1);
            if (pos > 0) unpack8(*(const u32x4v*)(src - NP), x0); else { for (int e = 0; e < 8; ++e) x0[e] = 0.f; }
            if (pos < T - 1) unpack8(*(const u32x4v*)(src + NP), x2); else { for (int e = 0; e < 8; ++e) x2[e] = 0.f; }
            const float* cw = p.in[I_CBW] + (size_t)l * 3 * 1024 + ch;
            ld8f(cw, w0); ld8f(cw + 1024, w1); ld8f(cw + 2048, w2); ld8f(p.in[I_CBB] + l * 1024 + ch, bb);
#pragma unroll
            for (int e = 0; e < 8; ++e) y[e] = siluf_(x0[e] * w0[e] + x1[e] * w1[e] + x2[e] * w2[e] + bb[e]);
            if (!isK) { *(LAS u32x4v*)(sQ + i * 136 + j0) = pack8(y); }
            else {
                const float wgi = __expf(sA[i] - mx);
#pragma unroll
                for (int e = 0; e < 8; ++e) y[e] *= 0.08838834764831845f;
                *(LAS u32x4v*)(sK + i * 136 + j0) = pack8(y);
#pragma unroll
                for (int e = 0; e < 8; ++e) sKt[(j0 + e) * 72 + i] = f2bf(y[e] * wgi);
            }
        }
#pragma unroll
        for (int it = 0; it < 2; ++it) {
            const int idx = tid + 512 * it, i = idx >> 4, g = idx & 15;
            const int ii = 64 * c + i, tk = d == 0 ? tok0 + ii : tok0 + T - 1 - ii;
            const u32x4v w = *(const u32x4v*)(proj + (size_t)tk * NP + B_V + h * 128 + 8 * g);
            LAS bf16_t* dst = sVt + (8 * g) * 72 + i;
            dst[0] = (bf16_t)(w.x & 0xffff); dst[72] = (bf16_t)(w.x >> 16); dst[144] = (bf16_t)(w.y & 0xffff); dst[216] = (bf16_t)(w.y >> 16);
            dst[288] = (bf16_t)(w.z & 0xffff); dst[360] = (bf16_t)(w.z >> 16); dst[432] = (bf16_t)(w.w & 0xffff); dst[504] = (bf16_t)(w.w >> 16);
        }
        __syncthreads();
        const int tm = wave >> 1;
        {
            const int tn0 = (wave & 1) * 2;
#pragma unroll
            for (int tt = 0; tt < 2; ++tt) {
                f32x4 acc = {0.f, 0.f, 0.f, 0.f};
#pragma unroll
                for (int ks = 0; ks < 4; ++ks) acc = MFMA16(frag(sQ, 16 * tm, 136, 32 * ks, lane), frag(sK, 16 * (tn0 + tt), 136, 32 * ks, lane), acc);
                const int scol = 16 * (tn0 + tt) + l15; const float as = sA[scol];
#pragma unroll
                for (int j = 0; j < 4; ++j) { const int t = 16 * tm + quad * 4 + j;
                    float pv = scol <= t ? __expf(as - fmaxf(m, sPm[t])) * acc[j] : 0.f;
                    sP[t * 72 + scol] = f2bf(pv);
                    pv = red16_sum(pv);
                    if (l15 == 0) sPs[t * 4 + tn0 + tt] = pv; }
            }
        }
        const int tnb = (wave & 1) * 4;
        f32x4 accq[4];
#pragma unroll
        for (int tt = 0; tt < 4; ++tt) { accq[tt] = (f32x4){0.f, 0.f, 0.f, 0.f};
#pragma unroll
            for (int ks = 0; ks < 4; ++ks) accq[tt] = MFMA16(frag(sQ, 16 * tm, 136, 32 * ks, lane), frag(sC, 16 * (tnb + tt), 136, 32 * ks, lane), accq[tt]); }
        { const int t = tid >> 3, part = tid & 7; float sacc = 0.f;
#pragma unroll
            for (int e = 0; e < 16; ++e) sacc += sN[16 * part + e] * bf2f(sQ[t * 136 + 16 * part + e]);
            sacc += __shfl_xor(sacc, 1); sacc += __shfl_xor(sacc, 2); sacc += __shfl_xor(sacc, 4);
            if (part == 0) sNq[t] = sacc; }
        __syncthreads();
        {
            f32x4 accp[4];
#pragma unroll
            for (int tt = 0; tt < 4; ++tt) { accp[tt] = (f32x4){0.f, 0.f, 0.f, 0.f};
#pragma unroll
                for (int ks = 0; ks < 2; ++ks) accp[tt] = MFMA16(frag(sP, 16 * tm, 72, 32 * ks, lane), frag(sVt, 16 * (tnb + tt), 72, 32 * ks, lane), accp[tt]); }
#pragma unroll
            for (int j = 0; j < 4; ++j) { const int t = 16 * tm + quad * 4 + j;
                const float mtm = fmaxf(m, sPm[t]), wi = __expf(m - mtm);
                const float den = wi * sNq[t] + ((sPs[t * 4] + sPs[t * 4 + 1]) + (sPs[t * 4 + 2] + sPs[t * 4 + 3]));
                const float mt = sB[t] + mtm; const float inv = 1.0f / fmaxf(fabsf(den), __expf(-mt));
                const int ii = 64 * c + t, tk = d == 0 ? tok0 + ii : tok0 + T - 1 - ii;
                float* dst = hd + (size_t)tk * 512 + h * 128 + 16 * tnb + l15;
#pragma unroll
                for (int tt = 0; tt < 4; ++tt) dst[16 * tt] = (wi * accq[tt][j] + accp[tt][j]) * inv; }
        }
        const float sc = __expf(m - mx);
        if (tid < 128) { float ns = 0.f;
#pragma unroll 8
            for (int e = 0; e < 64; ++e) ns += bf2f(sKt[tid * 72 + e]);
            sN[tid] = sc * sN[tid] + ns; }
#pragma unroll
        for (int tn = 0; tn < 8; ++tn) { f32x4 dc = {0.f, 0.f, 0.f, 0.f};
#pragma unroll
            for (int ks = 0; ks < 2; ++ks) dc = MFMA16(frag(sVt, 16 * wave, 72, 32 * ks, lane), frag(sKt, 16 * tn, 72, 32 * ks, lane), dc);
            cacc[tn] = sc * cacc[tn] + dc;
#pragma unroll
            for (int j = 0; j < 4; ++j) sC[(16 * wave + quad * 4 + j) * 136 + 16 * tn + l15] = f2bf(cacc[tn][j]); }
        m = bL + mx;
    }
    __syncthreads();
    if (s < 32) {
        const size_t sb = (((size_t)(s * 2 + l) * 2 + d) * 4 + h);
        float* Co = p.out + O_MC + sb * 128 * 128;
#pragma unroll
        for (int tn = 0; tn < 8; ++tn)
#pragma unroll
            for (int j = 0; j < 4; ++j) Co[(16 * wave + quad * 4 + j) * 128 + 16 * tn + l15] = cacc[tn][j];
        if (tid < 128) p.out[O_MN + sb * 128 + tid] = sN[tid];
        if (tid == 0) p.out[O_MM + sb] = m;
    }
}

__device__ __forceinline__ void attn_task(const Params& p, int l, int task, LAS unsigned char* lds) {
    const int tid = opaque_tid(), lane = tid & 63, wave = tid >> 6, quad = lane >> 4, l15 = lane & 15;
    const bool samp = task < 128;
    int b, h, qb;
    if (samp) { b = task >> 6; h = (task >> 3) & 7; qb = task & 7; } else { const int t2 = task - 128; b = t2 >> 4; h = (t2 >> 1) & 7; qb = t2 & 1; }
    const int tok0 = samp ? NPT + b * 1024 : b * 256, nkt = samp ? 24 : 4, nct = samp ? 8 : 0;
    LAS bf16_t* sK = (LAS bf16_t*)lds;
    LAS bf16_t* sVt = sK + 64 * 136;
    LAS bf16_t* sPw = sVt + 128 * 72 + wave * (16 * 72);
    const bf16_t* proj = (const bf16_t*)(p.ws + WS_PROJ);
    const float* ck = p.in[I_CK] + (((size_t)(b * 2 + l) * 8 + h) * 512) * 128;
    const float* cv = p.in[I_CV] + (((size_t)(b * 2 + l) * 8 + h) * 512) * 128;
    const float lam = ((const float*)(p.ws + WS_LAM))[l];
    const float lam_init = 0.8f - 0.6f * expf(-0.3f * (float)l);
    const int q0 = 128 * qb + 16 * wave;
    bf16x8 aq1[2], aq2[2];
    { const bf16_t* qp = proj + (size_t)(tok0 + q0 + l15) * NP + C_Q + h * 128 + quad * 8;
        aq1[0] = *(const bf16x8*)qp; aq1[1] = *(const bf16x8*)(qp + 32); aq2[0] = *(const bf16x8*)(qp + 64); aq2[1] = *(const bf16x8*)(qp + 96); }
    float m1[4], l1[4], m2[4], l2[4];
#pragma unroll
    for (int j = 0; j < 4; ++j) { m1[j] = -INFINITY; m2[j] = -INFINITY; l1[j] = 0.f; l2[j] = 0.f; }
    f32x4 oacc[8];
#pragma unroll
    for (int tn = 0; tn < 8; ++tn) oacc[tn] = (f32x4){0.f, 0.f, 0.f, 0.f};
    float il1[4], il2[4];
    for (int pass = 0; pass < 2; ++pass) {
        for (int kt = 0; kt < nkt; ++kt) {
            __syncthreads();
#pragma unroll
            for (int it = 0; it < 2; ++it) {
                const int idx = tid + 512 * it, i = idx >> 4, g = idx & 15;
                if (kt < nct) {
                    float x[8]; ld8f(ck + (size_t)(64 * kt + i) * 128 + 8 * g, x);
                    *(LAS u32x4v*)(sK + i * 136 + 8 * g) = pack8(x);
                    if (pass == 1) { ld8f(cv + (size_t)(64 * kt + i) * 128 + 8 * g, x);
#pragma unroll
                        for (int e = 0; e < 8; ++e) sVt[(8 * g + e) * 72 + i] = f2bf(x[e]); }
                } else {
                    const bf16_t* src = proj + (size_t)(tok0 + 64 * (kt - nct) + i) * NP + h * 128 + 8 * g;
                    *(LAS u32x4v*)(sK + i * 136 + 8 * g) = *(const u32x4v*)(src + C_K);
                    if (pass == 1) { const u32x4v w = *(const u32x4v*)(src + C_V); LAS bf16_t* dst = sVt + (8 * g) * 72 + i;
                        dst[0] = (bf16_t)(w.x & 0xffff); dst[72] = (bf16_t)(w.x >> 16); dst[144] = (bf16_t)(w.y & 0xffff); dst[216] = (bf16_t)(w.y >> 16);
                        dst[288] = (bf16_t)(w.z & 0xffff); dst[360] = (bf16_t)(w.z >> 16); dst[432] = (bf16_t)(w.w & 0xffff); dst[504] = (bf16_t)(w.w >> 16); }
                }
            }
            __syncthreads();
            f32x4 s1[4], s2[4];
#pragma unroll
            for (int tn = 0; tn < 4; ++tn) { s1[tn] = (f32x4){0.f, 0.f, 0.f, 0.f}; s2[tn] = s1[tn];
#pragma unroll
                for (int ks = 0; ks < 2; ++ks) { s1[tn] = MFMA16(aq1[ks], frag(sK, 16 * tn, 136, 32 * ks, lane), s1[tn]); s2[tn] = MFMA16(aq2[ks], frag(sK, 16 * tn, 136, 64 + 32 * ks, lane), s2[tn]); }
                s1[tn] *= 0.125f; s2[tn] *= 0.125f; }
            if (pass == 0) {
#pragma unroll
                for (int j = 0; j < 4; ++j) {
                    float t1 = fmaxf(fmaxf(s1[0][j], s1[1][j]), fmaxf(s1[2][j], s1[3][j])), t2 = fmaxf(fmaxf(s2[0][j], s2[1][j]), fmaxf(s2[2][j], s2[3][j]));
                    t1 = red16_max(t1); t2 = red16_max(t2);
                    const float n1 = fmaxf(m1[j], t1), n2 = fmaxf(m2[j], t2);
                    float e1 = (__expf(s1[0][j] - n1) + __expf(s1[1][j] - n1)) + (__expf(s1[2][j] - n1) + __expf(s1[3][j] - n1));
                    float e2 = (__expf(s2[0][j] - n2) + __expf(s2[1][j] - n2)) + (__expf(s2[2][j] - n2) + __expf(s2[3][j] - n2));
                    e1 = red16_sum(e1); e2 = red16_sum(e2);
                    l1[j] = l1[j] * __expf(m1[j] - n1) + e1; l2[j] = l2[j] * __expf(m2[j] - n2) + e2; m1[j] = n1; m2[j] = n2; }
            } else {
#pragma unroll
                for (int tn = 0; tn < 4; ++tn)
#pragma unroll
                    for (int j = 0; j < 4; ++j) sPw[(quad * 4 + j) * 72 + 16 * tn + l15] = f2bf(__expf(s1[tn][j] - m1[j]) * il1[j] - __expf(s2[tn][j] - m2[j]) * il2[j]);
                LDS_FENCE();
                const bf16x8 pa0 = frag(sPw, 0, 72, 0, lane), pa1 = frag(sPw, 0, 72, 32, lane);
#pragma unroll
                for (int tn = 0; tn < 8; ++tn) { oacc[tn] = MFMA16(pa0, frag(sVt, 16 * tn, 72, 0, lane), oacc[tn]); oacc[tn] = MFMA16(pa1, frag(sVt, 16 * tn, 72, 32, lane), oacc[tn]); }
            }
        }
        if (pass == 0) {
#pragma unroll
            for (int j = 0; j < 4; ++j) { il1[j] = 1.0f / l1[j]; il2[j] = lam / l2[j]; }
        }
    }
    bf16_t* mixed = (bf16_t*)(p.ws + WS_UM);
    const float* sg = p.in[I_SUBG] + l * 128;
#pragma unroll
    for (int j = 0; j < 4; ++j) {
        float ss = 0.f;
#pragma unroll
        for (int tn = 0; tn < 8; ++tn) ss += oacc[tn][j] * oacc[tn][j];
        ss = red16_sum(ss);
        const float r = rsqrtf(ss * (1.0f / 128.0f) + 1e-5f) * (1.0f - lam_init);
        const int tq = tok0 + q0 + quad * 4 + j;
#pragma unroll
        for (int tn = 0; tn < 8; ++tn) { const int dv = 16 * tn + l15;
            const float gt = bf2f(proj[(size_t)tq * NP + C_G + h * 128 + dv]);
            mixed[(size_t)tq * DM + 1024 + h * 128 + dv] = f2bf(oacc[tn][j] * r * sg[dv] * siluf_(gt)); }
    }
}

__device__ __forceinline__ void rwkv_prep_task(const Params& p, int l, int task, LAS unsigned char* lds) {
    const int tid = opaque_tid(), lane = tid & 63, wave = tid >> 6, quad = lane >> 4, l15 = lane & 15;
    const int tile = task >> 3, h = task & 7, tb = 64 * tile;
    const int T = tb < NPT ? 256 : 1024, seq0 = tb < NPT ? (tb & ~255) : NPT + ((tb - NPT) & ~1023);
    LAS bf16_t* sTW = (LAS bf16_t*)lds;
    LAS bf16_t* sAD = sTW + 2 * 64 * 72;
    LAS bf16_t* sWup = sAD + 2 * 64 * 72;
    LAS bf16_t* sAup = sWup + 2 * 64 * 72;
    LAS float* sR = (LAS float*)(sAup + 2 * 64 * 72);
    LAS float* sKf = sR + 4096; LAS float* sVf = sKf + 4096; LAS float* sNrm = sVf + 4096; LAS float* sRK = sNrm + 64;
    const bf16_t* proj = (const bf16_t*)(p.ws + WS_PROJ);
    __syncthreads();
#pragma unroll
    for (int it = 0; it < 4; ++it) {
        const int idx = tid + 512 * it, arr = idx >> 9, i = (idx >> 3) & 63, g = idx & 7;
        const u32x4v w = *(const u32x4v*)(proj + (size_t)(tb + i) * NP + A_WD + 64 * arr + 8 * g);
        if (arr < 2) { float x[8]; unpack8(w, x);
#pragma unroll
            for (int e = 0; e < 8; ++e) x[e] = tanhf(x[e]);
            *(LAS u32x4v*)(sTW + (arr * 64 + i) * 72 + 8 * g) = pack8(x); }
        else *(LAS u32x4v*)(sAD + ((arr - 2) * 64 + i) * 72 + 8 * g) = w;
    }
#pragma unroll 4
    for (int it = 0; it < 16; ++it) {
        const int idx = tid + 512 * it, dd = idx >> 12, j = (idx >> 6) & 63, c = idx & 63;
        const size_t gi = ((size_t)(l * 2 + dd) * 64 + j) * 512 + h * 64 + c;
        sWup[(dd * 64 + c) * 72 + j] = f2bf(p.in[I_WUP][gi]);
        sAup[(dd * 64 + c) * 72 + j] = f2bf(p.in[I_AUP][gi]);
    }
#pragma unroll
    for (int it = 0; it < 3; ++it) {
        const int idx = tid + 512 * it, which = idx >> 9, i = (idx >> 3) & 63, g = idx & 7, ch = which * 512 + h * 64 + 8 * g;
        const int tk = tb + i, pos = tk - seq0;
        const bf16_t* src = proj + (size_t)tk * NP + ch;
        float x0[8], x1[8], x2[8], w0[8], w1[8], w2[8], bb[8];
        unpack8(*(const u32x4v*)src, x1);
        if (pos > 0) unpack8(*(const u32x4v*)(src - NP), x0); else { for (int e = 0; e < 8; ++e) x0[e] = 0.f; }
        if (pos < T - 1) unpack8(*(const u32x4v*)(src + NP), x2); else { for (int e = 0; e < 8; ++e) x2[e] = 0.f; }
        const float* cw = p.in[I_CAW] + (size_t)l * 3 * 1536 + ch;
        ld8f(cw, w0); ld8f(cw + 1536, w1); ld8f(cw + 3072, w2); ld8f(p.in[I_CAB] + l * 1536 + ch, bb);
        LAS float* dst = (which == 0 ? sR : (which == 1 ? sKf : sVf)) + i * 64 + 8 * g;
#pragma unroll
        for (int e = 0; e < 8; ++e) dst[e] = x0[e] * w0[e] + x1[e] * w1[e] + x2[e] * w2[e] + bb[e];
    }
    __syncthreads();
    { const int t = tid >> 3, part = tid & 7; float ss = 0.f;
#pragma unroll
        for (int e = 0; e < 8; ++e) { const float v = sKf[t * 64 + 8 * part + e] * p.in[I_KK][l * 512 + h * 64 + 8 * part + e]; ss += v * v; }
        ss += __shfl_xor(ss, 1); ss += __shfl_xor(ss, 2); ss += __shfl_xor(ss, 4);
        if (part == 0) sNrm[t] = rsqrtf(ss + 1e-12f); }
    const int dd = wave >> 2, tm = wave & 3;
    f32x4 aw[4], aa[4];
#pragma unroll
    for (int tn = 0; tn < 4; ++tn) { aw[tn] = (f32x4){0.f, 0.f, 0.f, 0.f}; aa[tn] = aw[tn];
#pragma unroll
        for (int ks = 0; ks < 2; ++ks) { aw[tn] = MFMA16(frag(sTW + dd * 64 * 72, 16 * tm, 72, 32 * ks, lane), frag(sWup + dd * 64 * 72, 16 * tn, 72, 32 * ks, lane), aw[tn]);
            aa[tn] = MFMA16(frag(sAD + dd * 64 * 72, 16 * tm, 72, 32 * ks, lane), frag(sAup + dd * 64 * 72, 16 * tn, 72, 32 * ks, lane), aa[tn]); } }
    __syncthreads();
    {
        float* scw = (float*)(p.ws + WS_SCW) + (size_t)dd * NTOK * 512;
        bf16_t* sckt = (bf16_t*)(p.ws + WS_SCKT) + (size_t)dd * NTOK * 512;
        bf16_t* scka = (bf16_t*)(p.ws + WS_SCKA) + (size_t)dd * NTOK * 512;
        float rk[4] = {0.f, 0.f, 0.f, 0.f};
#pragma unroll
        for (int tn = 0; tn < 4; ++tn) { const int c = 16 * tn + l15, ch = h * 64 + c;
            const float w0v = p.in[I_W0][(l * 2 + dd) * 512 + ch], a0v = p.in[I_A0][(l * 2 + dd) * 512 + ch], kav = p.in[I_KA][l * 512 + ch], kkv = p.in[I_KK][l * 512 + ch], rkv = p.in[I_RK][l * 512 + ch];
#pragma unroll
            for (int j = 0; j < 4; ++j) { const int t = 16 * tm + quad * 4 + j; const size_t o = (size_t)(tb + t) * 512 + ch;
                const float z = w0v + aw[tn][j]; const float dec = __expf(-0.6065306597126334f * sigmoidf_(z));
                const float av = sigmoidf_(a0v + aa[tn][j]); const float kv = sKf[t * 64 + c];
                const float ktv = kv * (1.0f + (av - 1.0f) * kav); const float kk = kv * kkv * sNrm[t];
                scw[o] = dec; sckt[o] = f2bf(ktv); scka[o] = f2bf(kk * av);
                rk[j] += sR[t * 64 + c] * ktv * rkv; } }
#pragma unroll
        for (int j = 0; j < 4; ++j) { const float s = red16_sum(rk[j]); if (l15 == 0) sRK[dd * 64 + 16 * tm + quad * 4 + j] = s; }
    }
    __syncthreads();
    { const int i = tid >> 3, g = tid & 7; const size_t o = (size_t)(tb + i) * 512 + h * 64 + 8 * g;
        float r[8], k[8], v[8], bn[8]; const float nr = sNrm[i], rks = sRK[i] + sRK[64 + i];
#pragma unroll
        for (int e = 0; e < 8; ++e) { r[e] = sR[i * 64 + 8 * g + e]; k[e] = sKf[i * 64 + 8 * g + e] * p.in[I_KK][l * 512 + h * 64 + 8 * g + e] * nr; v[e] = sVf[i * 64 + 8 * g + e]; bn[e] = rks * v[e]; }
        *(u32x4v*)((bf16_t*)(p.ws + WS_SCR) + o) = pack8(r); *(u32x4v*)((bf16_t*)(p.ws + WS_SCKK) + o) = pack8(k);
        *(u32x4v*)((bf16_t*)(p.ws + WS_SCV) + o) = pack8(v); *(u32x4v*)((bf16_t*)(p.ws + WS_SCBON) + o) = pack8(bn); }
}

__device__ __forceinline__ void m1_phase(const Params& p, int l, LAS unsigned char* lds) {
    unsigned* ctr = (unsigned*)(p.ws + WS_CTL) + 64 * (1 + 4 * l);
    LAS int* slot = (LAS int*)(lds + LDS_SLOT);
#ifndef NO_MLSTM
    for (;;) { const int t = next_task(ctr, slot); if (t >= 272) break; const int u = t < 16 ? t + 256 : t - 16; mlstm_task(p, l, u >> 3, (u >> 2) & 1, u & 3, lds); }
#endif
#ifndef NO_ATTN
    for (;;) { const int t = next_task(ctr + 64, slot); if (t >= 640) break; attn_task(p, l, t, lds); }
#endif
#ifndef NO_PREP
    for (;;) { const int t = next_task(ctr + 128, slot); if (t >= 1280) break; rwkv_prep_task(p, l, t, lds); }
#endif
}

template <int KPL> struct ScanRaw { uint2 r[KPL / 4], kk[KPL / 4], kt[KPL / 4], ka[KPL / 4]; float4 w[KPL / 4]; bf16_t v; };
template <int KPL> __device__ __forceinline__ void scan_load(ScanRaw<KPL>& x, const bf16_t* pr, const bf16_t* pkk, const bf16_t* pkt, const bf16_t* pka, const float* pw, const bf16_t* pv, size_t off, size_t offv) {
#pragma unroll
    for (int q = 0; q < KPL / 4; ++q) { x.r[q] = *(const uint2*)(pr + off + 4 * q); x.kk[q] = *(const uint2*)(pkk + off + 4 * q); x.kt[q] = *(const uint2*)(pkt + off + 4 * q); x.ka[q] = *(const uint2*)(pka + off + 4 * q); x.w[q] = *(const float4*)(pw + off + 4 * q); }
    x.v = pv[offv];
}
template <int KPL> __device__ __forceinline__ float scan_step(float (&S)[KPL], const ScanRaw<KPL>& x) {
    float kk[KPL], sk = 0.f;
#pragma unroll
    for (int q = 0; q < KPL / 4; ++q) { kk[4 * q] = bflo(x.kk[q].x); kk[4 * q + 1] = bfhi(x.kk[q].x); kk[4 * q + 2] = bflo(x.kk[q].y); kk[4 * q + 3] = bfhi(x.kk[q].y); }
#pragma unroll
    for (int e = 0; e < KPL; ++e) sk += S[e] * kk[e];
    sk = KPL == 4 ? red16_sum(sk) : red4_sum(sk);
    const float vv = bf2f(x.v), nsk = -sk;
    float y = 0.f;
#pragma unroll
    for (int q = 0; q < KPL / 4; ++q) {
        const float w[4] = {x.w[q].x, x.w[q].y, x.w[q].z, x.w[q].w};
        const float kt[4] = {bflo(x.kt[q].x), bfhi(x.kt[q].x), bflo(x.kt[q].y), bfhi(x.kt[q].y)};
        const float ka[4] = {bflo(x.ka[q].x), bfhi(x.ka[q].x), bflo(x.ka[q].y), bfhi(x.ka[q].y)};
        const float r[4] = {bflo(x.r[q].x), bfhi(x.r[q].x), bflo(x.r[q].y), bfhi(x.r[q].y)};
#pragma unroll
        for (int e = 0; e < 4; ++e) { float s = S[4 * q + e] * w[e]; s = fmaf(nsk, ka[e], s); s = fmaf(vv, kt[e], s); S[4 * q + e] = s; y = fmaf(s, r[e], y); }
    }
    return KPL == 4 ? red16_sum(y) : red4_sum(y);
}
template <int KPL, int GS> __device__ __forceinline__ void rwkv_scan_task(const Params& p, int l, int s, int d, int h, int rg, int lane) {
    constexpr int LPR = 64 / KPL;
    const int T = s < 32 ? 256 : 1024, tok0 = s < 32 ? s * 256 : NPT + (s - 32) * 1024;
    const int row = rg * KPL + lane / LPR, kq = lane % LPR, k0 = kq * KPL;
    const bf16_t* pr = (const bf16_t*)(p.ws + WS_SCR); const bf16_t* pkk = (const bf16_t*)(p.ws + WS_SCKK); const bf16_t* pv = (const bf16_t*)(p.ws + WS_SCV);
    const bf16_t* pkt = (const bf16_t*)(p.ws + WS_SCKT) + (size_t)d * NTOK * 512; const bf16_t* pka = (const bf16_t*)(p.ws + WS_SCKA) + (size_t)d * NTOK * 512;
    const float* pw = (const float*)(p.ws + WS_SCW) + (size_t)d * NTOK * 512;
    float* yd = (float*)(p.ws + WS_YD) + (size_t)d * NTOK * 512;
    float S[KPL];
    if (s >= 32) { const float* s0 = p.in[I_SRW] + ((((size_t)((s - 32) * 2 + l) * 2 + d) * 8 + h) * 64 + row) * 64 + k0;
#pragma unroll
        for (int e = 0; e < KPL; ++e) S[e] = s0[e]; }
    else {
#pragma unroll
        for (int e = 0; e < KPL; ++e) S[e] = 0.f; }
    const int step = d == 0 ? 1 : -1; const int tstart = d == 0 ? tok0 : tok0 + T - 1;
    const size_t hk = (size_t)h * 64 + k0, hv = (size_t)h * 64 + row;
    ScanRaw<KPL> cur[GS], nxt[GS];
#pragma unroll
    for (int g = 0; g < GS; ++g) { const size_t tk = (size_t)(tstart + step * g); scan_load<KPL>(cur[g], pr, pkk, pkt, pka, pw, pv, tk * 512 + hk, tk * 512 + hv); }
    for (int t = 0; t < T; t += GS) {
        if (t + GS < T) {
#pragma unroll
            for (int g = 0; g < GS; ++g) { const size_t tk = (size_t)(tstart + step * (t + GS + g)); scan_load<KPL>(nxt[g], pr, pkk, pkt, pka, pw, pv, tk * 512 + hk, tk * 512 + hv); }
        }
#pragma unroll
        for (int g = 0; g < GS; ++g) { const float y = scan_step<KPL>(S, cur[g]); if (kq == 0) yd[(size_t)(tstart + step * (t + g)) * 512 + hv] = y; }
#pragma unroll
        for (int g = 0; g < GS; ++g) cur[g] = nxt[g];
    }
    if (s < 32) { float* so = p.out + O_RW + ((((size_t)(s * 2 + l) * 2 + d) * 8 + h) * 64 + row) * 64 + k0;
#pragma unroll
        for (int e = 0; e < KPL; ++e) so[e] = S[e]; }
}
__device__ __forceinline__ void m2_phase(const Params& p, int l) {
    const int tid_ = opaque_tid(); const int lane = tid_ & 63, wave = tid_ >> 6;
    unsigned* ctr = (unsigned*)(p.ws + WS_CTL) + 64 * (4 + 4 * l);
    if (wave < 2) { for (int t = blockIdx.x * 2 + wave; t < 512; t += gridDim.x * 2) rwkv_scan_task<4, 4>(p, l, 32 + (t >> 8), (t >> 7) & 1, (t >> 4) & 7, t & 15, lane); }
    for (;;) {
        int t = 0; if (lane == 0) t = (int)atomicAdd(ctr, 1u);
        t = __builtin_amdgcn_readfirstlane(t);
        if (t >= 2048) break;
        rwkv_scan_task<16, 1>(p, l, t >> 6, (t >> 5) & 1, (t >> 2) & 7, t & 3, lane);
    }
}

__device__ __forceinline__ void m3_phase(const Params& p, int l) {
    const int tid_ = opaque_tid(); const int lane = tid_ & 63, gw = blockIdx.x * 8 + (tid_ >> 6), NGW = gridDim.x * 8;
    const bf16_t* proj = (const bf16_t*)(p.ws + WS_PROJ);
    bf16_t* mixed = (bf16_t*)(p.ws + WS_UM);
    const int c = lane * 8;
    for (int tok = gw; tok < NTOK; tok += NGW) {
        const size_t o = (size_t)tok * 512 + c;
        {
            float y0[8], y1[8], g[8], bb[8], bn[8], gt[8], out[8];
            ld8f((const float*)(p.ws + WS_YD) + o, y0); ld8f((const float*)(p.ws + WS_YD) + (size_t)NTOK * 512 + o, y1);
            float s = 0.f;
#pragma unroll
            for (int e = 0; e < 8; ++e) { y0[e] += y1[e]; s += y0[e]; }
            s += __shfl_xor(s, 1); s += __shfl_xor(s, 2); s += __shfl_xor(s, 4);
            const float mu = s * (1.0f / 64.0f); float q = 0.f;
#pragma unroll
            for (int e = 0; e < 8; ++e) { y0[e] -= mu; q += y0[e] * y0[e]; }
            q += __shfl_xor(q, 1); q += __shfl_xor(q, 2); q += __shfl_xor(q, 4);
            const float rs = rsqrtf(q * (1.0f / 64.0f) + 64e-5f);
            ld8f(p.in[I_RGG] + l * 512 + c, g); ld8f(p.in[I_RGB] + l * 512 + c, bb);
            unpack8(*(const u32x4v*)((const bf16_t*)(p.ws + WS_SCBON) + o), bn);
            unpack8(*(const u32x4v*)(proj + (size_t)tok * NP + A_GATE + c), gt);
#pragma unroll
            for (int e = 0; e < 8; ++e) out[e] = (y0[e] * rs * g[e] + bb[e] + bn[e]) * siluf_(gt[e]);
            *(u32x4v*)(mixed + (size_t)tok * DM + c) = pack8(out);
        }
        {
            float h0[8], h1[8], g[8], bb[8], og[8], gt[8], out[8];
            ld8f((const float*)(p.ws + WS_HD) + o, h0); ld8f((const float*)(p.ws + WS_HD) + (size_t)NTOK * 512 + o, h1);
            unpack8(*(const u32x4v*)(proj + (size_t)tok * NP + B_O + c), og);
            float s = 0.f;
#pragma unroll
            for (int e = 0; e < 8; ++e) { h0[e] = (h0[e] + h1[e]) * sigmoidf_(og[e]); s += h0[e]; }
            s += __shfl_xor(s, 1); s += __shfl_xor(s, 2); s += __shfl_xor(s, 4); s += __shfl_xor(s, 8);
            const float mu = s * (1.0f / 128.0f); float q = 0.f;
#pragma unroll
            for (int e = 0; e < 8; ++e) { h0[e] -= mu; q += h0[e] * h0[e]; }
            q += __shfl_xor(q, 1); q += __shfl_xor(q, 2); q += __shfl_xor(q, 4); q += __shfl_xor(q, 8);
            const float rs = rsqrtf(q * (1.0f / 128.0f) + 1e-5f);
            ld8f(p.in[I_MGG] + l * 512 + c, g); ld8f(p.in[I_MGB] + l * 512 + c, bb);
            unpack8(*(const u32x4v*)(proj + (size_t)tok * NP + B_GATE + c), gt);
#pragma unroll
            for (int e = 0; e < 8; ++e) out[e] = (h0[e] * rs * g[e] + bb[e]) * siluf_(gt[e]);
            *(u32x4v*)(mixed + (size_t)tok * DM + 512 + c) = pack8(out);
        }
    }
}

__device__ __forceinline__ void ln_phase(const Params& p, int l) {
    const int tid_ = opaque_tid(); const int lane = tid_ & 63, gw = blockIdx.x * 8 + (tid_ >> 6), NGW = gridDim.x * 8;
    for (int tok = gw; tok < NTOK; tok += NGW) {
        float* zr = p.out + O_Y + (size_t)tok * DM;
        float v[4][8]; float s = 0.f;
#pragma unroll
        for (int j = 0; j < 4; ++j) { ld8f(zr + j * 512 + lane * 8, v[j]);
#pragma unroll
            for (int e = 0; e < 8; ++e) s += v[j][e]; }
#pragma unroll
        for (int o = 1; o < 64; o <<= 1) s += __shfl_xor(s, o);
        const float mu = s * (1.0f / 2048.0f); float q = 0.f;
#pragma unroll
        for (int j = 0; j < 4; ++j)
#pragma unroll
            for (int e = 0; e < 8; ++e) { v[j][e] -= mu; q += v[j][e] * v[j][e]; }
#pragma unroll
        for (int o = 1; o < 64; o <<= 1) q += __shfl_xor(q, o);
        const float rs = rsqrtf(q * (1.0f / 2048.0f) + 1e-5f);
        const float* mod = (const float*)(p.ws + WS_MOD) + (size_t)(3 + mod_row(tok)) * 6144;
        bf16_t* ur = (bf16_t*)(p.ws + WS_UM) + (size_t)tok * DM;
#pragma unroll
        for (int j = 0; j < 4; ++j) { const int c = j * 512 + lane * 8; float g[8], bb[8], y[8];
            ld8f(p.in[I_LNG] + l * DM + c, g); ld8f(p.in[I_LNB] + l * DM + c, bb);
#pragma unroll
            for (int e = 0; e < 8; ++e) y[e] = v[j][e] * rs * g[e] + bb[e];
            *(float4*)(zr + c) = make_float4(y[0], y[1], y[2], y[3]); *(float4*)(zr + c + 4) = make_float4(y[4], y[5], y[6], y[7]);
            if (l == 0) { float sh[8], sc[8], o[8]; ld8f(mod + c, sh); ld8f(mod + 2048 + c, sc);
#pragma unroll
                for (int e = 0; e < 8; ++e) o[e] = y[e] * (1.0f + sc[e]) + sh[e];
                *(u32x4v*)(ur + c) = pack8(o); } }
    }
}

#ifndef PH_ALL
#define PH_ALL 1
#endif
#ifndef PH_P0
#define PH_P0 PH_ALL
#endif
#ifndef PH_G1
#define PH_G1 PH_ALL
#endif
#ifndef PH_M1
#define PH_M1 PH_ALL
#endif
#ifndef PH_M2
#define PH_M2 PH_ALL
#endif
#ifndef PH_M3
#define PH_M3 PH_ALL
#endif
#ifndef PH_G2
#define PH_G2 PH_ALL
#endif
#ifndef PH_LN
#define PH_LN PH_ALL
#endif
__global__ void __launch_bounds__(NTHREADS) hybrid_fwd(Params p) {
    extern __shared__ __attribute__((aligned(16))) unsigned char smem[];
    LAS unsigned char* lds = (LAS unsigned char*)smem;
    cg::grid_group grid = cg::this_grid();
#if PH_P0
    p0_phase(p, lds);
#endif
    grid.sync();
#if PH_P0
    p0b_phase(p);
#endif
    grid.sync();
    for (int l = 0; l < 2; ++l) {
#if PH_G1
        {
            pg8::Gemm g; g.A = (const bf16_t*)(p.ws + WS_UM); g.Bt = (const bf16_t*)(p.ws + WS_WIN) + (size_t)l * NP * DM; g.M = NTOK; g.N = NP; g.K = DM;
            pg8::StaticOrder S; S.init(NTOK, NP, gridDim.x, blockIdx.x);
            EpiIn E; E.proj = (bf16_t*)(p.ws + WS_PROJ); E.gates = (float*)(p.ws + WS_GATES); E.newk = p.out + O_NK; E.newv = p.out + O_NV; E.rope = (const float*)(p.ws + WS_ROPE); E.layer = l;
            pg8::gemm_phase<EpiIn, pg8::StaticOrder, false>(lds, g, S, E, nullptr);
        }
#endif
        grid.sync();
#if PH_M1
        m1_phase(p, l, lds);
#endif
        grid.sync();
#if PH_M2
        m2_phase(p, l);
#endif
        grid.sync();
#if PH_M3
        m3_phase(p, l);
#endif
        grid.sync();
#if PH_G2
        {
            pg8::Gemm g; g.A = (const bf16_t*)(p.ws + WS_UM); g.Bt = (const bf16_t*)(p.ws + WS_WOUT) + (size_t)l * DM * DM; g.M = NTOK; g.N = DM; g.K = DM;
            pg8::StaticOrder S; S.init(NTOK, DM, gridDim.x, blockIdx.x);
            EpiOut E; E.xp = p.in[I_XP]; E.xs = p.in[I_XS]; E.mod = (const float*)(p.ws + WS_MOD) + (size_t)l * 3 * 6144; E.y = p.out + O_Y; E.layer = l;
            pg8::gemm_phase<EpiOut, pg8::StaticOrder, false>(lds, g, S, E, nullptr);
        }
#endif
        grid.sync();
#if PH_LN
        ln_phase(p, l);
#endif
        if (l == 0) grid.sync();
    }
}

extern "C" void kernel_launch(void* const* d_in, const int* in_sizes, int n_in, void* d_out, int out_size, void* d_ws, size_t ws_size, hipStream_t stream) {
    static int grid_blocks = 0;
    if (grid_blocks == 0) {
        if (n_in != 38 || ws_size < WS_END) { fprintf(stderr, "kernel_launch: unexpected n_in %d / ws_size %zu (need %zu)\n", n_in, ws_size, (size_t)WS_END); grid_blocks = -1; return; }
        int dev = 0, cus = 0, per_cu = 0;
        hipGetDevice(&dev);
        hipDeviceGetAttribute(&cus, hipDeviceAttributeMultiprocessorCount, dev);
        hipFuncSetAttribute((const void*)hybrid_fwd, hipFuncAttributeMaxDynamicSharedMemorySize, LDS_BYTES);
        hipOccupancyMaxActiveBlocksPerMultiprocessor(&per_cu, (const void*)hybrid_fwd, NTHREADS, LDS_BYTES);
        if (per_cu < 1) { fprintf(stderr, "kernel_launch: occupancy query gives %d blocks per CU\n", per_cu); per_cu = 1; }
        grid_blocks = cus * per_cu;
    }
    if (grid_blocks < 0) return;
    Params p{};
    for (int i = 0; i < 38; ++i) p.in[i] = (const float*)d_in[i];
    p.out = (float*)d_out; p.ws = (unsigned char*)d_ws;
    hipMemsetAsync(d_ws, 0, 4096, stream);
    void* args[] = {&p};
    hipError_t e = hipLaunchCooperativeKernel((const void*)hybrid_fwd, dim3(grid_blocks), dim3(NTHREADS), args, LDS_BYTES, stream);
    if (e != hipSuccess) fprintf(stderr, "cooperative launch failed: %s (grid %d)\n", hipGetErrorString(e), grid_blocks);
}
```

```cpp
#include <hip/hip_runtime.h>
#include <hip/hip_cooperative_groups.h>
#include <cstdio>
#include <cstdint>
namespace cg = cooperative_groups;
namespace pg8 {
#define PG8_LAS __attribute__((address_space(3)))
typedef unsigned short bf16_t;
typedef short bf16x8 __attribute__((ext_vector_type(8)));
typedef float f32x4 __attribute__((ext_vector_type(4)));
typedef unsigned u32x4 __attribute__((ext_vector_type(4)));
constexpr int BM = 256, BK = 64, HALF = 128, HTB = HALF * BK * 2  , STAGE_BYTES = 8 * HTB, NXCD = 8, WGM = 8;

__host__ __device__ __forceinline__ int lds_byte(int r, int c) { const int st = (r >> 4) * 2 + (c >> 5), rr = r & 15, cc = c & 31, ob = rr * 64 + cc * 2; return st * 1024 + (ob ^ (((ob >> 9) & 1) << 5)); }
__host__ __device__ __forceinline__ void stage_rc(int b, int& R, int& C) { const int st = b / 1024, sb = b % 1024, swz = sb ^ (((sb >> 9) & 1) << 5); R = (st >> 1) * 16 + swz / 64; C = (st & 1) * 32 + (swz % 64) / 2; }
__host__ __device__ __forceinline__ int perm32(int rho) { const int n = rho >> 4, i = rho & 15; return 8 * (i >> 2) + 4 * n + (i & 3); }

struct Unit { int pm, pn; };
struct Gemm { const bf16_t* A; const bf16_t* Bt; int M, N, K; };

struct StaticOrder {
    int nM, nN, nwg, G, c;
    __host__ __device__ void init(int M, int N, int G_, int c_) { nM = M / BM; nN = N / BM; nwg = nM * nN; G = G_; c = c_; }
    __host__ __device__ bool next(int i, Unit& u) const {
        const long L = (long)i * G + c; if (L >= nwg) return false;
        int wgid = (int)L; { const int q = nwg / NXCD, r = nwg % NXCD, xcd = wgid % NXCD, off = wgid / NXCD; wgid = (xcd < r ? xcd * (q + 1) : r * (q + 1) + (xcd - r) * q) + off; }
        const int nig = WGM * nN, gid = wgid / nig, fm = gid * WGM, gsz = (nM - fm) < WGM ? (nM - fm) : WGM;
        u.pm = fm + ((wgid % nig) % gsz); u.pn = (wgid % nig) / gsz; return true;
    }
    __device__ __forceinline__ void a_ready(const Unit&) const {}
    __device__ __forceinline__ void done(const Unit&) const {}
};
__device__ __forceinline__ unsigned cvt_pk_bf16(float lo, float hi) { unsigned r; asm volatile("v_cvt_pk_bf16_f32 %0, %1, %2" : "=v"(r) : "v"(lo), "v"(hi)); return r; }
template <class Epi, class Sched, bool STAMP = false>
__device__ __forceinline__ void gemm_phase(PG8_LAS unsigned char* lds, const Gemm g, const Sched& S, const Epi& E, unsigned long long* stamps) {
    int tid = threadIdx.x; asm volatile("" : "+v"(tid)); const int wid = __builtin_amdgcn_readfirstlane(tid >> 6), lane = tid & 63, wr = wid >> 2, wc = wid & 3, fr = lane & 15, fq = lane >> 4;
    const int K = g.K, nt = K / BK;
    int ts_lo = 0, ts_hi = 0, nts = 0; const unsigned long long rt_entry = STAMP ? (unsigned long long)wall_clock64() : 0ull;
#define PG8_STAMP() do { if (STAMP && wid == 0 && nts < 64) { const unsigned long long _c = (unsigned long long)clock64(); \
        ts_lo = (lane == nts) ? (int)(unsigned)_c : ts_lo; ts_hi = (lane == nts) ? (int)(unsigned)(_c >> 32) : ts_hi; ++nts; } } while (0)
    PG8_STAMP();
    unsigned voffA[2], voffB[2];
#pragma unroll
    for (int i = 0; i < 2; ++i) { int R, C; stage_rc(tid * 16 + i * 8192, R, C); const int Rb = Epi::PERM ? ((R & ~31) + perm32(R & 31)) : R;
        voffA[i] = (unsigned)(R * K + C) * 2u; voffB[i] = (unsigned)(Rb * K + C) * 2u; }
    const size_t kstep = (size_t)(BK * 2);
    const size_t hstep = (size_t)HALF * K * 2;
    const size_t tstep = 2 * hstep;
    const unsigned ldsw = (unsigned)wid * 1024u;
    const int aoff = lds_byte(wr * 64 + fr, fq * 8), boff = lds_byte(wc * 32 + fr, fq * 8);
#define PG8_SA(b, h) (((b) * 2 + (h)) * HTB)
#define PG8_SB(b, h) ((4 + (b) * 2 + (h)) * HTB)
#define PG8_STAGE(bufoff, gbase, voff) do { _Pragma("unroll") for (int _i = 0; _i < 2; ++_i) \
        __builtin_amdgcn_global_load_lds((const unsigned*)((const char*)(gbase) + (voff)[_i]), (PG8_LAS unsigned*)(lds + (bufoff) + ldsw + _i * 8192), 16, 0, 0); } while (0)
#define PG8_LDA(dst, b, h) do { _Pragma("unroll") for (int m = 0; m < 4; ++m) _Pragma("unroll") for (int k = 0; k < 2; ++k) dst[m][k] = *(const PG8_LAS bf16x8*)(lds + PG8_SA(b, h) + aoff + m * 2048 + k * 1024); } while (0)
#define PG8_LDB(dst, b, h) do { _Pragma("unroll") for (int n = 0; n < 2; ++n) _Pragma("unroll") for (int k = 0; k < 2; ++k) dst[n][k] = *(const PG8_LAS bf16x8*)(lds + PG8_SB(b, h) + boff + n * 2048 + k * 1024); } while (0)
#define PG8_MMA(ai, bj, At, Bt) do { __builtin_amdgcn_s_setprio(1); _Pragma("unroll") for (int m = 0; m < 4; ++m) _Pragma("unroll") for (int n = 0; n < 2; ++n) _Pragma("unroll") for (int k = 0; k < 2; ++k) \
        acc[ai][bj][m][n] = __builtin_amdgcn_mfma_f32_16x16x32_bf16(Bt[n][k], At[m][k], acc[ai][bj][m][n], 0, 0, 0); __builtin_amdgcn_s_setprio(0); } while (0)
#define PG8_WAIT_V(n) asm volatile("s_waitcnt vmcnt(" #n ")" ::: "memory")
#define PG8_WAIT_L(n) asm volatile("s_waitcnt lgkmcnt(" #n ")" ::: "memory")
#define PG8_BAR __builtin_amdgcn_s_barrier()
#define PG8_SCHED __builtin_amdgcn_sched_barrier(0)
    Unit cur, nxt; int ui = 0;
    if (!S.next(0, cur)) return;
    f32x4 acc[2][2][4][2];
#pragma unroll
    for (int a = 0; a < 2; ++a)
#pragma unroll
        for (int b = 0; b < 2; ++b)
#pragma unroll
            for (int m = 0; m < 4; ++m)
#pragma unroll
                for (int n = 0; n < 2; ++n) acc[a][b][m][n] = (f32x4){0.f, 0.f, 0.f, 0.f};
    bf16x8 At[4][2], B0[2][2], B1[2][2];
    const char* cA = (const char*)g.A + (size_t)cur.pm * tstep; const char* cB = (const char*)g.Bt + (size_t)cur.pn * tstep;
    S.a_ready(cur);
    PG8_STAGE(PG8_SB(0, 0), cB, voffB); PG8_STAGE(PG8_SA(0, 0), cA, voffA); PG8_STAGE(PG8_SB(0, 1), cB + hstep, voffB); PG8_STAGE(PG8_SA(0, 1), cA + hstep, voffA);
    if (wr == 1) PG8_BAR;
    PG8_WAIT_V(4); PG8_BAR;
    PG8_STAGE(PG8_SB(1, 0), cB + kstep, voffB); PG8_STAGE(PG8_SA(1, 0), cA + kstep, voffA); PG8_STAGE(PG8_SB(1, 1), cB + hstep + kstep, voffB);
    PG8_WAIT_V(6); PG8_BAR;
    PG8_STAMP();
    for (;;) {
        const bool has_next = S.next(ui + 1, nxt);
        const char* nA = has_next ? (const char*)g.A + (size_t)nxt.pm * tstep : cA; const char* nB = has_next ? (const char*)g.Bt + (size_t)nxt.pn * tstep : cB;
        for (int t = 0; t < nt; t += 2) {
            const bool last = (t == nt - 2);
            const char* a1 = cA + (size_t)(t + 1) * kstep;
            const char* a2 = last ? nA : cA + (size_t)(t + 2) * kstep; const char* b2 = last ? nB : cB + (size_t)(t + 2) * kstep;
            const char* a3 = a2 + kstep; const char* b3 = b2 + kstep;
            if (last && has_next) S.a_ready(nxt);
            PG8_LDB(B0, 0, 0); PG8_SCHED; PG8_LDA(At, 0, 0); PG8_STAGE(PG8_SA(1, 1), a1 + hstep, voffA);
            PG8_WAIT_L(8); PG8_BAR; PG8_WAIT_L(0); PG8_MMA(0, 0, At, B0); PG8_BAR; PG8_SCHED;
            PG8_LDB(B1, 0, 1); PG8_STAGE(PG8_SB(0, 0), b2, voffB);
            PG8_BAR; PG8_WAIT_L(0); PG8_MMA(0, 1, At, B1); PG8_BAR;
            PG8_LDA(At, 0, 1); PG8_STAGE(PG8_SA(0, 0), a2, voffA);
            PG8_BAR; PG8_WAIT_L(0); PG8_MMA(1, 0, At, B0); PG8_BAR; PG8_SCHED;
            PG8_STAGE(PG8_SB(0, 1), b2 + hstep, voffB);
            PG8_WAIT_V(6); PG8_BAR; PG8_MMA(1, 1, At, B1); PG8_BAR;
            PG8_LDB(B0, 1, 0); PG8_SCHED; PG8_LDA(At, 1, 0); PG8_STAGE(PG8_SA(0, 1), a2 + hstep, voffA);
            PG8_WAIT_L(8); PG8_BAR; PG8_WAIT_L(0); PG8_MMA(0, 0, At, B0); PG8_BAR; PG8_SCHED;
            PG8_LDB(B1, 1, 1); PG8_STAGE(PG8_SB(1, 0), b3, voffB);
            PG8_BAR; PG8_WAIT_L(0); PG8_MMA(0, 1, At, B1); PG8_BAR;
            PG8_LDA(At, 1, 1); PG8_STAGE(PG8_SA(1, 0), a3, voffA);
            PG8_BAR; PG8_WAIT_L(0); PG8_MMA(1, 0, At, B0); PG8_BAR; PG8_SCHED;
            PG8_STAGE(PG8_SB(1, 1), b3 + hstep, voffB);
            PG8_WAIT_V(6); PG8_BAR; PG8_MMA(1, 1, At, B1); PG8_BAR;
        }
        PG8_STAMP();
        if constexpr (!Epi::AFTER_DRAIN) { E(acc, cur, wr, wc, fr, fq); S.done(cur); }
        PG8_STAMP();
        if (!has_next) break;
#pragma unroll
        for (int a = 0; a < 2; ++a)
#pragma unroll
            for (int b = 0; b < 2; ++b)
#pragma unroll
                for (int m = 0; m < 4; ++m)
#pragma unroll
                    for (int n = 0; n < 2; ++n) acc[a][b][m][n] = (f32x4){0.f, 0.f, 0.f, 0.f};
        cur = nxt; cA = nA; cB = nB; ++ui;
    }
    PG8_WAIT_V(0);
    if (wr == 0) PG8_BAR;
    PG8_BAR;
    if constexpr (Epi::AFTER_DRAIN) { E.fused(acc, cur, wr, wc, fr, fq, lds, wid, lane); S.done(cur); }
    PG8_STAMP();
    if (STAMP && wid == 0) { stamps[lane] = lane < nts ? (((unsigned long long)(unsigned)ts_hi << 32) | (unsigned)ts_lo) : 0ull;
        if (lane == 62) stamps[62] = rt_entry; if (lane == 63) stamps[63] = (unsigned long long)wall_clock64(); }
#undef PG8_STAMP
#undef PG8_SA
#undef PG8_SB
#undef PG8_STAGE
#undef PG8_LDA
#undef PG8_LDB
#undef PG8_MMA
#undef PG8_WAIT_V
#undef PG8_WAIT_L
#undef PG8_BAR
#undef PG8_SCHED
}
}

#define LAS __attribute__((address_space(3)))
#ifndef DUP_M2MASK
#define DUP_M2MASK 3
#endif
typedef unsigned short bf16_t;
typedef short bf16x8 __attribute__((ext_vector_type(8)));
typedef float f32x4 __attribute__((ext_vector_type(4)));
typedef unsigned u32x4v __attribute__((ext_vector_type(4)));
typedef unsigned u32x2v __attribute__((ext_vector_type(2)));

constexpr int NTOK = 10240, NPT = 8192, DM = 2048, NP = 9216, PIN = 8976;
constexpr int C_Q = 4864, C_K = 5888, C_V = 6912, C_G = 7936, C_IF = 8960;
constexpr int A_WD = 1536, A_AD = 1664, A_GATE = 1792;
constexpr int B_Q = 2304, B_V = 3328, B_O = 3840, B_GATE = 4352;
constexpr int NTHREADS = 512;
constexpr int LDS_SLOT = 131072, LDS_BYTES = 131072 + 1024;

constexpr size_t WS_CTL = 0;
constexpr size_t WS_BAR = 8192;
constexpr size_t WS_MOD = 32768;
constexpr size_t WS_ROPE = WS_MOD + 147456;
constexpr size_t WS_LAM = WS_ROPE + 8192;
constexpr size_t WS_WIN = WS_LAM + 256;
constexpr size_t WS_WOUT = WS_WIN + 2ull * NP * DM * 2;
constexpr size_t WS_UM = WS_WOUT + 2ull * DM * DM * 2;
constexpr size_t WS_PROJ = WS_UM + (size_t)NTOK * DM * 2;
constexpr size_t WS_GATES = WS_PROJ + (size_t)NTOK * NP * 2;
constexpr size_t SZ16 = (size_t)NTOK * 512 * 2, SZ32 = (size_t)NTOK * 512 * 4;
constexpr size_t WS_SCV = WS_GATES + (size_t)NTOK * 16 * 4;
constexpr size_t WS_SCBON = WS_SCV + SZ16;
constexpr size_t WS_PK = WS_SCBON + SZ16;
constexpr size_t SZPK = (size_t)NTOK * 8 * 320 * 2;
constexpr size_t WS_YD = WS_PK + 2 * SZPK;
constexpr size_t WS_HD = WS_YD + 2 * SZ32;
constexpr size_t WS_KC = WS_HD + 2 * SZ32;
constexpr size_t WS_VTC = WS_KC + 4194304;
constexpr size_t WS_WUPT = WS_VTC + 4194304;
constexpr size_t WS_END = WS_WUPT + 524288;

constexpr size_t O_Y = 0, O_NK = 20971520, O_NV = 37748736, O_RW = 54525952, O_MC = 58720256, O_MN = 67108864, O_MM = 67174400;

struct Params { const float* in[38]; float* out; unsigned char* ws; };
enum { I_XP = 0, I_XS, I_CK, I_CV, I_SRW, I_SMC, I_SMN, I_SMM, I_C, I_CCTX, I_WADA, I_BADA, I_WIN, I_CAW, I_CAB, I_W0, I_WUP, I_A0, I_AUP, I_KK, I_KA, I_RK,
       I_RGG, I_RGB, I_CBW, I_CBB, I_BI, I_BF, I_MGG, I_MGB, I_LQ1, I_LK1, I_LQ2, I_LK2, I_SUBG, I_WOUT, I_LNG, I_LNB };

__device__ __forceinline__ float bf2f(bf16_t v) { return __uint_as_float(((unsigned)v) << 16); }
__device__ __forceinline__ float bflo(unsigned w) { return __uint_as_float(w << 16); }
__device__ __forceinline__ float bfhi(unsigned w) { return __uint_as_float(w & 0xffff0000u); }
__device__ __forceinline__ unsigned pk2(float lo, float hi) { return pg8::cvt_pk_bf16(lo, hi); }
__device__ __forceinline__ bf16_t f2bf(float f) { return (bf16_t)(pk2(f, 0.f) & 0xffffu); }
__device__ __forceinline__ void unpack8(const u32x4v w, float (&o)[8]) { o[0] = bflo(w.x); o[1] = bfhi(w.x); o[2] = bflo(w.y); o[3] = bfhi(w.y); o[4] = bflo(w.z); o[5] = bfhi(w.z); o[6] = bflo(w.w); o[7] = bfhi(w.w); }
__device__ __forceinline__ u32x4v pack8(const float (&o)[8]) { u32x4v w; w.x = pk2(o[0], o[1]); w.y = pk2(o[2], o[3]); w.z = pk2(o[4], o[5]); w.w = pk2(o[6], o[7]); return w; }
__device__ __forceinline__ void ld8f(const float* p, float (&o)[8]) { const float4 a = *(const float4*)p, b = *(const float4*)(p + 4); o[0] = a.x; o[1] = a.y; o[2] = a.z; o[3] = a.w; o[4] = b.x; o[5] = b.y; o[6] = b.z; o[7] = b.w; }
__device__ __forceinline__ float sigmoidf_(float x) { return __builtin_amdgcn_rcpf(1.0f + __expf(-x)); }
__device__ __forceinline__ float siluf_(float x) { return x * __builtin_amdgcn_rcpf(1.0f + __expf(-x)); }
__device__ __forceinline__ float tanhf_(float x) { return 1.0f - 2.0f * __builtin_amdgcn_rcpf(1.0f + __expf(2.0f * x)); }
__device__ __forceinline__ bf16x8 frag(const LAS bf16_t* base, int row0, int ld, int k0, int lane) { return *(const LAS bf16x8*)(base + (row0 + (lane & 15)) * ld + k0 + (lane >> 4) * 8); }
__device__ __forceinline__ bf16x8 fragsw(const LAS bf16_t* base, int row0, int k0, int lane) { const int r = row0 + (lane & 15), m = (k0 >> 3) + (lane >> 4); return *(const LAS bf16x8*)(base + r * 72 + 8 * (m ^ ((r >> 3) & 7))); }
#define MFMA16(a, b, c) __builtin_amdgcn_mfma_f32_16x16x32_bf16((a), (b), (c), 0, 0, 0)
#define LDS_FENCE() asm volatile("s_waitcnt lgkmcnt(0)" ::: "memory")
template <int CTRL> __device__ __forceinline__ float dppf(float x) { return __builtin_bit_cast(float, __builtin_amdgcn_mov_dpp(__builtin_bit_cast(int, x), CTRL, 0xf, 0xf, true)); }
__device__ __forceinline__ float red16_sum(float x) { x += dppf<0xB1>(x); x += dppf<0x4E>(x); x += dppf<0x124>(x); x += dppf<0x128>(x); return x; }
__device__ __forceinline__ float red4_sum(float x) { x += dppf<0xB1>(x); x += dppf<0x4E>(x); return x; }
__device__ __forceinline__ float red16_max(float x) { x = fmaxf(x, dppf<0xB1>(x)); x = fmaxf(x, dppf<0x4E>(x)); x = fmaxf(x, dppf<0x124>(x)); x = fmaxf(x, dppf<0x128>(x)); return x; }

__device__ __forceinline__ int opaque_tid() { int t = threadIdx.x; asm volatile("" : "+v"(t)); return t; }
__device__ __forceinline__ int next_task(unsigned* ctr, LAS int* slot) {
    __syncthreads();
    if (threadIdx.x == 0) *slot = (int)atomicAdd(ctr, 1u);
    __syncthreads();
    return *slot;
}
#define QNEXT_BEGIN(ctr) unsigned qn_ = 0u; if (threadIdx.x == 0) qn_ = atomicAdd((ctr), 1u)
#define QNEXT_END(slot, t) do { __syncthreads(); if (threadIdx.x == 0) *(slot) = (int)qn_; __syncthreads(); (t) = *(slot); } while (0)
__device__ __forceinline__ int win_src_col(int n) { return n < 4352 ? n : (n < 8960 ? n + 16 : (n < 8976 ? n - 8960 + 4352 : -1)); }
__device__ __forceinline__ int mod_row(int tok) { return tok < NPT ? 0 : 1 + ((tok - NPT) >> 10); }

__device__ __forceinline__ void p0_mod_item(const Params& p, int item, LAS unsigned char* lds) {
    const int tid = opaque_tid(), lane = tid & 63, wave = tid >> 6, kq = lane >> 4, cq = lane & 15;
    const int l = item / 96, cb = item % 96;
    LAS float* sS = (LAS float*)lds;
    LAS float* sRed = sS + 3 * 2048;
    for (int e = tid; e < 3 * 2048; e += NTHREADS) { const int r = e >> 11, k = e & 2047; const float cv = r == 0 ? p.in[I_CCTX][k] : p.in[I_C][(r - 1) * 2048 + k]; sS[e] = siluf_(cv); }
    __syncthreads();
    const float* W = p.in[I_WADA] + (size_t)l * 2048 * 6144 + cb * 64 + 4 * cq;
    float4 a0 = {0, 0, 0, 0}, a1 = a0, a2 = a0;
#pragma unroll 16
    for (int i = 0; i < 64; ++i) { const int k = wave * 256 + i * 4 + kq; const float4 w = *(const float4*)(W + (size_t)k * 6144);
        const float s0 = sS[k], s1 = sS[2048 + k], s2 = sS[4096 + k];
        a0.x += s0 * w.x; a0.y += s0 * w.y; a0.z += s0 * w.z; a0.w += s0 * w.w;
        a1.x += s1 * w.x; a1.y += s1 * w.y; a1.z += s1 * w.z; a1.w += s1 * w.w;
        a2.x += s2 * w.x; a2.y += s2 * w.y; a2.z += s2 * w.z; a2.w += s2 * w.w; }
    float v[12] = {a0.x, a0.y, a0.z, a0.w, a1.x, a1.y, a1.z, a1.w, a2.x, a2.y, a2.z, a2.w};
#pragma unroll
    for (int i = 0; i < 12; ++i) { v[i] += __shfl_xor(v[i], 16); v[i] += __shfl_xor(v[i], 32); }
    if (kq == 0) {
#pragma unroll
        for (int r = 0; r < 3; ++r)
#pragma unroll
            for (int e = 0; e < 4; ++e) sRed[(wave * 3 + r) * 64 + 4 * cq + e] = v[r * 4 + e];
    }
    __syncthreads();
    if (tid < 192) { const int r = tid >> 6, c = tid & 63; float s = 0.f;
#pragma unroll
        for (int w = 0; w < 8; ++w) s += sRed[(w * 3 + r) * 64 + c];
        ((float*)(p.ws + WS_MOD))[(l * 3 + r) * 6144 + cb * 64 + c] = s + p.in[I_BADA][l * 6144 + cb * 64 + c]; }
}
template <bool MAPCOL> __device__ __forceinline__ void p0_transpose_item(const float* W, int N, int nblk, bf16_t* WT, LAS float* scr, int item, int lane) {
    const int kb = item / nblk, nb = item % nblk, k0 = 64 * kb, n0 = 32 * nb;
    const int n = n0 + (lane & 31); const int oc = MAPCOL ? win_src_col(n) : n;
    float tv[32];
    const float* wp = W + (size_t)(k0 + (lane >> 5)) * N + (oc >= 0 ? oc : 0);
#pragma unroll
    for (int i = 0; i < 32; ++i) tv[i] = wp[(size_t)(2 * i) * N];
#pragma unroll
    for (int i = 0; i < 32; ++i) scr[(2 * i + (lane >> 5)) * 33 + (lane & 31)] = oc >= 0 ? tv[i] : 0.f;
    LDS_FENCE();
    const int c = lane & 7;
#pragma unroll
    for (int j = 0; j < 4; ++j) { const int nn = (lane >> 3) + 8 * j; const LAS float* s = scr + (8 * c) * 33 + nn;
        u32x4v o; o.x = pk2(s[0 * 33], s[1 * 33]); o.y = pk2(s[2 * 33], s[3 * 33]); o.z = pk2(s[4 * 33], s[5 * 33]); o.w = pk2(s[6 * 33], s[7 * 33]);
        *(u32x4v*)(WT + (size_t)(n0 + nn) * 2048 + k0 + 8 * c) = o; }
    LDS_FENCE();
}
__device__ __forceinline__ void p0_phase(const Params& p, LAS unsigned char* lds, int rep) {
    const int tid = opaque_tid(), lane = tid & 63, wave = tid >> 6;
    unsigned* ctr = (unsigned*)(p.ws + WS_CTL) + 64 * 15 * rep;
    LAS int* slot = (LAS int*)(lds + LDS_SLOT);
    constexpr int NT_MOD = 192, NT_TR = 2816, NT_A = NT_MOD + 1 + NT_TR, NT_KC = 512, NT_VT = 512, NT_WU = 64, NT = NT_A + NT_KC + NT_VT + NT_WU;
    for (;;) {
        const int t = next_task(ctr, slot);
        if (t >= NT) break;
        if (t < NT_MOD) { p0_mod_item(p, t, lds); continue; }
        if (t == NT_MOD) {
            float* rope = (float*)(p.ws + WS_ROPE);
            for (int e = tid; e < 1024; e += NTHREADS) { const int pos = e >> 4, i = e & 15; const float inv = 1.0f / powf(10000.0f, (float)(2 * i) / 32.0f); const float ang = (float)pos * inv;
                rope[pos * 32 + i] = cosf(ang); rope[pos * 32 + 16 + i] = sinf(ang); }
            if (tid < 2) { const int l = tid; float d1 = 0.f, d2 = 0.f;
                for (int i = 0; i < 64; ++i) { d1 += p.in[I_LQ1][l * 64 + i] * p.in[I_LK1][l * 64 + i]; d2 += p.in[I_LQ2][l * 64 + i] * p.in[I_LK2][l * 64 + i]; }
                const float lam_init = 0.8f - 0.6f * expf(-0.3f * (float)l);
                ((float*)(p.ws + WS_LAM))[l] = expf(d1) - expf(d2) + lam_init; }
            continue;
        }
        if (t >= NT_A) {
            int u = t - NT_A;
            if (u < NT_KC) { const size_t o = ((size_t)u * 512 + tid) * 8; float x[8]; ld8f(p.in[I_CK] + o, x); *(u32x4v*)((bf16_t*)(p.ws + WS_KC) + o) = pack8(x); continue; }
            u -= NT_KC;
            if (u < NT_VT) { const int idx = u * 512 + tid, dv = idx & 127, m = (idx >> 7) & 63, bh = idx >> 13; float x[8];
#pragma unroll
                for (int e = 0; e < 8; ++e) x[e] = p.in[I_CV][((size_t)bh * 512 + 8 * m + e) * 128 + dv];
                *(u32x4v*)((bf16_t*)(p.ws + WS_VTC) + ((size_t)bh * 128 + dv) * 512 + 8 * m) = pack8(x); continue; }
            u -= NT_VT;
#pragma unroll
            for (int e = 0; e < 8; ++e) { const int f = u * 4096 + e * 512 + tid, c = f & 63, j = (f >> 6) & 63, h = (f >> 12) & 7, which = (f >> 15) & 1, ld = f >> 16;
                const float v = (which ? p.in[I_AUP] : p.in[I_WUP])[((size_t)ld * 64 + j) * 512 + h * 64 + c];
                ((bf16_t*)(p.ws + WS_WUPT))[(f & ~4095) + c * 64 + j] = f2bf(v); }
            continue;
        }
        int it = (t - NT_MOD - 1) * 8 + wave;
        LAS float* scr = (LAS float*)(lds + wave * 8704);
        const int l = it / 11264; it -= l * 11264;
        if (it < 9216) p0_transpose_item<true>(p.in[I_WIN] + (size_t)l * 2048 * PIN, PIN, 288, (bf16_t*)(p.ws + WS_WIN) + (size_t)l * NP * 2048, scr, it, lane);
        else p0_transpose_item<false>(p.in[I_WOUT] + (size_t)l * 2048 * 2048, 2048, 64, (bf16_t*)(p.ws + WS_WOUT) + (size_t)l * 2048 * 2048, scr, it - 9216, lane);
    }
}
__device__ __forceinline__ void modulate_row(const float* xrow, const float* mod, bf16_t* urow, int lane) {
#pragma unroll
    for (int j = 0; j < 4; ++j) { const int c = j * 512 + lane * 8; float x[8], sh[8], sc[8], o[8]; ld8f(xrow + c, x); ld8f(mod + c, sh); ld8f(mod + 2048 + c, sc);
#pragma unroll
        for (int e = 0; e < 8; ++e) o[e] = x[e] * (1.0f + sc[e]) + sh[e];
        *(u32x4v*)(urow + c) = pack8(o); }
}
__device__ __forceinline__ void p0b_phase(const Params& p) {
    const int tid_ = opaque_tid(); const int lane = tid_ & 63, gw = blockIdx.x * 8 + (tid_ >> 6), NGW = gridDim.x * 8;
    for (int tok = gw; tok < NTOK; tok += NGW) {
        const float* xrow = tok < NPT ? p.in[I_XP] + (size_t)tok * DM : p.in[I_XS] + (size_t)(tok - NPT) * DM;
        modulate_row(xrow, (const float*)(p.ws + WS_MOD) + mod_row(tok) * 6144, (bf16_t*)(p.ws + WS_UM) + (size_t)tok * DM, lane);
    }
}

struct EpiIn {
    static constexpr bool PERM = true, AFTER_DRAIN = false;
    bf16_t* proj; float* gates; float* newk; float* newv; const float* rope; int layer;
    __device__ __forceinline__ void operator()(const f32x4 (&acc)[2][2][4][2], const pg8::Unit& u, int wr, int wc, int fr, int fq) const {
        const int row0 = u.pm * 256 + wr * 64 + fr, col0 = u.pn * 256 + wc * 32 + 8 * fq;
        const bool samp = u.pm >= 32;
        const bool is_rope = samp && u.pn >= 19 && u.pn < 27;
        const bool is_k = !samp && u.pn >= 23 && u.pn < 27, is_v = !samp && u.pn >= 27 && u.pn < 31, is_g = u.pn == 35;
#pragma unroll
        for (int ai = 0; ai < 2; ++ai)
#pragma unroll
            for (int m = 0; m < 4; ++m) {
                const int row = row0 + ai * 128 + m * 16;
                float cs[8], sn[8];
                if (is_rope) { const int pos = (row - NPT) & 1023; const int pp = (wc & 1) ? (pos & 63) : (pos >> 6); const float* rp = rope + pp * 32 + 8 * (fq & 1); ld8f(rp, cs); ld8f(rp + 16, sn); }
#pragma unroll
                for (int bj = 0; bj < 2; ++bj) {
                    f32x4 v0 = acc[ai][bj][m][0], v1 = acc[ai][bj][m][1];
                    if (is_rope) {
                        const float sg = (fq & 2) ? 1.0f : -1.0f;
#pragma unroll
                        for (int e = 0; e < 4; ++e) { const float p0 = __shfl_xor(v0[e], 32), p1 = __shfl_xor(v1[e], 32);
                            v0[e] = v0[e] * cs[e] + sg * p0 * sn[e]; v1[e] = v1[e] * cs[4 + e] + sg * p1 * sn[4 + e]; }
                    }
                    const int col = col0 + bj * 128;
                    u32x4v w; w.x = pk2(v0[0], v0[1]); w.y = pk2(v0[2], v0[3]); w.z = pk2(v1[0], v1[1]); w.w = pk2(v1[2], v1[3]);
                    *(u32x4v*)(proj + (size_t)row * NP + col) = w;
                    if (is_k || is_v) { const int ck = col - (is_k ? C_K : C_V), h = ck >> 7, j = ck & 127, b = row >> 8, t = row & 255;
                        float* dst = (is_k ? newk : newv) + ((((size_t)(b * 2 + layer) * 8 + h) * 256 + t) * 128 + j);
                        *(f32x4*)dst = v0; *(f32x4*)(dst + 4) = v1; }
                    if (is_g && bj == 0 && wc == 0 && fq < 2) { float* dst = gates + (size_t)row * 16 + 8 * fq; *(f32x4*)dst = v0; *(f32x4*)(dst + 4) = v1; }
                }
            }
    }
};
struct EpiOut {
    static constexpr bool PERM = false, AFTER_DRAIN = false;
    const float* xp; const float* xs; const float* mod; float* y; int layer;
    __device__ __forceinline__ void operator()(const f32x4 (&acc)[2][2][4][2], const pg8::Unit& u, int wr, int wc, int fr, int fq) const {
        const int row0 = u.pm * 256 + wr * 64 + fr, col0 = u.pn * 256 + wc * 32 + 4 * fq;
#pragma unroll
        for (int ai = 0; ai < 2; ++ai)
#pragma unroll
            for (int m = 0; m < 4; ++m) {
                const int row = row0 + ai * 128 + m * 16;
                const float* xrow = layer == 0 ? (row < NPT ? xp + (size_t)row * DM : xs + (size_t)(row - NPT) * DM) : y + (size_t)row * DM;
                const float* g = mod + mod_row(row) * 6144 + 4096;
#pragma unroll
                for (int bj = 0; bj < 2; ++bj)
#pragma unroll
                    for (int n = 0; n < 2; ++n) { const int c = col0 + bj * 128 + n * 16;
                        const f32x4 xv = *(const f32x4*)(xrow + c), gv = *(const f32x4*)(g + c);
                        *(f32x4*)(y + (size_t)row * DM + c) = 1.41421356237f * xv + gv * acc[ai][bj][m][n]; }
            }
    }
};

#define XB_TMO      128
#define XB_XCNT(j)  (256  + 64 * (j))
#define XB_XSUB(j)  (1280 + 64 * (j))
#define XB_XGEN(j)  (2304 + 64 * (j))
#define XB_TOP      3328
#define XB_TOPGEN   3392
#define XCD_BAR_WORDS 3456
#define XB_SPIN_CAP (1u << 18)

__device__ __forceinline__ unsigned xb_ld(unsigned* p)              { return __hip_atomic_load(p, __ATOMIC_RELAXED, __HIP_MEMORY_SCOPE_AGENT); }
__device__ __forceinline__ unsigned xb_add(unsigned* p, unsigned v) { return __hip_atomic_fetch_add(p, v, __ATOMIC_RELAXED, __HIP_MEMORY_SCOPE_AGENT); }
__device__ __forceinline__ unsigned xb_xcc_id() { return (unsigned)__builtin_amdgcn_s_getreg((3 << 11) | 20) & 0xFu; }
#define XB_SPIN(cond, bar) do { unsigned _sp = 0; while (cond) { __builtin_amdgcn_s_sleep(1); \
    if ((++_sp & 255u) == 0u) { if (xb_ld(&(bar)[XB_TMO])) break; if (_sp > XB_SPIN_CAP) { atomicAdd(&(bar)[XB_TMO], 1u); break; } } } } while (0)

struct XcdBarrier {
    unsigned* bar; unsigned x;
    volatile LAS unsigned* st;
};

__device__ __forceinline__ XcdBarrier xcd_barrier_post(unsigned* bar, volatile LAS unsigned* st) {
    XcdBarrier b; b.bar = bar; b.x = xb_xcc_id(); b.st = st;
    if (threadIdx.x == 0) (void)xb_add(&bar[XB_XCNT(b.x)], 1u);
    return b;
}
__device__ __forceinline__ void xcd_barrier_complete(unsigned* bar, unsigned x, unsigned& nloc, unsigned& nx) {
    const unsigned G = gridDim.x * gridDim.y * gridDim.z;
    unsigned sum, cnt, mine, sp = 0u;
    for (;;) {
        sum = 0u; cnt = 0u; mine = 0u;
#pragma unroll
        for (unsigned j = 0; j < 16; ++j) { const unsigned c = xb_ld(&bar[XB_XCNT(j)]); sum += c; cnt += (c > 0u) ? 1u : 0u; mine = (j == x) ? c : mine; }
        if (sum == G) break;
        __builtin_amdgcn_s_sleep(1);
        if ((++sp & 255u) == 0u) { if (xb_ld(&bar[XB_TMO])) break; if (sp > XB_SPIN_CAP) { atomicAdd(&bar[XB_TMO], 1u); break; } }
    }
    nloc = mine > 0u ? mine : 1u; nx = cnt > 0u ? cnt : 1u;
}

__device__ __forceinline__ unsigned xb_xcc_id_v() { unsigned r; asm volatile("s_getreg_b32 %0, hwreg(20, 0, 4)" : "=s"(r)); return r & 0xFu; }
__device__ __forceinline__ void xcd_barrier(const XcdBarrier& b) {
    asm volatile("s_waitcnt vmcnt(0)" ::: "memory");
    __syncthreads();
    if (threadIdx.x == 0) {
        unsigned* bar = b.bar; const unsigned bx = xb_xcc_id_v();
        __builtin_amdgcn_s_waitcnt(0);
        unsigned nloc = b.st[0], nx = b.st[1];
        if (nloc == 0u) { xcd_barrier_complete(bar, bx, nloc, nx); b.st[0] = nloc; b.st[1] = nx; }
        const unsigned old = xb_add(&bar[XB_XSUB(bx)], 1u);
        const unsigned gen = old / nloc;
        if (old + 1u == (gen + 1u) * nloc) {
            __builtin_amdgcn_fence(__ATOMIC_RELEASE, "agent");
            asm volatile("s_waitcnt vmcnt(0)" ::: "memory");
            const unsigned og = xb_add(&bar[XB_TOP], 1u);
            const unsigned tg = og / nx;
            if (og + 1u == (tg + 1u) * nx) xb_add(&bar[XB_TOPGEN], 1u);
            else XB_SPIN(xb_ld(&bar[XB_TOPGEN]) == tg, bar);
            __builtin_amdgcn_fence(__ATOMIC_ACQUIRE, "agent");
            xb_add(&bar[XB_XGEN(bx)], 1u);
            asm volatile("s_waitcnt vmcnt(0)" ::: "memory");
        } else {
            XB_SPIN(xb_ld(&bar[XB_XGEN(bx)]) == gen, bar);
            __builtin_amdgcn_fence(__ATOMIC_ACQUIRE, "agent");
            asm volatile("s_waitcnt vmcnt(0)" ::: "memory");
        }
    }
    __syncthreads();
}


__device__ __forceinline__ void mlstm_task(const Params& p, int l, int s, int d, int h, LAS unsigned char* lds) {
    const int tid = opaque_tid(), lane = tid & 63, wave = tid >> 6, quad = lane >> 4, l15 = lane & 15;
    const int T = s < 32 ? 256 : 1024, tok0 = s < 32 ? s * 256 : NPT + (s - 32) * 1024, nch = T / 64;
    LAS bf16_t* sQ = (LAS bf16_t*)lds;
    LAS bf16_t* sK = sQ + 64 * 136;
    LAS bf16_t* sKt = sK + 64 * 136;
    LAS bf16_t* sVt = sKt + 128 * 72;
    LAS bf16_t* sP = sVt + 128 * 72;
    LAS bf16_t* sC = sP + 64 * 72;
    LAS float* sf = (LAS float*)(sC + 128 * 136);
    LAS float *sA = sf, *sB = sf + 64, *sPm = sf + 128, *sN = sf + 192, *sNq = sf + 320, *sPs = sf + 384;
    const bf16_t* proj = (const bf16_t*)(p.ws + WS_PROJ);
    const float* gates = (const float*)(p.ws + WS_GATES);
    float* hd = (float*)(p.ws + WS_HD) + (size_t)d * NTOK * 512;
    const float bi = p.in[I_BI][l * 8 + d * 4 + h], bfb = p.in[I_BF][l * 8 + d * 4 + h];
    f32x4 cacc[8];
    float m;
    float cw0[8], cw1[8], cw2[8], cbb[8];
    { const int g = tid & 31, ch = ((g >> 4) ? 512 : 0) + h * 128 + (g & 15) * 8; const float* cw = p.in[I_CBW] + (size_t)l * 3 * 1024 + ch;
        ld8f(cw, cw0); ld8f(cw + 1024, cw1); ld8f(cw + 2048, cw2); ld8f(p.in[I_CBB] + l * 1024 + ch, cbb); }
    __syncthreads();
    if (s >= 32) {
        const size_t sb = (((size_t)((s - 32) * 2 + l) * 2 + d) * 4 + h);
        const float* C0 = p.in[I_SMC] + sb * 128 * 128;
#pragma unroll
        for (int tn = 0; tn < 8; ++tn)
#pragma unroll
            for (int j = 0; j < 4; ++j) cacc[tn][j] = C0[(16 * wave + quad * 4 + j) * 128 + 16 * tn + l15];
        if (tid < 128) sN[tid] = p.in[I_SMN][sb * 128 + tid];
        m = p.in[I_SMM][sb];
    } else {
#pragma unroll
        for (int tn = 0; tn < 8; ++tn) cacc[tn] = (f32x4){0.f, 0.f, 0.f, 0.f};
        if (tid < 128) sN[tid] = 0.f;
        m = 0.f;
    }
#pragma unroll
    for (int tn = 0; tn < 8; ++tn)
#pragma unroll
        for (int j = 0; j < 4; ++j) sC[(16 * wave + quad * 4 + j) * 136 + 16 * tn + l15] = f2bf(cacc[tn][j]);

    float gi_n = 0.f, gf_n = 0.f;
    if (wave == 0) { const int tk = d == 0 ? tok0 + lane : tok0 + T - 1 - lane; gi_n = gates[(size_t)tk * 16 + d * 4 + h]; gf_n = gates[(size_t)tk * 16 + 8 + d * 4 + h]; }
    for (int c = 0; c < nch; ++c) {
        __syncthreads();
        if (wave == 0) {
            const float gi = gi_n + bi, gf = gf_n + bfb;
            if (c + 1 < nch) { const int ii = 64 * (c + 1) + lane; const int tk = d == 0 ? tok0 + ii : tok0 + T - 1 - ii; gi_n = gates[(size_t)tk * 16 + d * 4 + h]; gf_n = gates[(size_t)tk * 16 + 8 + d * 4 + h]; }
            const float lf = fminf(gf, 0.f) - log1pf(__expf(-fabsf(gf)));
            float b = lf;
#pragma unroll
            for (int off = 1; off < 64; off <<= 1) { const float t = __shfl_up(b, off); if (lane >= off) b += t; }
            const float a = gi - b; float pm = a;
#pragma unroll
            for (int off = 1; off < 64; off <<= 1) { const float t = __shfl_up(pm, off); if (lane >= off) pm = fmaxf(pm, t); }
            sB[lane] = b; sA[lane] = a; sPm[lane] = pm;
        }
        __syncthreads();
        const float mx = fmaxf(m, sPm[63]), bL = sB[63];
#pragma unroll
        for (int it = 0; it < 4; ++it) {
            const int idx = tid + 512 * it, i = idx >> 5, g = idx & 31, isK = g >> 4, j0 = (g & 15) * 8, ch = (isK ? 512 : 0) + h * 128 + j0;
            const int ii = 64 * c + i, pos = d == 0 ? ii : T - 1 - ii, tk = tok0 + pos;
            const bf16_t* src = proj + (size_t)tk * NP + B_Q + ch;
            float x0[8], x1[8], x2[8], y[8];
            unpack8(*(const u32x4v*)src, x1);
            unpack8(*(const u32x4v*)(pos > 0 ? src - NP : src), x0); unpack8(*(const u32x4v*)(pos < T - 1 ? src + NP : src), x2);
            const float m0 = pos > 0 ? 1.f : 0.f, m2 = pos < T - 1 ? 1.f : 0.f;
#pragma unroll
            for (int e = 0; e < 8; ++e) y[e] = siluf_(m0 * x0[e] * cw0[e] + x1[e] * cw1[e] + m2 * x2[e] * cw2[e] + cbb[e]);
            if (!isK) { *(LAS u32x4v*)(sQ + i * 136 + j0) = pack8(y); }
            else {
                const float wgi = __expf(sA[i] - mx);
#pragma unroll
                for (int e = 0; e < 8; ++e) y[e] *= 0.08838834764831845f;
                *(LAS u32x4v*)(sK + i * 136 + j0) = pack8(y);
#pragma unroll
                for (int e = 0; e < 8; ++e) sKt[(j0 + e) * 72 + (i ^ (8 * ((j0 >> 3) & 7)))] = f2bf(y[e] * wgi);
            }
        }
#pragma unroll
        for (int it = 0; it < 2; ++it) {
            const int idx = tid + 512 * it, i = idx >> 4, g = idx & 15;
            const int ii = 64 * c + i, tk = d == 0 ? tok0 + ii : tok0 + T - 1 - ii;
            const u32x4v w = *(const u32x4v*)(proj + (size_t)tk * NP + B_V + h * 128 + 8 * g);
            LAS bf16_t* dst = sVt + (8 * g) * 72 + (i ^ (8 * (g & 7)));
            dst[0] = (bf16_t)(w.x & 0xffff); dst[72] = (bf16_t)(w.x >> 16); dst[144] = (bf16_t)(w.y & 0xffff); dst[216] = (bf16_t)(w.y >> 16);
            dst[288] = (bf16_t)(w.z & 0xffff); dst[360] = (bf16_t)(w.z >> 16); dst[432] = (bf16_t)(w.w & 0xffff); dst[504] = (bf16_t)(w.w >> 16);
        }
        __syncthreads();
        const int tm = wave >> 1;
        {
            const int tn0 = (wave & 1) * 2;
#pragma unroll
            for (int tt = 0; tt < 2; ++tt) {
                f32x4 acc = {0.f, 0.f, 0.f, 0.f};
#pragma unroll
                for (int ks = 0; ks < 4; ++ks) acc = MFMA16(frag(sQ, 16 * tm, 136, 32 * ks, lane), frag(sK, 16 * (tn0 + tt), 136, 32 * ks, lane), acc);
                const int scol = 16 * (tn0 + tt) + l15; const float as = sA[scol];
#pragma unroll
                for (int j = 0; j < 4; ++j) { const int t = 16 * tm + quad * 4 + j;
                    float pv = scol <= t ? __expf(as - fmaxf(m, sPm[t])) * acc[j] : 0.f;
                    sP[t * 72 + scol] = f2bf(pv);
                    pv = red16_sum(pv);
                    if (l15 == 0) sPs[t * 4 + tn0 + tt] = pv; }
            }
        }
        const int tnb = (wave & 1) * 4;
        f32x4 accq[4];
#pragma unroll
        for (int tt = 0; tt < 4; ++tt) { accq[tt] = (f32x4){0.f, 0.f, 0.f, 0.f};
#pragma unroll
            for (int ks = 0; ks < 4; ++ks) accq[tt] = MFMA16(frag(sQ, 16 * tm, 136, 32 * ks, lane), frag(sC, 16 * (tnb + tt), 136, 32 * ks, lane), accq[tt]); }
        { const int t = tid >> 3, part = tid & 7; float sacc = 0.f;
#pragma unroll
            for (int e = 0; e < 16; ++e) sacc += sN[16 * part + e] * bf2f(sQ[t * 136 + 16 * part + e]);
            sacc += __shfl_xor(sacc, 1); sacc += __shfl_xor(sacc, 2); sacc += __shfl_xor(sacc, 4);
            if (part == 0) sNq[t] = sacc; }
        __syncthreads();
        {
            f32x4 accp[4];
#pragma unroll
            for (int tt = 0; tt < 4; ++tt) { accp[tt] = (f32x4){0.f, 0.f, 0.f, 0.f};
#pragma unroll
                for (int ks = 0; ks < 2; ++ks) accp[tt] = MFMA16(frag(sP, 16 * tm, 72, 32 * ks, lane), fragsw(sVt, 16 * (tnb + tt), 32 * ks, lane), accp[tt]); }
#pragma unroll
            for (int j = 0; j < 4; ++j) { const int t = 16 * tm + quad * 4 + j;
                const float mtm = fmaxf(m, sPm[t]), wi = __expf(m - mtm);
                const float den = wi * sNq[t] + ((sPs[t * 4] + sPs[t * 4 + 1]) + (sPs[t * 4 + 2] + sPs[t * 4 + 3]));
                const float mt = sB[t] + mtm; const float inv = 1.0f / fmaxf(fabsf(den), __expf(-mt));
                const int ii = 64 * c + t, tk = d == 0 ? tok0 + ii : tok0 + T - 1 - ii;
                float* dst = hd + (size_t)tk * 512 + h * 128 + 16 * tnb + l15;
#pragma unroll
                for (int tt = 0; tt < 4; ++tt) dst[16 * tt] = (wi * accq[tt][j] + accp[tt][j]) * inv; }
        }
        const float sc = __expf(m - mx);
        if (tid < 128) { float ns = 0.f;
#pragma unroll 8
            for (int e = 0; e < 64; ++e) ns += bf2f(sKt[tid * 72 + e]);
            sN[tid] = sc * sN[tid] + ns; }
#pragma unroll
        for (int tn = 0; tn < 8; ++tn) { f32x4 dc = {0.f, 0.f, 0.f, 0.f};
#pragma unroll
            for (int ks = 0; ks < 2; ++ks) dc = MFMA16(fragsw(sVt, 16 * wave, 32 * ks, lane), fragsw(sKt, 16 * tn, 32 * ks, lane), dc);
            cacc[tn] = sc * cacc[tn] + dc;
#pragma unroll
            for (int j = 0; j < 4; ++j) sC[(16 * wave + quad * 4 + j) * 136 + 16 * tn + l15] = f2bf(cacc[tn][j]); }
        m = bL + mx;
    }
    __syncthreads();
    if (s < 32) {
        const size_t sb = (((size_t)(s * 2 + l) * 2 + d) * 4 + h);
        float* Co = p.out + O_MC + sb * 128 * 128;
#pragma unroll
        for (int tn = 0; tn < 8; ++tn)
#pragma unroll
            for (int j = 0; j < 4; ++j) Co[(16 * wave + quad * 4 + j) * 128 + 16 * tn + l15] = cacc[tn][j];
        if (tid < 128) p.out[O_MN + sb * 128 + tid] = sN[tid];
        if (tid == 0) p.out[O_MM + sb] = m;
    }
}

__device__ __forceinline__ void attn_task(const Params& p, int l, int task, LAS unsigned char* lds) {
    const int tid = opaque_tid(), lane = tid & 63, wave = tid >> 6, quad = lane >> 4, l15 = lane & 15;
    const bool samp = task < 128;
    int b, h, qb;
    if (samp) { b = task >> 6; h = (task >> 3) & 7; qb = task & 7; } else { const int t2 = task - 128; b = t2 >> 4; h = (t2 >> 1) & 7; qb = t2 & 1; }
    const int tok0 = samp ? NPT + b * 1024 : b * 256, nkt = samp ? 24 : 4, nct = samp ? 8 : 0;
    LAS bf16_t* sK = (LAS bf16_t*)lds;
    LAS bf16_t* sVt = sK + 64 * 136;
    LAS bf16_t* sPw = sVt + 128 * 72 + wave * (16 * 72);
    const bf16_t* proj = (const bf16_t*)(p.ws + WS_PROJ);
    const bf16_t* ck = (const bf16_t*)(p.ws + WS_KC) + (((unsigned)(b * 2 + l) * 8 + h) * 512) * 128;
    const bf16_t* cv = (const bf16_t*)(p.ws + WS_VTC) + (((unsigned)(b * 2 + l) * 8 + h) * 128) * 512;
    const float lam = ((const float*)(p.ws + WS_LAM))[l];
    const float lam_init = 0.8f - 0.6f * expf(-0.3f * (float)l);
    const int q0 = 128 * qb + 16 * wave;
    bf16x8 aq1[2], aq2[2];
    { const bf16_t* qp = proj + (unsigned)(tok0 + q0 + l15) * NP + C_Q + h * 128 + quad * 8;
        aq1[0] = *(const bf16x8*)qp; aq1[1] = *(const bf16x8*)(qp + 32); aq2[0] = *(const bf16x8*)(qp + 64); aq2[1] = *(const bf16x8*)(qp + 96); }
    float mx1 = -INFINITY, mx2 = -INFINITY, sm1 = 0.f, sm2 = 0.f, mc1 = 0.f, mc2 = 0.f;
    constexpr float CS = 0.125f * 1.4426950408889634f;
    f32x4 o1[8], o2[8];
#pragma unroll
    for (int tn = 0; tn < 8; ++tn) { o1[tn] = (f32x4){0.f, 0.f, 0.f, 0.f}; o2[tn] = o1[tn]; }
    u32x4v kreg[2], vreg[2];
#define ATT_LOAD(KT, PASS) do { int ktv = (KT); asm volatile("" : "+v"(ktv));     \
    _Pragma("unroll") for (int it = 0; it < 2; ++it) { const int idx = tid + 512 * it, i = idx >> 4, g = idx & 15; \
        if ((KT) < nct) { kreg[it] = *(const u32x4v*)(ck + (unsigned)((64 * ktv + i) * 128 + 8 * g)); \
            if ((PASS) == 1) { const int dv = idx >> 3, mm = idx & 7; vreg[it] = *(const u32x4v*)(cv + (unsigned)(dv * 512 + 64 * ktv + 8 * mm)); } } \
        else { kreg[it] = *(const u32x4v*)(proj + (unsigned)((tok0 + 64 * (ktv - nct) + i) * NP + C_K + h * 128 + 8 * g)); \
            if ((PASS) == 1) vreg[it] = *(const u32x4v*)(proj + (unsigned)((tok0 + 64 * (ktv - nct) + (idx & 63)) * NP + C_V + h * 128 + 8 * (idx >> 6))); } } } while (0)
    for (int pass = 0; pass < 2; ++pass) {
        ATT_LOAD(0, pass);
        for (int kt = 0; kt < nkt; ++kt) {
            __syncthreads();
#pragma unroll
            for (int it = 0; it < 2; ++it) {
                const int idx = tid + 512 * it, i = idx >> 4, g = idx & 15;
                *(LAS u32x4v*)(sK + i * 136 + 8 * g) = kreg[it];
                if (pass == 1) {
                    if (kt < nct) { const int dv = idx >> 3, mm = idx & 7; *(LAS u32x4v*)(sVt + dv * 72 + 8 * mm) = vreg[it]; }
                    else { const u32x4v w = vreg[it]; LAS bf16_t* dst = sVt + (8 * (idx >> 6)) * 72 + (idx & 63);
                        dst[0] = (bf16_t)(w.x & 0xffff); dst[72] = (bf16_t)(w.x >> 16); dst[144] = (bf16_t)(w.y & 0xffff); dst[216] = (bf16_t)(w.y >> 16);
                        dst[288] = (bf16_t)(w.z & 0xffff); dst[360] = (bf16_t)(w.z >> 16); dst[432] = (bf16_t)(w.w & 0xffff); dst[504] = (bf16_t)(w.w >> 16); }
                }
            }
            if (kt + 1 < nkt) ATT_LOAD(kt + 1, pass);
            __syncthreads();
#pragma unroll
            for (int bb = 0; bb < 2; ++bb) {
                f32x4 s1[2], s2[2];
#pragma unroll
                for (int t = 0; t < 2; ++t) { s1[t] = (f32x4){0.f, 0.f, 0.f, 0.f}; s2[t] = s1[t];
#pragma unroll
                    for (int ks = 0; ks < 2; ++ks) { s1[t] = MFMA16(frag(sK, 32 * bb + 16 * t, 136, 32 * ks, lane), aq1[ks], s1[t]); s2[t] = MFMA16(frag(sK, 32 * bb + 16 * t, 136, 64 + 32 * ks, lane), aq2[ks], s2[t]); } }
                if (pass == 0) {
#pragma unroll
                    for (int t = 0; t < 2; ++t)
#pragma unroll
                        for (int j = 0; j < 4; ++j) { mx1 = fmaxf(mx1, s1[t][j]); mx2 = fmaxf(mx2, s2[t][j]); }
                } else {
                    bf16x8 pa1, pa2;
                    { float p1[8];
#pragma unroll
                        for (int jj = 0; jj < 8; ++jj) { p1[jj] = __builtin_amdgcn_exp2f(s1[jj >> 2][jj & 3] * CS - mc1); sm1 += p1[jj]; }
                        pa1 = __builtin_bit_cast(bf16x8, pack8(p1)); }
                    { float p2[8];
#pragma unroll
                        for (int jj = 0; jj < 8; ++jj) { p2[jj] = __builtin_amdgcn_exp2f(s2[jj >> 2][jj & 3] * CS - mc2); sm2 += p2[jj]; }
                        pa2 = __builtin_bit_cast(bf16x8, pack8(p2)); }
#pragma unroll
                    for (int tn2 = 0; tn2 < 8; ++tn2) { const LAS bf16_t* vrow = sVt + (16 * tn2 + l15) * 72 + 32 * bb + quad * 4;
                        const u32x2v lo = *(const LAS u32x2v*)vrow, hi = *(const LAS u32x2v*)(vrow + 16);
                        u32x4v vw; vw.x = lo.x; vw.y = lo.y; vw.z = hi.x; vw.w = hi.y;
                        const bf16x8 vb = __builtin_bit_cast(bf16x8, vw);
                        o1[tn2] = MFMA16(pa1, vb, o1[tn2]); o2[tn2] = MFMA16(pa2, vb, o2[tn2]); }
                }
                asm volatile("" ::: "memory");
            }
        }
        if (pass == 0) { mx1 = fmaxf(mx1, __shfl_xor(mx1, 16)); mx1 = fmaxf(mx1, __shfl_xor(mx1, 32)); mx2 = fmaxf(mx2, __shfl_xor(mx2, 16)); mx2 = fmaxf(mx2, __shfl_xor(mx2, 32)); mc1 = mx1 * CS; mc2 = mx2 * CS; }
    }
    sm1 += __shfl_xor(sm1, 16); sm1 += __shfl_xor(sm1, 32); sm2 += __shfl_xor(sm2, 16); sm2 += __shfl_xor(sm2, 32);
    const float il1 = 1.0f / sm1, il2 = lam / sm2;
    float f1[4], f2[4];
#pragma unroll
    for (int j = 0; j < 4; ++j) { f1[j] = __shfl(il1, quad * 4 + j); f2[j] = __shfl(il2, quad * 4 + j); }
#pragma unroll
    for (int tn = 0; tn < 8; ++tn)
#pragma unroll
        for (int j = 0; j < 4; ++j) o1[tn][j] = o1[tn][j] * f1[j] - o2[tn][j] * f2[j];
    asm volatile("" ::: "memory");
#define oacc o1
#undef ATT_LOAD
    bf16_t* mixed = (bf16_t*)(p.ws + WS_UM);
    const float* sg = p.in[I_SUBG] + l * 128;
#pragma unroll
    for (int j = 0; j < 4; ++j) {
        float ss = 0.f;
#pragma unroll
        for (int tn = 0; tn < 8; ++tn) ss += oacc[tn][j] * oacc[tn][j];
        ss = red16_sum(ss);
        const float r = rsqrtf(ss * (1.0f / 128.0f) + 1e-5f) * (1.0f - lam_init);
        const int tq = tok0 + q0 + quad * 4 + j;
#pragma unroll
        for (int tn = 0; tn < 8; ++tn) { const int dv = 16 * tn + l15;
            const float gt = bf2f(proj[(unsigned)tq * NP + C_G + h * 128 + dv]);
            mixed[(unsigned)tq * DM + 1024 + h * 128 + dv] = f2bf(oacc[tn][j] * r * sg[dv] * siluf_(gt)); }
    }
}

#undef oacc
__device__ __forceinline__ void rwkv_prep_task(const Params& p, int l, int task, LAS unsigned char* lds) {
    const int tid = opaque_tid(), lane = tid & 63, wave = tid >> 6, quad = lane >> 4, l15 = lane & 15;
    const int tile = task >> 3, h = task & 7, tb = 64 * tile;
    const int T = tb < NPT ? 256 : 1024, seq0 = tb < NPT ? (tb & ~255) : NPT + ((tb - NPT) & ~1023);
    LAS bf16_t* sTW = (LAS bf16_t*)lds;
    LAS bf16_t* sAD = sTW + 2 * 64 * 72;
    LAS bf16_t* sWup = sAD + 2 * 64 * 72;
    LAS bf16_t* sAup = sWup + 2 * 64 * 72;
    LAS float* sR = (LAS float*)(sAup + 2 * 64 * 72);
    LAS float* sKf = sR + 4096; LAS float* sVf = sKf + 4096; LAS float* sNrm = sVf + 4096; LAS float* sRK = sNrm + 64;
    const bf16_t* proj = (const bf16_t*)(p.ws + WS_PROJ);
    __syncthreads();
#pragma unroll
    for (int it = 0; it < 4; ++it) {
        const int idx = tid + 512 * it, arr = idx >> 9, i = (idx >> 3) & 63, g = idx & 7;
        const u32x4v w = *(const u32x4v*)(proj + (size_t)(tb + i) * NP + A_WD + 64 * arr + 8 * g);
        if (arr < 2) { float x[8]; unpack8(w, x);
#pragma unroll
            for (int e = 0; e < 8; ++e) x[e] = tanhf_(x[e]);
            *(LAS u32x4v*)(sTW + (arr * 64 + i) * 72 + 8 * g) = pack8(x); }
        else *(LAS u32x4v*)(sAD + ((arr - 2) * 64 + i) * 72 + 8 * g) = w;
    }
#pragma unroll
    for (int it = 0; it < 4; ++it) {
        const int dd2 = it >> 1, which = it & 1, c = tid >> 3, jg = tid & 7;
        const bf16_t* src = (const bf16_t*)(p.ws + WS_WUPT) + ((((size_t)(l * 2 + dd2) * 2 + which) * 8 + h) * 4096) + c * 64 + 8 * jg;
        *(LAS u32x4v*)((which ? sAup : sWup) + (dd2 * 64 + c) * 72 + 8 * jg) = *(const u32x4v*)src;
    }
#pragma unroll
    for (int it = 0; it < 3; ++it) {
        const int idx = tid + 512 * it, which = idx >> 9, i = (idx >> 3) & 63, g = idx & 7, ch = which * 512 + h * 64 + 8 * g;
        const int tk = tb + i, pos = tk - seq0;
        const bf16_t* src = proj + (size_t)tk * NP + ch;
        float x0[8], x1[8], x2[8], w0[8], w1[8], w2[8], bb[8];
        unpack8(*(const u32x4v*)src, x1);
        unpack8(*(const u32x4v*)(pos > 0 ? src - NP : src), x0); unpack8(*(const u32x4v*)(pos < T - 1 ? src + NP : src), x2);
        const float m0 = pos > 0 ? 1.f : 0.f, m2 = pos < T - 1 ? 1.f : 0.f;
        const float* cw = p.in[I_CAW] + (size_t)l * 3 * 1536 + ch;
        ld8f(cw, w0); ld8f(cw + 1536, w1); ld8f(cw + 3072, w2); ld8f(p.in[I_CAB] + l * 1536 + ch, bb);
        LAS float* dst = (which == 0 ? sR : (which == 1 ? sKf : sVf)) + i * 64 + 8 * g;
#pragma unroll
        for (int e = 0; e < 8; ++e) dst[e] = m0 * x0[e] * w0[e] + x1[e] * w1[e] + m2 * x2[e] * w2[e] + bb[e];
    }
    __syncthreads();
    { const int t = tid >> 3, part = tid & 7; float ss = 0.f;
#pragma unroll
        for (int e = 0; e < 8; ++e) { const float v = sKf[t * 64 + 8 * part + e] * p.in[I_KK][l * 512 + h * 64 + 8 * part + e]; ss += v * v; }
        ss += __shfl_xor(ss, 1); ss += __shfl_xor(ss, 2); ss += __shfl_xor(ss, 4);
        if (part == 0) sNrm[t] = rsqrtf(ss + 1e-12f); }
    const int dd = wave >> 2, tm = wave & 3;
    f32x4 aw[4], aa[4];
#pragma unroll
    for (int tn = 0; tn < 4; ++tn) { aw[tn] = (f32x4){0.f, 0.f, 0.f, 0.f}; aa[tn] = aw[tn];
#pragma unroll
        for (int ks = 0; ks < 2; ++ks) { aw[tn] = MFMA16(frag(sTW + dd * 64 * 72, 16 * tm, 72, 32 * ks, lane), frag(sWup + dd * 64 * 72, 16 * tn, 72, 32 * ks, lane), aw[tn]);
            aa[tn] = MFMA16(frag(sAD + dd * 64 * 72, 16 * tm, 72, 32 * ks, lane), frag(sAup + dd * 64 * 72, 16 * tn, 72, 32 * ks, lane), aa[tn]); } }
    __syncthreads();
    {
        LAS bf16_t* so = sTW + dd * (3 * 4096);
        float rk[4] = {0.f, 0.f, 0.f, 0.f};
#pragma unroll
        for (int tn = 0; tn < 4; ++tn) { const int c = 16 * tn + l15, ch = h * 64 + c;
            const float w0v = p.in[I_W0][(l * 2 + dd) * 512 + ch], a0v = p.in[I_A0][(l * 2 + dd) * 512 + ch], kav = p.in[I_KA][l * 512 + ch], kkv = p.in[I_KK][l * 512 + ch], rkv = p.in[I_RK][l * 512 + ch];
#pragma unroll
            for (int j = 0; j < 4; ++j) { const int t = 16 * tm + quad * 4 + j; const int o = t * 64 + c;
                const float z = w0v + aw[tn][j]; const float dec = __expf(-0.6065306597126334f * sigmoidf_(z));
                const float av = sigmoidf_(a0v + aa[tn][j]); const float kv = sKf[t * 64 + c];
                const float ktv = kv * (1.0f + (av - 1.0f) * kav); const float kk = kv * kkv * sNrm[t];
                so[o] = f2bf(ktv); so[4096 + o] = f2bf(kk * av); so[8192 + o] = f2bf(dec - 1.0f);
                rk[j] += sR[t * 64 + c] * ktv * rkv; } }
#pragma unroll
        for (int j = 0; j < 4; ++j) { const float s = red16_sum(rk[j]); if (l15 == 0) sRK[dd * 64 + 16 * tm + quad * 4 + j] = s; }
    }
    __syncthreads();
    { const int i = tid >> 3, g = tid & 7; const size_t o = (size_t)(tb + i) * 512 + h * 64 + 8 * g;
        float r[8], k[8], v[8], bn[8]; const float nr = sNrm[i], rks = sRK[i] + sRK[64 + i];
#pragma unroll
        for (int e = 0; e < 8; ++e) { r[e] = sR[i * 64 + 8 * g + e]; k[e] = sKf[i * 64 + 8 * g + e] * p.in[I_KK][l * 512 + h * 64 + 8 * g + e] * nr; v[e] = sVf[i * 64 + 8 * g + e]; bn[e] = rks * v[e]; }
        const size_t o2 = ((size_t)(tb + i) * 8 + h) * 320 + 8 * g; bf16_t* pk = (bf16_t*)(p.ws + WS_PK);
#pragma unroll
        for (int dd2 = 0; dd2 < 2; ++dd2)
#pragma unroll
            for (int ar = 0; ar < 3; ++ar) *(u32x4v*)(pk + (size_t)dd2 * NTOK * 2560 + o2 + 128 + 64 * ar) = *(const LAS u32x4v*)(sTW + dd2 * (3 * 4096) + ar * 4096 + i * 64 + 8 * g);
        const u32x4v rr = pack8(r), kk8 = pack8(k);
        *(u32x4v*)(pk + o2) = rr; *(u32x4v*)(pk + o2 + 64) = kk8; *(u32x4v*)(pk + (size_t)NTOK * 2560 + o2) = rr; *(u32x4v*)(pk + (size_t)NTOK * 2560 + o2 + 64) = kk8;
        *(u32x4v*)((bf16_t*)(p.ws + WS_SCV) + o) = pack8(v); *(u32x4v*)((bf16_t*)(p.ws + WS_SCBON) + o) = pack8(bn); }
}

__device__ __forceinline__ void m1_phase(const Params& p, int l, LAS unsigned char* lds, int rep, int mask) {
    unsigned* ctr = (unsigned*)(p.ws + WS_CTL) + 64 * (1 + 4 * l + 8 * rep);
    LAS int* slot = (LAS int*)(lds + LDS_SLOT);
#ifndef NO_MLSTM
    if (mask & 1) for (;;) { const int t = next_task(ctr, slot); if (t >= 272) break; const int u = t < 16 ? t + 256 : t - 16; mlstm_task(p, l, u >> 3, (u >> 2) & 1, u & 3, lds); }
#endif
#ifndef NO_ATTN
    if (mask & 2) for (;;) { const int t = next_task(ctr + 64, slot); if (t >= 640) break; attn_task(p, l, t, lds); }
#endif
#ifndef NO_PREP
    if (mask & 4) for (;;) { const int t = next_task(ctr + 128, slot); if (t >= 1280) break; rwkv_prep_task(p, l, t, lds); }
#endif
}

#ifdef EXP_LITE
#if EXP_LITE == 1
#define EXPY(v) (bf2f(sBt[(quad * 4 + j) * 24 + l15]) + bf2f(sGt[(16 + quad * 4 + j) * 24 + l15]) + sW[l15 + 16 * quad])
#elif EXP_LITE == 2
#define EXPY(v) (bf2f(sAt[(quad * 4 + j) * 72 + l15]) + bf2f(sX2[(quad * 4 + j) * 24 + l15]))
#else
#define EXPY(v) (bf2f(sPy[(quad * 4 + j) * 72 + 16 + l15]) + bf2f(sQy[(quad * 4 + j) * 24 + l15]))
#endif
#define EXPS(v) 0.f
#else
#define EXPY(v) (v)
#define EXPS(v) (v)
#endif
__device__ __forceinline__ bf16_t f2bf_sw(float f) { unsigned u = __float_as_uint(f); u += 0x7FFFu + ((u >> 16) & 1u); return (bf16_t)(u >> 16); }
__device__ __forceinline__ bf16x8 frag16(const LAS bf16_t* base, int row0, int ld, int lane) {
    bf16x8 z = {0, 0, 0, 0, 0, 0, 0, 0};
    if ((lane >> 4) < 2) z = *(const LAS bf16x8*)(base + (row0 + (lane & 15)) * ld + (lane >> 4) * 8);
    return z;
}
__device__ __forceinline__ void cp_task(const Params& p, int task, int lane, LAS unsigned char* wl) {
    int s, d, h, c, T;
    if (task < 8192) { s = task >> 8; d = (task >> 7) & 1; h = (task >> 4) & 7; c = task & 15; T = 256; }
    else { const int u = task - 8192; s = 32 + (u >> 10); d = (u >> 9) & 1; h = (u >> 6) & 7; c = u & 63; T = 1024; }
    const int tok0 = s < 32 ? s * 256 : NPT + (s - 32) * 1024, quad = lane >> 4, l15 = lane & 15;
    const long step = d == 0 ? 1 : -1; const int tfirst = d == 0 ? tok0 + 16 * c : tok0 + T - 1 - 16 * c;
    bf16_t* pk = (bf16_t*)(p.ws + WS_PK) + (size_t)d * NTOK * 2560 + ((size_t)tfirst * 8 + h) * 320;
    LAS bf16_t* sA = (LAS bf16_t*)wl;
    LAS bf16_t* sB = sA + 16 * 72, *sG = sB + 16 * 72, *sR = sG + 16 * 72;
    LAS float* mL1 = (LAS float*)(sR + 16 * 72);
    LAS bf16_t* sL2 = (LAS bf16_t*)(mL1 + 16 * 17);
    LAS bf16_t* sM1t = sL2 + 16 * 24;
    LAS bf16_t* sTt = sM1t + 16 * 24;
    LAS bf16_t* sAtil = sTt + 16 * 24;
    LAS bf16_t* sX2 = sTt;
    LAS bf16_t* oAt = sB;
    LAS bf16_t* oPy = sG;
    LAS bf16_t* oX2 = (LAS bf16_t*)mL1;
    LAS bf16_t* oQy = sL2;
    float bt[16], gt[16], W = 1.0f;
    { const int k = lane;
        float rr[16], kk[16], kt[16], ka[16], wm[16];
#pragma unroll
        for (int i = 0; i < 16; ++i) { const bf16_t* rec = pk + step * 2560 * i + k; rr[i] = bf2f(rec[0]); kk[i] = bf2f(rec[64]); kt[i] = bf2f(rec[128]); ka[i] = bf2f(rec[192]); wm[i] = bf2f(rec[256]); }
#pragma unroll
        for (int i = 0; i < 16; ++i) { const float Wp = W; W = W + W * wm[i]; const float iw = __builtin_amdgcn_rcpf(W);
            sA[i * 72 + k] = f2bf(Wp * kk[i]); bt[i] = ka[i] * iw; gt[i] = kt[i] * iw; sB[i * 72 + k] = f2bf(bt[i]); sG[i * 72 + k] = f2bf(gt[i]); sR[i * 72 + k] = f2bf(W * rr[i]); } }
    LDS_FENCE();
    f32x4 m2acc;
    { f32x4 a1 = {0.f, 0.f, 0.f, 0.f}, a2 = a1, a3 = a1, a4 = a1;
#pragma unroll
        for (int ks = 0; ks < 2; ++ks) { const bf16x8 fb = frag(sB, 0, 72, 32 * ks, lane), fg = frag(sG, 0, 72, 32 * ks, lane), fa = frag(sA, 0, 72, 32 * ks, lane), fr = frag(sR, 0, 72, 32 * ks, lane);
            a1 = MFMA16(fb, fa, a1); a2 = MFMA16(fg, fa, a2); a3 = MFMA16(fb, fr, a3); a4 = MFMA16(fg, fr, a4); }
#pragma unroll
        for (int j = 0; j < 4; ++j) { const int i = quad * 4 + j, t = l15;
            mL1[i * 17 + t] = i < t ? a1[j] : 0.f; sL2[i * 24 + t] = f2bf(i < t ? a2[j] : 0.f); sM1t[t * 24 + i] = f2bf(i <= t ? a3[j] : 0.f); m2acc[j] = i <= t ? a4[j] : 0.f; } }
    LDS_FENCE();
    { float Tr[16];
#pragma unroll
        for (int t = 0; t < 16; ++t) { float acc = (l15 == t) ? 1.0f : 0.0f;
#pragma unroll
            for (int i = 0; i < t; ++i) acc -= Tr[i] * mL1[i * 17 + t];
            Tr[t] = acc; }
        if (quad == 0) {
#pragma unroll
            for (int t = 0; t < 16; ++t) sTt[t * 24 + l15] = f2bf(Tr[t]); } }
    LDS_FENCE();
    const bf16x8 ftt = frag16(sTt, 0, 24, lane);
#pragma unroll
    for (int kt2 = 0; kt2 < 4; ++kt2) {
        u32x4v aw = {0u, 0u, 0u, 0u};
        if (quad < 2) { const LAS bf16_t* col = sA + (quad * 8) * 72 + 16 * kt2 + l15;
            aw.x = (unsigned)col[0] | ((unsigned)col[72] << 16); aw.y = (unsigned)col[144] | ((unsigned)col[216] << 16); aw.z = (unsigned)col[288] | ((unsigned)col[360] << 16); aw.w = (unsigned)col[432] | ((unsigned)col[504] << 16); }
        f32x4 acc = {0.f, 0.f, 0.f, 0.f};
        acc = MFMA16(__builtin_bit_cast(bf16x8, aw), ftt, acc);
#pragma unroll
        for (int j = 0; j < 4; ++j) { const int k = 16 * kt2 + quad * 4 + j; const bf16_t v = f2bf_sw(acc[j]); sAtil[k * 24 + l15] = v; oAt[l15 * 72 + k] = v; }
    }
    { f32x4 acc = {0.f, 0.f, 0.f, 0.f};
        acc = MFMA16(frag16(sL2, 0, 24, lane), ftt, acc);
#pragma unroll
        for (int j = 0; j < 4; ++j) { const bf16_t v = f2bf_sw(acc[j]); sX2[(quad * 4 + j) * 24 + l15] = v; oX2[l15 * 24 + quad * 4 + j] = v; } }
    LDS_FENCE();
    const bf16x8 fm1 = frag16(sM1t, 0, 24, lane);
#pragma unroll
    for (int kt2 = 0; kt2 < 4; ++kt2) { f32x4 acc = {0.f, 0.f, 0.f, 0.f};
        acc = MFMA16(frag16(sAtil, 16 * kt2, 24, lane), fm1, acc);
#pragma unroll
        for (int j = 0; j < 4; ++j) { const int k = 16 * kt2 + quad * 4 + j; oPy[l15 * 72 + k] = f2bf(bf2f(sR[l15 * 72 + k]) - acc[j]); } }
    { f32x4 acc = {0.f, 0.f, 0.f, 0.f};
        acc = MFMA16(frag16(sX2, 0, 24, lane), fm1, acc);
#pragma unroll
        for (int j = 0; j < 4; ++j) oQy[l15 * 24 + quad * 4 + j] = f2bf(m2acc[j] - acc[j]); }
    LDS_FENCE();
    { float bb8[8]; const int k = lane; bf16_t* rec = pk + step * 2560 * (k >> 2);
#pragma unroll
        for (int hh = 0; hh < 2; ++hh) {
#pragma unroll
            for (int e = 0; e < 8; ++e) bb8[e] = bt[8 * hh + e];
            *(u32x4v*)(rec + 128 + (k & 3) * 16 + 8 * hh) = pack8(bb8);
#pragma unroll
            for (int e = 0; e < 8; ++e) bb8[e] = gt[8 * hh + e];
            *(u32x4v*)(rec + 192 + (k & 3) * 16 + 8 * hh) = pack8(bb8); }
        ((float*)(rec + 288))[k & 3] = W; }
#pragma unroll
    for (int it = 0; it < 2; ++it) { const int f = lane + 64 * it, t = f >> 3, q = f & 7; bf16_t* rec = pk + step * 2560 * t;
        *(u32x4v*)(rec + 8 * q) = *(const LAS u32x4v*)(oAt + t * 72 + 8 * q); *(u32x4v*)(rec + 64 + 8 * q) = *(const LAS u32x4v*)(oPy + t * 72 + 8 * q); }
    if (lane < 32) { const int t = lane >> 1, q = lane & 1; bf16_t* rec = pk + step * 2560 * t;
        *(u32x4v*)(rec + 256 + 8 * q) = *(const LAS u32x4v*)(oX2 + t * 24 + 8 * q); *(u32x4v*)(rec + 272 + 8 * q) = *(const LAS u32x4v*)(oQy + t * 24 + 8 * q); }
    LDS_FENCE();
}
constexpr int CP_LDS = 16 * 72 * 2 * 4 + 16 * 17 * 4 + (16 * 24 * 3 + 64 * 24 + 16 * 24) * 2 + 16 * 72 * 2 * 2 + 16 * 24 * 2 * 2;

__device__ __forceinline__ void ap_task(const Params& p, int l, int task, int lane, LAS unsigned char* wl) {
    int s, d, h, rt;
    if (task < 128) { s = 32 + (task >> 6); d = (task >> 5) & 1; h = (task >> 2) & 7; rt = task & 3; }
    else { const int u = task - 128; s = u >> 6; d = (u >> 5) & 1; h = (u >> 2) & 7; rt = u & 3; }
    const int T = s < 32 ? 256 : 1024, nch = T / 16, tok0 = s < 32 ? s * 256 : NPT + (s - 32) * 1024, quad = lane >> 4, l15 = lane & 15;
    const long step = d == 0 ? 1 : -1; const int tstart = d == 0 ? tok0 : tok0 + T - 1;
    const bf16_t* pk = (const bf16_t*)(p.ws + WS_PK) + (size_t)d * NTOK * 2560 + ((size_t)tstart * 8 + h) * 320;
    const bf16_t* pv = (const bf16_t*)(p.ws + WS_SCV) + (size_t)tstart * 512 + h * 64 + 16 * rt;
    float* yd = (float*)(p.ws + WS_YD) + (size_t)d * NTOK * 512 + (size_t)tstart * 512 + h * 64 + 16 * rt;
    constexpr int IS = 328;
    LAS bf16_t* img = (LAS bf16_t*)wl;
    LAS bf16_t* sS = img + 16 * IS;
    LAS bf16_t* sCm = sS + 16 * 72;
    f32x4 S[4];
    if (s >= 32) { const float* s0 = p.in[I_SRW] + ((((size_t)((s - 32) * 2 + l) * 2 + d) * 8 + h) * 64 + 16 * rt) * 64;
#pragma unroll
        for (int tn = 0; tn < 4; ++tn)
#pragma unroll
            for (int j = 0; j < 4; ++j) S[tn][j] = s0[(quad * 4 + j) * 64 + 16 * tn + l15]; }
    else {
#pragma unroll
        for (int tn = 0; tn < 4; ++tn) S[tn] = (f32x4){0.f, 0.f, 0.f, 0.f}; }
    const bf16_t* gsrc = pk + step * 2560 * (lane >> 2) + 8 * (lane & 3);
    LAS bf16_t* ldst = img + (lane >> 2) * IS + 8 * (lane & 3);
    u32x4v rawA[10], rawB[10]; bf16_t vrA[8], vrB[8];
#define AP_LOAD(raw, vraw, CH) do { int chv = (CH); asm volatile("" : "+v"(chv)); const bf16_t* cb = gsrc + step * 2560 * (16 * chv); \
        _Pragma("unroll") for (int jj = 0; jj < 10; ++jj) raw[jj] = *(const u32x4v*)(cb + 32 * jj); \
        if (quad < 2) { _Pragma("unroll") for (int e = 0; e < 8; ++e) vraw[e] = pv[step * 512 * (16 * chv + quad * 8 + e) + l15]; } } while (0)
#define AP_STAGE(raw) do { _Pragma("unroll") for (int jj = 0; jj < 10; ++jj) *(LAS u32x4v*)(ldst + 32 * jj) = raw[jj]; } while (0)
    AP_LOAD(rawA, vrA, 0);
    if (nch > 1) AP_LOAD(rawB, vrB, 1);
    const LAS bf16_t* pBt = img + (l15 >> 2) * IS + 128 + (l15 & 3) * 16 + quad * 8;
    const LAS float* pW = (const LAS float*)(img + (l15 >> 2) * IS + 288) + (l15 & 3);
#define AP_CHUNK(raw, vraw, CC) do { const int c = (CC); \
        AP_STAGE(raw); \
        u32x4v vw = {0u, 0u, 0u, 0u}; \
        if (quad < 2) { vw.x = (unsigned)vraw[0] | ((unsigned)vraw[1] << 16); vw.y = (unsigned)vraw[2] | ((unsigned)vraw[3] << 16); vw.z = (unsigned)vraw[4] | ((unsigned)vraw[5] << 16); vw.w = (unsigned)vraw[6] | ((unsigned)vraw[7] << 16); } \
        asm volatile("" : "+v"(vw)); \
        if (c + 2 < nch) AP_LOAD(raw, vraw, c + 2); \
        ap_compute(c, vw); } while (0)
    auto ap_compute = [&](int c, u32x4v vw) {
        const bf16x8 va = __builtin_bit_cast(bf16x8, vw);
#pragma unroll
        for (int tn = 0; tn < 4; ++tn) { const unsigned w01 = pk2(S[tn][0], S[tn][1]), w23 = pk2(S[tn][2], S[tn][3]); LAS bf16_t* ds = sS + (quad * 4) * 72 + 16 * tn + l15;
            ds[0] = (bf16_t)(w01 & 0xffff); ds[72] = (bf16_t)(w01 >> 16); ds[144] = (bf16_t)(w23 & 0xffff); ds[216] = (bf16_t)(w23 >> 16); }
        LDS_FENCE();
        f32x4 cm = {0.f, 0.f, 0.f, 0.f}, yy = {0.f, 0.f, 0.f, 0.f};
#pragma unroll
        for (int ks = 0; ks < 2; ++ks) { const bf16x8 fs = frag(sS, 0, 72, 32 * ks, lane); cm = MFMA16(fs, frag(img, 0, IS, 32 * ks, lane), cm); yy = MFMA16(fs, frag(img + 64, 0, IS, 32 * ks, lane), yy); }
        cm = MFMA16(va, frag16(img + 256, 0, IS, lane), cm); yy = MFMA16(va, frag16(img + 272, 0, IS, lane), yy);
#pragma unroll
        for (int j = 0; j < 4; ++j) { yd[step * 512 * (16 * c + l15) + quad * 4 + j] = yy[j]; sCm[(quad * 4 + j) * 24 + l15] = f2bf_sw(cm[j]); }
        LDS_FENCE();
        const bf16x8 fc = frag16(sCm, 0, 24, lane);
#pragma unroll
        for (int tn = 0; tn < 4; ++tn) { f32x4 ab = {0.f, 0.f, 0.f, 0.f}, ag = ab;
            bf16x8 fb = {0, 0, 0, 0, 0, 0, 0, 0}, fg = fb;
            if (quad < 2) { fb = *(const LAS bf16x8*)(pBt + tn * 4 * IS); fg = *(const LAS bf16x8*)(pBt + tn * 4 * IS + 64); }
            ab = MFMA16(fc, fb, ab); ag = MFMA16(va, fg, ag);
            const float w16 = pW[tn * 2 * IS];
#pragma unroll
            for (int j = 0; j < 4; ++j) S[tn][j] = (S[tn][j] - ab[j] + ag[j]) * w16; }
        LDS_FENCE();
    };
    for (int c2 = 0; c2 < nch; c2 += 2) { AP_CHUNK(rawA, vrA, c2); AP_CHUNK(rawB, vrB, c2 + 1); }
#undef AP_CHUNK
#undef AP_LOAD
#undef AP_STAGE
    if (s < 32) { float* so = p.out + O_RW + ((((size_t)(s * 2 + l) * 2 + d) * 8 + h) * 64 + 16 * rt) * 64;
#pragma unroll
        for (int tn = 0; tn < 4; ++tn)
#pragma unroll
            for (int j = 0; j < 4; ++j) so[(quad * 4 + j) * 64 + 16 * tn + l15] = S[tn][j]; }
}
constexpr int AP_LDS = (16 * 72 * 2 + 64 * 24 * 2 + 16 * 24 * 2) * 2 + 64 * 4 + (16 * 72 + 16 * 24) * 2;

typedef float f32x2 __attribute__((ext_vector_type(2)));
__device__ __forceinline__ void m2_phase(const Params& p, int l, int rep, LAS unsigned char* lds, const XcdBarrier& xbar) {
    const int tid_ = opaque_tid(); const int lane = tid_ & 63, wave = tid_ >> 6;
    LAS unsigned char* wl = lds + wave * 16384;
    LAS unsigned* lq = (LAS unsigned*)(lds + LDS_SLOT + 32);
    if (tid_ == 0) *lq = 0u;
    for (int t = blockIdx.x * 8 + wave; t < 10240; t += gridDim.x * 8) cp_task(p, t, lane, wl);
    xcd_barrier(xbar);
    const int G = gridDim.x, b = blockIdx.x;
    const int nS = b < 128 ? (128 - b + G - 1) / G : 0, nP = b < 2048 ? (2048 - b + G - 1) / G : 0;
    for (;;) {
        int k = 0; if (lane == 0) k = (int)__hip_atomic_fetch_add(lq, 1u, __ATOMIC_RELAXED, __HIP_MEMORY_SCOPE_WORKGROUP);
        k = __builtin_amdgcn_readfirstlane(k);
        if (k >= nS + nP) break;
        ap_task(p, l, k < nS ? b + k * G : 128 + b + (k - nS) * G, lane, wl);
    }
}

__device__ __forceinline__ void m3_phase(const Params& p, int l) {
    const int tid_ = opaque_tid(); const int lane = tid_ & 63, gw = blockIdx.x * 8 + (tid_ >> 6), NGW = gridDim.x * 8;
    const bf16_t* proj = (const bf16_t*)(p.ws + WS_PROJ);
    bf16_t* mixed = (bf16_t*)(p.ws + WS_UM);
    const int c = lane * 8;
    for (int tok = gw; tok < NTOK; tok += NGW) {
        const size_t o = (size_t)tok * 512 + c;
        {
            float y0[8], y1[8], g[8], bb[8], bn[8], gt[8], out[8];
            ld8f((const float*)(p.ws + WS_YD) + o, y0); ld8f((const float*)(p.ws + WS_YD) + (size_t)NTOK * 512 + o, y1);
            float s = 0.f;
#pragma unroll
            for (int e = 0; e < 8; ++e) { y0[e] += y1[e]; s += y0[e]; }
            s += __shfl_xor(s, 1); s += __shfl_xor(s, 2); s += __shfl_xor(s, 4);
            const float mu = s * (1.0f / 64.0f); float q = 0.f;
#pragma unroll
            for (int e = 0; e < 8; ++e) { y0[e] -= mu; q += y0[e] * y0[e]; }
            q += __shfl_xor(q, 1); q += __shfl_xor(q, 2); q += __shfl_xor(q, 4);
            const float rs = rsqrtf(q * (1.0f / 64.0f) + 64e-5f);
            ld8f(p.in[I_RGG] + l * 512 + c, g); ld8f(p.in[I_RGB] + l * 512 + c, bb);
            unpack8(*(const u32x4v*)((const bf16_t*)(p.ws + WS_SCBON) + o), bn);
            unpack8(*(const u32x4v*)(proj + (size_t)tok * NP + A_GATE + c), gt);
#pragma unroll
            for (int e = 0; e < 8; ++e) out[e] = (y0[e] * rs * g[e] + bb[e] + bn[e]) * siluf_(gt[e]);
            *(u32x4v*)(mixed + (size_t)tok * DM + c) = pack8(out);
        }
        {
            float h0[8], h1[8], g[8], bb[8], og[8], gt[8], out[8];
            ld8f((const float*)(p.ws + WS_HD) + o, h0); ld8f((const float*)(p.ws + WS_HD) + (size_t)NTOK * 512 + o, h1);
            unpack8(*(const u32x4v*)(proj + (size_t)tok * NP + B_O + c), og);
            float s = 0.f;
#pragma unroll
            for (int e = 0; e < 8; ++e) { h0[e] = (h0[e] + h1[e]) * sigmoidf_(og[e]); s += h0[e]; }
            s += __shfl_xor(s, 1); s += __shfl_xor(s, 2); s += __shfl_xor(s, 4); s += __shfl_xor(s, 8);
            const float mu = s * (1.0f / 128.0f); float q = 0.f;
#pragma unroll
            for (int e = 0; e < 8; ++e) { h0[e] -= mu; q += h0[e] * h0[e]; }
            q += __shfl_xor(q, 1); q += __shfl_xor(q, 2); q += __shfl_xor(q, 4); q += __shfl_xor(q, 8);
            const float rs = rsqrtf(q * (1.0f / 128.0f) + 1e-5f);
            ld8f(p.in[I_MGG] + l * 512 + c, g); ld8f(p.in[I_MGB] + l * 512 + c, bb);
            unpack8(*(const u32x4v*)(proj + (size_t)tok * NP + B_GATE + c), gt);
#pragma unroll
            for (int e = 0; e < 8; ++e) out[e] = (h0[e] * rs * g[e] + bb[e]) * siluf_(gt[e]);
            *(u32x4v*)(mixed + (size_t)tok * DM + 512 + c) = pack8(out);
        }
    }
}

__device__ __forceinline__ void ln_phase(const Params& p, int l) {
    const int tid_ = opaque_tid(); const int lane = tid_ & 63, gw = blockIdx.x * 8 + (tid_ >> 6), NGW = gridDim.x * 8;
    for (int tok = gw; tok < NTOK; tok += NGW) {
        float* zr = p.out + O_Y + (size_t)tok * DM;
        float v[4][8]; float s = 0.f;
#pragma unroll
        for (int j = 0; j < 4; ++j) { ld8f(zr + j * 512 + lane * 8, v[j]);
#pragma unroll
            for (int e = 0; e < 8; ++e) s += v[j][e]; }
#pragma unroll
        for (int o = 1; o < 64; o <<= 1) s += __shfl_xor(s, o);
        const float mu = s * (1.0f / 2048.0f); float q = 0.f;
#pragma unroll
        for (int j = 0; j < 4; ++j)
#pragma unroll
            for (int e = 0; e < 8; ++e) { v[j][e] -= mu; q += v[j][e] * v[j][e]; }
#pragma unroll
        for (int o = 1; o < 64; o <<= 1) q += __shfl_xor(q, o);
        const float rs = rsqrtf(q * (1.0f / 2048.0f) + 1e-5f);
        const float* mod = (const float*)(p.ws + WS_MOD) + (size_t)(3 + mod_row(tok)) * 6144;
        bf16_t* ur = (bf16_t*)(p.ws + WS_UM) + (size_t)tok * DM;
#pragma unroll
        for (int j = 0; j < 4; ++j) { const int c = j * 512 + lane * 8; float g[8], bb[8], y[8];
            ld8f(p.in[I_LNG] + l * DM + c, g); ld8f(p.in[I_LNB] + l * DM + c, bb);
#pragma unroll
            for (int e = 0; e < 8; ++e) y[e] = v[j][e] * rs * g[e] + bb[e];
            *(float4*)(zr + c) = make_float4(y[0], y[1], y[2], y[3]); *(float4*)(zr + c + 4) = make_float4(y[4], y[5], y[6], y[7]);
            if (l == 0) { float sh[8], sc[8], o[8]; ld8f(mod + c, sh); ld8f(mod + 2048 + c, sc);
#pragma unroll
                for (int e = 0; e < 8; ++e) o[e] = y[e] * (1.0f + sc[e]) + sh[e];
                *(u32x4v*)(ur + c) = pack8(o); } }
    }
}

#ifndef DUP_P0B
#define DUP_P0B 0
#endif
#ifndef DUP_SYNC
#define DUP_SYNC 0
#endif
#ifndef DUP_M3
#define DUP_M3 0
#endif
#ifndef DUP_G2
#define DUP_G2 0
#endif
#ifndef DUP_P0
#define DUP_P0 0
#endif
#ifndef DUP_M1
#define DUP_M1 0
#endif
#ifndef DUP_M2
#define DUP_M2 0
#endif
#ifndef DUP_G1
#define DUP_G1 0
#endif
#ifndef DUP_MASK
#define DUP_MASK 7
#endif
#ifndef PH_ALL
#define PH_ALL 1
#endif
#ifndef PH_P0
#define PH_P0 PH_ALL
#endif
#ifndef PH_G1
#define PH_G1 PH_ALL
#endif
#ifndef PH_M1
#define PH_M1 PH_ALL
#endif
#ifndef PH_M2
#define PH_M2 PH_ALL
#endif
#ifndef PH_M3
#define PH_M3 PH_ALL
#endif
#ifndef PH_G2
#define PH_G2 PH_ALL
#endif
#ifndef PH_LN
#define PH_LN PH_ALL
#endif
__global__ void __launch_bounds__(NTHREADS) hybrid_fwd(Params p) {
    extern __shared__ __attribute__((aligned(16))) unsigned char smem[];
    LAS unsigned char* lds = (LAS unsigned char*)smem;
    cg::grid_group grid = cg::this_grid();
    volatile LAS unsigned* xst = (volatile LAS unsigned*)(lds + LDS_SLOT + 16);
    if (threadIdx.x == 0) { xst[0] = 0u; xst[1] = 0u; }
    __syncthreads();
    const XcdBarrier xbar = xcd_barrier_post((unsigned*)(p.ws + WS_BAR), xst);
#define GSYNC() xcd_barrier(xbar)
#if PH_P0
    for (int rep = 0; rep < 1 + DUP_P0; ++rep) { p0_phase(p, lds, rep); if (rep < DUP_P0) GSYNC(); }
#endif
    grid.sync();
#if PH_P0
    for (int rep = 0; rep < 1 + DUP_P0B; ++rep) p0b_phase(p);
#endif
    GSYNC();
    for (int i = 0; i < DUP_SYNC; ++i) GSYNC();
    for (int l = 0; l < 2; ++l) {
#if PH_G1
        for (int rep = 0; rep < 1 + DUP_G1; ++rep) {
            pg8::Gemm g; g.A = (const bf16_t*)(p.ws + WS_UM); g.Bt = (const bf16_t*)(p.ws + WS_WIN) + (size_t)l * NP * DM; g.M = NTOK; g.N = NP; g.K = DM;
            pg8::StaticOrder S; S.init(NTOK, NP, gridDim.x, blockIdx.x);
            EpiIn E; E.proj = (bf16_t*)(p.ws + WS_PROJ); E.gates = (float*)(p.ws + WS_GATES); E.newk = p.out + O_NK; E.newv = p.out + O_NV; E.rope = (const float*)(p.ws + WS_ROPE); E.layer = l;
            pg8::gemm_phase<EpiIn, pg8::StaticOrder, false>(lds, g, S, E, nullptr);
            if (rep < DUP_G1) GSYNC();
        }
#endif
        GSYNC();
#if PH_M1
        for (int rep = 0; rep < 1 + DUP_M1; ++rep) { m1_phase(p, l, lds, rep, rep == 0 ? 7 : DUP_MASK); if (rep < DUP_M1) GSYNC(); }
#endif
        GSYNC();
#if PH_M2
        for (int rep = 0; rep < 1 + DUP_M2; ++rep) { m2_phase(p, l, rep, lds, xbar); if (rep < DUP_M2) GSYNC(); }
#endif
        GSYNC();
#if PH_M3
        for (int rep = 0; rep < 1 + DUP_M3; ++rep) m3_phase(p, l);
#endif
        GSYNC();
#if PH_G2
        for (int rep = 0; rep < 1 + (l == 0 ? DUP_G2 : 0); ++rep) {
            pg8::Gemm g; g.A = (const bf16_t*)(p.ws + WS_UM); g.Bt = (const bf16_t*)(p.ws + WS_WOUT) + (size_t)l * DM * DM; g.M = NTOK; g.N = DM; g.K = DM;
            pg8::StaticOrder S; S.init(NTOK, DM, gridDim.x, blockIdx.x);
            EpiOut E; E.xp = p.in[I_XP]; E.xs = p.in[I_XS]; E.mod = (const float*)(p.ws + WS_MOD) + (size_t)l * 3 * 6144; E.y = p.out + O_Y; E.layer = l;
            pg8::gemm_phase<EpiOut, pg8::StaticOrder, false>(lds, g, S, E, nullptr);
            if (rep < (l == 0 ? DUP_G2 : 0)) GSYNC();
        }
#endif
        GSYNC();
#if PH_LN
        ln_phase(p, l);
#endif
        if (l == 0) GSYNC();
    }
}

extern "C" void kernel_launch(void* const* d_in, const int* in_sizes, int n_in, void* d_out, int out_size, void* d_ws, size_t ws_size, hipStream_t stream) {
    static int grid_blocks = 0;
    if (grid_blocks == 0) {
        if (n_in != 38 || ws_size < WS_END) { fprintf(stderr, "kernel_launch: unexpected n_in %d / ws_size %zu (need %zu)\n", n_in, ws_size, (size_t)WS_END); grid_blocks = -1; return; }
        int dev = 0, cus = 0, per_cu = 0;
        hipGetDevice(&dev);
        hipDeviceGetAttribute(&cus, hipDeviceAttributeMultiprocessorCount, dev);
        hipFuncSetAttribute((const void*)hybrid_fwd, hipFuncAttributeMaxDynamicSharedMemorySize, LDS_BYTES);
        hipOccupancyMaxActiveBlocksPerMultiprocessor(&per_cu, (const void*)hybrid_fwd, NTHREADS, LDS_BYTES);
        if (per_cu < 1) { fprintf(stderr, "kernel_launch: occupancy query gives %d blocks per CU\n", per_cu); per_cu = 1; }
        grid_blocks = cus * per_cu;
    }
    if (grid_blocks < 0) return;
    Params p{};
    for (int i = 0; i < 38; ++i) p.in[i] = (const float*)d_in[i];
    p.out = (float*)d_out; p.ws = (unsigned char*)d_ws;
    hipMemsetAsync(d_ws, 0, 32768, stream);
    void* args[] = {&p};
    hipError_t e = hipLaunchCooperativeKernel((const void*)hybrid_fwd, dim3(grid_blocks), dim3(NTHREADS), args, LDS_BYTES, stream);
    if (e != hipSuccess) fprintf(stderr, "cooperative launch failed: %s (grid %d)\n", hipGetErrorString(e), grid_blocks);
}
```

```cpp
#include <hip/hip_runtime.h>
#include <hip/hip_cooperative_groups.h>
#include <cstdio>
#include <cstdint>
namespace cg = cooperative_groups;
namespace pg8 {
#define PG8_LAS __attribute__((address_space(3)))
typedef unsigned short bf16_t;
typedef short bf16x8 __attribute__((ext_vector_type(8)));
typedef float f32x4 __attribute__((ext_vector_type(4)));
typedef unsigned u32x4 __attribute__((ext_vector_type(4)));
constexpr int BM = 256, BK = 64, HALF = 128, HTB = HALF * BK * 2  , STAGE_BYTES = 8 * HTB, NXCD = 8, WGM = 8;

__host__ __device__ __forceinline__ int lds_byte(int r, int c) { const int st = (r >> 4) * 2 + (c >> 5), rr = r & 15, cc = c & 31, ob = rr * 64 + cc * 2; return st * 1024 + (ob ^ (((ob >> 9) & 1) << 5)); }
__host__ __device__ __forceinline__ void stage_rc(int b, int& R, int& C) { const int st = b / 1024, sb = b % 1024, swz = sb ^ (((sb >> 9) & 1) << 5); R = (st >> 1) * 16 + swz / 64; C = (st & 1) * 32 + (swz % 64) / 2; }
__host__ __device__ __forceinline__ int perm32(int rho) { const int n = rho >> 4, i = rho & 15; return 8 * (i >> 2) + 4 * n + (i & 3); }

struct Unit { int pm, pn; };
struct Gemm { const bf16_t* A; const bf16_t* Bt; int M, N, K; };

struct StaticOrder {
    int nM, nN, nwg, G, c;
    __host__ __device__ void init(int M, int N, int G_, int c_) { nM = M / BM; nN = N / BM; nwg = nM * nN; G = G_; c = c_; }
    __host__ __device__ bool next(int i, Unit& u) const {
        const long L = (long)i * G + c; if (L >= nwg) return false;
        int wgid = (int)L; { const int q = nwg / NXCD, r = nwg % NXCD, xcd = wgid % NXCD, off = wgid / NXCD; wgid = (xcd < r ? xcd * (q + 1) : r * (q + 1) + (xcd - r) * q) + off; }
        const int nig = WGM * nN, gid = wgid / nig, fm = gid * WGM, gsz = (nM - fm) < WGM ? (nM - fm) : WGM;
        u.pm = fm + ((wgid % nig) % gsz); u.pn = (wgid % nig) / gsz; return true;
    }
    __device__ __forceinline__ void a_ready(const Unit&) const {}
    __device__ __forceinline__ void done(const Unit&) const {}
};
__device__ __forceinline__ unsigned cvt_pk_bf16(float lo, float hi) { unsigned r; asm volatile("v_cvt_pk_bf16_f32 %0, %1, %2" : "=v"(r) : "v"(lo), "v"(hi)); return r; }
template <class Epi, class Sched, bool STAMP = false>
__device__ __forceinline__ void gemm_phase(PG8_LAS unsigned char* lds, const Gemm g, const Sched& S, const Epi& E, unsigned long long* stamps) {
    int tid = threadIdx.x; asm volatile("" : "+v"(tid)); const int wid = __builtin_amdgcn_readfirstlane(tid >> 6), lane = tid & 63, wr = wid >> 2, wc = wid & 3, fr = lane & 15, fq = lane >> 4;
    const int K = g.K, nt = K / BK;
    int ts_lo = 0, ts_hi = 0, nts = 0; const unsigned long long rt_entry = STAMP ? (unsigned long long)wall_clock64() : 0ull;
#define PG8_STAMP() do { if (STAMP && wid == 0 && nts < 64) { const unsigned long long _c = (unsigned long long)clock64(); \
        ts_lo = (lane == nts) ? (int)(unsigned)_c : ts_lo; ts_hi = (lane == nts) ? (int)(unsigned)(_c >> 32) : ts_hi; ++nts; } } while (0)
    PG8_STAMP();
    unsigned voffA[2], voffB[2];
#pragma unroll
    for (int i = 0; i < 2; ++i) { int R, C; stage_rc(tid * 16 + i * 8192, R, C); const int Rb = Epi::PERM ? ((R & ~31) + perm32(R & 31)) : R;
        voffA[i] = (unsigned)(R * K + C) * 2u; voffB[i] = (unsigned)(Rb * K + C) * 2u; }
    const size_t kstep = (size_t)(BK * 2);
    const size_t hstep = (size_t)HALF * K * 2;
    const size_t tstep = 2 * hstep;
    const unsigned ldsw = (unsigned)wid * 1024u;
    const int aoff = lds_byte(wr * 64 + fr, fq * 8), boff = lds_byte(wc * 32 + fr, fq * 8);
#define PG8_SA(b, h) (((b) * 2 + (h)) * HTB)
#define PG8_SB(b, h) ((4 + (b) * 2 + (h)) * HTB)
#define PG8_STAGE(bufoff, gbase, voff) do { _Pragma("unroll") for (int _i = 0; _i < 2; ++_i) \
        __builtin_amdgcn_global_load_lds((const unsigned*)((const char*)(gbase) + (voff)[_i]), (PG8_LAS unsigned*)(lds + (bufoff) + ldsw + _i * 8192), 16, 0, 0); } while (0)
#define PG8_LDA(dst, b, h) do { _Pragma("unroll") for (int m = 0; m < 4; ++m) _Pragma("unroll") for (int k = 0; k < 2; ++k) dst[m][k] = *(const PG8_LAS bf16x8*)(lds + PG8_SA(b, h) + aoff + m * 2048 + k * 1024); } while (0)
#define PG8_LDB(dst, b, h) do { _Pragma("unroll") for (int n = 0; n < 2; ++n) _Pragma("unroll") for (int k = 0; k < 2; ++k) dst[n][k] = *(const PG8_LAS bf16x8*)(lds + PG8_SB(b, h) + boff + n * 2048 + k * 1024); } while (0)
#define PG8_MMA(ai, bj, At, Bt) do { __builtin_amdgcn_s_setprio(1); _Pragma("unroll") for (int m = 0; m < 4; ++m) _Pragma("unroll") for (int n = 0; n < 2; ++n) _Pragma("unroll") for (int k = 0; k < 2; ++k) \
        acc[ai][bj][m][n] = __builtin_amdgcn_mfma_f32_16x16x32_bf16(Bt[n][k], At[m][k], acc[ai][bj][m][n], 0, 0, 0); __builtin_amdgcn_s_setprio(0); } while (0)
#define PG8_WAIT_V(n) asm volatile("s_waitcnt vmcnt(" #n ")" ::: "memory")
#define PG8_WAIT_L(n) asm volatile("s_waitcnt lgkmcnt(" #n ")" ::: "memory")
#define PG8_BAR __builtin_amdgcn_s_barrier()
#define PG8_SCHED __builtin_amdgcn_sched_barrier(0)
    Unit cur, nxt; int ui = 0;
    if (!S.next(0, cur)) return;
    f32x4 acc[2][2][4][2];
#pragma unroll
    for (int a = 0; a < 2; ++a)
#pragma unroll
        for (int b = 0; b < 2; ++b)
#pragma unroll
            for (int m = 0; m < 4; ++m)
#pragma unroll
                for (int n = 0; n < 2; ++n) acc[a][b][m][n] = (f32x4){0.f, 0.f, 0.f, 0.f};
    bf16x8 At[4][2], B0[2][2], B1[2][2];
    const char* cA = (const char*)g.A + (size_t)cur.pm * tstep; const char* cB = (const char*)g.Bt + (size_t)cur.pn * tstep;
    S.a_ready(cur);
    PG8_STAGE(PG8_SB(0, 0), cB, voffB); PG8_STAGE(PG8_SA(0, 0), cA, voffA); PG8_STAGE(PG8_SB(0, 1), cB + hstep, voffB); PG8_STAGE(PG8_SA(0, 1), cA + hstep, voffA);
    if (wr == 1) PG8_BAR;
    PG8_WAIT_V(4); PG8_BAR;
    PG8_STAGE(PG8_SB(1, 0), cB + kstep, voffB); PG8_STAGE(PG8_SA(1, 0), cA + kstep, voffA); PG8_STAGE(PG8_SB(1, 1), cB + hstep + kstep, voffB);
    PG8_WAIT_V(6); PG8_BAR;
    PG8_STAMP();
    for (;;) {
        const bool has_next = S.next(ui + 1, nxt);
        const char* nA = has_next ? (const char*)g.A + (size_t)nxt.pm * tstep : cA; const char* nB = has_next ? (const char*)g.Bt + (size_t)nxt.pn * tstep : cB;
        for (int t = 0; t < nt; t += 2) {
            const bool last = (t == nt - 2);
            const char* a1 = cA + (size_t)(t + 1) * kstep;
            const char* a2 = last ? nA : cA + (size_t)(t + 2) * kstep; const char* b2 = last ? nB : cB + (size_t)(t + 2) * kstep;
            const char* a3 = a2 + kstep; const char* b3 = b2 + kstep;
            if (last && has_next) S.a_ready(nxt);
            PG8_LDB(B0, 0, 0); PG8_SCHED; PG8_LDA(At, 0, 0); PG8_STAGE(PG8_SA(1, 1), a1 + hstep, voffA);
            PG8_WAIT_L(8); PG8_BAR; PG8_WAIT_L(0); PG8_MMA(0, 0, At, B0); PG8_BAR; PG8_SCHED;
            PG8_LDB(B1, 0, 1); PG8_STAGE(PG8_SB(0, 0), b2, voffB);
            PG8_BAR; PG8_WAIT_L(0); PG8_MMA(0, 1, At, B1); PG8_BAR;
            PG8_LDA(At, 0, 1); PG8_STAGE(PG8_SA(0, 0), a2, voffA);
            PG8_BAR; PG8_WAIT_L(0); PG8_MMA(1, 0, At, B0); PG8_BAR; PG8_SCHED;
            PG8_STAGE(PG8_SB(0, 1), b2 + hstep, voffB);
            PG8_WAIT_V(6); PG8_BAR; PG8_MMA(1, 1, At, B1); PG8_BAR;
            PG8_LDB(B0, 1, 0); PG8_SCHED; PG8_LDA(At, 1, 0); PG8_STAGE(PG8_SA(0, 1), a2 + hstep, voffA);
            PG8_WAIT_L(8); PG8_BAR; PG8_WAIT_L(0); PG8_MMA(0, 0, At, B0); PG8_BAR; PG8_SCHED;
            PG8_LDB(B1, 1, 1); PG8_STAGE(PG8_SB(1, 0), b3, voffB);
            PG8_BAR; PG8_WAIT_L(0); PG8_MMA(0, 1, At, B1); PG8_BAR;
            PG8_LDA(At, 1, 1); PG8_STAGE(PG8_SA(1, 0), a3, voffA);
            PG8_BAR; PG8_WAIT_L(0); PG8_MMA(1, 0, At, B0); PG8_BAR; PG8_SCHED;
            PG8_STAGE(PG8_SB(1, 1), b3 + hstep, voffB);
            PG8_WAIT_V(6); PG8_BAR; PG8_MMA(1, 1, At, B1); PG8_BAR;
        }
        PG8_STAMP();
        if constexpr (!Epi::AFTER_DRAIN) { E(acc, cur, wr, wc, fr, fq); S.done(cur); }
        PG8_STAMP();
        if (!has_next) break;
#pragma unroll
        for (int a = 0; a < 2; ++a)
#pragma unroll
            for (int b = 0; b < 2; ++b)
#pragma unroll
                for (int m = 0; m < 4; ++m)
#pragma unroll
                    for (int n = 0; n < 2; ++n) acc[a][b][m][n] = (f32x4){0.f, 0.f, 0.f, 0.f};
        cur = nxt; cA = nA; cB = nB; ++ui;
    }
    PG8_WAIT_V(0);
    if (wr == 0) PG8_BAR;
    PG8_BAR;
    if constexpr (Epi::AFTER_DRAIN) { E.fused(acc, cur, wr, wc, fr, fq, lds, wid, lane); S.done(cur); }
    PG8_STAMP();
    if (STAMP && wid == 0) { stamps[lane] = lane < nts ? (((unsigned long long)(unsigned)ts_hi << 32) | (unsigned)ts_lo) : 0ull;
        if (lane == 62) stamps[62] = rt_entry; if (lane == 63) stamps[63] = (unsigned long long)wall_clock64(); }
#undef PG8_STAMP
#undef PG8_SA
#undef PG8_SB
#undef PG8_STAGE
#undef PG8_LDA
#undef PG8_LDB
#undef PG8_MMA
#undef PG8_WAIT_V
#undef PG8_WAIT_L
#undef PG8_BAR
#undef PG8_SCHED
}
}

#define LAS __attribute__((address_space(3)))
#ifndef DUP_M2MASK
#define DUP_M2MASK 3
#endif
typedef unsigned short bf16_t;
typedef short bf16x8 __attribute__((ext_vector_type(8)));
typedef float f32x4 __attribute__((ext_vector_type(4)));
typedef unsigned u32x4v __attribute__((ext_vector_type(4)));
typedef unsigned u32x2v __attribute__((ext_vector_type(2)));

constexpr int NTOK = 10240, NPT = 8192, DM = 2048, NP = 9216, PIN = 8976;
constexpr int C_Q = 4864, C_K = 5888, C_V = 6912, C_G = 7936, C_IF = 8960;
constexpr int A_WD = 1536, A_AD = 1664, A_GATE = 1792;
constexpr int B_Q = 2304, B_V = 3328, B_O = 3840, B_GATE = 4352;
constexpr int NTHREADS = 512;
constexpr int LDS_SLOT = 131072, LDS_BYTES = 131072 + 1024;

constexpr size_t WS_CTL = 0;
constexpr size_t WS_BAR = 8192;
constexpr size_t WS_MOD = 32768;
constexpr size_t WS_ROPE = WS_MOD + 147456;
constexpr size_t WS_LAM = WS_ROPE + 8192;
constexpr size_t WS_WIN = WS_LAM + 256;
constexpr size_t WS_WOUT = WS_WIN + 2ull * NP * DM * 2;
constexpr size_t WS_UM = WS_WOUT + 2ull * DM * DM * 2;
constexpr size_t WS_PROJ = WS_UM + (size_t)NTOK * DM * 2;
constexpr size_t WS_GATES = WS_PROJ + (size_t)NTOK * NP * 2;
constexpr size_t SZ16 = (size_t)NTOK * 512 * 2, SZ32 = (size_t)NTOK * 512 * 4;
constexpr size_t WS_SCV = WS_GATES + (size_t)NTOK * 16 * 4;
constexpr size_t WS_SCBON = WS_SCV + SZ16;
constexpr size_t WS_PK = WS_SCBON + SZ16;
constexpr size_t SZPK = (size_t)NTOK * 8 * 320 * 2;
constexpr size_t WS_YD = WS_PK + 2 * SZPK;
constexpr size_t WS_HD = WS_YD + 2 * SZ32;
constexpr size_t WS_KC = WS_HD + 2 * SZ32;
constexpr size_t WS_VTC = WS_KC + 4194304;
constexpr size_t WS_WUPT = WS_VTC + 4194304;
constexpr size_t WS_END = WS_WUPT + 524288;

constexpr size_t O_Y = 0, O_NK = 20971520, O_NV = 37748736, O_RW = 54525952, O_MC = 58720256, O_MN = 67108864, O_MM = 67174400;

struct Params { const float* in[38]; float* out; unsigned char* ws; };
enum { I_XP = 0, I_XS, I_CK, I_CV, I_SRW, I_SMC, I_SMN, I_SMM, I_C, I_CCTX, I_WADA, I_BADA, I_WIN, I_CAW, I_CAB, I_W0, I_WUP, I_A0, I_AUP, I_KK, I_KA, I_RK,
       I_RGG, I_RGB, I_CBW, I_CBB, I_BI, I_BF, I_MGG, I_MGB, I_LQ1, I_LK1, I_LQ2, I_LK2, I_SUBG, I_WOUT, I_LNG, I_LNB };

__device__ __forceinline__ float bf2f(bf16_t v) { return __uint_as_float(((unsigned)v) << 16); }
__device__ __forceinline__ float bflo(unsigned w) { return __uint_as_float(w << 16); }
__device__ __forceinline__ float bfhi(unsigned w) { return __uint_as_float(w & 0xffff0000u); }
__device__ __forceinline__ unsigned pk2(float lo, float hi) { return pg8::cvt_pk_bf16(lo, hi); }
__device__ __forceinline__ bf16_t f2bf(float f) { return (bf16_t)(pk2(f, 0.f) & 0xffffu); }
__device__ __forceinline__ void unpack8(const u32x4v w, float (&o)[8]) { o[0] = bflo(w.x); o[1] = bfhi(w.x); o[2] = bflo(w.y); o[3] = bfhi(w.y); o[4] = bflo(w.z); o[5] = bfhi(w.z); o[6] = bflo(w.w); o[7] = bfhi(w.w); }
__device__ __forceinline__ u32x4v pack8(const float (&o)[8]) { u32x4v w; w.x = pk2(o[0], o[1]); w.y = pk2(o[2], o[3]); w.z = pk2(o[4], o[5]); w.w = pk2(o[6], o[7]); return w; }
__device__ __forceinline__ void ld8f(const float* p, float (&o)[8]) { const float4 a = *(const float4*)p, b = *(const float4*)(p + 4); o[0] = a.x; o[1] = a.y; o[2] = a.z; o[3] = a.w; o[4] = b.x; o[5] = b.y; o[6] = b.z; o[7] = b.w; }
__device__ __forceinline__ float sigmoidf_(float x) { return __builtin_amdgcn_rcpf(1.0f + __expf(-x)); }
__device__ __forceinline__ float siluf_(float x) { return x * __builtin_amdgcn_rcpf(1.0f + __expf(-x)); }
__device__ __forceinline__ float tanhf_(float x) { return 1.0f - 2.0f * __builtin_amdgcn_rcpf(1.0f + __expf(2.0f * x)); }
__device__ __forceinline__ bf16x8 frag(const LAS bf16_t* base, int row0, int ld, int k0, int lane) { return *(const LAS bf16x8*)(base + (row0 + (lane & 15)) * ld + k0 + (lane >> 4) * 8); }
__device__ __forceinline__ bf16x8 fragsw(const LAS bf16_t* base, int row0, int k0, int lane) { const int r = row0 + (lane & 15), m = (k0 >> 3) + (lane >> 4); return *(const LAS bf16x8*)(base + r * 72 + 8 * (m ^ ((r >> 3) & 7))); }
#define MFMA16(a, b, c) __builtin_amdgcn_mfma_f32_16x16x32_bf16((a), (b), (c), 0, 0, 0)
#define LDS_FENCE() asm volatile("s_waitcnt lgkmcnt(0)" ::: "memory")
template <int CTRL> __device__ __forceinline__ float dppf(float x) { return __builtin_bit_cast(float, __builtin_amdgcn_mov_dpp(__builtin_bit_cast(int, x), CTRL, 0xf, 0xf, true)); }
__device__ __forceinline__ float red16_sum(float x) { x += dppf<0xB1>(x); x += dppf<0x4E>(x); x += dppf<0x124>(x); x += dppf<0x128>(x); return x; }
__device__ __forceinline__ float red4_sum(float x) { x += dppf<0xB1>(x); x += dppf<0x4E>(x); return x; }
__device__ __forceinline__ float red16_max(float x) { x = fmaxf(x, dppf<0xB1>(x)); x = fmaxf(x, dppf<0x4E>(x)); x = fmaxf(x, dppf<0x124>(x)); x = fmaxf(x, dppf<0x128>(x)); return x; }

__device__ __forceinline__ int opaque_tid() { int t = threadIdx.x; asm volatile("" : "+v"(t)); return t; }
__device__ __forceinline__ int next_task(unsigned* ctr, LAS int* slot) {
    __syncthreads();
    if (threadIdx.x == 0) *slot = (int)atomicAdd(ctr, 1u);
    __syncthreads();
    return *slot;
}
#define QNEXT_BEGIN(ctr) unsigned qn_ = 0u; if (threadIdx.x == 0) qn_ = atomicAdd((ctr), 1u)
#define QNEXT_END(slot, t) do { __syncthreads(); if (threadIdx.x == 0) *(slot) = (int)qn_; __syncthreads(); (t) = *(slot); } while (0)
__device__ __forceinline__ int win_src_col(int n) { return n < 4352 ? n : (n < 8960 ? n + 16 : (n < 8976 ? n - 8960 + 4352 : -1)); }
__device__ __forceinline__ int mod_row(int tok) { return tok < NPT ? 0 : 1 + ((tok - NPT) >> 10); }

__device__ __forceinline__ void p0_mod_item(const Params& p, int item, LAS unsigned char* lds) {
    const int tid = opaque_tid(), lane = tid & 63, wave = tid >> 6, kq = lane >> 4, cq = lane & 15;
    const int l = item / 96, cb = item % 96;
    LAS float* sS = (LAS float*)lds;
    LAS float* sRed = sS + 3 * 2048;
    for (int e = tid; e < 3 * 2048; e += NTHREADS) { const int r = e >> 11, k = e & 2047; const float cv = r == 0 ? p.in[I_CCTX][k] : p.in[I_C][(r - 1) * 2048 + k]; sS[e] = siluf_(cv); }
    __syncthreads();
    const float* W = p.in[I_WADA] + (size_t)l * 2048 * 6144 + cb * 64 + 4 * cq;
    float4 a0 = {0, 0, 0, 0}, a1 = a0, a2 = a0;
#pragma unroll 16
    for (int i = 0; i < 64; ++i) { const int k = wave * 256 + i * 4 + kq; const float4 w = *(const float4*)(W + (size_t)k * 6144);
        const float s0 = sS[k], s1 = sS[2048 + k], s2 = sS[4096 + k];
        a0.x += s0 * w.x; a0.y += s0 * w.y; a0.z += s0 * w.z; a0.w += s0 * w.w;
        a1.x += s1 * w.x; a1.y += s1 * w.y; a1.z += s1 * w.z; a1.w += s1 * w.w;
        a2.x += s2 * w.x; a2.y += s2 * w.y; a2.z += s2 * w.z; a2.w += s2 * w.w; }
    float v[12] = {a0.x, a0.y, a0.z, a0.w, a1.x, a1.y, a1.z, a1.w, a2.x, a2.y, a2.z, a2.w};
#pragma unroll
    for (int i = 0; i < 12; ++i) { v[i] += __shfl_xor(v[i], 16); v[i] += __shfl_xor(v[i], 32); }
    if (kq == 0) {
#pragma unroll
        for (int r = 0; r < 3; ++r)
#pragma unroll
            for (int e = 0; e < 4; ++e) sRed[(wave * 3 + r) * 64 + 4 * cq + e] = v[r * 4 + e];
    }
    __syncthreads();
    if (tid < 192) { const int r = tid >> 6, c = tid & 63; float s = 0.f;
#pragma unroll
        for (int w = 0; w < 8; ++w) s += sRed[(w * 3 + r) * 64 + c];
        ((float*)(p.ws + WS_MOD))[(l * 3 + r) * 6144 + cb * 64 + c] = s + p.in[I_BADA][l * 6144 + cb * 64 + c]; }
}
template <bool MAPCOL> __device__ __forceinline__ void p0_transpose_item(const float* W, int N, int nblk, bf16_t* WT, LAS float* scr, int item, int lane) {
    const int kb = item / nblk, nb = item % nblk, k0 = 64 * kb, n0 = 32 * nb;
    const int n = n0 + (lane & 31); const int oc = MAPCOL ? win_src_col(n) : n;
    float tv[32];
    const float* wp = W + (size_t)(k0 + (lane >> 5)) * N + (oc >= 0 ? oc : 0);
#pragma unroll
    for (int i = 0; i < 32; ++i) tv[i] = wp[(size_t)(2 * i) * N];
#pragma unroll
    for (int i = 0; i < 32; ++i) scr[(2 * i + (lane >> 5)) * 33 + (lane & 31)] = oc >= 0 ? tv[i] : 0.f;
    LDS_FENCE();
    const int c = lane & 7;
#pragma unroll
    for (int j = 0; j < 4; ++j) { const int nn = (lane >> 3) + 8 * j; const LAS float* s = scr + (8 * c) * 33 + nn;
        u32x4v o; o.x = pk2(s[0 * 33], s[1 * 33]); o.y = pk2(s[2 * 33], s[3 * 33]); o.z = pk2(s[4 * 33], s[5 * 33]); o.w = pk2(s[6 * 33], s[7 * 33]);
        *(u32x4v*)(WT + (size_t)(n0 + nn) * 2048 + k0 + 8 * c) = o; }
    LDS_FENCE();
}
__device__ __forceinline__ void p0_phase(const Params& p, LAS unsigned char* lds, int rep) {
    const int tid = opaque_tid(), lane = tid & 63, wave = tid >> 6;
    unsigned* ctr = (unsigned*)(p.ws + WS_CTL) + 64 * 15 * rep;
    LAS int* slot = (LAS int*)(lds + LDS_SLOT);
    constexpr int NT_MOD = 192, NT_TR = 2816, NT_A = NT_MOD + 1 + NT_TR, NT_KC = 512, NT_VT = 512, NT_WU = 64, NT = NT_A + NT_KC + NT_VT + NT_WU;
    for (;;) {
        const int t = next_task(ctr, slot);
        if (t >= NT) break;
        if (t < NT_MOD) { p0_mod_item(p, t, lds); continue; }
        if (t == NT_MOD) {
            float* rope = (float*)(p.ws + WS_ROPE);
            for (int e = tid; e < 1024; e += NTHREADS) { const int pos = e >> 4, i = e & 15; const float inv = 1.0f / powf(10000.0f, (float)(2 * i) / 32.0f); const float ang = (float)pos * inv;
                rope[pos * 32 + i] = cosf(ang); rope[pos * 32 + 16 + i] = sinf(ang); }
            if (tid < 2) { const int l = tid; float d1 = 0.f, d2 = 0.f;
                for (int i = 0; i < 64; ++i) { d1 += p.in[I_LQ1][l * 64 + i] * p.in[I_LK1][l * 64 + i]; d2 += p.in[I_LQ2][l * 64 + i] * p.in[I_LK2][l * 64 + i]; }
                const float lam_init = 0.8f - 0.6f * expf(-0.3f * (float)l);
                ((float*)(p.ws + WS_LAM))[l] = expf(d1) - expf(d2) + lam_init; }
            continue;
        }
        if (t >= NT_A) {
            int u = t - NT_A;
            if (u < NT_KC) { const size_t o = ((size_t)u * 512 + tid) * 8; float x[8]; ld8f(p.in[I_CK] + o, x); *(u32x4v*)((bf16_t*)(p.ws + WS_KC) + o) = pack8(x); continue; }
            u -= NT_KC;
            if (u < NT_VT) { const int idx = u * 512 + tid, dv = idx & 127, m = (idx >> 7) & 63, bh = idx >> 13; float x[8];
#pragma unroll
                for (int e = 0; e < 8; ++e) x[e] = p.in[I_CV][((size_t)bh * 512 + 8 * m + e) * 128 + dv];
                *(u32x4v*)((bf16_t*)(p.ws + WS_VTC) + ((size_t)bh * 128 + dv) * 512 + 8 * m) = pack8(x); continue; }
            u -= NT_VT;
#pragma unroll
            for (int e = 0; e < 8; ++e) { const int f = u * 4096 + e * 512 + tid, c = f & 63, j = (f >> 6) & 63, h = (f >> 12) & 7, which = (f >> 15) & 1, ld = f >> 16;
                const float v = (which ? p.in[I_AUP] : p.in[I_WUP])[((size_t)ld * 64 + j) * 512 + h * 64 + c];
                ((bf16_t*)(p.ws + WS_WUPT))[(f & ~4095) + c * 64 + j] = f2bf(v); }
            continue;
        }
        int it = (t - NT_MOD - 1) * 8 + wave;
        LAS float* scr = (LAS float*)(lds + wave * 8704);
        const int l = it / 11264; it -= l * 11264;
        if (it < 9216) p0_transpose_item<true>(p.in[I_WIN] + (size_t)l * 2048 * PIN, PIN, 288, (bf16_t*)(p.ws + WS_WIN) + (size_t)l * NP * 2048, scr, it, lane);
        else p0_transpose_item<false>(p.in[I_WOUT] + (size_t)l * 2048 * 2048, 2048, 64, (bf16_t*)(p.ws + WS_WOUT) + (size_t)l * 2048 * 2048, scr, it - 9216, lane);
    }
}
__device__ __forceinline__ void modulate_row(const float* xrow, const float* mod, bf16_t* urow, int lane) {
#pragma unroll
    for (int j = 0; j < 4; ++j) { const int c = j * 512 + lane * 8; float x[8], sh[8], sc[8], o[8]; ld8f(xrow + c, x); ld8f(mod + c, sh); ld8f(mod + 2048 + c, sc);
#pragma unroll
        for (int e = 0; e < 8; ++e) o[e] = x[e] * (1.0f + sc[e]) + sh[e];
        *(u32x4v*)(urow + c) = pack8(o); }
}
__device__ __forceinline__ void p0b_phase(const Params& p) {
    const int tid_ = opaque_tid(); const int lane = tid_ & 63, gw = blockIdx.x * 8 + (tid_ >> 6), NGW = gridDim.x * 8;
    for (int tok = gw; tok < NTOK; tok += NGW) {
        const float* xrow = tok < NPT ? p.in[I_XP] + (size_t)tok * DM : p.in[I_XS] + (size_t)(tok - NPT) * DM;
        modulate_row(xrow, (const float*)(p.ws + WS_MOD) + mod_row(tok) * 6144, (bf16_t*)(p.ws + WS_UM) + (size_t)tok * DM, lane);
    }
}

struct EpiIn {
    static constexpr bool PERM = true, AFTER_DRAIN = false;
    bf16_t* proj; float* gates; float* newk; float* newv; const float* rope; int layer;
    __device__ __forceinline__ void operator()(const f32x4 (&acc)[2][2][4][2], const pg8::Unit& u, int wr, int wc, int fr, int fq) const {
        const int row0 = u.pm * 256 + wr * 64 + fr, col0 = u.pn * 256 + wc * 32 + 8 * fq;
        const bool samp = u.pm >= 32;
        const bool is_rope = samp && u.pn >= 19 && u.pn < 27;
        const bool is_k = !samp && u.pn >= 23 && u.pn < 27, is_v = !samp && u.pn >= 27 && u.pn < 31, is_g = u.pn == 35;
#pragma unroll
        for (int ai = 0; ai < 2; ++ai)
#pragma unroll
            for (int m = 0; m < 4; ++m) {
                const int row = row0 + ai * 128 + m * 16;
                float cs[8], sn[8];
                if (is_rope) { const int pos = (row - NPT) & 1023; const int pp = (wc & 1) ? (pos & 63) : (pos >> 6); const float* rp = rope + pp * 32 + 8 * (fq & 1); ld8f(rp, cs); ld8f(rp + 16, sn); }
#pragma unroll
                for (int bj = 0; bj < 2; ++bj) {
                    f32x4 v0 = acc[ai][bj][m][0], v1 = acc[ai][bj][m][1];
                    if (is_rope) {
                        const float sg = (fq & 2) ? 1.0f : -1.0f;
#pragma unroll
                        for (int e = 0; e < 4; ++e) { const float p0 = __shfl_xor(v0[e], 32), p1 = __shfl_xor(v1[e], 32);
                            v0[e] = v0[e] * cs[e] + sg * p0 * sn[e]; v1[e] = v1[e] * cs[4 + e] + sg * p1 * sn[4 + e]; }
                    }
                    const int col = col0 + bj * 128;
                    u32x4v w; w.x = pk2(v0[0], v0[1]); w.y = pk2(v0[2], v0[3]); w.z = pk2(v1[0], v1[1]); w.w = pk2(v1[2], v1[3]);
                    *(u32x4v*)(proj + (size_t)row * NP + col) = w;
                    if (is_k || is_v) { const int ck = col - (is_k ? C_K : C_V), h = ck >> 7, j = ck & 127, b = row >> 8, t = row & 255;
                        float* dst = (is_k ? newk : newv) + ((((size_t)(b * 2 + layer) * 8 + h) * 256 + t) * 128 + j);
                        *(f32x4*)dst = v0; *(f32x4*)(dst + 4) = v1; }
                    if (is_g && bj == 0 && wc == 0 && fq < 2) { float* dst = gates + (size_t)row * 16 + 8 * fq; *(f32x4*)dst = v0; *(f32x4*)(dst + 4) = v1; }
                }
            }
    }
};
struct EpiOut {
    static constexpr bool PERM = false, AFTER_DRAIN = false;
    const float* xp; const float* xs; const float* mod; float* y; int layer;
    __device__ __forceinline__ void operator()(const f32x4 (&acc)[2][2][4][2], const pg8::Unit& u, int wr, int wc, int fr, int fq) const {
        const int row0 = u.pm * 256 + wr * 64 + fr, col0 = u.pn * 256 + wc * 32 + 4 * fq;
#pragma unroll
        for (int ai = 0; ai < 2; ++ai)
#pragma unroll
            for (int m = 0; m < 4; ++m) {
                const int row = row0 + ai * 128 + m * 16;
                const float* xrow = layer == 0 ? (row < NPT ? xp + (size_t)row * DM : xs + (size_t)(row - NPT) * DM) : y + (size_t)row * DM;
                const float* g = mod + mod_row(row) * 6144 + 4096;
#pragma unroll
                for (int bj = 0; bj < 2; ++bj)
#pragma unroll
                    for (int n = 0; n < 2; ++n) { const int c = col0 + bj * 128 + n * 16;
                        const f32x4 xv = *(const f32x4*)(xrow + c), gv = *(const f32x4*)(g + c);
                        *(f32x4*)(y + (size_t)row * DM + c) = 1.41421356237f * xv + gv * acc[ai][bj][m][n]; }
            }
    }
};

#define XB_TMO      128
#define XB_XCNT(j)  (256  + 64 * (j))
#define XB_XSUB(j)  (1280 + 64 * (j))
#define XB_XGEN(j)  (2304 + 64 * (j))
#define XB_TOP      3328
#define XB_TOPGEN   3392
#define XCD_BAR_WORDS 3456
#define XB_SPIN_CAP (1u << 18)

__device__ __forceinline__ unsigned xb_ld(unsigned* p)              { return __hip_atomic_load(p, __ATOMIC_RELAXED, __HIP_MEMORY_SCOPE_AGENT); }
__device__ __forceinline__ unsigned xb_add(unsigned* p, unsigned v) { return __hip_atomic_fetch_add(p, v, __ATOMIC_RELAXED, __HIP_MEMORY_SCOPE_AGENT); }
__device__ __forceinline__ unsigned xb_xcc_id() { return (unsigned)__builtin_amdgcn_s_getreg((3 << 11) | 20) & 0xFu; }
#define XB_SPIN(cond, bar) do { unsigned _sp = 0; while (cond) { __builtin_amdgcn_s_sleep(1); \
    if ((++_sp & 255u) == 0u) { if (xb_ld(&(bar)[XB_TMO])) break; if (_sp > XB_SPIN_CAP) { atomicAdd(&(bar)[XB_TMO], 1u); break; } } } } while (0)

struct XcdBarrier {
    unsigned* bar; unsigned x;
    volatile LAS unsigned* st;
};

__device__ __forceinline__ XcdBarrier xcd_barrier_post(unsigned* bar, volatile LAS unsigned* st) {
    XcdBarrier b; b.bar = bar; b.x = xb_xcc_id(); b.st = st;
    if (threadIdx.x == 0) (void)xb_add(&bar[XB_XCNT(b.x)], 1u);
    return b;
}
__device__ __forceinline__ void xcd_barrier_complete(unsigned* bar, unsigned x, unsigned& nloc, unsigned& nx) {
    const unsigned G = gridDim.x * gridDim.y * gridDim.z;
    unsigned sum, cnt, mine, sp = 0u;
    for (;;) {
        sum = 0u; cnt = 0u; mine = 0u;
#pragma unroll
        for (unsigned j = 0; j < 16; ++j) { const unsigned c = xb_ld(&bar[XB_XCNT(j)]); sum += c; cnt += (c > 0u) ? 1u : 0u; mine = (j == x) ? c : mine; }
        if (sum == G) break;
        __builtin_amdgcn_s_sleep(1);
        if ((++sp & 255u) == 0u) { if (xb_ld(&bar[XB_TMO])) break; if (sp > XB_SPIN_CAP) { atomicAdd(&bar[XB_TMO], 1u); break; } }
    }
    nloc = mine > 0u ? mine : 1u; nx = cnt > 0u ? cnt : 1u;
}

__device__ __forceinline__ unsigned xb_xcc_id_v() { unsigned r; asm volatile("s_getreg_b32 %0, hwreg(20, 0, 4)" : "=s"(r)); return r & 0xFu; }
__device__ __forceinline__ void xcd_barrier(const XcdBarrier& b) {
    asm volatile("s_waitcnt vmcnt(0)" ::: "memory");
    __syncthreads();
    if (threadIdx.x == 0) {
        unsigned* bar = b.bar; const unsigned bx = xb_xcc_id_v();
        __builtin_amdgcn_s_waitcnt(0);
        unsigned nloc = b.st[0], nx = b.st[1];
        if (nloc == 0u) { xcd_barrier_complete(bar, bx, nloc, nx); b.st[0] = nloc; b.st[1] = nx; }
        const unsigned old = xb_add(&bar[XB_XSUB(bx)], 1u);
        const unsigned gen = old / nloc;
        if (old + 1u == (gen + 1u) * nloc) {
            __builtin_amdgcn_fence(__ATOMIC_RELEASE, "agent");
            asm volatile("s_waitcnt vmcnt(0)" ::: "memory");
            const unsigned og = xb_add(&bar[XB_TOP], 1u);
            const unsigned tg = og / nx;
            if (og + 1u == (tg + 1u) * nx) xb_add(&bar[XB_TOPGEN], 1u);
            else XB_SPIN(xb_ld(&bar[XB_TOPGEN]) == tg, bar);
            __builtin_amdgcn_fence(__ATOMIC_ACQUIRE, "agent");
            xb_add(&bar[XB_XGEN(bx)], 1u);
            asm volatile("s_waitcnt vmcnt(0)" ::: "memory");
        } else {
            XB_SPIN(xb_ld(&bar[XB_XGEN(bx)]) == gen, bar);
            __builtin_amdgcn_fence(__ATOMIC_ACQUIRE, "agent");
            asm volatile("s_waitcnt vmcnt(0)" ::: "memory");
        }
    }
    __syncthreads();
}


__device__ __forceinline__ void mlstm_task(const Params& p, int l, int s, int d, int h, LAS unsigned char* lds) {
    const int tid = opaque_tid(), lane = tid & 63, wave = tid >> 6, quad = lane >> 4, l15 = lane & 15;
    const int T = s < 32 ? 256 : 1024, tok0 = s < 32 ? s * 256 : NPT + (s - 32) * 1024, nch = T / 64;
    LAS bf16_t* sQ = (LAS bf16_t*)lds;
    LAS bf16_t* sK = sQ + 64 * 136;
    LAS bf16_t* sKt = sK + 64 * 136;
    LAS bf16_t* sVt = sKt + 128 * 72;
    LAS bf16_t* sP = sVt + 128 * 72;
    LAS bf16_t* sC = sP + 64 * 72;
    LAS float* sf = (LAS float*)(sC + 128 * 136);
    LAS float *sA = sf, *sB = sf + 64, *sPm = sf + 128, *sN = sf + 192, *sNq = sf + 320, *sPs = sf + 384;
    const bf16_t* proj = (const bf16_t*)(p.ws + WS_PROJ);
    const float* gates = (const float*)(p.ws + WS_GATES);
    float* hd = (float*)(p.ws + WS_HD) + (size_t)d * NTOK * 512;
    const float bi = p.in[I_BI][l * 8 + d * 4 + h], bfb = p.in[I_BF][l * 8 + d * 4 + h];
    f32x4 cacc[8];
    float m;
    float cw0[8], cw1[8], cw2[8], cbb[8];
    { const int g = tid & 31, ch = ((g >> 4) ? 512 : 0) + h * 128 + (g & 15) * 8; const float* cw = p.in[I_CBW] + (size_t)l * 3 * 1024 + ch;
        ld8f(cw, cw0); ld8f(cw + 1024, cw1); ld8f(cw + 2048, cw2); ld8f(p.in[I_CBB] + l * 1024 + ch, cbb); }
    __syncthreads();
    if (s >= 32) {
        const size_t sb = (((size_t)((s - 32) * 2 + l) * 2 + d) * 4 + h);
        const float* C0 = p.in[I_SMC] + sb * 128 * 128;
#pragma unroll
        for (int tn = 0; tn < 8; ++tn)
#pragma unroll
            for (int j = 0; j < 4; ++j) cacc[tn][j] = C0[(16 * wave + quad * 4 + j) * 128 + 16 * tn + l15];
        if (tid < 128) sN[tid] = p.in[I_SMN][sb * 128 + tid];
        m = p.in[I_SMM][sb];
    } else {
#pragma unroll
        for (int tn = 0; tn < 8; ++tn) cacc[tn] = (f32x4){0.f, 0.f, 0.f, 0.f};
        if (tid < 128) sN[tid] = 0.f;
        m = 0.f;
    }
#pragma unroll
    for (int tn = 0; tn < 8; ++tn)
#pragma unroll
        for (int j = 0; j < 4; ++j) sC[(16 * wave + quad * 4 + j) * 136 + 16 * tn + l15] = f2bf(cacc[tn][j]);

    float gi_n = 0.f, gf_n = 0.f;
    if (wave == 0) { const int tk = d == 0 ? tok0 + lane : tok0 + T - 1 - lane; gi_n = gates[(size_t)tk * 16 + d * 4 + h]; gf_n = gates[(size_t)tk * 16 + 8 + d * 4 + h]; }
    for (int c = 0; c < nch; ++c) {
        __syncthreads();
        if (wave == 0) {
            const float gi = gi_n + bi, gf = gf_n + bfb;
            if (c + 1 < nch) { const int ii = 64 * (c + 1) + lane; const int tk = d == 0 ? tok0 + ii : tok0 + T - 1 - ii; gi_n = gates[(size_t)tk * 16 + d * 4 + h]; gf_n = gates[(size_t)tk * 16 + 8 + d * 4 + h]; }
            const float lf = fminf(gf, 0.f) - log1pf(__expf(-fabsf(gf)));
            float b = lf;
#pragma unroll
            for (int off = 1; off < 64; off <<= 1) { const float t = __shfl_up(b, off); if (lane >= off) b += t; }
            const float a = gi - b; float pm = a;
#pragma unroll
            for (int off = 1; off < 64; off <<= 1) { const float t = __shfl_up(pm, off); if (lane >= off) pm = fmaxf(pm, t); }
            sB[lane] = b; sA[lane] = a; sPm[lane] = pm;
        }
        __syncthreads();
        const float mx = fmaxf(m, sPm[63]), bL = sB[63];
#pragma unroll
        for (int it = 0; it < 4; ++it) {
            const int idx = tid + 512 * it, i = idx >> 5, g = idx & 31, isK = g >> 4, j0 = (g & 15) * 8, ch = (isK ? 512 : 0) + h * 128 + j0;
            const int ii = 64 * c + i, pos = d == 0 ? ii : T - 1 - ii, tk = tok0 + pos;
            const bf16_t* src = proj + (size_t)tk * NP + B_Q + ch;
            float x0[8], x1[8], x2[8], y[8];
            unpack8(*(const u32x4v*)src, x1);
            unpack8(*(const u32x4v*)(pos > 0 ? src - NP : src), x0); unpack8(*(const u32x4v*)(pos < T - 1 ? src + NP : src), x2);
            const float m0 = pos > 0 ? 1.f : 0.f, m2 = pos < T - 1 ? 1.f : 0.f;
#pragma unroll
            for (int e = 0; e < 8; ++e) y[e] = siluf_(m0 * x0[e] * cw0[e] + x1[e] * cw1[e] + m2 * x2[e] * cw2[e] + cbb[e]);
            if (!isK) { *(LAS u32x4v*)(sQ + i * 136 + j0) = pack8(y); }
            else {
                const float wgi = __expf(sA[i] - mx);
#pragma unroll
                for (int e = 0; e < 8; ++e) y[e] *= 0.08838834764831845f;
                *(LAS u32x4v*)(sK + i * 136 + j0) = pack8(y);
#pragma unroll
                for (int e = 0; e < 8; ++e) sKt[(j0 + e) * 72 + (i ^ (8 * ((j0 >> 3) & 7)))] = f2bf(y[e] * wgi);
            }
        }
#pragma unroll
        for (int it = 0; it < 2; ++it) {
            const int idx = tid + 512 * it, i = idx >> 4, g = idx & 15;
            const int ii = 64 * c + i, tk = d == 0 ? tok0 + ii : tok0 + T - 1 - ii;
            const u32x4v w = *(const u32x4v*)(proj + (size_t)tk * NP + B_V + h * 128 + 8 * g);
            LAS bf16_t* dst = sVt + (8 * g) * 72 + (i ^ (8 * (g & 7)));
            dst[0] = (bf16_t)(w.x & 0xffff); dst[72] = (bf16_t)(w.x >> 16); dst[144] = (bf16_t)(w.y & 0xffff); dst[216] = (bf16_t)(w.y >> 16);
            dst[288] = (bf16_t)(w.z & 0xffff); dst[360] = (bf16_t)(w.z >> 16); dst[432] = (bf16_t)(w.w & 0xffff); dst[504] = (bf16_t)(w.w >> 16);
        }
        __syncthreads();
        const int tm = wave >> 1;
        {
            const int tn0 = (wave & 1) * 2;
#pragma unroll
            for (int tt = 0; tt < 2; ++tt) {
                f32x4 acc = {0.f, 0.f, 0.f, 0.f};
#pragma unroll
                for (int ks = 0; ks < 4; ++ks) acc = MFMA16(frag(sQ, 16 * tm, 136, 32 * ks, lane), frag(sK, 16 * (tn0 + tt), 136, 32 * ks, lane), acc);
                const int scol = 16 * (tn0 + tt) + l15; const float as = sA[scol];
#pragma unroll
                for (int j = 0; j < 4; ++j) { const int t = 16 * tm + quad * 4 + j;
                    float pv = scol <= t ? __expf(as - fmaxf(m, sPm[t])) * acc[j] : 0.f;
                    sP[t * 72 + scol] = f2bf(pv);
                    pv = red16_sum(pv);
                    if (l15 == 0) sPs[t * 4 + tn0 + tt] = pv; }
            }
        }
        const int tnb = (wave & 1) * 4;
        f32x4 accq[4];
#pragma unroll
        for (int tt = 0; tt < 4; ++tt) { accq[tt] = (f32x4){0.f, 0.f, 0.f, 0.f};
#pragma unroll
            for (int ks = 0; ks < 4; ++ks) accq[tt] = MFMA16(frag(sQ, 16 * tm, 136, 32 * ks, lane), frag(sC, 16 * (tnb + tt), 136, 32 * ks, lane), accq[tt]); }
        { const int t = tid >> 3, part = tid & 7; float sacc = 0.f;
#pragma unroll
            for (int e = 0; e < 16; ++e) sacc += sN[16 * part + e] * bf2f(sQ[t * 136 + 16 * part + e]);
            sacc += __shfl_xor(sacc, 1); sacc += __shfl_xor(sacc, 2); sacc += __shfl_xor(sacc, 4);
            if (part == 0) sNq[t] = sacc; }
        __syncthreads();
        {
            f32x4 accp[4];
#pragma unroll
            for (int tt = 0; tt < 4; ++tt) { accp[tt] = (f32x4){0.f, 0.f, 0.f, 0.f};
#pragma unroll
                for (int ks = 0; ks < 2; ++ks) accp[tt] = MFMA16(frag(sP, 16 * tm, 72, 32 * ks, lane), fragsw(sVt, 16 * (tnb + tt), 32 * ks, lane), accp[tt]); }
#pragma unroll
            for (int j = 0; j < 4; ++j) { const int t = 16 * tm + quad * 4 + j;
                const float mtm = fmaxf(m, sPm[t]), wi = __expf(m - mtm);
                const float den = wi * sNq[t] + ((sPs[t * 4] + sPs[t * 4 + 1]) + (sPs[t * 4 + 2] + sPs[t * 4 + 3]));
                const float mt = sB[t] + mtm; const float inv = 1.0f / fmaxf(fabsf(den), __expf(-mt));
                const int ii = 64 * c + t, tk = d == 0 ? tok0 + ii : tok0 + T - 1 - ii;
                float* dst = hd + (size_t)tk * 512 + h * 128 + 16 * tnb + l15;
#pragma unroll
                for (int tt = 0; tt < 4; ++tt) dst[16 * tt] = (wi * accq[tt][j] + accp[tt][j]) * inv; }
        }
        const float sc = __expf(m - mx);
        if (tid < 128) { float ns = 0.f;
#pragma unroll 8
            for (int e = 0; e < 64; ++e) ns += bf2f(sKt[tid * 72 + e]);
            sN[tid] = sc * sN[tid] + ns; }
#pragma unroll
        for (int tn = 0; tn < 8; ++tn) { f32x4 dc = {0.f, 0.f, 0.f, 0.f};
#pragma unroll
            for (int ks = 0; ks < 2; ++ks) dc = MFMA16(fragsw(sVt, 16 * wave, 32 * ks, lane), fragsw(sKt, 16 * tn, 32 * ks, lane), dc);
            cacc[tn] = sc * cacc[tn] + dc;
#pragma unroll
            for (int j = 0; j < 4; ++j) sC[(16 * wave + quad * 4 + j) * 136 + 16 * tn + l15] = f2bf(cacc[tn][j]); }
        m = bL + mx;
    }
    __syncthreads();
    if (s < 32) {
        const size_t sb = (((size_t)(s * 2 + l) * 2 + d) * 4 + h);
        float* Co = p.out + O_MC + sb * 128 * 128;
#pragma unroll
        for (int tn = 0; tn < 8; ++tn)
#pragma unroll
            for (int j = 0; j < 4; ++j) Co[(16 * wave + quad * 4 + j) * 128 + 16 * tn + l15] = cacc[tn][j];
        if (tid < 128) p.out[O_MN + sb * 128 + tid] = sN[tid];
        if (tid == 0) p.out[O_MM + sb] = m;
    }
}

__device__ __forceinline__ void attn_task(const Params& p, int l, int task, LAS unsigned char* lds) {
    const int tid = opaque_tid(), lane = tid & 63, wave = tid >> 6, quad = lane >> 4, l15 = lane & 15;
    const bool samp = task < 128;
    int b, h, qb;
    if (samp) { b = task >> 6; h = (task >> 3) & 7; qb = task & 7; } else { const int t2 = task - 128; b = t2 >> 4; h = (t2 >> 1) & 7; qb = t2 & 1; }
    const int tok0 = samp ? NPT + b * 1024 : b * 256, nkt = samp ? 24 : 4, nct = samp ? 8 : 0;
    LAS bf16_t* sK = (LAS bf16_t*)lds;
    LAS bf16_t* sVt = sK + 64 * 136;
    LAS bf16_t* sPw = sVt + 128 * 72 + wave * (16 * 72);
    const bf16_t* proj = (const bf16_t*)(p.ws + WS_PROJ);
    const bf16_t* ck = (const bf16_t*)(p.ws + WS_KC) + (((unsigned)(b * 2 + l) * 8 + h) * 512) * 128;
    const bf16_t* cv = (const bf16_t*)(p.ws + WS_VTC) + (((unsigned)(b * 2 + l) * 8 + h) * 128) * 512;
    const float lam = ((const float*)(p.ws + WS_LAM))[l];
    const float lam_init = 0.8f - 0.6f * expf(-0.3f * (float)l);
    const int q0 = 128 * qb + 16 * wave;
    bf16x8 aq1[2], aq2[2];
    { const bf16_t* qp = proj + (unsigned)(tok0 + q0 + l15) * NP + C_Q + h * 128 + quad * 8;
        aq1[0] = *(const bf16x8*)qp; aq1[1] = *(const bf16x8*)(qp + 32); aq2[0] = *(const bf16x8*)(qp + 64); aq2[1] = *(const bf16x8*)(qp + 96); }
    float mx1 = -INFINITY, mx2 = -INFINITY, sm1 = 0.f, sm2 = 0.f, mc1 = 0.f, mc2 = 0.f;
    constexpr float CS = 0.125f * 1.4426950408889634f;
    f32x4 o1[8], o2[8];
#pragma unroll
    for (int tn = 0; tn < 8; ++tn) { o1[tn] = (f32x4){0.f, 0.f, 0.f, 0.f}; o2[tn] = o1[tn]; }
    u32x4v kreg[2], vreg[2];
#define ATT_LOAD(KT, PASS) do { int ktv = (KT); asm volatile("" : "+v"(ktv));     \
    _Pragma("unroll") for (int it = 0; it < 2; ++it) { const int idx = tid + 512 * it, i = idx >> 4, g = idx & 15; \
        if ((KT) < nct) { kreg[it] = *(const u32x4v*)(ck + (unsigned)((64 * ktv + i) * 128 + 8 * g)); \
            if ((PASS) == 1) { const int dv = idx >> 3, mm = idx & 7; vreg[it] = *(const u32x4v*)(cv + (unsigned)(dv * 512 + 64 * ktv + 8 * mm)); } } \
        else { kreg[it] = *(const u32x4v*)(proj + (unsigned)((tok0 + 64 * (ktv - nct) + i) * NP + C_K + h * 128 + 8 * g)); \
            if ((PASS) == 1) vreg[it] = *(const u32x4v*)(proj + (unsigned)((tok0 + 64 * (ktv - nct) + (idx & 63)) * NP + C_V + h * 128 + 8 * (idx >> 6))); } } } while (0)
    for (int pass = 0; pass < 2; ++pass) {
        ATT_LOAD(0, pass);
        for (int kt = 0; kt < nkt; ++kt) {
            __syncthreads();
#pragma unroll
            for (int it = 0; it < 2; ++it) {
                const int idx = tid + 512 * it, i = idx >> 4, g = idx & 15;
                *(LAS u32x4v*)(sK + i * 136 + 8 * g) = kreg[it];
                if (pass == 1) {
                    if (kt < nct) { const int dv = idx >> 3, mm = idx & 7; *(LAS u32x4v*)(sVt + dv * 72 + 8 * mm) = vreg[it]; }
                    else { const u32x4v w = vreg[it]; LAS bf16_t* dst = sVt + (8 * (idx >> 6)) * 72 + (idx & 63);
                        dst[0] = (bf16_t)(w.x & 0xffff); dst[72] = (bf16_t)(w.x >> 16); dst[144] = (bf16_t)(w.y & 0xffff); dst[216] = (bf16_t)(w.y >> 16);
                        dst[288] = (bf16_t)(w.z & 0xffff); dst[360] = (bf16_t)(w.z >> 16); dst[432] = (bf16_t)(w.w & 0xffff); dst[504] = (bf16_t)(w.w >> 16); }
                }
            }
            if (kt + 1 < nkt) ATT_LOAD(kt + 1, pass);
            __syncthreads();
#pragma unroll
            for (int bb = 0; bb < 2; ++bb) {
                f32x4 s1[2], s2[2];
#pragma unroll
                for (int t = 0; t < 2; ++t) { s1[t] = (f32x4){0.f, 0.f, 0.f, 0.f}; s2[t] = s1[t];
#pragma unroll
                    for (int ks = 0; ks < 2; ++ks) { s1[t] = MFMA16(frag(sK, 32 * bb + 16 * t, 136, 32 * ks, lane), aq1[ks], s1[t]); s2[t] = MFMA16(frag(sK, 32 * bb + 16 * t, 136, 64 + 32 * ks, lane), aq2[ks], s2[t]); } }
                if (pass == 0) {
#pragma unroll
                    for (int t = 0; t < 2; ++t)
#pragma unroll
                        for (int j = 0; j < 4; ++j) { mx1 = fmaxf(mx1, s1[t][j]); mx2 = fmaxf(mx2, s2[t][j]); }
                } else {
                    bf16x8 pa1, pa2;
                    { float p1[8];
#pragma unroll
                        for (int jj = 0; jj < 8; ++jj) { p1[jj] = __builtin_amdgcn_exp2f(s1[jj >> 2][jj & 3] * CS - mc1); sm1 += p1[jj]; }
                        pa1 = __builtin_bit_cast(bf16x8, pack8(p1)); }
                    { float p2[8];
#pragma unroll
                        for (int jj = 0; jj < 8; ++jj) { p2[jj] = __builtin_amdgcn_exp2f(s2[jj >> 2][jj & 3] * CS - mc2); sm2 += p2[jj]; }
                        pa2 = __builtin_bit_cast(bf16x8, pack8(p2)); }
#pragma unroll
                    for (int tn2 = 0; tn2 < 8; ++tn2) { const LAS bf16_t* vrow = sVt + (16 * tn2 + l15) * 72 + 32 * bb + quad * 4;
                        const u32x2v lo = *(const LAS u32x2v*)vrow, hi = *(const LAS u32x2v*)(vrow + 16);
                        u32x4v vw; vw.x = lo.x; vw.y = lo.y; vw.z = hi.x; vw.w = hi.y;
                        const bf16x8 vb = __builtin_bit_cast(bf16x8, vw);
                        o1[tn2] = MFMA16(pa1, vb, o1[tn2]); o2[tn2] = MFMA16(pa2, vb, o2[tn2]); }
                }
                asm volatile("" ::: "memory");
            }
        }
        if (pass == 0) { mx1 = fmaxf(mx1, __shfl_xor(mx1, 16)); mx1 = fmaxf(mx1, __shfl_xor(mx1, 32)); mx2 = fmaxf(mx2, __shfl_xor(mx2, 16)); mx2 = fmaxf(mx2, __shfl_xor(mx2, 32)); mc1 = mx1 * CS; mc2 = mx2 * CS; }
    }
    sm1 += __shfl_xor(sm1, 16); sm1 += __shfl_xor(sm1, 32); sm2 += __shfl_xor(sm2, 16); sm2 += __shfl_xor(sm2, 32);
    const float il1 = 1.0f / sm1, il2 = lam / sm2;
    float f1[4], f2[4];
#pragma unroll
    for (int j = 0; j < 4; ++j) { f1[j] = __shfl(il1, quad * 4 + j); f2[j] = __shfl(il2, quad * 4 + j); }
#pragma unroll
    for (int tn = 0; tn < 8; ++tn)
#pragma unroll
        for (int j = 0; j < 4; ++j) o1[tn][j] = o1[tn][j] * f1[j] - o2[tn][j] * f2[j];
    asm volatile("" ::: "memory");
#define oacc o1
#undef ATT_LOAD
    bf16_t* mixed = (bf16_t*)(p.ws + WS_UM);
    const float* sg = p.in[I_SUBG] + l * 128;
#pragma unroll
    for (int j = 0; j < 4; ++j) {
        float ss = 0.f;
#pragma unroll
        for (int tn = 0; tn < 8; ++tn) ss += oacc[tn][j] * oacc[tn][j];
        ss = red16_sum(ss);
        const float r = rsqrtf(ss * (1.0f / 128.0f) + 1e-5f) * (1.0f - lam_init);
        const int tq = tok0 + q0 + quad * 4 + j;
#pragma unroll
        for (int tn = 0; tn < 8; ++tn) { const int dv = 16 * tn + l15;
            const float gt = bf2f(proj[(unsigned)tq * NP + C_G + h * 128 + dv]);
            mixed[(unsigned)tq * DM + 1024 + h * 128 + dv] = f2bf(oacc[tn][j] * r * sg[dv] * siluf_(gt)); }
    }
}

#undef oacc
__device__ __forceinline__ void rwkv_prep_task(const Params& p, int l, int task, LAS unsigned char* lds) {
    const int tid = opaque_tid(), lane = tid & 63, wave = tid >> 6, quad = lane >> 4, l15 = lane & 15;
    const int tile = task >> 3, h = task & 7, tb = 64 * tile;
    const int T = tb < NPT ? 256 : 1024, seq0 = tb < NPT ? (tb & ~255) : NPT + ((tb - NPT) & ~1023);
    LAS bf16_t* sTW = (LAS bf16_t*)lds;
    LAS bf16_t* sAD = sTW + 2 * 64 * 72;
    LAS bf16_t* sWup = sAD + 2 * 64 * 72;
    LAS bf16_t* sAup = sWup + 2 * 64 * 72;
    LAS float* sR = (LAS float*)(sAup + 2 * 64 * 72);
    LAS float* sKf = sR + 4096; LAS float* sVf = sKf + 4096; LAS float* sNrm = sVf + 4096; LAS float* sRK = sNrm + 64;
    const bf16_t* proj = (const bf16_t*)(p.ws + WS_PROJ);
    __syncthreads();
#pragma unroll
    for (int it = 0; it < 4; ++it) {
        const int idx = tid + 512 * it, arr = idx >> 9, i = (idx >> 3) & 63, g = idx & 7;
        const u32x4v w = *(const u32x4v*)(proj + (size_t)(tb + i) * NP + A_WD + 64 * arr + 8 * g);
        if (arr < 2) { float x[8]; unpack8(w, x);
#pragma unroll
            for (int e = 0; e < 8; ++e) x[e] = tanhf_(x[e]);
            *(LAS u32x4v*)(sTW + (arr * 64 + i) * 72 + 8 * g) = pack8(x); }
        else *(LAS u32x4v*)(sAD + ((arr - 2) * 64 + i) * 72 + 8 * g) = w;
    }
#pragma unroll
    for (int it = 0; it < 4; ++it) {
        const int dd2 = it >> 1, which = it & 1, c = tid >> 3, jg = tid & 7;
        const bf16_t* src = (const bf16_t*)(p.ws + WS_WUPT) + ((((size_t)(l * 2 + dd2) * 2 + which) * 8 + h) * 4096) + c * 64 + 8 * jg;
        *(LAS u32x4v*)((which ? sAup : sWup) + (dd2 * 64 + c) * 72 + 8 * jg) = *(const u32x4v*)src;
    }
#pragma unroll
    for (int it = 0; it < 3; ++it) {
        const int idx = tid + 512 * it, which = idx >> 9, i = (idx >> 3) & 63, g = idx & 7, ch = which * 512 + h * 64 + 8 * g;
        const int tk = tb + i, pos = tk - seq0;
        const bf16_t* src = proj + (size_t)tk * NP + ch;
        float x0[8], x1[8], x2[8], w0[8], w1[8], w2[8], bb[8];
        unpack8(*(const u32x4v*)src, x1);
        unpack8(*(const u32x4v*)(pos > 0 ? src - NP : src), x0); unpack8(*(const u32x4v*)(pos < T - 1 ? src + NP : src), x2);
        const float m0 = pos > 0 ? 1.f : 0.f, m2 = pos < T - 1 ? 1.f : 0.f;
        const float* cw = p.in[I_CAW] + (size_t)l * 3 * 1536 + ch;
        ld8f(cw, w0); ld8f(cw + 1536, w1); ld8f(cw + 3072, w2); ld8f(p.in[I_CAB] + l * 1536 + ch, bb);
        LAS float* dst = (which == 0 ? sR : (which == 1 ? sKf : sVf)) + i * 64 + 8 * g;
#pragma unroll
        for (int e = 0; e < 8; ++e) dst[e] = m0 * x0[e] * w0[e] + x1[e] * w1[e] + m2 * x2[e] * w2[e] + bb[e];
    }
    __syncthreads();
    { const int t = tid >> 3, part = tid & 7; float ss = 0.f;
#pragma unroll
        for (int e = 0; e < 8; ++e) { const float v = sKf[t * 64 + 8 * part + e] * p.in[I_KK][l * 512 + h * 64 + 8 * part + e]; ss += v * v; }
        ss += __shfl_xor(ss, 1); ss += __shfl_xor(ss, 2); ss += __shfl_xor(ss, 4);
        if (part == 0) sNrm[t] = rsqrtf(ss + 1e-12f); }
    const int dd = wave >> 2, tm = wave & 3;
    f32x4 aw[4], aa[4];
#pragma unroll
    for (int tn = 0; tn < 4; ++tn) { aw[tn] = (f32x4){0.f, 0.f, 0.f, 0.f}; aa[tn] = aw[tn];
#pragma unroll
        for (int ks = 0; ks < 2; ++ks) { aw[tn] = MFMA16(frag(sTW + dd * 64 * 72, 16 * tm, 72, 32 * ks, lane), frag(sWup + dd * 64 * 72, 16 * tn, 72, 32 * ks, lane), aw[tn]);
            aa[tn] = MFMA16(frag(sAD + dd * 64 * 72, 16 * tm, 72, 32 * ks, lane), frag(sAup + dd * 64 * 72, 16 * tn, 72, 32 * ks, lane), aa[tn]); } }
    __syncthreads();
    {
        LAS bf16_t* so = sTW + dd * (3 * 4096);
        float rk[4] = {0.f, 0.f, 0.f, 0.f};
#pragma unroll
        for (int tn = 0; tn < 4; ++tn) { const int c = 16 * tn + l15, ch = h * 64 + c;
            const float w0v = p.in[I_W0][(l * 2 + dd) * 512 + ch], a0v = p.in[I_A0][(l * 2 + dd) * 512 + ch], kav = p.in[I_KA][l * 512 + ch], kkv = p.in[I_KK][l * 512 + ch], rkv = p.in[I_RK][l * 512 + ch];
#pragma unroll
            for (int j = 0; j < 4; ++j) { const int t = 16 * tm + quad * 4 + j; const int o = t * 64 + c;
                const float z = w0v + aw[tn][j]; const float dec = __expf(-0.6065306597126334f * sigmoidf_(z));
                const float av = sigmoidf_(a0v + aa[tn][j]); const float kv = sKf[t * 64 + c];
                const float ktv = kv * (1.0f + (av - 1.0f) * kav); const float kk = kv * kkv * sNrm[t];
                so[o] = f2bf(ktv); so[4096 + o] = f2bf(kk * av); so[8192 + o] = f2bf(dec - 1.0f);
                rk[j] += sR[t * 64 + c] * ktv * rkv; } }
#pragma unroll
        for (int j = 0; j < 4; ++j) { const float s = red16_sum(rk[j]); if (l15 == 0) sRK[dd * 64 + 16 * tm + quad * 4 + j] = s; }
    }
    __syncthreads();
    { const int i = tid >> 3, g = tid & 7; const size_t o = (size_t)(tb + i) * 512 + h * 64 + 8 * g;
        float r[8], k[8], v[8], bn[8]; const float nr = sNrm[i], rks = sRK[i] + sRK[64 + i];
#pragma unroll
        for (int e = 0; e < 8; ++e) { r[e] = sR[i * 64 + 8 * g + e]; k[e] = sKf[i * 64 + 8 * g + e] * p.in[I_KK][l * 512 + h * 64 + 8 * g + e] * nr; v[e] = sVf[i * 64 + 8 * g + e]; bn[e] = rks * v[e]; }
        const size_t o2 = ((size_t)(tb + i) * 8 + h) * 320 + 8 * g; bf16_t* pk = (bf16_t*)(p.ws + WS_PK);
#pragma unroll
        for (int dd2 = 0; dd2 < 2; ++dd2)
#pragma unroll
            for (int ar = 0; ar < 3; ++ar) *(u32x4v*)(pk + (size_t)dd2 * NTOK * 2560 + o2 + 128 + 64 * ar) = *(const LAS u32x4v*)(sTW + dd2 * (3 * 4096) + ar * 4096 + i * 64 + 8 * g);
        const u32x4v rr = pack8(r), kk8 = pack8(k);
        *(u32x4v*)(pk + o2) = rr; *(u32x4v*)(pk + o2 + 64) = kk8; *(u32x4v*)(pk + (size_t)NTOK * 2560 + o2) = rr; *(u32x4v*)(pk + (size_t)NTOK * 2560 + o2 + 64) = kk8;
        *(u32x4v*)((bf16_t*)(p.ws + WS_SCV) + o) = pack8(v); *(u32x4v*)((bf16_t*)(p.ws + WS_SCBON) + o) = pack8(bn); }
}

__device__ __forceinline__ void m1_phase(const Params& p, int l, LAS unsigned char* lds, int rep, int mask) {
    unsigned* ctr = (unsigned*)(p.ws + WS_CTL) + 64 * (1 + 4 * l + 8 * rep);
    LAS int* slot = (LAS int*)(lds + LDS_SLOT);
#ifndef NO_MLSTM
    if (mask & 1) for (;;) { const int t = next_task(ctr, slot); if (t >= 272) break; const int u = t < 16 ? t + 256 : t - 16; mlstm_task(p, l, u >> 3, (u >> 2) & 1, u & 3, lds); }
#endif
#ifndef NO_ATTN
    if (mask & 2) for (;;) { const int t = next_task(ctr + 64, slot); if (t >= 640) break; attn_task(p, l, t, lds); }
#endif
#ifndef NO_PREP
    if (mask & 4) for (;;) { const int t = next_task(ctr + 128, slot); if (t >= 1280) break; rwkv_prep_task(p, l, t, lds); }
#endif
}

#ifdef EXP_LITE
#if EXP_LITE == 1
#define EXPY(v) (bf2f(sBt[(quad * 4 + j) * 24 + l15]) + bf2f(sGt[(16 + quad * 4 + j) * 24 + l15]) + sW[l15 + 16 * quad])
#elif EXP_LITE == 2
#define EXPY(v) (bf2f(sAt[(quad * 4 + j) * 72 + l15]) + bf2f(sX2[(quad * 4 + j) * 24 + l15]))
#else
#define EXPY(v) (bf2f(sPy[(quad * 4 + j) * 72 + 16 + l15]) + bf2f(sQy[(quad * 4 + j) * 24 + l15]))
#endif
#define EXPS(v) 0.f
#else
#define EXPY(v) (v)
#define EXPS(v) (v)
#endif
__device__ __forceinline__ bf16_t f2bf_sw(float f) { unsigned u = __float_as_uint(f); u += 0x7FFFu + ((u >> 16) & 1u); return (bf16_t)(u >> 16); }
__device__ __forceinline__ bf16x8 frag16(const LAS bf16_t* base, int row0, int ld, int lane) {
    bf16x8 z = {0, 0, 0, 0, 0, 0, 0, 0};
    if ((lane >> 4) < 2) z = *(const LAS bf16x8*)(base + (row0 + (lane & 15)) * ld + (lane >> 4) * 8);
    return z;
}
__device__ __forceinline__ void cp_task(const Params& p, int task, int lane, LAS unsigned char* wl) {
    int s, d, h, c, T;
    if (task < 8192) { s = task >> 8; d = (task >> 7) & 1; h = (task >> 4) & 7; c = task & 15; T = 256; }
    else { const int u = task - 8192; s = 32 + (u >> 10); d = (u >> 9) & 1; h = (u >> 6) & 7; c = u & 63; T = 1024; }
    const int tok0 = s < 32 ? s * 256 : NPT + (s - 32) * 1024, quad = lane >> 4, l15 = lane & 15;
    const long step = d == 0 ? 1 : -1; const int tfirst = d == 0 ? tok0 + 16 * c : tok0 + T - 1 - 16 * c;
    bf16_t* pk = (bf16_t*)(p.ws + WS_PK) + (size_t)d * NTOK * 2560 + ((size_t)tfirst * 8 + h) * 320;
    LAS bf16_t* sA = (LAS bf16_t*)wl;
    LAS bf16_t* sB = sA + 16 * 72, *sG = sB + 16 * 72, *sR = sG + 16 * 72;
    LAS float* mL1 = (LAS float*)(sR + 16 * 72);
    LAS bf16_t* sL2 = (LAS bf16_t*)(mL1 + 16 * 17);
    LAS bf16_t* sM1t = sL2 + 16 * 24;
    LAS bf16_t* sTt = sM1t + 16 * 24;
    LAS bf16_t* sAtil = sTt + 16 * 24;
    LAS bf16_t* sX2 = sTt;
    LAS bf16_t* oAt = sB;
    LAS bf16_t* oPy = sG;
    LAS bf16_t* oX2 = (LAS bf16_t*)mL1;
    LAS bf16_t* oQy = sL2;
    float bt[16], gt[16], W = 1.0f;
    { const int k = lane;
        float rr[16], kk[16], kt[16], ka[16], wm[16];
#pragma unroll
        for (int i = 0; i < 16; ++i) { const bf16_t* rec = pk + step * 2560 * i + k; rr[i] = bf2f(rec[0]); kk[i] = bf2f(rec[64]); kt[i] = bf2f(rec[128]); ka[i] = bf2f(rec[192]); wm[i] = bf2f(rec[256]); }
#pragma unroll
        for (int i = 0; i < 16; ++i) { const float Wp = W; W = W + W * wm[i]; const float iw = __builtin_amdgcn_rcpf(W);
            sA[i * 72 + k] = f2bf(Wp * kk[i]); bt[i] = ka[i] * iw; gt[i] = kt[i] * iw; sB[i * 72 + k] = f2bf(bt[i]); sG[i * 72 + k] = f2bf(gt[i]); sR[i * 72 + k] = f2bf(W * rr[i]); } }
    LDS_FENCE();
    f32x4 m2acc;
    { f32x4 a1 = {0.f, 0.f, 0.f, 0.f}, a2 = a1, a3 = a1, a4 = a1;
#pragma unroll
        for (int ks = 0; ks < 2; ++ks) { const bf16x8 fb = frag(sB, 0, 72, 32 * ks, lane), fg = frag(sG, 0, 72, 32 * ks, lane), fa = frag(sA, 0, 72, 32 * ks, lane), fr = frag(sR, 0, 72, 32 * ks, lane);
            a1 = MFMA16(fb, fa, a1); a2 = MFMA16(fg, fa, a2); a3 = MFMA16(fb, fr, a3); a4 = MFMA16(fg, fr, a4); }
#pragma unroll
        for (int j = 0; j < 4; ++j) { const int i = quad * 4 + j, t = l15;
            mL1[i * 17 + t] = i < t ? a1[j] : 0.f; sL2[i * 24 + t] = f2bf(i < t ? a2[j] : 0.f); sM1t[t * 24 + i] = f2bf(i <= t ? a3[j] : 0.f); m2acc[j] = i <= t ? a4[j] : 0.f; } }
    LDS_FENCE();
    { float Tr[16];
#pragma unroll
        for (int t = 0; t < 16; ++t) { float acc = (l15 == t) ? 1.0f : 0.0f;
#pragma unroll
            for (int i = 0; i < t; ++i) acc -= Tr[i] * mL1[i * 17 + t];
            Tr[t] = acc; }
        if (quad == 0) {
#pragma unroll
            for (int t = 0; t < 16; ++t) sTt[t * 24 + l15] = f2bf(Tr[t]); } }
    LDS_FENCE();
    const bf16x8 ftt = frag16(sTt, 0, 24, lane);
#pragma unroll
    for (int kt2 = 0; kt2 < 4; ++kt2) {
        u32x4v aw = {0u, 0u, 0u, 0u};
        if (quad < 2) { const LAS bf16_t* col = sA + (quad * 8) * 72 + 16 * kt2 + l15;
            aw.x = (unsigned)col[0] | ((unsigned)col[72] << 16); aw.y = (unsigned)col[144] | ((unsigned)col[216] << 16); aw.z = (unsigned)col[288] | ((unsigned)col[360] << 16); aw.w = (unsigned)col[432] | ((unsigned)col[504] << 16); }
        f32x4 acc = {0.f, 0.f, 0.f, 0.f};
        acc = MFMA16(__builtin_bit_cast(bf16x8, aw), ftt, acc);
#pragma unroll
        for (int j = 0; j < 4; ++j) { const int k = 16 * kt2 + quad * 4 + j; const bf16_t v = f2bf_sw(acc[j]); sAtil[k * 24 + l15] = v; oAt[l15 * 72 + k] = v; }
    }
    { f32x4 acc = {0.f, 0.f, 0.f, 0.f};
        acc = MFMA16(frag16(sL2, 0, 24, lane), ftt, acc);
#pragma unroll
        for (int j = 0; j < 4; ++j) { const bf16_t v = f2bf_sw(acc[j]); sX2[(quad * 4 + j) * 24 + l15] = v; oX2[l15 * 24 + quad * 4 + j] = v; } }
    LDS_FENCE();
    const bf16x8 fm1 = frag16(sM1t, 0, 24, lane);
#pragma unroll
    for (int kt2 = 0; kt2 < 4; ++kt2) { f32x4 acc = {0.f, 0.f, 0.f, 0.f};
        acc = MFMA16(frag16(sAtil, 16 * kt2, 24, lane), fm1, acc);
#pragma unroll
        for (int j = 0; j < 4; ++j) { const int k = 16 * kt2 + quad * 4 + j; oPy[l15 * 72 + k] = f2bf(bf2f(sR[l15 * 72 + k]) - acc[j]); } }
    { f32x4 acc = {0.f, 0.f, 0.f, 0.f};
        acc = MFMA16(frag16(sX2, 0, 24, lane), fm1, acc);
#pragma unroll
        for (int j = 0; j < 4; ++j) oQy[l15 * 24 + quad * 4 + j] = f2bf(m2acc[j] - acc[j]); }
    LDS_FENCE();
    { float bb8[8]; const int k = lane; bf16_t* rec = pk + step * 2560 * (k >> 2);
#pragma unroll
        for (int hh = 0; hh < 2; ++hh) {
#pragma unroll
            for (int e = 0; e < 8; ++e) bb8[e] = bt[8 * hh + e];
            *(u32x4v*)(rec + 128 + (k & 3) * 16 + 8 * hh) = pack8(bb8);
#pragma unroll
            for (int e = 0; e < 8; ++e) bb8[e] = gt[8 * hh + e];
            *(u32x4v*)(rec + 192 + (k & 3) * 16 + 8 * hh) = pack8(bb8); }
        ((float*)(rec + 288))[k & 3] = W; }
#pragma unroll
    for (int it = 0; it < 2; ++it) { const int f = lane + 64 * it, t = f >> 3, q = f & 7; bf16_t* rec = pk + step * 2560 * t;
        *(u32x4v*)(rec + 8 * q) = *(const LAS u32x4v*)(oAt + t * 72 + 8 * q); *(u32x4v*)(rec + 64 + 8 * q) = *(const LAS u32x4v*)(oPy + t * 72 + 8 * q); }
    if (lane < 32) { const int t = lane >> 1, q = lane & 1; bf16_t* rec = pk + step * 2560 * t;
        *(u32x4v*)(rec + 256 + 8 * q) = *(const LAS u32x4v*)(oX2 + t * 24 + 8 * q); *(u32x4v*)(rec + 272 + 8 * q) = *(const LAS u32x4v*)(oQy + t * 24 + 8 * q); }
    LDS_FENCE();
}
constexpr int CP_LDS = 16 * 72 * 2 * 4 + 16 * 17 * 4 + (16 * 24 * 3 + 64 * 24 + 16 * 24) * 2 + 16 * 72 * 2 * 2 + 16 * 24 * 2 * 2;

__device__ __forceinline__ void ap_task(const Params& p, int l, int task, int lane, LAS unsigned char* wl) {
    int s, d, h, rt;
    if (task < 128) { s = 32 + (task >> 6); d = (task >> 5) & 1; h = (task >> 2) & 7; rt = task & 3; }
    else { const int u = task - 128; s = u >> 6; d = (u >> 5) & 1; h = (u >> 2) & 7; rt = u & 3; }
    const int T = s < 32 ? 256 : 1024, nch = T / 16, tok0 = s < 32 ? s * 256 : NPT + (s - 32) * 1024, quad = lane >> 4, l15 = lane & 15;
    const long step = d == 0 ? 1 : -1; const int tstart = d == 0 ? tok0 : tok0 + T - 1;
    const bf16_t* pk = (const bf16_t*)(p.ws + WS_PK) + (size_t)d * NTOK * 2560 + ((size_t)tstart * 8 + h) * 320;
    const bf16_t* pv = (const bf16_t*)(p.ws + WS_SCV) + (size_t)tstart * 512 + h * 64 + 16 * rt;
    float* yd = (float*)(p.ws + WS_YD) + (size_t)d * NTOK * 512 + (size_t)tstart * 512 + h * 64 + 16 * rt;
    constexpr int IS = 328;
    LAS bf16_t* img = (LAS bf16_t*)wl;
    LAS bf16_t* sS = img + 16 * IS;
    LAS bf16_t* sCm = sS + 16 * 72;
    f32x4 S[4];
    if (s >= 32) { const float* s0 = p.in[I_SRW] + ((((size_t)((s - 32) * 2 + l) * 2 + d) * 8 + h) * 64 + 16 * rt) * 64;
#pragma unroll
        for (int tn = 0; tn < 4; ++tn)
#pragma unroll
            for (int j = 0; j < 4; ++j) S[tn][j] = s0[(quad * 4 + j) * 64 + 16 * tn + l15]; }
    else {
#pragma unroll
        for (int tn = 0; tn < 4; ++tn) S[tn] = (f32x4){0.f, 0.f, 0.f, 0.f}; }
    const bf16_t* gsrc = pk + step * 2560 * (lane >> 2) + 8 * (lane & 3);
    LAS bf16_t* ldst = img + (lane >> 2) * IS + 8 * (lane & 3);
    u32x4v rawA[10], rawB[10]; bf16_t vrA[8], vrB[8];
#define AP_LOAD(raw, vraw, CH) do { int chv = (CH); asm volatile("" : "+v"(chv)); const bf16_t* cb = gsrc + step * 2560 * (16 * chv); \
        _Pragma("unroll") for (int jj = 0; jj < 10; ++jj) raw[jj] = *(const u32x4v*)(cb + 32 * jj); \
        if (quad < 2) { _Pragma("unroll") for (int e = 0; e < 8; ++e) vraw[e] = pv[step * 512 * (16 * chv + quad * 8 + e) + l15]; } } while (0)
#define AP_STAGE(raw) do { _Pragma("unroll") for (int jj = 0; jj < 10; ++jj) *(LAS u32x4v*)(ldst + 32 * jj) = raw[jj]; } while (0)
    AP_LOAD(rawA, vrA, 0);
    if (nch > 1) AP_LOAD(rawB, vrB, 1);
    const LAS bf16_t* pBt = img + (l15 >> 2) * IS + 128 + (l15 & 3) * 16 + quad * 8;
    const LAS float* pW = (const LAS float*)(img + (l15 >> 2) * IS + 288) + (l15 & 3);
#define AP_CHUNK(raw, vraw, CC) do { const int c = (CC); \
        AP_STAGE(raw); \
        u32x4v vw = {0u, 0u, 0u, 0u}; \
        if (quad < 2) { vw.x = (unsigned)vraw[0] | ((unsigned)vraw[1] << 16); vw.y = (unsigned)vraw[2] | ((unsigned)vraw[3] << 16); vw.z = (unsigned)vraw[4] | ((unsigned)vraw[5] << 16); vw.w = (unsigned)vraw[6] | ((unsigned)vraw[7] << 16); } \
        asm volatile("" : "+v"(vw)); \
        if (c + 2 < nch) AP_LOAD(raw, vraw, c + 2); \
        ap_compute(c, vw); } while (0)
    auto ap_compute = [&](int c, u32x4v vw) {
        const bf16x8 va = __builtin_bit_cast(bf16x8, vw);
#pragma unroll
        for (int tn = 0; tn < 4; ++tn) { const unsigned w01 = pk2(S[tn][0], S[tn][1]), w23 = pk2(S[tn][2], S[tn][3]); LAS bf16_t* ds = sS + (quad * 4) * 72 + 16 * tn + l15;
            ds[0] = (bf16_t)(w01 & 0xffff); ds[72] = (bf16_t)(w01 >> 16); ds[144] = (bf16_t)(w23 & 0xffff); ds[216] = (bf16_t)(w23 >> 16); }
        LDS_FENCE();
        f32x4 cm = {0.f, 0.f, 0.f, 0.f}, yy = {0.f, 0.f, 0.f, 0.f};
#pragma unroll
        for (int ks = 0; ks < 2; ++ks) { const bf16x8 fs = frag(sS, 0, 72, 32 * ks, lane); cm = MFMA16(fs, frag(img, 0, IS, 32 * ks, lane), cm); yy = MFMA16(fs, frag(img + 64, 0, IS, 32 * ks, lane), yy); }
        cm = MFMA16(va, frag16(img + 256, 0, IS, lane), cm); yy = MFMA16(va, frag16(img + 272, 0, IS, lane), yy);
#pragma unroll
        for (int j = 0; j < 4; ++j) { yd[step * 512 * (16 * c + l15) + quad * 4 + j] = yy[j]; sCm[(quad * 4 + j) * 24 + l15] = f2bf_sw(cm[j]); }
        LDS_FENCE();
        const bf16x8 fc = frag16(sCm, 0, 24, lane);
#pragma unroll
        for (int tn = 0; tn < 4; ++tn) { f32x4 ab = {0.f, 0.f, 0.f, 0.f}, ag = ab;
            bf16x8 fb = {0, 0, 0, 0, 0, 0, 0, 0}, fg = fb;
            if (quad < 2) { fb = *(const LAS bf16x8*)(pBt + tn * 4 * IS); fg = *(const LAS bf16x8*)(pBt + tn * 4 * IS + 64); }
            ab = MFMA16(fc, fb, ab); ag = MFMA16(va, fg, ag);
            const float w16 = pW[tn * 2 * IS];
#pragma unroll
            for (int j = 0; j < 4; ++j) S[tn][j] = (S[tn][j] - ab[j] + ag[j]) * w16; }
        LDS_FENCE();
    };
    for (int c2 = 0; c2 < nch; c2 += 2) { AP_CHUNK(rawA, vrA, c2); AP_CHUNK(rawB, vrB, c2 + 1); }
#undef AP_CHUNK
#undef AP_LOAD
#undef AP_STAGE
    if (s < 32) { float* so = p.out + O_RW + ((((size_t)(s * 2 + l) * 2 + d) * 8 + h) * 64 + 16 * rt) * 64;
#pragma unroll
        for (int tn = 0; tn < 4; ++tn)
#pragma unroll
            for (int j = 0; j < 4; ++j) so[(quad * 4 + j) * 64 + 16 * tn + l15] = S[tn][j]; }
}
constexpr int AP_LDS = (16 * 72 * 2 + 64 * 24 * 2 + 16 * 24 * 2) * 2 + 64 * 4 + (16 * 72 + 16 * 24) * 2;

typedef float f32x2 __attribute__((ext_vector_type(2)));
__device__ __forceinline__ void m2_phase(const Params& p, int l, int rep, LAS unsigned char* lds, const XcdBarrier& xbar) {
    const int tid_ = opaque_tid(); const int lane = tid_ & 63, wave = tid_ >> 6;
    LAS unsigned char* wl = lds + wave * 16384;
    LAS unsigned* lq = (LAS unsigned*)(lds + LDS_SLOT + 32);
    if (tid_ == 0) *lq = 0u;
    for (int t = blockIdx.x * 8 + wave; t < 10240; t += gridDim.x * 8) cp_task(p, t, lane, wl);
    xcd_barrier(xbar);
    const int G = gridDim.x, b = blockIdx.x;
    const int nS = b < 128 ? (128 - b + G - 1) / G : 0, nP = b < 2048 ? (2048 - b + G - 1) / G : 0;
    for (;;) {
        int k = 0; if (lane == 0) k = (int)__hip_atomic_fetch_add(lq, 1u, __ATOMIC_RELAXED, __HIP_MEMORY_SCOPE_WORKGROUP);
        k = __builtin_amdgcn_readfirstlane(k);
        if (k >= nS + nP) break;
        ap_task(p, l, k < nS ? b + k * G : 128 + b + (k - nS) * G, lane, wl);
    }
}

__device__ __forceinline__ void m3_phase(const Params& p, int l) {
    const int tid_ = opaque_tid(); const int lane = tid_ & 63, gw = blockIdx.x * 8 + (tid_ >> 6), NGW = gridDim.x * 8;
    const bf16_t* proj = (const bf16_t*)(p.ws + WS_PROJ);
    bf16_t* mixed = (bf16_t*)(p.ws + WS_UM);
    const int c = lane * 8;
    for (int tok = gw; tok < NTOK; tok += NGW) {
        const size_t o = (size_t)tok * 512 + c;
        {
            float y0[8], y1[8], g[8], bb[8], bn[8], gt[8], out[8];
            ld8f((const float*)(p.ws + WS_YD) + o, y0); ld8f((const float*)(p.ws + WS_YD) + (size_t)NTOK * 512 + o, y1);
            float s = 0.f;
#pragma unroll
            for (int e = 0; e < 8; ++e) { y0[e] += y1[e]; s += y0[e]; }
            s += __shfl_xor(s, 1); s += __shfl_xor(s, 2); s += __shfl_xor(s, 4);
            const float mu = s * (1.0f / 64.0f); float q = 0.f;
#pragma unroll
            for (int e = 0; e < 8; ++e) { y0[e] -= mu; q += y0[e] * y0[e]; }
            q += __shfl_xor(q, 1); q += __shfl_xor(q, 2); q += __shfl_xor(q, 4);
            const float rs = rsqrtf(q * (1.0f / 64.0f) + 64e-5f);
            ld8f(p.in[I_RGG] + l * 512 + c, g); ld8f(p.in[I_RGB] + l * 512 + c, bb);
            unpack8(*(const u32x4v*)((const bf16_t*)(p.ws + WS_SCBON) + o), bn);
            unpack8(*(const u32x4v*)(proj + (size_t)tok * NP + A_GATE + c), gt);
#pragma unroll
            for (int e = 0; e < 8; ++e) out[e] = (y0[e] * rs * g[e] + bb[e] + bn[e]) * siluf_(gt[e]);
            *(u32x4v*)(mixed + (size_t)tok * DM + c) = pack8(out);
        }
        {
            float h0[8], h1[8], g[8], bb[8], og[8], gt[8], out[8];
            ld8f((const float*)(p.ws + WS_HD) + o, h0); ld8f((const float*)(p.ws + WS_HD) + (size_t)NTOK * 512 + o, h1);
            unpack8(*(const u32x4v*)(proj + (size_t)tok * NP + B_O + c), og);
            float s = 0.f;
#pragma unroll
            for (int e = 0; e < 8; ++e) { h0[e] = (h0[e] + h1[e]) * sigmoidf_(og[e]); s += h0[e]; }
            s += __shfl_xor(s, 1); s += __shfl_xor(s, 2); s += __shfl_xor(s, 4); s += __shfl_xor(s, 8);
            const float mu = s * (1.0f / 128.0f); float q = 0.f;
#pragma unroll
            for (int e = 0; e < 8; ++e) { h0[e] -= mu; q += h0[e] * h0[e]; }
            q += __shfl_xor(q, 1); q += __shfl_xor(q, 2); q += __shfl_xor(q, 4); q += __shfl_xor(q, 8);
            const float rs = rsqrtf(q * (1.0f / 128.0f) + 1e-5f);
            ld8f(p.in[I_MGG] + l * 512 + c, g); ld8f(p.in[I_MGB] + l * 512 + c, bb);
            unpack8(*(const u32x4v*)(proj + (size_t)tok * NP + B_GATE + c), gt);
#pragma unroll
            for (int e = 0; e < 8; ++e) out[e] = (h0[e] * rs * g[e] + bb[e]) * siluf_(gt[e]);
            *(u32x4v*)(mixed + (size_t)tok * DM + 512 + c) = pack8(out);
        }
    }
}

__device__ __forceinline__ void ln_phase(const Params& p, int l) {
    const int tid_ = opaque_tid(); const int lane = tid_ & 63, gw = blockIdx.x * 8 + (tid_ >> 6), NGW = gridDim.x * 8;
    for (int tok = gw; tok < NTOK; tok += NGW) {
        float* zr = p.out + O_Y + (size_t)tok * DM;
        float v[4][8]; float s = 0.f;
#pragma unroll
        for (int j = 0; j < 4; ++j) { ld8f(zr + j * 512 + lane * 8, v[j]);
#pragma unroll
            for (int e = 0; e < 8; ++e) s += v[j][e]; }
#pragma unroll
        for (int o = 1; o < 64; o <<= 1) s += __shfl_xor(s, o);
        const float mu = s * (1.0f / 2048.0f); float q = 0.f;
#pragma unroll
        for (int j = 0; j < 4; ++j)
#pragma unroll
            for (int e = 0; e < 8; ++e) { v[j][e] -= mu; q += v[j][e] * v[j][e]; }
#pragma unroll
        for (int o = 1; o < 64; o <<= 1) q += __shfl_xor(q, o);
        const float rs = rsqrtf(q * (1.0f / 2048.0f) + 1e-5f);
        const float* mod = (const float*)(p.ws + WS_MOD) + (size_t)(3 + mod_row(tok)) * 6144;
        bf16_t* ur = (bf16_t*)(p.ws + WS_UM) + (size_t)tok * DM;
#pragma unroll
        for (int j = 0; j < 4; ++j) { const int c = j * 512 + lane * 8; float g[8], bb[8], y[8];
            ld8f(p.in[I_LNG] + l * DM + c, g); ld8f(p.in[I_LNB] + l * DM + c, bb);
#pragma unroll
            for (int e = 0; e < 8; ++e) y[e] = v[j][e] * rs * g[e] + bb[e];
            *(float4*)(zr + c) = make_float4(y[0], y[1], y[2], y[3]); *(float4*)(zr + c + 4) = make_float4(y[4], y[5], y[6], y[7]);
            if (l == 0) { float sh[8], sc[8], o[8]; ld8f(mod + c, sh); ld8f(mod + 2048 + c, sc);
#pragma unroll
                for (int e = 0; e < 8; ++e) o[e] = y[e] * (1.0f + sc[e]) + sh[e];
                *(u32x4v*)(ur + c) = pack8(o); } }
    }
}

#ifndef DUP_P0B
#define DUP_P0B 0
#endif
#ifndef DUP_SYNC
#define DUP_SYNC 0
#endif
#ifndef DUP_M3
#define DUP_M3 0
#endif
#ifndef DUP_G2
#define DUP_G2 0
#endif
#ifndef DUP_P0
#define DUP_P0 0
#endif
#ifndef DUP_M1
#define DUP_M1 0
#endif
#ifndef DUP_M2
#define DUP_M2 0
#endif
#ifndef DUP_G1
#define DUP_G1 0
#endif
#ifndef DUP_MASK
#define DUP_MASK 7
#endif
#ifndef PH_ALL
#define PH_ALL 1
#endif
#ifndef PH_P0
#define PH_P0 PH_ALL
#endif
#ifndef PH_G1
#define PH_G1 PH_ALL
#endif
#ifndef PH_M1
#define PH_M1 PH_ALL
#endif
#ifndef PH_M2
#define PH_M2 PH_ALL
#endif
#ifndef PH_M3
#define PH_M3 PH_ALL
#endif
#ifndef PH_G2
#define PH_G2 PH_ALL
#endif
#ifndef PH_LN
#define PH_LN PH_ALL
#endif
__global__ void __launch_bounds__(NTHREADS) hybrid_fwd(Params p) {
    extern __shared__ __attribute__((aligned(16))) unsigned char smem[];
    LAS unsigned char* lds = (LAS unsigned char*)smem;
    cg::grid_group grid = cg::this_grid();
    volatile LAS unsigned* xst = (volatile LAS unsigned*)(lds + LDS_SLOT + 16);
    if (threadIdx.x == 0) { xst[0] = 0u; xst[1] = 0u; }
    __syncthreads();
    const XcdBarrier xbar = xcd_barrier_post((unsigned*)(p.ws + WS_BAR), xst);
#define GSYNC() xcd_barrier(xbar)
#if PH_P0
    for (int rep = 0; rep < 1 + DUP_P0; ++rep) { p0_phase(p, lds, rep); if (rep < DUP_P0) GSYNC(); }
#endif
    if (p.ws == nullptr) grid.sync();
    GSYNC();
#if PH_P0
    for (int rep = 0; rep < 1 + DUP_P0B; ++rep) p0b_phase(p);
#endif
    GSYNC();
    for (int i = 0; i < DUP_SYNC; ++i) GSYNC();
    for (int l = 0; l < 2; ++l) {
#if PH_G1
        for (int rep = 0; rep < 1 + DUP_G1; ++rep) {
            pg8::Gemm g; g.A = (const bf16_t*)(p.ws + WS_UM); g.Bt = (const bf16_t*)(p.ws + WS_WIN) + (size_t)l * NP * DM; g.M = NTOK; g.N = NP; g.K = DM;
            pg8::StaticOrder S; S.init(NTOK, NP, gridDim.x, blockIdx.x);
            EpiIn E; E.proj = (bf16_t*)(p.ws + WS_PROJ); E.gates = (float*)(p.ws + WS_GATES); E.newk = p.out + O_NK; E.newv = p.out + O_NV; E.rope = (const float*)(p.ws + WS_ROPE); E.layer = l;
            pg8::gemm_phase<EpiIn, pg8::StaticOrder, false>(lds, g, S, E, nullptr);
            if (rep < DUP_G1) GSYNC();
        }
#endif
        GSYNC();
#if PH_M1
        for (int rep = 0; rep < 1 + DUP_M1; ++rep) { m1_phase(p, l, lds, rep, rep == 0 ? 7 : DUP_MASK); if (rep < DUP_M1) GSYNC(); }
#endif
        GSYNC();
#if PH_M2
        for (int rep = 0; rep < 1 + DUP_M2; ++rep) { m2_phase(p, l, rep, lds, xbar); if (rep < DUP_M2) GSYNC(); }
#endif
        GSYNC();
#if PH_M3
        for (int rep = 0; rep < 1 + DUP_M3; ++rep) m3_phase(p, l);
#endif
        GSYNC();
#if PH_G2
        for (int rep = 0; rep < 1 + (l == 0 ? DUP_G2 : 0); ++rep) {
            pg8::Gemm g; g.A = (const bf16_t*)(p.ws + WS_UM); g.Bt = (const bf16_t*)(p.ws + WS_WOUT) + (size_t)l * DM * DM; g.M = NTOK; g.N = DM; g.K = DM;
            pg8::StaticOrder S; S.init(NTOK, DM, gridDim.x, blockIdx.x);
            EpiOut E; E.xp = p.in[I_XP]; E.xs = p.in[I_XS]; E.mod = (const float*)(p.ws + WS_MOD) + (size_t)l * 3 * 6144; E.y = p.out + O_Y; E.layer = l;
            pg8::gemm_phase<EpiOut, pg8::StaticOrder, false>(lds, g, S, E, nullptr);
            if (rep < (l == 0 ? DUP_G2 : 0)) GSYNC();
        }
#endif
        GSYNC();
#if PH_LN
        ln_phase(p, l);
#endif
        if (l == 0) GSYNC();
    }
}

extern "C" void kernel_launch(void* const* d_in, const int* in_sizes, int n_in, void* d_out, int out_size, void* d_ws, size_t ws_size, hipStream_t stream) {
    static int grid_blocks = 0;
    if (grid_blocks == 0) {
        if (n_in != 38 || ws_size < WS_END) { fprintf(stderr, "kernel_launch: unexpected n_in %d / ws_size %zu (need %zu)\n", n_in, ws_size, (size_t)WS_END); grid_blocks = -1; return; }
        int dev = 0, cus = 0, per_cu = 0;
        hipGetDevice(&dev);
        hipDeviceGetAttribute(&cus, hipDeviceAttributeMultiprocessorCount, dev);
        hipFuncSetAttribute((const void*)hybrid_fwd, hipFuncAttributeMaxDynamicSharedMemorySize, LDS_BYTES);
        hipOccupancyMaxActiveBlocksPerMultiprocessor(&per_cu, (const void*)hybrid_fwd, NTHREADS, LDS_BYTES);
        if (per_cu < 1) { fprintf(stderr, "kernel_launch: occupancy query gives %d blocks per CU\n", per_cu); per_cu = 1; }
        grid_blocks = cus * per_cu;
    }
    if (grid_blocks < 0) return;
    Params p{};
    for (int i = 0; i < 38; ++i) p.in[i] = (const float*)d_in[i];
    p.out = (float*)d_out; p.ws = (unsigned char*)d_ws;
    hipMemsetAsync(d_ws, 0, 32768, stream);
    void* args[] = {&p};
    hipError_t e = hipLaunchCooperativeKernel((const void*)hybrid_fwd, dim3(grid_blocks), dim3(NTHREADS), args, LDS_BYTES, stream);
    if (e != hipSuccess) fprintf(stderr, "cooperative launch failed: %s (grid %d)\n", hipGetErrorString(e), grid_blocks);
}
```

```cpp
#include <hip/hip_runtime.h>
#include <hip/hip_cooperative_groups.h>
#include <cstdio>
#include <cstdint>
namespace cg = cooperative_groups;
namespace pg8 {
#define PG8_LAS __attribute__((address_space(3)))
typedef unsigned short bf16_t;
typedef short bf16x8 __attribute__((ext_vector_type(8)));
typedef float f32x4 __attribute__((ext_vector_type(4)));
typedef unsigned u32x4 __attribute__((ext_vector_type(4)));
constexpr int BM = 256, BK = 64, HALF = 128, HTB = HALF * BK * 2  , STAGE_BYTES = 8 * HTB, NXCD = 8, WGM = 8;

__host__ __device__ __forceinline__ int lds_byte(int r, int c) { const int st = (r >> 4) * 2 + (c >> 5), rr = r & 15, cc = c & 31, ob = rr * 64 + cc * 2; return st * 1024 + (ob ^ (((ob >> 9) & 1) << 5)); }
__host__ __device__ __forceinline__ void stage_rc(int b, int& R, int& C) { const int st = b / 1024, sb = b % 1024, swz = sb ^ (((sb >> 9) & 1) << 5); R = (st >> 1) * 16 + swz / 64; C = (st & 1) * 32 + (swz % 64) / 2; }
__host__ __device__ __forceinline__ int perm32(int rho) { const int n = rho >> 4, i = rho & 15; return 8 * (i >> 2) + 4 * n + (i & 3); }

struct Unit { int pm, pn; };
struct Gemm { const bf16_t* A; const bf16_t* Bt; int M, N, K; };

struct StaticOrder {
    int nM, nN, nwg, G, c;
    __host__ __device__ void init(int M, int N, int G_, int c_) { nM = M / BM; nN = N / BM; nwg = nM * nN; G = G_; c = c_; }
    __host__ __device__ bool next(int i, Unit& u) const {
        const long L = (long)i * G + c; if (L >= nwg) return false;
        int wgid = (int)L; { const int q = nwg / NXCD, r = nwg % NXCD, xcd = wgid % NXCD, off = wgid / NXCD; wgid = (xcd < r ? xcd * (q + 1) : r * (q + 1) + (xcd - r) * q) + off; }
        const int nig = WGM * nN, gid = wgid / nig, fm = gid * WGM, gsz = (nM - fm) < WGM ? (nM - fm) : WGM;
        u.pm = fm + ((wgid % nig) % gsz); u.pn = (wgid % nig) / gsz; return true;
    }
    __device__ __forceinline__ void a_ready(const Unit&) const {}
    __device__ __forceinline__ void done(const Unit&) const {}
};
__device__ __forceinline__ unsigned cvt_pk_bf16(float lo, float hi) { unsigned r; asm volatile("v_cvt_pk_bf16_f32 %0, %1, %2" : "=v"(r) : "v"(lo), "v"(hi)); return r; }
template <class Epi, class Sched, bool STAMP = false>
__device__ __forceinline__ void gemm_phase(PG8_LAS unsigned char* lds, const Gemm g, const Sched& S, const Epi& E, unsigned long long* stamps) {
    int tid = threadIdx.x; asm volatile("" : "+v"(tid)); const int wid = __builtin_amdgcn_readfirstlane(tid >> 6), lane = tid & 63, wr = wid >> 2, wc = wid & 3, fr = lane & 15, fq = lane >> 4;
    const int K = g.K, nt = K / BK;
    int ts_lo = 0, ts_hi = 0, nts = 0; const unsigned long long rt_entry = STAMP ? (unsigned long long)wall_clock64() : 0ull;
#define PG8_STAMP() do { if (STAMP && wid == 0 && nts < 64) { const unsigned long long _c = (unsigned long long)clock64(); \
        ts_lo = (lane == nts) ? (int)(unsigned)_c : ts_lo; ts_hi = (lane == nts) ? (int)(unsigned)(_c >> 32) : ts_hi; ++nts; } } while (0)
    PG8_STAMP();
    unsigned voffA[2], voffB[2];
#pragma unroll
    for (int i = 0; i < 2; ++i) { int R, C; stage_rc(tid * 16 + i * 8192, R, C); const int Rb = Epi::PERM ? ((R & ~31) + perm32(R & 31)) : R;
        voffA[i] = (unsigned)(R * K + C) * 2u; voffB[i] = (unsigned)(Rb * K + C) * 2u; }
    const size_t kstep = (size_t)(BK * 2);
    const size_t hstep = (size_t)HALF * K * 2;
    const size_t tstep = 2 * hstep;
    const unsigned ldsw = (unsigned)wid * 1024u;
    const int aoff = lds_byte(wr * 64 + fr, fq * 8), boff = lds_byte(wc * 32 + fr, fq * 8);
#define PG8_SA(b, h) (((b) * 2 + (h)) * HTB)
#define PG8_SB(b, h) ((4 + (b) * 2 + (h)) * HTB)
#define PG8_STAGE(bufoff, gbase, voff) do { _Pragma("unroll") for (int _i = 0; _i < 2; ++_i) \
        __builtin_amdgcn_global_load_lds((const unsigned*)((const char*)(gbase) + (voff)[_i]), (PG8_LAS unsigned*)(lds + (bufoff) + ldsw + _i * 8192), 16, 0, 0); } while (0)
#define PG8_LDA(dst, b, h) do { _Pragma("unroll") for (int m = 0; m < 4; ++m) _Pragma("unroll") for (int k = 0; k < 2; ++k) dst[m][k] = *(const PG8_LAS bf16x8*)(lds + PG8_SA(b, h) + aoff + m * 2048 + k * 1024); } while (0)
#define PG8_LDB(dst, b, h) do { _Pragma("unroll") for (int n = 0; n < 2; ++n) _Pragma("unroll") for (int k = 0; k < 2; ++k) dst[n][k] = *(const PG8_LAS bf16x8*)(lds + PG8_SB(b, h) + boff + n * 2048 + k * 1024); } while (0)
#define PG8_MMA(ai, bj, At, Bt) do { __builtin_amdgcn_s_setprio(1); _Pragma("unroll") for (int m = 0; m < 4; ++m) _Pragma("unroll") for (int n = 0; n < 2; ++n) _Pragma("unroll") for (int k = 0; k < 2; ++k) \
        acc[ai][bj][m][n] = __builtin_amdgcn_mfma_f32_16x16x32_bf16(Bt[n][k], At[m][k], acc[ai][bj][m][n], 0, 0, 0); __builtin_amdgcn_s_setprio(0); } while (0)
#define PG8_WAIT_V(n) asm volatile("s_waitcnt vmcnt(" #n ")" ::: "memory")
#define PG8_WAIT_L(n) asm volatile("s_waitcnt lgkmcnt(" #n ")" ::: "memory")
#define PG8_BAR __builtin_amdgcn_s_barrier()
#define PG8_SCHED __builtin_amdgcn_sched_barrier(0)
    Unit cur, nxt; int ui = 0;
    if (!S.next(0, cur)) return;
    f32x4 acc[2][2][4][2];
#pragma unroll
    for (int a = 0; a < 2; ++a)
#pragma unroll
        for (int b = 0; b < 2; ++b)
#pragma unroll
            for (int m = 0; m < 4; ++m)
#pragma unroll
                for (int n = 0; n < 2; ++n) acc[a][b][m][n] = (f32x4){0.f, 0.f, 0.f, 0.f};
    bf16x8 At[4][2], B0[2][2], B1[2][2];
    const char* cA = (const char*)g.A + (size_t)cur.pm * tstep; const char* cB = (const char*)g.Bt + (size_t)cur.pn * tstep;
    S.a_ready(cur);
    PG8_STAGE(PG8_SB(0, 0), cB, voffB); PG8_STAGE(PG8_SA(0, 0), cA, voffA); PG8_STAGE(PG8_SB(0, 1), cB + hstep, voffB); PG8_STAGE(PG8_SA(0, 1), cA + hstep, voffA);
    if (wr == 1) PG8_BAR;
    PG8_WAIT_V(4); PG8_BAR;
    PG8_STAGE(PG8_SB(1, 0), cB + kstep, voffB); PG8_STAGE(PG8_SA(1, 0), cA + kstep, voffA); PG8_STAGE(PG8_SB(1, 1), cB + hstep + kstep, voffB);
    PG8_WAIT_V(6); PG8_BAR;
    PG8_STAMP();
    for (;;) {
        const bool has_next = S.next(ui + 1, nxt);
        const char* nA = has_next ? (const char*)g.A + (size_t)nxt.pm * tstep : cA; const char* nB = has_next ? (const char*)g.Bt + (size_t)nxt.pn * tstep : cB;
        for (int t = 0; t < nt; t += 2) {
            const bool last = (t == nt - 2);
            const char* a1 = cA + (size_t)(t + 1) * kstep;
            const char* a2 = last ? nA : cA + (size_t)(t + 2) * kstep; const char* b2 = last ? nB : cB + (size_t)(t + 2) * kstep;
            const char* a3 = a2 + kstep; const char* b3 = b2 + kstep;
            if (last && has_next) S.a_ready(nxt);
            PG8_LDB(B0, 0, 0); PG8_SCHED; PG8_LDA(At, 0, 0); PG8_STAGE(PG8_SA(1, 1), a1 + hstep, voffA);
            PG8_WAIT_L(8); PG8_BAR; PG8_WAIT_L(0); PG8_MMA(0, 0, At, B0); PG8_BAR; PG8_SCHED;
            PG8_LDB(B1, 0, 1); PG8_STAGE(PG8_SB(0, 0), b2, voffB);
            PG8_BAR; PG8_WAIT_L(0); PG8_MMA(0, 1, At, B1); PG8_BAR;
            PG8_LDA(At, 0, 1); PG8_STAGE(PG8_SA(0, 0), a2, voffA);
            PG8_BAR; PG8_WAIT_L(0); PG8_MMA(1, 0, At, B0); PG8_BAR; PG8_SCHED;
            PG8_STAGE(PG8_SB(0, 1), b2 + hstep, voffB);
            PG8_WAIT_V(6); PG8_BAR; PG8_MMA(1, 1, At, B1); PG8_BAR;
            PG8_LDB(B0, 1, 0); PG8_SCHED; PG8_LDA(At, 1, 0); PG8_STAGE(PG8_SA(0, 1), a2 + hstep, voffA);
            PG8_WAIT_L(8); PG8_BAR; PG8_WAIT_L(0); PG8_MMA(0, 0, At, B0); PG8_BAR; PG8_SCHED;
            PG8_LDB(B1, 1, 1); PG8_STAGE(PG8_SB(1, 0), b3, voffB);
            PG8_BAR; PG8_WAIT_L(0); PG8_MMA(0, 1, At, B1); PG8_BAR;
            PG8_LDA(At, 1, 1); PG8_STAGE(PG8_SA(1, 0), a3, voffA);
            PG8_BAR; PG8_WAIT_L(0); PG8_MMA(1, 0, At, B0); PG8_BAR; PG8_SCHED;
            PG8_STAGE(PG8_SB(1, 1), b3 + hstep, voffB);
            PG8_WAIT_V(6); PG8_BAR; PG8_MMA(1, 1, At, B1); PG8_BAR;
        }
        PG8_STAMP();
        if constexpr (!Epi::AFTER_DRAIN) { E(acc, cur, wr, wc, fr, fq); S.done(cur); }
        PG8_STAMP();
        if (!has_next) break;
#pragma unroll
        for (int a = 0; a < 2; ++a)
#pragma unroll
            for (int b = 0; b < 2; ++b)
#pragma unroll
                for (int m = 0; m < 4; ++m)
#pragma unroll
                    for (int n = 0; n < 2; ++n) acc[a][b][m][n] = (f32x4){0.f, 0.f, 0.f, 0.f};
        cur = nxt; cA = nA; cB = nB; ++ui;
    }
    PG8_WAIT_V(0);
    if (wr == 0) PG8_BAR;
    PG8_BAR;
    if constexpr (Epi::AFTER_DRAIN) { E.fused(acc, cur, wr, wc, fr, fq, lds, wid, lane); S.done(cur); }
    PG8_STAMP();
    if (STAMP && wid == 0) { stamps[lane] = lane < nts ? (((unsigned long long)(unsigned)ts_hi << 32) | (unsigned)ts_lo) : 0ull;
        if (lane == 62) stamps[62] = rt_entry; if (lane == 63) stamps[63] = (unsigned long long)wall_clock64(); }
#undef PG8_STAMP
#undef PG8_SA
#undef PG8_SB
#undef PG8_STAGE
#undef PG8_LDA
#undef PG8_LDB
#undef PG8_MMA
#undef PG8_WAIT_V
#undef PG8_WAIT_L
#undef PG8_BAR
#undef PG8_SCHED
}
}

#define LAS __attribute__((address_space(3)))
#ifndef DUP_M2MASK
#define DUP_M2MASK 3
#endif
typedef unsigned short bf16_t;
typedef short bf16x8 __attribute__((ext_vector_type(8)));
typedef float f32x4 __attribute__((ext_vector_type(4)));
typedef unsigned u32x4v __attribute__((ext_vector_type(4)));
typedef unsigned u32x2v __attribute__((ext_vector_type(2)));

constexpr int NTOK = 10240, NPT = 8192, DM = 2048, NP = 9216, PIN = 8976;
constexpr int C_Q = 4864, C_K = 5888, C_V = 6912, C_G = 7936, C_IF = 8960;
constexpr int A_WD = 1536, A_AD = 1664, A_GATE = 1792;
constexpr int B_Q = 2304, B_V = 3328, B_O = 3840, B_GATE = 4352;
constexpr int NTHREADS = 512;
constexpr int LDS_SLOT = 131072, LDS_BYTES = 131072 + 1024;

constexpr size_t WS_CTL = 0;
constexpr size_t WS_BAR = 8192;
constexpr size_t WS_MOD = 32768;
constexpr size_t WS_ROPE = WS_MOD + 147456;
constexpr size_t WS_LAM = WS_ROPE + 8192;
constexpr size_t WS_WIN = WS_LAM + 256;
constexpr size_t WS_WOUT = WS_WIN + 2ull * NP * DM * 2;
constexpr size_t WS_UM = WS_WOUT + 2ull * DM * DM * 2;
constexpr size_t WS_PROJ = WS_UM + (size_t)NTOK * DM * 2;
constexpr size_t WS_GATES = WS_PROJ + (size_t)NTOK * NP * 2;
constexpr size_t SZ16 = (size_t)NTOK * 512 * 2, SZ32 = (size_t)NTOK * 512 * 4;
constexpr size_t WS_SCV = WS_GATES + (size_t)NTOK * 16 * 4;
constexpr size_t WS_SCBON = WS_SCV + SZ16;
constexpr size_t WS_PK = WS_SCBON + SZ16;
constexpr size_t SZPK = (size_t)NTOK * 8 * 320 * 2;
constexpr size_t WS_YD = WS_PK + 2 * SZPK;
constexpr size_t WS_HD = WS_YD + 2 * SZ32;
constexpr size_t WS_KC = WS_HD + 2 * SZ32;
constexpr size_t WS_VTC = WS_KC + 4194304;
constexpr size_t WS_WUPT = WS_VTC + 4194304;
constexpr size_t WS_END = WS_WUPT + 524288;

constexpr size_t O_Y = 0, O_NK = 20971520, O_NV = 37748736, O_RW = 54525952, O_MC = 58720256, O_MN = 67108864, O_MM = 67174400;

struct Params { const float* in[38]; float* out; unsigned char* ws; };
enum { I_XP = 0, I_XS, I_CK, I_CV, I_SRW, I_SMC, I_SMN, I_SMM, I_C, I_CCTX, I_WADA, I_BADA, I_WIN, I_CAW, I_CAB, I_W0, I_WUP, I_A0, I_AUP, I_KK, I_KA, I_RK,
       I_RGG, I_RGB, I_CBW, I_CBB, I_BI, I_BF, I_MGG, I_MGB, I_LQ1, I_LK1, I_LQ2, I_LK2, I_SUBG, I_WOUT, I_LNG, I_LNB };

__device__ __forceinline__ float bf2f(bf16_t v) { return __uint_as_float(((unsigned)v) << 16); }
__device__ __forceinline__ float bflo(unsigned w) { return __uint_as_float(w << 16); }
__device__ __forceinline__ float bfhi(unsigned w) { return __uint_as_float(w & 0xffff0000u); }
__device__ __forceinline__ unsigned pk2(float lo, float hi) { return pg8::cvt_pk_bf16(lo, hi); }
__device__ __forceinline__ bf16_t f2bf(float f) { return (bf16_t)(pk2(f, 0.f) & 0xffffu); }
__device__ __forceinline__ void unpack8(const u32x4v w, float (&o)[8]) { o[0] = bflo(w.x); o[1] = bfhi(w.x); o[2] = bflo(w.y); o[3] = bfhi(w.y); o[4] = bflo(w.z); o[5] = bfhi(w.z); o[6] = bflo(w.w); o[7] = bfhi(w.w); }
__device__ __forceinline__ u32x4v pack8(const float (&o)[8]) { u32x4v w; w.x = pk2(o[0], o[1]); w.y = pk2(o[2], o[3]); w.z = pk2(o[4], o[5]); w.w = pk2(o[6], o[7]); return w; }
__device__ __forceinline__ void ld8f(const float* p, float (&o)[8]) { const float4 a = *(const float4*)p, b = *(const float4*)(p + 4); o[0] = a.x; o[1] = a.y; o[2] = a.z; o[3] = a.w; o[4] = b.x; o[5] = b.y; o[6] = b.z; o[7] = b.w; }
__device__ __forceinline__ float sigmoidf_(float x) { return __builtin_amdgcn_rcpf(1.0f + __expf(-x)); }
__device__ __forceinline__ float siluf_(float x) { return x * __builtin_amdgcn_rcpf(1.0f + __expf(-x)); }
__device__ __forceinline__ float tanhf_(float x) { return 1.0f - 2.0f * __builtin_amdgcn_rcpf(1.0f + __expf(2.0f * x)); }
__device__ __forceinline__ bf16x8 frag(const LAS bf16_t* base, int row0, int ld, int k0, int lane) { return *(const LAS bf16x8*)(base + (row0 + (lane & 15)) * ld + k0 + (lane >> 4) * 8); }
__device__ __forceinline__ bf16x8 fragsw(const LAS bf16_t* base, int row0, int k0, int lane) { const int r = row0 + (lane & 15), m = (k0 >> 3) + (lane >> 4); return *(const LAS bf16x8*)(base + r * 72 + 8 * (m ^ ((r >> 3) & 7))); }
#define MFMA16(a, b, c) __builtin_amdgcn_mfma_f32_16x16x32_bf16((a), (b), (c), 0, 0, 0)
#define LDS_FENCE() asm volatile("s_waitcnt lgkmcnt(0)" ::: "memory")
template <int CTRL> __device__ __forceinline__ float dppf(float x) { return __builtin_bit_cast(float, __builtin_amdgcn_mov_dpp(__builtin_bit_cast(int, x), CTRL, 0xf, 0xf, true)); }
__device__ __forceinline__ float red16_sum(float x) { x += dppf<0xB1>(x); x += dppf<0x4E>(x); x += dppf<0x124>(x); x += dppf<0x128>(x); return x; }
__device__ __forceinline__ float red4_sum(float x) { x += dppf<0xB1>(x); x += dppf<0x4E>(x); return x; }
__device__ __forceinline__ float red16_max(float x) { x = fmaxf(x, dppf<0xB1>(x)); x = fmaxf(x, dppf<0x4E>(x)); x = fmaxf(x, dppf<0x124>(x)); x = fmaxf(x, dppf<0x128>(x)); return x; }

__device__ __forceinline__ int opaque_tid() { int t = threadIdx.x; asm volatile("" : "+v"(t)); return t; }
__device__ __forceinline__ int next_task(unsigned* ctr, LAS int* slot) {
    __syncthreads();
    if (threadIdx.x == 0) *slot = (int)atomicAdd(ctr, 1u);
    __syncthreads();
    return *slot;
}
#define QNEXT_BEGIN(ctr) unsigned qn_ = 0u; if (threadIdx.x == 0) qn_ = atomicAdd((ctr), 1u)
#define QNEXT_END(slot, t) do { __syncthreads(); if (threadIdx.x == 0) *(slot) = (int)qn_; __syncthreads(); (t) = *(slot); } while (0)
__device__ __forceinline__ int win_src_col(int n) { return n < 4352 ? n : (n < 8960 ? n + 16 : (n < 8976 ? n - 8960 + 4352 : -1)); }
__device__ __forceinline__ int mod_row(int tok) { return tok < NPT ? 0 : 1 + ((tok - NPT) >> 10); }

__device__ __forceinline__ void p0_mod_item(const Params& p, int item, LAS unsigned char* lds) {
    const int tid = opaque_tid(), lane = tid & 63, wave = tid >> 6, kq = lane >> 4, cq = lane & 15;
    const int l = item / 96, cb = item % 96;
    LAS float* sS = (LAS float*)lds;
    LAS float* sRed = sS + 3 * 2048;
    for (int e = tid; e < 3 * 2048; e += NTHREADS) { const int r = e >> 11, k = e & 2047; const float cv = r == 0 ? p.in[I_CCTX][k] : p.in[I_C][(r - 1) * 2048 + k]; sS[e] = siluf_(cv); }
    __syncthreads();
    const float* W = p.in[I_WADA] + (size_t)l * 2048 * 6144 + cb * 64 + 4 * cq;
    float4 a0 = {0, 0, 0, 0}, a1 = a0, a2 = a0;
#pragma unroll 16
    for (int i = 0; i < 64; ++i) { const int k = wave * 256 + i * 4 + kq; const float4 w = *(const float4*)(W + (size_t)k * 6144);
        const float s0 = sS[k], s1 = sS[2048 + k], s2 = sS[4096 + k];
        a0.x += s0 * w.x; a0.y += s0 * w.y; a0.z += s0 * w.z; a0.w += s0 * w.w;
        a1.x += s1 * w.x; a1.y += s1 * w.y; a1.z += s1 * w.z; a1.w += s1 * w.w;
        a2.x += s2 * w.x; a2.y += s2 * w.y; a2.z += s2 * w.z; a2.w += s2 * w.w; }
    float v[12] = {a0.x, a0.y, a0.z, a0.w, a1.x, a1.y, a1.z, a1.w, a2.x, a2.y, a2.z, a2.w};
#pragma unroll
    for (int i = 0; i < 12; ++i) { v[i] += __shfl_xor(v[i], 16); v[i] += __shfl_xor(v[i], 32); }
    if (kq == 0) {
#pragma unroll
        for (int r = 0; r < 3; ++r)
#pragma unroll
            for (int e = 0; e < 4; ++e) sRed[(wave * 3 + r) * 64 + 4 * cq + e] = v[r * 4 + e];
    }
    __syncthreads();
    if (tid < 192) { const int r = tid >> 6, c = tid & 63; float s = 0.f;
#pragma unroll
        for (int w = 0; w < 8; ++w) s += sRed[(w * 3 + r) * 64 + c];
        ((float*)(p.ws + WS_MOD))[(l * 3 + r) * 6144 + cb * 64 + c] = s + p.in[I_BADA][l * 6144 + cb * 64 + c]; }
}
template <bool MAPCOL> __device__ __forceinline__ void p0_transpose_item(const float* W, int N, int nblk, bf16_t* WT, LAS float* scr, int item, int lane) {
    const int kb = item / nblk, nb = item % nblk, k0 = 64 * kb, n0 = 32 * nb;
    const int n = n0 + (lane & 31); const int oc = MAPCOL ? win_src_col(n) : n;
    float tv[32];
    const float* wp = W + (size_t)(k0 + (lane >> 5)) * N + (oc >= 0 ? oc : 0);
#pragma unroll
    for (int i = 0; i < 32; ++i) tv[i] = wp[(size_t)(2 * i) * N];
#pragma unroll
    for (int i = 0; i < 32; ++i) scr[(2 * i + (lane >> 5)) * 33 + (lane & 31)] = oc >= 0 ? tv[i] : 0.f;
    LDS_FENCE();
    const int c = lane & 7;
#pragma unroll
    for (int j = 0; j < 4; ++j) { const int nn = (lane >> 3) + 8 * j; const LAS float* s = scr + (8 * c) * 33 + nn;
        u32x4v o; o.x = pk2(s[0 * 33], s[1 * 33]); o.y = pk2(s[2 * 33], s[3 * 33]); o.z = pk2(s[4 * 33], s[5 * 33]); o.w = pk2(s[6 * 33], s[7 * 33]);
        *(u32x4v*)(WT + (size_t)(n0 + nn) * 2048 + k0 + 8 * c) = o; }
    LDS_FENCE();
}
__device__ __forceinline__ void p0_phase(const Params& p, LAS unsigned char* lds, int rep) {
    const int tid = opaque_tid(), lane = tid & 63, wave = tid >> 6;
    unsigned* ctr = (unsigned*)(p.ws + WS_CTL) + 64 * 15 * rep;
    LAS int* slot = (LAS int*)(lds + LDS_SLOT);
    constexpr int NT_MOD = 192, NT_TR = 2816, NT_A = NT_MOD + 1 + NT_TR, NT_KC = 512, NT_VT = 512, NT_WU = 64, NT = NT_A + NT_KC + NT_VT + NT_WU;
    for (;;) {
        const int t = next_task(ctr, slot);
        if (t >= NT) break;
        if (t < NT_MOD) { p0_mod_item(p, t, lds); continue; }
        if (t == NT_MOD) {
            float* rope = (float*)(p.ws + WS_ROPE);
            for (int e = tid; e < 1024; e += NTHREADS) { const int pos = e >> 4, i = e & 15; const float inv = 1.0f / powf(10000.0f, (float)(2 * i) / 32.0f); const float ang = (float)pos * inv;
                rope[pos * 32 + i] = cosf(ang); rope[pos * 32 + 16 + i] = sinf(ang); }
            if (tid < 2) { const int l = tid; float d1 = 0.f, d2 = 0.f;
                for (int i = 0; i < 64; ++i) { d1 += p.in[I_LQ1][l * 64 + i] * p.in[I_LK1][l * 64 + i]; d2 += p.in[I_LQ2][l * 64 + i] * p.in[I_LK2][l * 64 + i]; }
                const float lam_init = 0.8f - 0.6f * expf(-0.3f * (float)l);
                ((float*)(p.ws + WS_LAM))[l] = expf(d1) - expf(d2) + lam_init; }
            continue;
        }
        if (t >= NT_A) {
            int u = t - NT_A;
            if (u < NT_KC) { const size_t o = ((size_t)u * 512 + tid) * 8; float x[8]; ld8f(p.in[I_CK] + o, x); *(u32x4v*)((bf16_t*)(p.ws + WS_KC) + o) = pack8(x); continue; }
            u -= NT_KC;
            if (u < NT_VT) { const int idx = u * 512 + tid, dv = idx & 127, m = (idx >> 7) & 63, bh = idx >> 13; float x[8];
#pragma unroll
                for (int e = 0; e < 8; ++e) x[e] = p.in[I_CV][((size_t)bh * 512 + 8 * m + e) * 128 + dv];
                *(u32x4v*)((bf16_t*)(p.ws + WS_VTC) + ((size_t)bh * 128 + dv) * 512 + 8 * m) = pack8(x); continue; }
            u -= NT_VT;
#pragma unroll
            for (int e = 0; e < 8; ++e) { const int f = u * 4096 + e * 512 + tid, c = f & 63, j = (f >> 6) & 63, h = (f >> 12) & 7, which = (f >> 15) & 1, ld = f >> 16;
                const float v = (which ? p.in[I_AUP] : p.in[I_WUP])[((size_t)ld * 64 + j) * 512 + h * 64 + c];
                ((bf16_t*)(p.ws + WS_WUPT))[(f & ~4095) + c * 64 + j] = f2bf(v); }
            continue;
        }
        int it = (t - NT_MOD - 1) * 8 + wave;
        LAS float* scr = (LAS float*)(lds + wave * 8704);
        const int l = it / 11264; it -= l * 11264;
        if (it < 9216) p0_transpose_item<true>(p.in[I_WIN] + (size_t)l * 2048 * PIN, PIN, 288, (bf16_t*)(p.ws + WS_WIN) + (size_t)l * NP * 2048, scr, it, lane);
        else p0_transpose_item<false>(p.in[I_WOUT] + (size_t)l * 2048 * 2048, 2048, 64, (bf16_t*)(p.ws + WS_WOUT) + (size_t)l * 2048 * 2048, scr, it - 9216, lane);
    }
}
__device__ __forceinline__ void modulate_row(const float* xrow, const float* mod, bf16_t* urow, int lane) {
#pragma unroll
    for (int j = 0; j < 4; ++j) { const int c = j * 512 + lane * 8; float x[8], sh[8], sc[8], o[8]; ld8f(xrow + c, x); ld8f(mod + c, sh); ld8f(mod + 2048 + c, sc);
#pragma unroll
        for (int e = 0; e < 8; ++e) o[e] = x[e] * (1.0f + sc[e]) + sh[e];
        *(u32x4v*)(urow + c) = pack8(o); }
}
__device__ __forceinline__ void p0b_phase(const Params& p) {
    const int tid_ = opaque_tid(); const int lane = tid_ & 63, gw = blockIdx.x * 8 + (tid_ >> 6), NGW = gridDim.x * 8;
    for (int tok = gw; tok < NTOK; tok += NGW) {
        const float* xrow = tok < NPT ? p.in[I_XP] + (size_t)tok * DM : p.in[I_XS] + (size_t)(tok - NPT) * DM;
        modulate_row(xrow, (const float*)(p.ws + WS_MOD) + mod_row(tok) * 6144, (bf16_t*)(p.ws + WS_UM) + (size_t)tok * DM, lane);
    }
}

struct EpiIn {
    static constexpr bool PERM = true, AFTER_DRAIN = false;
    bf16_t* proj; float* gates; float* newk; float* newv; const float* rope; int layer;
    __device__ __forceinline__ void operator()(const f32x4 (&acc)[2][2][4][2], const pg8::Unit& u, int wr, int wc, int fr, int fq) const {
        const int row0 = u.pm * 256 + wr * 64 + fr, col0 = u.pn * 256 + wc * 32 + 8 * fq;
        const bool samp = u.pm >= 32;
        const bool is_rope = samp && u.pn >= 19 && u.pn < 27;
        const bool is_k = !samp && u.pn >= 23 && u.pn < 27, is_v = !samp && u.pn >= 27 && u.pn < 31, is_g = u.pn == 35;
#pragma unroll
        for (int ai = 0; ai < 2; ++ai)
#pragma unroll
            for (int m = 0; m < 4; ++m) {
                const int row = row0 + ai * 128 + m * 16;
                float cs[8], sn[8];
                if (is_rope) { const int pos = (row - NPT) & 1023; const int pp = (wc & 1) ? (pos & 63) : (pos >> 6); const float* rp = rope + pp * 32 + 8 * (fq & 1); ld8f(rp, cs); ld8f(rp + 16, sn); }
#pragma unroll
                for (int bj = 0; bj < 2; ++bj) {
                    f32x4 v0 = acc[ai][bj][m][0], v1 = acc[ai][bj][m][1];
                    if (is_rope) {
                        const float sg = (fq & 2) ? 1.0f : -1.0f;
#pragma unroll
                        for (int e = 0; e < 4; ++e) { const float p0 = __shfl_xor(v0[e], 32), p1 = __shfl_xor(v1[e], 32);
                            v0[e] = v0[e] * cs[e] + sg * p0 * sn[e]; v1[e] = v1[e] * cs[4 + e] + sg * p1 * sn[4 + e]; }
                    }
                    const int col = col0 + bj * 128;
                    u32x4v w; w.x = pk2(v0[0], v0[1]); w.y = pk2(v0[2], v0[3]); w.z = pk2(v1[0], v1[1]); w.w = pk2(v1[2], v1[3]);
                    *(u32x4v*)(proj + (size_t)row * NP + col) = w;
                    if (is_k || is_v) { const int ck = col - (is_k ? C_K : C_V), h = ck >> 7, j = ck & 127, b = row >> 8, t = row & 255;
                        float* dst = (is_k ? newk : newv) + ((((size_t)(b * 2 + layer) * 8 + h) * 256 + t) * 128 + j);
                        *(f32x4*)dst = v0; *(f32x4*)(dst + 4) = v1; }
                    if (is_g && bj == 0 && wc == 0 && fq < 2) { float* dst = gates + (size_t)row * 16 + 8 * fq; *(f32x4*)dst = v0; *(f32x4*)(dst + 4) = v1; }
                }
            }
    }
};
struct EpiOut {
    static constexpr bool PERM = false, AFTER_DRAIN = false;
    const float* xp; const float* xs; const float* mod; float* y; int layer;
    __device__ __forceinline__ void operator()(const f32x4 (&acc)[2][2][4][2], const pg8::Unit& u, int wr, int wc, int fr, int fq) const {
        const int row0 = u.pm * 256 + wr * 64 + fr, col0 = u.pn * 256 + wc * 32 + 4 * fq;
#pragma unroll
        for (int ai = 0; ai < 2; ++ai)
#pragma unroll
            for (int m = 0; m < 4; ++m) {
                const int row = row0 + ai * 128 + m * 16;
                const float* xrow = layer == 0 ? (row < NPT ? xp + (size_t)row * DM : xs + (size_t)(row - NPT) * DM) : y + (size_t)row * DM;
                const float* g = mod + mod_row(row) * 6144 + 4096;
#pragma unroll
                for (int bj = 0; bj < 2; ++bj)
#pragma unroll
                    for (int n = 0; n < 2; ++n) { const int c = col0 + bj * 128 + n * 16;
                        const f32x4 xv = *(const f32x4*)(xrow + c), gv = *(const f32x4*)(g + c);
                        *(f32x4*)(y + (size_t)row * DM + c) = 1.41421356237f * xv + gv * acc[ai][bj][m][n]; }
            }
    }
};

#define XB_TMO      128
#define XB_XCNT(j)  (256  + 64 * (j))
#define XB_XSUB(j)  (1280 + 64 * (j))
#define XB_XGEN(j)  (2304 + 64 * (j))
#define XB_TOP      3328
#define XB_TOPGEN   3392
#define XCD_BAR_WORDS 3456
#define XB_SPIN_CAP (1u << 18)

__device__ __forceinline__ unsigned xb_ld(unsigned* p)              { return __hip_atomic_load(p, __ATOMIC_RELAXED, __HIP_MEMORY_SCOPE_AGENT); }
__device__ __forceinline__ unsigned xb_add(unsigned* p, unsigned v) { return __hip_atomic_fetch_add(p, v, __ATOMIC_RELAXED, __HIP_MEMORY_SCOPE_AGENT); }
__device__ __forceinline__ unsigned xb_xcc_id() { return (unsigned)__builtin_amdgcn_s_getreg((3 << 11) | 20) & 0xFu; }
#define XB_SPIN(cond, bar) do { unsigned _sp = 0; while (cond) { __builtin_amdgcn_s_sleep(1); \
    if ((++_sp & 255u) == 0u) { if (xb_ld(&(bar)[XB_TMO])) break; if (_sp > XB_SPIN_CAP) { atomicAdd(&(bar)[XB_TMO], 1u); break; } } } } while (0)

struct XcdBarrier {
    unsigned* bar; unsigned x;
    volatile LAS unsigned* st;
};

__device__ __forceinline__ XcdBarrier xcd_barrier_post(unsigned* bar, volatile LAS unsigned* st) {
    XcdBarrier b; b.bar = bar; b.x = xb_xcc_id(); b.st = st;
    if (threadIdx.x == 0) (void)xb_add(&bar[XB_XCNT(b.x)], 1u);
    return b;
}
__device__ __forceinline__ void xcd_barrier_complete(unsigned* bar, unsigned x, unsigned& nloc, unsigned& nx) {
    const unsigned G = gridDim.x * gridDim.y * gridDim.z;
    unsigned sum, cnt, mine, sp = 0u;
    for (;;) {
        sum = 0u; cnt = 0u; mine = 0u;
#pragma unroll
        for (unsigned j = 0; j < 16; ++j) { const unsigned c = xb_ld(&bar[XB_XCNT(j)]); sum += c; cnt += (c > 0u) ? 1u : 0u; mine = (j == x) ? c : mine; }
        if (sum == G) break;
        __builtin_amdgcn_s_sleep(1);
        if ((++sp & 255u) == 0u) { if (xb_ld(&bar[XB_TMO])) break; if (sp > XB_SPIN_CAP) { atomicAdd(&bar[XB_TMO], 1u); break; } }
    }
    nloc = mine > 0u ? mine : 1u; nx = cnt > 0u ? cnt : 1u;
}

__device__ __forceinline__ unsigned xb_xcc_id_v() { unsigned r; asm volatile("s_getreg_b32 %0, hwreg(20, 0, 4)" : "=s"(r)); return r & 0xFu; }
__device__ __forceinline__ void xcd_barrier(const XcdBarrier& b) {
    asm volatile("s_waitcnt vmcnt(0)" ::: "memory");
    __syncthreads();
    if (threadIdx.x == 0) {
        unsigned* bar = b.bar; const unsigned bx = xb_xcc_id_v();
        __builtin_amdgcn_s_waitcnt(0);
        unsigned nloc = b.st[0], nx = b.st[1];
        if (nloc == 0u) { xcd_barrier_complete(bar, bx, nloc, nx); b.st[0] = nloc; b.st[1] = nx; }
        const unsigned old = xb_add(&bar[XB_XSUB(bx)], 1u);
        const unsigned gen = old / nloc;
        if (old + 1u == (gen + 1u) * nloc) {
            __builtin_amdgcn_fence(__ATOMIC_RELEASE, "agent");
            asm volatile("s_waitcnt vmcnt(0)" ::: "memory");
            const unsigned og = xb_add(&bar[XB_TOP], 1u);
            const unsigned tg = og / nx;
            if (og + 1u == (tg + 1u) * nx) xb_add(&bar[XB_TOPGEN], 1u);
            else XB_SPIN(xb_ld(&bar[XB_TOPGEN]) == tg, bar);
            __builtin_amdgcn_fence(__ATOMIC_ACQUIRE, "agent");
            xb_add(&bar[XB_XGEN(bx)], 1u);
            asm volatile("s_waitcnt vmcnt(0)" ::: "memory");
        } else {
            XB_SPIN(xb_ld(&bar[XB_XGEN(bx)]) == gen, bar);
            __builtin_amdgcn_fence(__ATOMIC_ACQUIRE, "agent");
            asm volatile("s_waitcnt vmcnt(0)" ::: "memory");
        }
    }
    __syncthreads();
}


__device__ __forceinline__ void mlstm_task(const Params& p, int l, int s, int d, int h, LAS unsigned char* lds) {
    const int tid = opaque_tid(), lane = tid & 63, wave = tid >> 6, quad = lane >> 4, l15 = lane & 15;
    const int T = s < 32 ? 256 : 1024, tok0 = s < 32 ? s * 256 : NPT + (s - 32) * 1024, nch = T / 64;
    LAS bf16_t* sQ = (LAS bf16_t*)lds;
    LAS bf16_t* sK = sQ + 64 * 136;
    LAS bf16_t* sKt = sK + 64 * 136;
    LAS bf16_t* sVt = sKt + 128 * 72;
    LAS bf16_t* sP = sVt + 128 * 72;
    LAS bf16_t* sC = sP + 64 * 72;
    LAS float* sf = (LAS float*)(sC + 128 * 136);
    LAS float *sA = sf, *sB = sf + 64, *sPm = sf + 128, *sN = sf + 192, *sNq = sf + 320, *sPs = sf + 384;
    const bf16_t* proj = (const bf16_t*)(p.ws + WS_PROJ);
    const float* gates = (const float*)(p.ws + WS_GATES);
    float* hd = (float*)(p.ws + WS_HD) + (size_t)d * NTOK * 512;
    const float bi = p.in[I_BI][l * 8 + d * 4 + h], bfb = p.in[I_BF][l * 8 + d * 4 + h];
    f32x4 cacc[8];
    float m;
    float cw0[8], cw1[8], cw2[8], cbb[8];
    { const int g = tid & 31, ch = ((g >> 4) ? 512 : 0) + h * 128 + (g & 15) * 8; const float* cw = p.in[I_CBW] + (size_t)l * 3 * 1024 + ch;
        ld8f(cw, cw0); ld8f(cw + 1024, cw1); ld8f(cw + 2048, cw2); ld8f(p.in[I_CBB] + l * 1024 + ch, cbb); }
    __syncthreads();
    if (s >= 32) {
        const size_t sb = (((size_t)((s - 32) * 2 + l) * 2 + d) * 4 + h);
        const float* C0 = p.in[I_SMC] + sb * 128 * 128;
#pragma unroll
        for (int tn = 0; tn < 8; ++tn)
#pragma unroll
            for (int j = 0; j < 4; ++j) cacc[tn][j] = C0[(16 * wave + quad * 4 + j) * 128 + 16 * tn + l15];
        if (tid < 128) sN[tid] = p.in[I_SMN][sb * 128 + tid];
        m = p.in[I_SMM][sb];
    } else {
#pragma unroll
        for (int tn = 0; tn < 8; ++tn) cacc[tn] = (f32x4){0.f, 0.f, 0.f, 0.f};
        if (tid < 128) sN[tid] = 0.f;
        m = 0.f;
    }
#pragma unroll
    for (int tn = 0; tn < 8; ++tn)
#pragma unroll
        for (int j = 0; j < 4; ++j) sC[(16 * wave + quad * 4 + j) * 136 + 16 * tn + l15] = f2bf(cacc[tn][j]);

    float gi_n = 0.f, gf_n = 0.f;
    if (wave == 0) { const int tk = d == 0 ? tok0 + lane : tok0 + T - 1 - lane; gi_n = gates[(size_t)tk * 16 + d * 4 + h]; gf_n = gates[(size_t)tk * 16 + 8 + d * 4 + h]; }
    for (int c = 0; c < nch; ++c) {
        __syncthreads();
        if (wave == 0) {
            const float gi = gi_n + bi, gf = gf_n + bfb;
            if (c + 1 < nch) { const int ii = 64 * (c + 1) + lane; const int tk = d == 0 ? tok0 + ii : tok0 + T - 1 - ii; gi_n = gates[(size_t)tk * 16 + d * 4 + h]; gf_n = gates[(size_t)tk * 16 + 8 + d * 4 + h]; }
            const float lf = fminf(gf, 0.f) - log1pf(__expf(-fabsf(gf)));
            float b = lf;
#pragma unroll
            for (int off = 1; off < 64; off <<= 1) { const float t = __shfl_up(b, off); if (lane >= off) b += t; }
            const float a = gi - b; float pm = a;
#pragma unroll
            for (int off = 1; off < 64; off <<= 1) { const float t = __shfl_up(pm, off); if (lane >= off) pm = fmaxf(pm, t); }
            sB[lane] = b; sA[lane] = a; sPm[lane] = pm;
        }
        __syncthreads();
        const float mx = fmaxf(m, sPm[63]), bL = sB[63];
#pragma unroll
        for (int it = 0; it < 4; ++it) {
            const int idx = tid + 512 * it, i = idx >> 5, g = idx & 31, isK = g >> 4, j0 = (g & 15) * 8, ch = (isK ? 512 : 0) + h * 128 + j0;
            const int ii = 64 * c + i, pos = d == 0 ? ii : T - 1 - ii, tk = tok0 + pos;
            const bf16_t* src = proj + (size_t)tk * NP + B_Q + ch;
            float x0[8], x1[8], x2[8], y[8];
            unpack8(*(const u32x4v*)src, x1);
            unpack8(*(const u32x4v*)(pos > 0 ? src - NP : src), x0); unpack8(*(const u32x4v*)(pos < T - 1 ? src + NP : src), x2);
            const float m0 = pos > 0 ? 1.f : 0.f, m2 = pos < T - 1 ? 1.f : 0.f;
#pragma unroll
            for (int e = 0; e < 8; ++e) y[e] = siluf_(m0 * x0[e] * cw0[e] + x1[e] * cw1[e] + m2 * x2[e] * cw2[e] + cbb[e]);
            if (!isK) { *(LAS u32x4v*)(sQ + i * 136 + j0) = pack8(y); }
            else {
                const float wgi = __expf(sA[i] - mx);
#pragma unroll
                for (int e = 0; e < 8; ++e) y[e] *= 0.08838834764831845f;
                *(LAS u32x4v*)(sK + i * 136 + j0) = pack8(y);
#pragma unroll
                for (int e = 0; e < 8; ++e) sKt[(j0 + e) * 72 + (i ^ (8 * ((j0 >> 3) & 7)))] = f2bf(y[e] * wgi);
            }
        }
#pragma unroll
        for (int it = 0; it < 2; ++it) {
            const int idx = tid + 512 * it, i = idx >> 4, g = idx & 15;
            const int ii = 64 * c + i, tk = d == 0 ? tok0 + ii : tok0 + T - 1 - ii;
            const u32x4v w = *(const u32x4v*)(proj + (size_t)tk * NP + B_V + h * 128 + 8 * g);
            LAS bf16_t* dst = sVt + (8 * g) * 72 + (i ^ (8 * (g & 7)));
            dst[0] = (bf16_t)(w.x & 0xffff); dst[72] = (bf16_t)(w.x >> 16); dst[144] = (bf16_t)(w.y & 0xffff); dst[216] = (bf16_t)(w.y >> 16);
            dst[288] = (bf16_t)(w.z & 0xffff); dst[360] = (bf16_t)(w.z >> 16); dst[432] = (bf16_t)(w.w & 0xffff); dst[504] = (bf16_t)(w.w >> 16);
        }
        __syncthreads();
        const int tm = wave >> 1;
        {
            const int tn0 = (wave & 1) * 2;
#pragma unroll
            for (int tt = 0; tt < 2; ++tt) {
                f32x4 acc = {0.f, 0.f, 0.f, 0.f};
#pragma unroll
                for (int ks = 0; ks < 4; ++ks) acc = MFMA16(frag(sQ, 16 * tm, 136, 32 * ks, lane), frag(sK, 16 * (tn0 + tt), 136, 32 * ks, lane), acc);
                const int scol = 16 * (tn0 + tt) + l15; const float as = sA[scol];
#pragma unroll
                for (int j = 0; j < 4; ++j) { const int t = 16 * tm + quad * 4 + j;
                    float pv = scol <= t ? __expf(as - fmaxf(m, sPm[t])) * acc[j] : 0.f;
                    sP[t * 72 + scol] = f2bf(pv);
                    pv = red16_sum(pv);
                    if (l15 == 0) sPs[t * 4 + tn0 + tt] = pv; }
            }
        }
        const int tnb = (wave & 1) * 4;
        f32x4 accq[4];
#pragma unroll
        for (int tt = 0; tt < 4; ++tt) { accq[tt] = (f32x4){0.f, 0.f, 0.f, 0.f};
#pragma unroll
            for (int ks = 0; ks < 4; ++ks) accq[tt] = MFMA16(frag(sQ, 16 * tm, 136, 32 * ks, lane), frag(sC, 16 * (tnb + tt), 136, 32 * ks, lane), accq[tt]); }
        { const int t = tid >> 3, part = tid & 7; float sacc = 0.f;
#pragma unroll
            for (int e = 0; e < 16; ++e) sacc += sN[16 * part + e] * bf2f(sQ[t * 136 + 16 * part + e]);
            sacc += __shfl_xor(sacc, 1); sacc += __shfl_xor(sacc, 2); sacc += __shfl_xor(sacc, 4);
            if (part == 0) sNq[t] = sacc; }
        __syncthreads();
        {
            f32x4 accp[4];
#pragma unroll
            for (int tt = 0; tt < 4; ++tt) { accp[tt] = (f32x4){0.f, 0.f, 0.f, 0.f};
#pragma unroll
                for (int ks = 0; ks < 2; ++ks) accp[tt] = MFMA16(frag(sP, 16 * tm, 72, 32 * ks, lane), fragsw(sVt, 16 * (tnb + tt), 32 * ks, lane), accp[tt]); }
#pragma unroll
            for (int j = 0; j < 4; ++j) { const int t = 16 * tm + quad * 4 + j;
                const float mtm = fmaxf(m, sPm[t]), wi = __expf(m - mtm);
                const float den = wi * sNq[t] + ((sPs[t * 4] + sPs[t * 4 + 1]) + (sPs[t * 4 + 2] + sPs[t * 4 + 3]));
                const float mt = sB[t] + mtm; const float inv = 1.0f / fmaxf(fabsf(den), __expf(-mt));
                const int ii = 64 * c + t, tk = d == 0 ? tok0 + ii : tok0 + T - 1 - ii;
                float* dst = hd + (size_t)tk * 512 + h * 128 + 16 * tnb + l15;
#pragma unroll
                for (int tt = 0; tt < 4; ++tt) dst[16 * tt] = (wi * accq[tt][j] + accp[tt][j]) * inv; }
        }
        const float sc = __expf(m - mx);
        if (tid < 128) { float ns = 0.f;
#pragma unroll 8
            for (int e = 0; e < 64; ++e) ns += bf2f(sKt[tid * 72 + e]);
            sN[tid] = sc * sN[tid] + ns; }
#pragma unroll
        for (int tn = 0; tn < 8; ++tn) { f32x4 dc = {0.f, 0.f, 0.f, 0.f};
#pragma unroll
            for (int ks = 0; ks < 2; ++ks) dc = MFMA16(fragsw(sVt, 16 * wave, 32 * ks, lane), fragsw(sKt, 16 * tn, 32 * ks, lane), dc);
            cacc[tn] = sc * cacc[tn] + dc;
#pragma unroll
            for (int j = 0; j < 4; ++j) sC[(16 * wave + quad * 4 + j) * 136 + 16 * tn + l15] = f2bf(cacc[tn][j]); }
        m = bL + mx;
    }
    __syncthreads();
    if (s < 32) {
        const size_t sb = (((size_t)(s * 2 + l) * 2 + d) * 4 + h);
        float* Co = p.out + O_MC + sb * 128 * 128;
#pragma unroll
        for (int tn = 0; tn < 8; ++tn)
#pragma unroll
            for (int j = 0; j < 4; ++j) Co[(16 * wave + quad * 4 + j) * 128 + 16 * tn + l15] = cacc[tn][j];
        if (tid < 128) p.out[O_MN + sb * 128 + tid] = sN[tid];
        if (tid == 0) p.out[O_MM + sb] = m;
    }
}

__device__ __forceinline__ void attn_task(const Params& p, int l, int task, LAS unsigned char* lds) {
    const int tid = opaque_tid(), lane = tid & 63, wave = tid >> 6, quad = lane >> 4, l15 = lane & 15;
    const bool samp = task < 128;
    int b, h, qb;
    if (samp) { b = task >> 6; h = (task >> 3) & 7; qb = task & 7; } else { const int t2 = task - 128; b = t2 >> 4; h = (t2 >> 1) & 7; qb = t2 & 1; }
    const int tok0 = samp ? NPT + b * 1024 : b * 256, nkt = samp ? 24 : 4, nct = samp ? 8 : 0;
    LAS bf16_t* sK = (LAS bf16_t*)lds;
    LAS bf16_t* sVt = sK + 64 * 136;
    LAS bf16_t* sPw = sVt + 128 * 72 + wave * (16 * 72);
    const bf16_t* proj = (const bf16_t*)(p.ws + WS_PROJ);
    const bf16_t* ck = (const bf16_t*)(p.ws + WS_KC) + (((unsigned)(b * 2 + l) * 8 + h) * 512) * 128;
    const bf16_t* cv = (const bf16_t*)(p.ws + WS_VTC) + (((unsigned)(b * 2 + l) * 8 + h) * 128) * 512;
    const float lam = ((const float*)(p.ws + WS_LAM))[l];
    const float lam_init = 0.8f - 0.6f * expf(-0.3f * (float)l);
    const int q0 = 128 * qb + 16 * wave;
    bf16x8 aq1[2], aq2[2];
    { const bf16_t* qp = proj + (unsigned)(tok0 + q0 + l15) * NP + C_Q + h * 128 + quad * 8;
        aq1[0] = *(const bf16x8*)qp; aq1[1] = *(const bf16x8*)(qp + 32); aq2[0] = *(const bf16x8*)(qp + 64); aq2[1] = *(const bf16x8*)(qp + 96); }
    float mx1 = -INFINITY, mx2 = -INFINITY, sm1 = 0.f, sm2 = 0.f, mc1 = 0.f, mc2 = 0.f;
    constexpr float CS = 0.125f * 1.4426950408889634f;
    f32x4 o1[8], o2[8];
#pragma unroll
    for (int tn = 0; tn < 8; ++tn) { o1[tn] = (f32x4){0.f, 0.f, 0.f, 0.f}; o2[tn] = o1[tn]; }
    u32x4v kreg[2], vreg[2];
#define ATT_LOAD(KT, PASS) do { int ktv = (KT); asm volatile("" : "+v"(ktv));     \
    _Pragma("unroll") for (int it = 0; it < 2; ++it) { const int idx = tid + 512 * it, i = idx >> 4, g = idx & 15; \
        if ((KT) < nct) { kreg[it] = *(const u32x4v*)(ck + (unsigned)((64 * ktv + i) * 128 + 8 * g)); \
            if ((PASS) == 1) { const int dv = idx >> 3, mm = idx & 7; vreg[it] = *(const u32x4v*)(cv + (unsigned)(dv * 512 + 64 * ktv + 8 * mm)); } } \
        else { kreg[it] = *(const u32x4v*)(proj + (unsigned)((tok0 + 64 * (ktv - nct) + i) * NP + C_K + h * 128 + 8 * g)); \
            if ((PASS) == 1) vreg[it] = *(const u32x4v*)(proj + (unsigned)((tok0 + 64 * (ktv - nct) + (idx & 63)) * NP + C_V + h * 128 + 8 * (idx >> 6))); } } } while (0)
    for (int pass = 0; pass < 2; ++pass) {
        ATT_LOAD(0, pass);
        for (int kt = 0; kt < nkt; ++kt) {
            __syncthreads();
#pragma unroll
            for (int it = 0; it < 2; ++it) {
                const int idx = tid + 512 * it, i = idx >> 4, g = idx & 15;
                *(LAS u32x4v*)(sK + i * 136 + 8 * g) = kreg[it];
                if (pass == 1) {
                    if (kt < nct) { const int dv = idx >> 3, mm = idx & 7; *(LAS u32x4v*)(sVt + dv * 72 + 8 * mm) = vreg[it]; }
                    else { const u32x4v w = vreg[it]; LAS bf16_t* dst = sVt + (8 * (idx >> 6)) * 72 + (idx & 63);
                        dst[0] = (bf16_t)(w.x & 0xffff); dst[72] = (bf16_t)(w.x >> 16); dst[144] = (bf16_t)(w.y & 0xffff); dst[216] = (bf16_t)(w.y >> 16);
                        dst[288] = (bf16_t)(w.z & 0xffff); dst[360] = (bf16_t)(w.z >> 16); dst[432] = (bf16_t)(w.w & 0xffff); dst[504] = (bf16_t)(w.w >> 16); }
                }
            }
            if (kt + 1 < nkt) ATT_LOAD(kt + 1, pass);
            __syncthreads();
#pragma unroll
            for (int bb = 0; bb < 2; ++bb) {
                f32x4 s1[2], s2[2];
#pragma unroll
                for (int t = 0; t < 2; ++t) { s1[t] = (f32x4){0.f, 0.f, 0.f, 0.f}; s2[t] = s1[t];
#pragma unroll
                    for (int ks = 0; ks < 2; ++ks) { s1[t] = MFMA16(frag(sK, 32 * bb + 16 * t, 136, 32 * ks, lane), aq1[ks], s1[t]); s2[t] = MFMA16(frag(sK, 32 * bb + 16 * t, 136, 64 + 32 * ks, lane), aq2[ks], s2[t]); } }
                if (pass == 0) {
#pragma unroll
                    for (int t = 0; t < 2; ++t)
#pragma unroll
                        for (int j = 0; j < 4; ++j) { mx1 = fmaxf(mx1, s1[t][j]); mx2 = fmaxf(mx2, s2[t][j]); }
                } else {
                    bf16x8 pa1, pa2;
                    { float p1[8];
#pragma unroll
                        for (int jj = 0; jj < 8; ++jj) { p1[jj] = __builtin_amdgcn_exp2f(s1[jj >> 2][jj & 3] * CS - mc1); sm1 += p1[jj]; }
                        pa1 = __builtin_bit_cast(bf16x8, pack8(p1)); }
                    { float p2[8];
#pragma unroll
                        for (int jj = 0; jj < 8; ++jj) { p2[jj] = __builtin_amdgcn_exp2f(s2[jj >> 2][jj & 3] * CS - mc2); sm2 += p2[jj]; }
                        pa2 = __builtin_bit_cast(bf16x8, pack8(p2)); }
#pragma unroll
                    for (int tn2 = 0; tn2 < 8; ++tn2) { const LAS bf16_t* vrow = sVt + (16 * tn2 + l15) * 72 + 32 * bb + quad * 4;
                        const u32x2v lo = *(const LAS u32x2v*)vrow, hi = *(const LAS u32x2v*)(vrow + 16);
                        u32x4v vw; vw.x = lo.x; vw.y = lo.y; vw.z = hi.x; vw.w = hi.y;
                        const bf16x8 vb = __builtin_bit_cast(bf16x8, vw);
                        o1[tn2] = MFMA16(pa1, vb, o1[tn2]); o2[tn2] = MFMA16(pa2, vb, o2[tn2]); }
                }
                asm volatile("" ::: "memory");
            }
        }
        if (pass == 0) { mx1 = fmaxf(mx1, __shfl_xor(mx1, 16)); mx1 = fmaxf(mx1, __shfl_xor(mx1, 32)); mx2 = fmaxf(mx2, __shfl_xor(mx2, 16)); mx2 = fmaxf(mx2, __shfl_xor(mx2, 32)); mc1 = mx1 * CS; mc2 = mx2 * CS; }
    }
    sm1 += __shfl_xor(sm1, 16); sm1 += __shfl_xor(sm1, 32); sm2 += __shfl_xor(sm2, 16); sm2 += __shfl_xor(sm2, 32);
    const float il1 = 1.0f / sm1, il2 = lam / sm2;
    float f1[4], f2[4];
#pragma unroll
    for (int j = 0; j < 4; ++j) { f1[j] = __shfl(il1, quad * 4 + j); f2[j] = __shfl(il2, quad * 4 + j); }
#pragma unroll
    for (int tn = 0; tn < 8; ++tn)
#pragma unroll
        for (int j = 0; j < 4; ++j) o1[tn][j] = o1[tn][j] * f1[j] - o2[tn][j] * f2[j];
    asm volatile("" ::: "memory");
#define oacc o1
#undef ATT_LOAD
    bf16_t* mixed = (bf16_t*)(p.ws + WS_UM);
    const float* sg = p.in[I_SUBG] + l * 128;
#pragma unroll
    for (int j = 0; j < 4; ++j) {
        float ss = 0.f;
#pragma unroll
        for (int tn = 0; tn < 8; ++tn) ss += oacc[tn][j] * oacc[tn][j];
        ss = red16_sum(ss);
        const float r = rsqrtf(ss * (1.0f / 128.0f) + 1e-5f) * (1.0f - lam_init);
        const int tq = tok0 + q0 + quad * 4 + j;
#pragma unroll
        for (int tn = 0; tn < 8; ++tn) { const int dv = 16 * tn + l15;
            const float gt = bf2f(proj[(unsigned)tq * NP + C_G + h * 128 + dv]);
            mixed[(unsigned)tq * DM + 1024 + h * 128 + dv] = f2bf(oacc[tn][j] * r * sg[dv] * siluf_(gt)); }
    }
}

#undef oacc
__device__ __forceinline__ void rwkv_prep_task(const Params& p, int l, int task, LAS unsigned char* lds) {
    const int tid = opaque_tid(), lane = tid & 63, wave = tid >> 6, quad = lane >> 4, l15 = lane & 15;
    const int tile = task >> 3, h = task & 7, tb = 64 * tile;
    const int T = tb < NPT ? 256 : 1024, seq0 = tb < NPT ? (tb & ~255) : NPT + ((tb - NPT) & ~1023);
    LAS bf16_t* sTW = (LAS bf16_t*)lds;
    LAS bf16_t* sAD = sTW + 2 * 64 * 72;
    LAS bf16_t* sWup = sAD + 2 * 64 * 72;
    LAS bf16_t* sAup = sWup + 2 * 64 * 72;
    LAS float* sR = (LAS float*)(sAup + 2 * 64 * 72);
    LAS float* sKf = sR + 4096; LAS float* sVf = sKf + 4096; LAS float* sNrm = sVf + 4096; LAS float* sRK = sNrm + 64;
    const bf16_t* proj = (const bf16_t*)(p.ws + WS_PROJ);
    __syncthreads();
#pragma unroll
    for (int it = 0; it < 4; ++it) {
        const int idx = tid + 512 * it, arr = idx >> 9, i = (idx >> 3) & 63, g = idx & 7;
        const u32x4v w = *(const u32x4v*)(proj + (size_t)(tb + i) * NP + A_WD + 64 * arr + 8 * g);
        if (arr < 2) { float x[8]; unpack8(w, x);
#pragma unroll
            for (int e = 0; e < 8; ++e) x[e] = tanhf_(x[e]);
            *(LAS u32x4v*)(sTW + (arr * 64 + i) * 72 + 8 * g) = pack8(x); }
        else *(LAS u32x4v*)(sAD + ((arr - 2) * 64 + i) * 72 + 8 * g) = w;
    }
#pragma unroll
    for (int it = 0; it < 4; ++it) {
        const int dd2 = it >> 1, which = it & 1, c = tid >> 3, jg = tid & 7;
        const bf16_t* src = (const bf16_t*)(p.ws + WS_WUPT) + ((((size_t)(l * 2 + dd2) * 2 + which) * 8 + h) * 4096) + c * 64 + 8 * jg;
        *(LAS u32x4v*)((which ? sAup : sWup) + (dd2 * 64 + c) * 72 + 8 * jg) = *(const u32x4v*)src;
    }
#pragma unroll
    for (int it = 0; it < 3; ++it) {
        const int idx = tid + 512 * it, which = idx >> 9, i = (idx >> 3) & 63, g = idx & 7, ch = which * 512 + h * 64 + 8 * g;
        const int tk = tb + i, pos = tk - seq0;
        const bf16_t* src = proj + (size_t)tk * NP + ch;
        float x0[8], x1[8], x2[8], w0[8], w1[8], w2[8], bb[8];
        unpack8(*(const u32x4v*)src, x1);
        unpack8(*(const u32x4v*)(pos > 0 ? src - NP : src), x0); unpack8(*(const u32x4v*)(pos < T - 1 ? src + NP : src), x2);
        const float m0 = pos > 0 ? 1.f : 0.f, m2 = pos < T - 1 ? 1.f : 0.f;
        const float* cw = p.in[I_CAW] + (size_t)l * 3 * 1536 + ch;
        ld8f(cw, w0); ld8f(cw + 1536, w1); ld8f(cw + 3072, w2); ld8f(p.in[I_CAB] + l * 1536 + ch, bb);
        LAS float* dst = (which == 0 ? sR : (which == 1 ? sKf : sVf)) + i * 64 + 8 * g;
#pragma unroll
        for (int e = 0; e < 8; ++e) dst[e] = m0 * x0[e] * w0[e] + x1[e] * w1[e] + m2 * x2[e] * w2[e] + bb[e];
    }
    __syncthreads();
    { const int t = tid >> 3, part = tid & 7; float ss = 0.f;
#pragma unroll
        for (int e = 0; e < 8; ++e) { const float v = sKf[t * 64 + 8 * part + e] * p.in[I_KK][l * 512 + h * 64 + 8 * part + e]; ss += v * v; }
        ss += __shfl_xor(ss, 1); ss += __shfl_xor(ss, 2); ss += __shfl_xor(ss, 4);
        if (part == 0) sNrm[t] = rsqrtf(ss + 1e-12f); }
    const int dd = wave >> 2, tm = wave & 3;
    f32x4 aw[4], aa[4];
#pragma unroll
    for (int tn = 0; tn < 4; ++tn) { aw[tn] = (f32x4){0.f, 0.f, 0.f, 0.f}; aa[tn] = aw[tn];
#pragma unroll
        for (int ks = 0; ks < 2; ++ks) { aw[tn] = MFMA16(frag(sTW + dd * 64 * 72, 16 * tm, 72, 32 * ks, lane), frag(sWup + dd * 64 * 72, 16 * tn, 72, 32 * ks, lane), aw[tn]);
            aa[tn] = MFMA16(frag(sAD + dd * 64 * 72, 16 * tm, 72, 32 * ks, lane), frag(sAup + dd * 64 * 72, 16 * tn, 72, 32 * ks, lane), aa[tn]); } }
    __syncthreads();
    {
        LAS bf16_t* so = sTW + dd * (3 * 4096);
        float rk[4] = {0.f, 0.f, 0.f, 0.f};
#pragma unroll
        for (int tn = 0; tn < 4; ++tn) { const int c = 16 * tn + l15, ch = h * 64 + c;
            const float w0v = p.in[I_W0][(l * 2 + dd) * 512 + ch], a0v = p.in[I_A0][(l * 2 + dd) * 512 + ch], kav = p.in[I_KA][l * 512 + ch], kkv = p.in[I_KK][l * 512 + ch], rkv = p.in[I_RK][l * 512 + ch];
#pragma unroll
            for (int j = 0; j < 4; ++j) { const int t = 16 * tm + quad * 4 + j; const int o = t * 64 + c;
                const float z = w0v + aw[tn][j]; const float dec = __expf(-0.6065306597126334f * sigmoidf_(z));
                const float av = sigmoidf_(a0v + aa[tn][j]); const float kv = sKf[t * 64 + c];
                const float ktv = kv * (1.0f + (av - 1.0f) * kav); const float kk = kv * kkv * sNrm[t];
                so[o] = f2bf(ktv); so[4096 + o] = f2bf(kk * av); so[8192 + o] = f2bf(dec - 1.0f);
                rk[j] += sR[t * 64 + c] * ktv * rkv; } }
#pragma unroll
        for (int j = 0; j < 4; ++j) { const float s = red16_sum(rk[j]); if (l15 == 0) sRK[dd * 64 + 16 * tm + quad * 4 + j] = s; }
    }
    __syncthreads();
    { const int i = tid >> 3, g = tid & 7; const size_t o = (size_t)(tb + i) * 512 + h * 64 + 8 * g;
        float r[8], k[8], v[8], bn[8]; const float nr = sNrm[i], rks = sRK[i] + sRK[64 + i];
#pragma unroll
        for (int e = 0; e < 8; ++e) { r[e] = sR[i * 64 + 8 * g + e]; k[e] = sKf[i * 64 + 8 * g + e] * p.in[I_KK][l * 512 + h * 64 + 8 * g + e] * nr; v[e] = sVf[i * 64 + 8 * g + e]; bn[e] = rks * v[e]; }
        const size_t o2 = ((size_t)(tb + i) * 8 + h) * 320 + 8 * g; bf16_t* pk = (bf16_t*)(p.ws + WS_PK);
#pragma unroll
        for (int dd2 = 0; dd2 < 2; ++dd2)
#pragma unroll
            for (int ar = 0; ar < 3; ++ar) *(u32x4v*)(pk + (size_t)dd2 * NTOK * 2560 + o2 + 128 + 64 * ar) = *(const LAS u32x4v*)(sTW + dd2 * (3 * 4096) + ar * 4096 + i * 64 + 8 * g);
        const u32x4v rr = pack8(r), kk8 = pack8(k);
        *(u32x4v*)(pk + o2) = rr; *(u32x4v*)(pk + o2 + 64) = kk8; *(u32x4v*)(pk + (size_t)NTOK * 2560 + o2) = rr; *(u32x4v*)(pk + (size_t)NTOK * 2560 + o2 + 64) = kk8;
        *(u32x4v*)((bf16_t*)(p.ws + WS_SCV) + o) = pack8(v); *(u32x4v*)((bf16_t*)(p.ws + WS_SCBON) + o) = pack8(bn); }
}

__device__ __forceinline__ void m1_phase(const Params& p, int l, LAS unsigned char* lds, int rep, int mask) {
    unsigned* ctr = (unsigned*)(p.ws + WS_CTL) + 64 * (1 + 4 * l + 8 * rep);
    LAS int* slot = (LAS int*)(lds + LDS_SLOT);
#ifndef NO_MLSTM
    if (mask & 1) for (;;) { const int t = next_task(ctr, slot); if (t >= 272) break; const int u = t < 16 ? t + 256 : t - 16; mlstm_task(p, l, u >> 3, (u >> 2) & 1, u & 3, lds); }
#endif
#ifndef NO_ATTN
    if (mask & 2) for (;;) { const int t = next_task(ctr + 64, slot); if (t >= 640) break; attn_task(p, l, t, lds); }
#endif
#ifndef NO_PREP
    if (mask & 4) for (;;) { const int t = next_task(ctr + 128, slot); if (t >= 1280) break; rwkv_prep_task(p, l, t, lds); }
#endif
}

#ifdef EXP_LITE
#if EXP_LITE == 1
#define EXPY(v) (bf2f(sBt[(quad * 4 + j) * 24 + l15]) + bf2f(sGt[(16 + quad * 4 + j) * 24 + l15]) + sW[l15 + 16 * quad])
#elif EXP_LITE == 2
#define EXPY(v) (bf2f(sAt[(quad * 4 + j) * 72 + l15]) + bf2f(sX2[(quad * 4 + j) * 24 + l15]))
#else
#define EXPY(v) (bf2f(sPy[(quad * 4 + j) * 72 + 16 + l15]) + bf2f(sQy[(quad * 4 + j) * 24 + l15]))
#endif
#define EXPS(v) 0.f
#else
#define EXPY(v) (v)
#define EXPS(v) (v)
#endif
__device__ __forceinline__ bf16_t f2bf_sw(float f) { unsigned u = __float_as_uint(f); u += 0x7FFFu + ((u >> 16) & 1u); return (bf16_t)(u >> 16); }
__device__ __forceinline__ bf16x8 frag16(const LAS bf16_t* base, int row0, int ld, int lane) {
    bf16x8 z = {0, 0, 0, 0, 0, 0, 0, 0};
    if ((lane >> 4) < 2) z = *(const LAS bf16x8*)(base + (row0 + (lane & 15)) * ld + (lane >> 4) * 8);
    return z;
}
__device__ __forceinline__ void cp_task(const Params& p, int task, int lane, LAS unsigned char* wl) {
    int s, d, h, c, T;
    if (task < 8192) { s = task >> 8; d = (task >> 7) & 1; h = (task >> 4) & 7; c = task & 15; T = 256; }
    else { const int u = task - 8192; s = 32 + (u >> 10); d = (u >> 9) & 1; h = (u >> 6) & 7; c = u & 63; T = 1024; }
    const int tok0 = s < 32 ? s * 256 : NPT + (s - 32) * 1024, quad = lane >> 4, l15 = lane & 15;
    const long step = d == 0 ? 1 : -1; const int tfirst = d == 0 ? tok0 + 16 * c : tok0 + T - 1 - 16 * c;
    bf16_t* pk = (bf16_t*)(p.ws + WS_PK) + (size_t)d * NTOK * 2560 + ((size_t)tfirst * 8 + h) * 320;
    LAS bf16_t* sA = (LAS bf16_t*)wl;
    LAS bf16_t* sB = sA + 16 * 72, *sG = sB + 16 * 72, *sR = sG + 16 * 72;
    LAS float* mL1 = (LAS float*)(sR + 16 * 72);
    LAS bf16_t* sL2 = (LAS bf16_t*)(mL1 + 16 * 17);
    LAS bf16_t* sM1t = sL2 + 16 * 24;
    LAS bf16_t* sTt = sM1t + 16 * 24;
    LAS bf16_t* sAtil = sTt + 16 * 24;
    LAS bf16_t* sX2 = sTt;
    LAS bf16_t* oAt = sB;
    LAS bf16_t* oPy = sG;
    LAS bf16_t* oX2 = (LAS bf16_t*)mL1;
    LAS bf16_t* oQy = sL2;
    float bt[16], gt[16], W = 1.0f;
    { const int k = lane;
        float rr[16], kk[16], kt[16], ka[16], wm[16];
#pragma unroll
        for (int i = 0; i < 16; ++i) { const bf16_t* rec = pk + step * 2560 * i + k; rr[i] = bf2f(rec[0]); kk[i] = bf2f(rec[64]); kt[i] = bf2f(rec[128]); ka[i] = bf2f(rec[192]); wm[i] = bf2f(rec[256]); }
#pragma unroll
        for (int i = 0; i < 16; ++i) { const float Wp = W; W = W + W * wm[i]; const float iw = __builtin_amdgcn_rcpf(W);
            sA[i * 72 + k] = f2bf(Wp * kk[i]); bt[i] = ka[i] * iw; gt[i] = kt[i] * iw; sB[i * 72 + k] = f2bf(bt[i]); sG[i * 72 + k] = f2bf(gt[i]); sR[i * 72 + k] = f2bf(W * rr[i]); } }
    LDS_FENCE();
    f32x4 m2acc;
    { f32x4 a1 = {0.f, 0.f, 0.f, 0.f}, a2 = a1, a3 = a1, a4 = a1;
#pragma unroll
        for (int ks = 0; ks < 2; ++ks) { const bf16x8 fb = frag(sB, 0, 72, 32 * ks, lane), fg = frag(sG, 0, 72, 32 * ks, lane), fa = frag(sA, 0, 72, 32 * ks, lane), fr = frag(sR, 0, 72, 32 * ks, lane);
            a1 = MFMA16(fb, fa, a1); a2 = MFMA16(fg, fa, a2); a3 = MFMA16(fb, fr, a3); a4 = MFMA16(fg, fr, a4); }
#pragma unroll
        for (int j = 0; j < 4; ++j) { const int i = quad * 4 + j, t = l15;
            mL1[i * 17 + t] = i < t ? a1[j] : 0.f; sL2[i * 24 + t] = f2bf(i < t ? a2[j] : 0.f); sM1t[t * 24 + i] = f2bf(i <= t ? a3[j] : 0.f); m2acc[j] = i <= t ? a4[j] : 0.f; } }
    LDS_FENCE();
    { float Tr[16];
#pragma unroll
        for (int t = 0; t < 16; ++t) { float acc = (l15 == t) ? 1.0f : 0.0f;
#pragma unroll
            for (int i = 0; i < t; ++i) acc -= Tr[i] * mL1[i * 17 + t];
            Tr[t] = acc; }
        if (quad == 0) {
#pragma unroll
            for (int t = 0; t < 16; ++t) sTt[t * 24 + l15] = f2bf(Tr[t]); } }
    LDS_FENCE();
    const bf16x8 ftt = frag16(sTt, 0, 24, lane);
#pragma unroll
    for (int kt2 = 0; kt2 < 4; ++kt2) {
        u32x4v aw = {0u, 0u, 0u, 0u};
        if (quad < 2) { const LAS bf16_t* col = sA + (quad * 8) * 72 + 16 * kt2 + l15;
            aw.x = (unsigned)col[0] | ((unsigned)col[72] << 16); aw.y = (unsigned)col[144] | ((unsigned)col[216] << 16); aw.z = (unsigned)col[288] | ((unsigned)col[360] << 16); aw.w = (unsigned)col[432] | ((unsigned)col[504] << 16); }
        f32x4 acc = {0.f, 0.f, 0.f, 0.f};
        acc = MFMA16(__builtin_bit_cast(bf16x8, aw), ftt, acc);
#pragma unroll
        for (int j = 0; j < 4; ++j) { const int k = 16 * kt2 + quad * 4 + j; const bf16_t v = f2bf_sw(acc[j]); sAtil[k * 24 + l15] = v; oAt[l15 * 72 + k] = v; }
    }
    { f32x4 acc = {0.f, 0.f, 0.f, 0.f};
        acc = MFMA16(frag16(sL2, 0, 24, lane), ftt, acc);
#pragma unroll
        for (int j = 0; j < 4; ++j) { const bf16_t v = f2bf_sw(acc[j]); sX2[(quad * 4 + j) * 24 + l15] = v; oX2[l15 * 24 + quad * 4 + j] = v; } }
    LDS_FENCE();
    const bf16x8 fm1 = frag16(sM1t, 0, 24, lane);
#pragma unroll
    for (int kt2 = 0; kt2 < 4; ++kt2) { f32x4 acc = {0.f, 0.f, 0.f, 0.f};
        acc = MFMA16(frag16(sAtil, 16 * kt2, 24, lane), fm1, acc);
#pragma unroll
        for (int j = 0; j < 4; ++j) { const int k = 16 * kt2 + quad * 4 + j; oPy[l15 * 72 + k] = f2bf(bf2f(sR[l15 * 72 + k]) - acc[j]); } }
    { f32x4 acc = {0.f, 0.f, 0.f, 0.f};
        acc = MFMA16(frag16(sX2, 0, 24, lane), fm1, acc);
#pragma unroll
        for (int j = 0; j < 4; ++j) oQy[l15 * 24 + quad * 4 + j] = f2bf(m2acc[j] - acc[j]); }
    LDS_FENCE();
    { float bb8[8]; const int k = lane; bf16_t* rec = pk + step * 2560 * (k >> 2);
#pragma unroll
        for (int hh = 0; hh < 2; ++hh) {
#pragma unroll
            for (int e = 0; e < 8; ++e) bb8[e] = bt[8 * hh + e];
            *(u32x4v*)(rec + 128 + (k & 3) * 16 + 8 * hh) = pack8(bb8);
#pragma unroll
            for (int e = 0; e < 8; ++e) bb8[e] = gt[8 * hh + e];
            *(u32x4v*)(rec + 192 + (k & 3) * 16 + 8 * hh) = pack8(bb8); }
        ((float*)(rec + 288))[k & 3] = W; }
#pragma unroll
    for (int it = 0; it < 2; ++it) { const int f = lane + 64 * it, t = f >> 3, q = f & 7; bf16_t* rec = pk + step * 2560 * t;
        *(u32x4v*)(rec + 8 * q) = *(const LAS u32x4v*)(oAt + t * 72 + 8 * q); *(u32x4v*)(rec + 64 + 8 * q) = *(const LAS u32x4v*)(oPy + t * 72 + 8 * q); }
    if (lane < 32) { const int t = lane >> 1, q = lane & 1; bf16_t* rec = pk + step * 2560 * t;
        *(u32x4v*)(rec + 256 + 8 * q) = *(const LAS u32x4v*)(oX2 + t * 24 + 8 * q); *(u32x4v*)(rec + 272 + 8 * q) = *(const LAS u32x4v*)(oQy + t * 24 + 8 * q); }
    LDS_FENCE();
}
constexpr int CP_LDS = 16 * 72 * 2 * 4 + 16 * 17 * 4 + (16 * 24 * 3 + 64 * 24 + 16 * 24) * 2 + 16 * 72 * 2 * 2 + 16 * 24 * 2 * 2;

__device__ __forceinline__ void ap_task(const Params& p, int l, int task, int lane, LAS unsigned char* wl) {
    int s, d, h, rt;
    if (task < 128) { s = 32 + (task >> 6); d = (task >> 5) & 1; h = (task >> 2) & 7; rt = task & 3; }
    else { const int u = task - 128; s = u >> 6; d = (u >> 5) & 1; h = (u >> 2) & 7; rt = u & 3; }
    const int T = s < 32 ? 256 : 1024, nch = T / 16, tok0 = s < 32 ? s * 256 : NPT + (s - 32) * 1024, quad = lane >> 4, l15 = lane & 15;
    const long step = d == 0 ? 1 : -1; const int tstart = d == 0 ? tok0 : tok0 + T - 1;
    const bf16_t* pk = (const bf16_t*)(p.ws + WS_PK) + (size_t)d * NTOK * 2560 + ((size_t)tstart * 8 + h) * 320;
    const bf16_t* pv = (const bf16_t*)(p.ws + WS_SCV) + (size_t)tstart * 512 + h * 64 + 16 * rt;
    float* yd = (float*)(p.ws + WS_YD) + (size_t)d * NTOK * 512 + (size_t)tstart * 512 + h * 64 + 16 * rt;
    constexpr int IS = 328;
    LAS bf16_t* img = (LAS bf16_t*)wl;
    LAS bf16_t* sS = img + 16 * IS;
    LAS bf16_t* sCm = sS + 16 * 72;
    f32x4 S[4];
    if (s >= 32) { const float* s0 = p.in[I_SRW] + ((((size_t)((s - 32) * 2 + l) * 2 + d) * 8 + h) * 64 + 16 * rt) * 64;
#pragma unroll
        for (int tn = 0; tn < 4; ++tn)
#pragma unroll
            for (int j = 0; j < 4; ++j) S[tn][j] = s0[(quad * 4 + j) * 64 + 16 * tn + l15]; }
    else {
#pragma unroll
        for (int tn = 0; tn < 4; ++tn) S[tn] = (f32x4){0.f, 0.f, 0.f, 0.f}; }
    const bf16_t* gsrc = pk + step * 2560 * (lane >> 2) + 8 * (lane & 3);
    LAS bf16_t* ldst = img + (lane >> 2) * IS + 8 * (lane & 3);
    u32x4v rawA[10], rawB[10]; bf16_t vrA[8], vrB[8];
#define AP_LOAD(raw, vraw, CH) do { int chv = (CH); asm volatile("" : "+v"(chv)); const bf16_t* cb = gsrc + step * 2560 * (16 * chv); \
        _Pragma("unroll") for (int jj = 0; jj < 10; ++jj) raw[jj] = *(const u32x4v*)(cb + 32 * jj); \
        if (quad < 2) { _Pragma("unroll") for (int e = 0; e < 8; ++e) vraw[e] = pv[step * 512 * (16 * chv + quad * 8 + e) + l15]; } } while (0)
#define AP_STAGE(raw) do { _Pragma("unroll") for (int jj = 0; jj < 10; ++jj) *(LAS u32x4v*)(ldst + 32 * jj) = raw[jj]; } while (0)
    AP_LOAD(rawA, vrA, 0);
    if (nch > 1) AP_LOAD(rawB, vrB, 1);
    const LAS bf16_t* pBt = img + (l15 >> 2) * IS + 128 + (l15 & 3) * 16 + quad * 8;
    const LAS float* pW = (const LAS float*)(img + (l15 >> 2) * IS + 288) + (l15 & 3);
#define AP_CHUNK(raw, vraw, CC) do { const int c = (CC); \
        AP_STAGE(raw); \
        u32x4v vw = {0u, 0u, 0u, 0u}; \
        if (quad < 2) { vw.x = (unsigned)vraw[0] | ((unsigned)vraw[1] << 16); vw.y = (unsigned)vraw[2] | ((unsigned)vraw[3] << 16); vw.z = (unsigned)vraw[4] | ((unsigned)vraw[5] << 16); vw.w = (unsigned)vraw[6] | ((unsigned)vraw[7] << 16); } \
        asm volatile("" : "+v"(vw)); \
        if (c + 2 < nch) AP_LOAD(raw, vraw, c + 2); \
        ap_compute(c, vw); } while (0)
    auto ap_compute = [&](int c, u32x4v vw) {
        const bf16x8 va = __builtin_bit_cast(bf16x8, vw);
#pragma unroll
        for (int tn = 0; tn < 4; ++tn) { const unsigned w01 = pk2(S[tn][0], S[tn][1]), w23 = pk2(S[tn][2], S[tn][3]); LAS bf16_t* ds = sS + (quad * 4) * 72 + 16 * tn + l15;
            ds[0] = (bf16_t)(w01 & 0xffff); ds[72] = (bf16_t)(w01 >> 16); ds[144] = (bf16_t)(w23 & 0xffff); ds[216] = (bf16_t)(w23 >> 16); }
        LDS_FENCE();
        f32x4 cm = {0.f, 0.f, 0.f, 0.f}, yy = {0.f, 0.f, 0.f, 0.f};
#pragma unroll
        for (int ks = 0; ks < 2; ++ks) { const bf16x8 fs = frag(sS, 0, 72, 32 * ks, lane); cm = MFMA16(fs, frag(img, 0, IS, 32 * ks, lane), cm); yy = MFMA16(fs, frag(img + 64, 0, IS, 32 * ks, lane), yy); }
        cm = MFMA16(va, frag16(img + 256, 0, IS, lane), cm); yy = MFMA16(va, frag16(img + 272, 0, IS, lane), yy);
#pragma unroll
        for (int j = 0; j < 4; ++j) { yd[step * 512 * (16 * c + l15) + quad * 4 + j] = yy[j]; sCm[(quad * 4 + j) * 24 + l15] = f2bf_sw(cm[j]); }
        LDS_FENCE();
        const bf16x8 fc = frag16(sCm, 0, 24, lane);
#pragma unroll
        for (int tn = 0; tn < 4; ++tn) { f32x4 ab = {0.f, 0.f, 0.f, 0.f}, ag = ab;
            bf16x8 fb = {0, 0, 0, 0, 0, 0, 0, 0}, fg = fb;
            if (quad < 2) { fb = *(const LAS bf16x8*)(pBt + tn * 4 * IS); fg = *(const LAS bf16x8*)(pBt + tn * 4 * IS + 64); }
            ab = MFMA16(fc, fb, ab); ag = MFMA16(va, fg, ag);
            const float w16 = pW[tn * 2 * IS];
#pragma unroll
            for (int j = 0; j < 4; ++j) S[tn][j] = (S[tn][j] - ab[j] + ag[j]) * w16; }
        LDS_FENCE();
    };
    for (int c2 = 0; c2 < nch; c2 += 2) { AP_CHUNK(rawA, vrA, c2); AP_CHUNK(rawB, vrB, c2 + 1); }
#undef AP_CHUNK
#undef AP_LOAD
#undef AP_STAGE
    if (s < 32) { float* so = p.out + O_RW + ((((size_t)(s * 2 + l) * 2 + d) * 8 + h) * 64 + 16 * rt) * 64;
#pragma unroll
        for (int tn = 0; tn < 4; ++tn)
#pragma unroll
            for (int j = 0; j < 4; ++j) so[(quad * 4 + j) * 64 + 16 * tn + l15] = S[tn][j]; }
}
constexpr int AP_LDS = (16 * 72 * 2 + 64 * 24 * 2 + 16 * 24 * 2) * 2 + 64 * 4 + (16 * 72 + 16 * 24) * 2;

typedef float f32x2 __attribute__((ext_vector_type(2)));
__device__ __forceinline__ void m2_phase(const Params& p, int l, int rep, LAS unsigned char* lds, const XcdBarrier& xbar) {
    const int tid_ = opaque_tid(); const int lane = tid_ & 63, wave = tid_ >> 6;
    LAS unsigned char* wl = lds + wave * 16384;
    LAS unsigned* lq = (LAS unsigned*)(lds + LDS_SLOT + 32);
    if (tid_ == 0) *lq = 0u;
    for (int t = blockIdx.x * 8 + wave; t < 10240; t += gridDim.x * 8) cp_task(p, t, lane, wl);
    xcd_barrier(xbar);
    const int G = gridDim.x, b = blockIdx.x;
    const int nS = b < 128 ? (128 - b + G - 1) / G : 0, nP = b < 2048 ? (2048 - b + G - 1) / G : 0;
    for (;;) {
        int k = 0; if (lane == 0) k = (int)__hip_atomic_fetch_add(lq, 1u, __ATOMIC_RELAXED, __HIP_MEMORY_SCOPE_WORKGROUP);
        k = __builtin_amdgcn_readfirstlane(k);
        if (k >= nS + nP) break;
        ap_task(p, l, k < nS ? b + k * G : 128 + b + (k - nS) * G, lane, wl);
    }
}

__device__ __forceinline__ void m3_phase(const Params& p, int l) {
    const int tid_ = opaque_tid(); const int lane = tid_ & 63, gw = blockIdx.x * 8 + (tid_ >> 6), NGW = gridDim.x * 8;
    const bf16_t* proj = (const bf16_t*)(p.ws + WS_PROJ);
    bf16_t* mixed = (bf16_t*)(p.ws + WS_UM);
    const int c = lane * 8;
    for (int tok = gw; tok < NTOK; tok += NGW) {
        const size_t o = (size_t)tok * 512 + c;
        {
            float y0[8], y1[8], g[8], bb[8], bn[8], gt[8], out[8];
            ld8f((const float*)(p.ws + WS_YD) + o, y0); ld8f((const float*)(p.ws + WS_YD) + (size_t)NTOK * 512 + o, y1);
            float s = 0.f;
#pragma unroll
            for (int e = 0; e < 8; ++e) { y0[e] += y1[e]; s += y0[e]; }
            s += __shfl_xor(s, 1); s += __shfl_xor(s, 2); s += __shfl_xor(s, 4);
            const float mu = s * (1.0f / 64.0f); float q = 0.f;
#pragma unroll
            for (int e = 0; e < 8; ++e) { y0[e] -= mu; q += y0[e] * y0[e]; }
            q += __shfl_xor(q, 1); q += __shfl_xor(q, 2); q += __shfl_xor(q, 4);
            const float rs = rsqrtf(q * (1.0f / 64.0f) + 64e-5f);
            ld8f(p.in[I_RGG] + l * 512 + c, g); ld8f(p.in[I_RGB] + l * 512 + c, bb);
            unpack8(*(const u32x4v*)((const bf16_t*)(p.ws + WS_SCBON) + o), bn);
            unpack8(*(const u32x4v*)(proj + (size_t)tok * NP + A_GATE + c), gt);
#pragma unroll
            for (int e = 0; e < 8; ++e) out[e] = (y0[e] * rs * g[e] + bb[e] + bn[e]) * siluf_(gt[e]);
            *(u32x4v*)(mixed + (size_t)tok * DM + c) = pack8(out);
        }
        {
            float h0[8], h1[8], g[8], bb[8], og[8], gt[8], out[8];
            ld8f((const float*)(p.ws + WS_HD) + o, h0); ld8f((const float*)(p.ws + WS_HD) + (size_t)NTOK * 512 + o, h1);
            unpack8(*(const u32x4v*)(proj + (size_t)tok * NP + B_O + c), og);
            float s = 0.f;
#pragma unroll
            for (int e = 0; e < 8; ++e) { h0[e] = (h0[e] + h1[e]) * sigmoidf_(og[e]); s += h0[e]; }
            s += __shfl_xor(s, 1); s += __shfl_xor(s, 2); s += __shfl_xor(s, 4); s += __shfl_xor(s, 8);
            const float mu = s * (1.0f / 128.0f); float q = 0.f;
#pragma unroll
            for (int e = 0; e < 8; ++e) { h0[e] -= mu; q += h0[e] * h0[e]; }
            q += __shfl_xor(q, 1); q += __shfl_xor(q, 2); q += __shfl_xor(q, 4); q += __shfl_xor(q, 8);
            const float rs = rsqrtf(q * (1.0f / 128.0f) + 1e-5f);
            ld8f(p.in[I_MGG] + l * 512 + c, g); ld8f(p.in[I_MGB] + l * 512 + c, bb);
            unpack8(*(const u32x4v*)(proj + (size_t)tok * NP + B_GATE + c), gt);
#pragma unroll
            for (int e = 0; e < 8; ++e) out[e] = (h0[e] * rs * g[e] + bb[e]) * siluf_(gt[e]);
            *(u32x4v*)(mixed + (size_t)tok * DM + 512 + c) = pack8(out);
        }
    }
}

__device__ __forceinline__ void ln_phase(const Params& p, int l) {
    const int tid_ = opaque_tid(); const int lane = tid_ & 63, gw = blockIdx.x * 8 + (tid_ >> 6), NGW = gridDim.x * 8;
    for (int tok0 = gw; tok0 < NTOK; tok0 += 2 * NGW) {
        const int tok1 = tok0 + NGW; const bool has1 = tok1 < NTOK;
        float* zr0 = p.out + O_Y + (size_t)tok0 * DM; float* zr1 = p.out + O_Y + (size_t)(has1 ? tok1 : tok0) * DM;
        float v0[4][8], v1[4][8]; float s0 = 0.f, s1 = 0.f;
#pragma unroll
        for (int j = 0; j < 4; ++j) { ld8f(zr0 + j * 512 + lane * 8, v0[j]); ld8f(zr1 + j * 512 + lane * 8, v1[j]); }
#pragma unroll
        for (int j = 0; j < 4; ++j)
#pragma unroll
            for (int e = 0; e < 8; ++e) { s0 += v0[j][e]; s1 += v1[j][e]; }
#pragma unroll
        for (int o = 1; o < 64; o <<= 1) { s0 += __shfl_xor(s0, o); s1 += __shfl_xor(s1, o); }
        const float mu0 = s0 * (1.0f / 2048.0f), mu1 = s1 * (1.0f / 2048.0f); float q0 = 0.f, q1 = 0.f;
#pragma unroll
        for (int j = 0; j < 4; ++j)
#pragma unroll
            for (int e = 0; e < 8; ++e) { v0[j][e] -= mu0; q0 += v0[j][e] * v0[j][e]; v1[j][e] -= mu1; q1 += v1[j][e] * v1[j][e]; }
#pragma unroll
        for (int o = 1; o < 64; o <<= 1) { q0 += __shfl_xor(q0, o); q1 += __shfl_xor(q1, o); }
        const float rs0 = rsqrtf(q0 * (1.0f / 2048.0f) + 1e-5f), rs1 = rsqrtf(q1 * (1.0f / 2048.0f) + 1e-5f);
        const float* mod0 = (const float*)(p.ws + WS_MOD) + (size_t)(3 + mod_row(tok0)) * 6144;
        const float* mod1 = (const float*)(p.ws + WS_MOD) + (size_t)(3 + mod_row(has1 ? tok1 : tok0)) * 6144;
        bf16_t* ur0 = (bf16_t*)(p.ws + WS_UM) + (size_t)tok0 * DM; bf16_t* ur1 = (bf16_t*)(p.ws + WS_UM) + (size_t)(has1 ? tok1 : tok0) * DM;
#pragma unroll
        for (int j = 0; j < 4; ++j) { const int c = j * 512 + lane * 8; float g[8], bb[8], y0[8], y1[8];
            ld8f(p.in[I_LNG] + l * DM + c, g); ld8f(p.in[I_LNB] + l * DM + c, bb);
#pragma unroll
            for (int e = 0; e < 8; ++e) { y0[e] = v0[j][e] * rs0 * g[e] + bb[e]; y1[e] = v1[j][e] * rs1 * g[e] + bb[e]; }
            *(float4*)(zr0 + c) = make_float4(y0[0], y0[1], y0[2], y0[3]); *(float4*)(zr0 + c + 4) = make_float4(y0[4], y0[5], y0[6], y0[7]);
            if (has1) { *(float4*)(zr1 + c) = make_float4(y1[0], y1[1], y1[2], y1[3]); *(float4*)(zr1 + c + 4) = make_float4(y1[4], y1[5], y1[6], y1[7]); }
            if (l == 0) { float sh[8], sc[8], o[8]; ld8f(mod0 + c, sh); ld8f(mod0 + 2048 + c, sc);
#pragma unroll
                for (int e = 0; e < 8; ++e) o[e] = y0[e] * (1.0f + sc[e]) + sh[e];
                *(u32x4v*)(ur0 + c) = pack8(o);
                if (has1) { ld8f(mod1 + c, sh); ld8f(mod1 + 2048 + c, sc);
#pragma unroll
                    for (int e = 0; e < 8; ++e) o[e] = y1[e] * (1.0f + sc[e]) + sh[e];
                    *(u32x4v*)(ur1 + c) = pack8(o); } } }
    }
}

#ifndef DUP_P0B
#define DUP_P0B 0
#endif
#ifndef DUP_SYNC
#define DUP_SYNC 0
#endif
#ifndef DUP_M3
#define DUP_M3 0
#endif
#ifndef DUP_G2
#define DUP_G2 0
#endif
#ifndef DUP_P0
#define DUP_P0 0
#endif
#ifndef DUP_M1
#define DUP_M1 0
#endif
#ifndef DUP_M2
#define DUP_M2 0
#endif
#ifndef DUP_G1
#define DUP_G1 0
#endif
#ifndef DUP_MASK
#define DUP_MASK 7
#endif
#ifndef PH_ALL
#define PH_ALL 1
#endif
#ifndef PH_P0
#define PH_P0 PH_ALL
#endif
#ifndef PH_G1
#define PH_G1 PH_ALL
#endif
#ifndef PH_M1
#define PH_M1 PH_ALL
#endif
#ifndef PH_M2
#define PH_M2 PH_ALL
#endif
#ifndef PH_M3
#define PH_M3 PH_ALL
#endif
#ifndef PH_G2
#define PH_G2 PH_ALL
#endif
#ifndef PH_LN
#define PH_LN PH_ALL
#endif
__global__ void __launch_bounds__(NTHREADS) hybrid_fwd(Params p) {
    extern __shared__ __attribute__((aligned(16))) unsigned char smem[];
    LAS unsigned char* lds = (LAS unsigned char*)smem;
    cg::grid_group grid = cg::this_grid();
    volatile LAS unsigned* xst = (volatile LAS unsigned*)(lds + LDS_SLOT + 16);
    if (threadIdx.x == 0) { xst[0] = 0u; xst[1] = 0u; }
    __syncthreads();
    const XcdBarrier xbar = xcd_barrier_post((unsigned*)(p.ws + WS_BAR), xst);
#define GSYNC() xcd_barrier(xbar)
#if PH_P0
    for (int rep = 0; rep < 1 + DUP_P0; ++rep) { p0_phase(p, lds, rep); if (rep < DUP_P0) GSYNC(); }
#endif
    if (p.ws == nullptr) grid.sync();
    GSYNC();
#if PH_P0
    for (int rep = 0; rep < 1 + DUP_P0B; ++rep) p0b_phase(p);
#endif
    GSYNC();
    for (int i = 0; i < DUP_SYNC; ++i) GSYNC();
    for (int l = 0; l < 2; ++l) {
#if PH_G1
        for (int rep = 0; rep < 1 + DUP_G1; ++rep) {
            pg8::Gemm g; g.A = (const bf16_t*)(p.ws + WS_UM); g.Bt = (const bf16_t*)(p.ws + WS_WIN) + (size_t)l * NP * DM; g.M = NTOK; g.N = NP; g.K = DM;
            pg8::StaticOrder S; S.init(NTOK, NP, gridDim.x, blockIdx.x);
            EpiIn E; E.proj = (bf16_t*)(p.ws + WS_PROJ); E.gates = (float*)(p.ws + WS_GATES); E.newk = p.out + O_NK; E.newv = p.out + O_NV; E.rope = (const float*)(p.ws + WS_ROPE); E.layer = l;
            pg8::gemm_phase<EpiIn, pg8::StaticOrder, false>(lds, g, S, E, nullptr);
            if (rep < DUP_G1) GSYNC();
        }
#endif
        GSYNC();
#if PH_M1
        for (int rep = 0; rep < 1 + DUP_M1; ++rep) { m1_phase(p, l, lds, rep, rep == 0 ? 7 : DUP_MASK); if (rep < DUP_M1) GSYNC(); }
#endif
        GSYNC();
#if PH_M2
        for (int rep = 0; rep < 1 + DUP_M2; ++rep) { m2_phase(p, l, rep, lds, xbar); if (rep < DUP_M2) GSYNC(); }
#endif
        GSYNC();
#if PH_M3
        for (int rep = 0; rep < 1 + DUP_M3; ++rep) m3_phase(p, l);
#endif
        GSYNC();
#if PH_G2
        for (int rep = 0; rep < 1 + (l == 0 ? DUP_G2 : 0); ++rep) {
            pg8::Gemm g; g.A = (const bf16_t*)(p.ws + WS_UM); g.Bt = (const bf16_t*)(p.ws + WS_WOUT) + (size_t)l * DM * DM; g.M = NTOK; g.N = DM; g.K = DM;
            pg8::StaticOrder S; S.init(NTOK, DM, gridDim.x, blockIdx.x);
            EpiOut E; E.xp = p.in[I_XP]; E.xs = p.in[I_XS]; E.mod = (const float*)(p.ws + WS_MOD) + (size_t)l * 3 * 6144; E.y = p.out + O_Y; E.layer = l;
            pg8::gemm_phase<EpiOut, pg8::StaticOrder, false>(lds, g, S, E, nullptr);
            if (rep < (l == 0 ? DUP_G2 : 0)) GSYNC();
        }
#endif
        GSYNC();
#if PH_LN
        ln_phase(p, l);
#endif
        if (l == 0) GSYNC();
    }
}

extern "C" void kernel_launch(void* const* d_in, const int* in_sizes, int n_in, void* d_out, int out_size, void* d_ws, size_t ws_size, hipStream_t stream) {
    static int grid_blocks = 0;
    if (grid_blocks == 0) {
        if (n_in != 38 || ws_size < WS_END) { fprintf(stderr, "kernel_launch: unexpected n_in %d / ws_size %zu (need %zu)\n", n_in, ws_size, (size_t)WS_END); grid_blocks = -1; return; }
        int dev = 0, cus = 0, per_cu = 0;
        hipGetDevice(&dev);
        hipDeviceGetAttribute(&cus, hipDeviceAttributeMultiprocessorCount, dev);
        hipFuncSetAttribute((const void*)hybrid_fwd, hipFuncAttributeMaxDynamicSharedMemorySize, LDS_BYTES);
        hipOccupancyMaxActiveBlocksPerMultiprocessor(&per_cu, (const void*)hybrid_fwd, NTHREADS, LDS_BYTES);
        if (per_cu < 1) { fprintf(stderr, "kernel_launch: occupancy query gives %d blocks per CU\n", per_cu); per_cu = 1; }
        grid_blocks = cus * per_cu;
    }
    if (grid_blocks < 0) return;
    Params p{};
    for (int i = 0; i < 38; ++i) p.in[i] = (const float*)d_in[i];
    p.out = (float*)d_out; p.ws = (unsigned char*)d_ws;
    hipMemsetAsync(d_ws, 0, 32768, stream);
    void* args[] = {&p};
    hipError_t e = hipLaunchCooperativeKernel((const void*)hybrid_fwd, dim3(grid_blocks), dim3(NTHREADS), args, LDS_BYTES, stream);
    if (e != hipSuccess) fprintf(stderr, "cooperative launch failed: %s (grid %d)\n", hipGetErrorString(e), grid_blocks);
}
```

```cpp
#include <hip/hip_runtime.h>
#include <hip/hip_cooperative_groups.h>
#include <cstdio>
#include <cstdint>
namespace cg = cooperative_groups;
namespace pg8 {
#define PG8_LAS __attribute__((address_space(3)))
typedef unsigned short bf16_t;
typedef short bf16x8 __attribute__((ext_vector_type(8)));
typedef float f32x4 __attribute__((ext_vector_type(4)));
typedef unsigned u32x4 __attribute__((ext_vector_type(4)));
constexpr int BM = 256, BK = 64, HALF = 128, HTB = HALF * BK * 2  , STAGE_BYTES = 8 * HTB, NXCD = 8, WGM = 8;

__host__ __device__ __forceinline__ int lds_byte(int r, int c) { const int st = (r >> 4) * 2 + (c >> 5), rr = r & 15, cc = c & 31, ob = rr * 64 + cc * 2; return st * 1024 + (ob ^ (((ob >> 9) & 1) << 5)); }
__host__ __device__ __forceinline__ void stage_rc(int b, int& R, int& C) { const int st = b / 1024, sb = b % 1024, swz = sb ^ (((sb >> 9) & 1) << 5); R = (st >> 1) * 16 + swz / 64; C = (st & 1) * 32 + (swz % 64) / 2; }
__host__ __device__ __forceinline__ int perm32(int rho) { const int n = rho >> 4, i = rho & 15; return 8 * (i >> 2) + 4 * n + (i & 3); }

struct Unit { int pm, pn; };
struct Gemm { const bf16_t* A; const bf16_t* Bt; int M, N, K; };

struct StaticOrder {
    int nM, nN, nwg, G, c;
    __host__ __device__ void init(int M, int N, int G_, int c_) { nM = M / BM; nN = N / BM; nwg = nM * nN; G = G_; c = c_; }
    __host__ __device__ bool next(int i, Unit& u) const {
        const long L = (long)i * G + c; if (L >= nwg) return false;
        int wgid = (int)L; { const int q = nwg / NXCD, r = nwg % NXCD, xcd = wgid % NXCD, off = wgid / NXCD; wgid = (xcd < r ? xcd * (q + 1) : r * (q + 1) + (xcd - r) * q) + off; }
        const int nig = WGM * nN, gid = wgid / nig, fm = gid * WGM, gsz = (nM - fm) < WGM ? (nM - fm) : WGM;
        u.pm = fm + ((wgid % nig) % gsz); u.pn = (wgid % nig) / gsz; return true;
    }
    __device__ __forceinline__ void a_ready(const Unit&) const {}
    __device__ __forceinline__ void done(const Unit&) const {}
};
__device__ __forceinline__ unsigned cvt_pk_bf16(float lo, float hi) { unsigned r; asm volatile("v_cvt_pk_bf16_f32 %0, %1, %2" : "=v"(r) : "v"(lo), "v"(hi)); return r; }
template <class Epi, class Sched, bool STAMP = false>
__device__ __forceinline__ void gemm_phase(PG8_LAS unsigned char* lds, const Gemm g, const Sched& S, const Epi& E, unsigned long long* stamps) {
    int tid = threadIdx.x; asm volatile("" : "+v"(tid)); const int wid = __builtin_amdgcn_readfirstlane(tid >> 6), lane = tid & 63, wr = wid >> 2, wc = wid & 3, fr = lane & 15, fq = lane >> 4;
    const int K = g.K, nt = K / BK;
    int ts_lo = 0, ts_hi = 0, nts = 0; const unsigned long long rt_entry = STAMP ? (unsigned long long)wall_clock64() : 0ull;
#define PG8_STAMP() do { if (STAMP && wid == 0 && nts < 64) { const unsigned long long _c = (unsigned long long)clock64(); \
        ts_lo = (lane == nts) ? (int)(unsigned)_c : ts_lo; ts_hi = (lane == nts) ? (int)(unsigned)(_c >> 32) : ts_hi; ++nts; } } while (0)
    PG8_STAMP();
    unsigned voffA[2], voffB[2];
#pragma unroll
    for (int i = 0; i < 2; ++i) { int R, C; stage_rc(tid * 16 + i * 8192, R, C); const int Rb = Epi::PERM ? ((R & ~31) + perm32(R & 31)) : R;
        voffA[i] = (unsigned)(R * K + C) * 2u; voffB[i] = (unsigned)(Rb * K + C) * 2u; }
    const size_t kstep = (size_t)(BK * 2);
    const size_t hstep = (size_t)HALF * K * 2;
    const size_t tstep = 2 * hstep;
    const unsigned ldsw = (unsigned)wid * 1024u;
    const int aoff = lds_byte(wr * 64 + fr, fq * 8), boff = lds_byte(wc * 32 + fr, fq * 8);
#define PG8_SA(b, h) (((b) * 2 + (h)) * HTB)
#define PG8_SB(b, h) ((4 + (b) * 2 + (h)) * HTB)
#define PG8_STAGE(bufoff, gbase, voff) do { _Pragma("unroll") for (int _i = 0; _i < 2; ++_i) \
        __builtin_amdgcn_global_load_lds((const unsigned*)((const char*)(gbase) + (voff)[_i]), (PG8_LAS unsigned*)(lds + (bufoff) + ldsw + _i * 8192), 16, 0, 0); } while (0)
#define PG8_LDA(dst, b, h) do { _Pragma("unroll") for (int m = 0; m < 4; ++m) _Pragma("unroll") for (int k = 0; k < 2; ++k) dst[m][k] = *(const PG8_LAS bf16x8*)(lds + PG8_SA(b, h) + aoff + m * 2048 + k * 1024); } while (0)
#define PG8_LDB(dst, b, h) do { _Pragma("unroll") for (int n = 0; n < 2; ++n) _Pragma("unroll") for (int k = 0; k < 2; ++k) dst[n][k] = *(const PG8_LAS bf16x8*)(lds + PG8_SB(b, h) + boff + n * 2048 + k * 1024); } while (0)
#define PG8_MMA(ai, bj, At, Bt) do { __builtin_amdgcn_s_setprio(1); _Pragma("unroll") for (int m = 0; m < 4; ++m) _Pragma("unroll") for (int n = 0; n < 2; ++n) _Pragma("unroll") for (int k = 0; k < 2; ++k) \
        acc[ai][bj][m][n] = __builtin_amdgcn_mfma_f32_16x16x32_bf16(Bt[n][k], At[m][k], acc[ai][bj][m][n], 0, 0, 0); __builtin_amdgcn_s_setprio(0); } while (0)
#define PG8_WAIT_V(n) asm volatile("s_waitcnt vmcnt(" #n ")" ::: "memory")
#define PG8_WAIT_L(n) asm volatile("s_waitcnt lgkmcnt(" #n ")" ::: "memory")
#define PG8_BAR __builtin_amdgcn_s_barrier()
#define PG8_SCHED __builtin_amdgcn_sched_barrier(0)
    Unit cur, nxt; int ui = 0;
    if (!S.next(0, cur)) return;
    f32x4 acc[2][2][4][2];
#pragma unroll
    for (int a = 0; a < 2; ++a)
#pragma unroll
        for (int b = 0; b < 2; ++b)
#pragma unroll
            for (int m = 0; m < 4; ++m)
#pragma unroll
                for (int n = 0; n < 2; ++n) acc[a][b][m][n] = (f32x4){0.f, 0.f, 0.f, 0.f};
    bf16x8 At[4][2], B0[2][2], B1[2][2];
    const char* cA = (const char*)g.A + (size_t)cur.pm * tstep; const char* cB = (const char*)g.Bt + (size_t)cur.pn * tstep;
    S.a_ready(cur);
    PG8_STAGE(PG8_SB(0, 0), cB, voffB); PG8_STAGE(PG8_SA(0, 0), cA, voffA); PG8_STAGE(PG8_SB(0, 1), cB + hstep, voffB); PG8_STAGE(PG8_SA(0, 1), cA + hstep, voffA);
    if (wr == 1) PG8_BAR;
    PG8_WAIT_V(4); PG8_BAR;
    PG8_STAGE(PG8_SB(1, 0), cB + kstep, voffB); PG8_STAGE(PG8_SA(1, 0), cA + kstep, voffA); PG8_STAGE(PG8_SB(1, 1), cB + hstep + kstep, voffB);
    PG8_WAIT_V(6); PG8_BAR;
    PG8_STAMP();
    for (;;) {
        const bool has_next = S.next(ui + 1, nxt);
        const char* nA = has_next ? (const char*)g.A + (size_t)nxt.pm * tstep : cA; const char* nB = has_next ? (const char*)g.Bt + (size_t)nxt.pn * tstep : cB;
        for (int t = 0; t < nt; t += 2) {
            const bool last = (t == nt - 2);
            const char* a1 = cA + (size_t)(t + 1) * kstep;
            const char* a2 = last ? nA : cA + (size_t)(t + 2) * kstep; const char* b2 = last ? nB : cB + (size_t)(t + 2) * kstep;
            const char* a3 = a2 + kstep; const char* b3 = b2 + kstep;
            if (last && has_next) S.a_ready(nxt);
            PG8_LDB(B0, 0, 0); PG8_SCHED; PG8_LDA(At, 0, 0); PG8_STAGE(PG8_SA(1, 1), a1 + hstep, voffA);
            PG8_WAIT_L(8); PG8_BAR; PG8_WAIT_L(0); PG8_MMA(0, 0, At, B0); PG8_BAR; PG8_SCHED;
            PG8_LDB(B1, 0, 1); PG8_STAGE(PG8_SB(0, 0), b2, voffB);
            PG8_BAR; PG8_WAIT_L(0); PG8_MMA(0, 1, At, B1); PG8_BAR;
            PG8_LDA(At, 0, 1); PG8_STAGE(PG8_SA(0, 0), a2, voffA);
            PG8_BAR; PG8_WAIT_L(0); PG8_MMA(1, 0, At, B0); PG8_BAR; PG8_SCHED;
            PG8_STAGE(PG8_SB(0, 1), b2 + hstep, voffB);
            PG8_WAIT_V(6); PG8_BAR; PG8_MMA(1, 1, At, B1); PG8_BAR;
            PG8_LDB(B0, 1, 0); PG8_SCHED; PG8_LDA(At, 1, 0); PG8_STAGE(PG8_SA(0, 1), a2 + hstep, voffA);
            PG8_WAIT_L(8); PG8_BAR; PG8_WAIT_L(0); PG8_MMA(0, 0, At, B0); PG8_BAR; PG8_SCHED;
            PG8_LDB(B1, 1, 1); PG8_STAGE(PG8_SB(1, 0), b3, voffB);
            PG8_BAR; PG8_WAIT_L(0); PG8_MMA(0, 1, At, B1); PG8_BAR;
            PG8_LDA(At, 1, 1); PG8_STAGE(PG8_SA(1, 0), a3, voffA);
            PG8_BAR; PG8_WAIT_L(0); PG8_MMA(1, 0, At, B0); PG8_BAR; PG8_SCHED;
            PG8_STAGE(PG8_SB(1, 1), b3 + hstep, voffB);
            PG8_WAIT_V(6); PG8_BAR; PG8_MMA(1, 1, At, B1); PG8_BAR;
        }
        PG8_STAMP();
        if constexpr (!Epi::AFTER_DRAIN) { E(acc, cur, wr, wc, fr, fq); S.done(cur); }
        PG8_STAMP();
        if (!has_next) break;
#pragma unroll
        for (int a = 0; a < 2; ++a)
#pragma unroll
            for (int b = 0; b < 2; ++b)
#pragma unroll
                for (int m = 0; m < 4; ++m)
#pragma unroll
                    for (int n = 0; n < 2; ++n) acc[a][b][m][n] = (f32x4){0.f, 0.f, 0.f, 0.f};
        cur = nxt; cA = nA; cB = nB; ++ui;
    }
    PG8_WAIT_V(0);
    if (wr == 0) PG8_BAR;
    PG8_BAR;
    if constexpr (Epi::AFTER_DRAIN) { E.fused(acc, cur, wr, wc, fr, fq, lds, wid, lane); S.done(cur); }
    PG8_STAMP();
    if (STAMP && wid == 0) { stamps[lane] = lane < nts ? (((unsigned long long)(unsigned)ts_hi << 32) | (unsigned)ts_lo) : 0ull;
        if (lane == 62) stamps[62] = rt_entry; if (lane == 63) stamps[63] = (unsigned long long)wall_clock64(); }
#undef PG8_STAMP
#undef PG8_SA
#undef PG8_SB
#undef PG8_STAGE
#undef PG8_LDA
#undef PG8_LDB
#undef PG8_MMA
#undef PG8_WAIT_V
#undef PG8_WAIT_L
#undef PG8_BAR
#undef PG8_SCHED
}
}

#define LAS __attribute__((address_space(3)))
#ifndef DUP_M2MASK
#define DUP_M2MASK 3
#endif
typedef unsigned short bf16_t;
typedef short bf16x8 __attribute__((ext_vector_type(8)));
typedef float f32x4 __attribute__((ext_vector_type(4)));
typedef unsigned u32x4v __attribute__((ext_vector_type(4)));
typedef unsigned u32x2v __attribute__((ext_vector_type(2)));

constexpr int NTOK = 10240, NPT = 8192, DM = 2048, NP = 9216, PIN = 8976;
constexpr int C_Q = 4864, C_K = 5888, C_V = 6912, C_G = 7936, C_IF = 8960;
constexpr int A_WD = 1536, A_AD = 1664, A_GATE = 1792;
constexpr int B_Q = 2304, B_V = 3328, B_O = 3840, B_GATE = 4352;
constexpr int NTHREADS = 512;
constexpr int LDS_SLOT = 131072, LDS_BYTES = 131072 + 1024;

constexpr size_t WS_CTL = 0;
constexpr size_t WS_BAR = 8192;
constexpr size_t WS_MOD = 32768;
constexpr size_t WS_ROPE = WS_MOD + 147456;
constexpr size_t WS_LAM = WS_ROPE + 8192;
constexpr size_t WS_WIN = WS_LAM + 256;
constexpr size_t WS_WOUT = WS_WIN + 2ull * NP * DM * 2;
constexpr size_t WS_UM = WS_WOUT + 2ull * DM * DM * 2;
constexpr size_t WS_PROJ = WS_UM + (size_t)NTOK * DM * 2;
constexpr size_t WS_GATES = WS_PROJ + (size_t)NTOK * NP * 2;
constexpr size_t SZ16 = (size_t)NTOK * 512 * 2, SZ32 = (size_t)NTOK * 512 * 4;
constexpr size_t WS_SCV = WS_GATES + (size_t)NTOK * 16 * 4;
constexpr size_t WS_SCBON = WS_SCV + SZ16;
constexpr size_t WS_PK = WS_SCBON + SZ16;
constexpr size_t SZPK = (size_t)NTOK * 8 * 320 * 2;
constexpr size_t WS_YD = WS_PK + 2 * SZPK;
constexpr size_t WS_HD = WS_YD + 2 * SZ32;
constexpr size_t WS_KC = WS_HD + 2 * SZ32;
constexpr size_t WS_VTC = WS_KC + 4194304;
constexpr size_t WS_WUPT = WS_VTC + 4194304;
constexpr size_t WS_END = WS_WUPT + 524288;

constexpr size_t O_Y = 0, O_NK = 20971520, O_NV = 37748736, O_RW = 54525952, O_MC = 58720256, O_MN = 67108864, O_MM = 67174400;

struct Params { const float* in[38]; float* out; unsigned char* ws; };
enum { I_XP = 0, I_XS, I_CK, I_CV, I_SRW, I_SMC, I_SMN, I_SMM, I_C, I_CCTX, I_WADA, I_BADA, I_WIN, I_CAW, I_CAB, I_W0, I_WUP, I_A0, I_AUP, I_KK, I_KA, I_RK,
       I_RGG, I_RGB, I_CBW, I_CBB, I_BI, I_BF, I_MGG, I_MGB, I_LQ1, I_LK1, I_LQ2, I_LK2, I_SUBG, I_WOUT, I_LNG, I_LNB };

__device__ __forceinline__ float bf2f(bf16_t v) { return __uint_as_float(((unsigned)v) << 16); }
__device__ __forceinline__ float bflo(unsigned w) { return __uint_as_float(w << 16); }
__device__ __forceinline__ float bfhi(unsigned w) { return __uint_as_float(w & 0xffff0000u); }
__device__ __forceinline__ unsigned pk2(float lo, float hi) { return pg8::cvt_pk_bf16(lo, hi); }
__device__ __forceinline__ bf16_t f2bf(float f) { return (bf16_t)(pk2(f, 0.f) & 0xffffu); }
__device__ __forceinline__ void unpack8(const u32x4v w, float (&o)[8]) { o[0] = bflo(w.x); o[1] = bfhi(w.x); o[2] = bflo(w.y); o[3] = bfhi(w.y); o[4] = bflo(w.z); o[5] = bfhi(w.z); o[6] = bflo(w.w); o[7] = bfhi(w.w); }
__device__ __forceinline__ u32x4v pack8(const float (&o)[8]) { u32x4v w; w.x = pk2(o[0], o[1]); w.y = pk2(o[2], o[3]); w.z = pk2(o[4], o[5]); w.w = pk2(o[6], o[7]); return w; }
__device__ __forceinline__ void ld8f(const float* p, float (&o)[8]) { const float4 a = *(const float4*)p, b = *(const float4*)(p + 4); o[0] = a.x; o[1] = a.y; o[2] = a.z; o[3] = a.w; o[4] = b.x; o[5] = b.y; o[6] = b.z; o[7] = b.w; }
__device__ __forceinline__ float sigmoidf_(float x) { return __builtin_amdgcn_rcpf(1.0f + __expf(-x)); }
__device__ __forceinline__ float siluf_(float x) { return x * __builtin_amdgcn_rcpf(1.0f + __expf(-x)); }
__device__ __forceinline__ float tanhf_(float x) { return 1.0f - 2.0f * __builtin_amdgcn_rcpf(1.0f + __expf(2.0f * x)); }
__device__ __forceinline__ bf16x8 frag(const LAS bf16_t* base, int row0, int ld, int k0, int lane) { return *(const LAS bf16x8*)(base + (row0 + (lane & 15)) * ld + k0 + (lane >> 4) * 8); }
__device__ __forceinline__ bf16x8 fragsw(const LAS bf16_t* base, int row0, int k0, int lane) { const int r = row0 + (lane & 15), m = (k0 >> 3) + (lane >> 4); return *(const LAS bf16x8*)(base + r * 72 + 8 * (m ^ ((r >> 3) & 7))); }
#define MFMA16(a, b, c) __builtin_amdgcn_mfma_f32_16x16x32_bf16((a), (b), (c), 0, 0, 0)
#define LDS_FENCE() asm volatile("s_waitcnt lgkmcnt(0)" ::: "memory")
template <int CTRL> __device__ __forceinline__ float dppf(float x) { return __builtin_bit_cast(float, __builtin_amdgcn_mov_dpp(__builtin_bit_cast(int, x), CTRL, 0xf, 0xf, true)); }
__device__ __forceinline__ float red16_sum(float x) { x += dppf<0xB1>(x); x += dppf<0x4E>(x); x += dppf<0x124>(x); x += dppf<0x128>(x); return x; }
__device__ __forceinline__ float red4_sum(float x) { x += dppf<0xB1>(x); x += dppf<0x4E>(x); return x; }
__device__ __forceinline__ float red16_max(float x) { x = fmaxf(x, dppf<0xB1>(x)); x = fmaxf(x, dppf<0x4E>(x)); x = fmaxf(x, dppf<0x124>(x)); x = fmaxf(x, dppf<0x128>(x)); return x; }

__device__ __forceinline__ int opaque_tid() { int t = threadIdx.x; asm volatile("" : "+v"(t)); return t; }
__device__ __forceinline__ int next_task(unsigned* ctr, LAS int* slot) {
    __syncthreads();
    if (threadIdx.x == 0) *slot = (int)atomicAdd(ctr, 1u);
    __syncthreads();
    return *slot;
}
#define QNEXT_BEGIN(ctr) unsigned qn_ = 0u; if (threadIdx.x == 0) qn_ = atomicAdd((ctr), 1u)
#define QNEXT_END(slot, t) do { __syncthreads(); if (threadIdx.x == 0) *(slot) = (int)qn_; __syncthreads(); (t) = *(slot); } while (0)
__device__ __forceinline__ int win_src_col(int n) { return n < 4352 ? n : (n < 8960 ? n + 16 : (n < 8976 ? n - 8960 + 4352 : -1)); }
__device__ __forceinline__ int mod_row(int tok) { return tok < NPT ? 0 : 1 + ((tok - NPT) >> 10); }

__device__ __forceinline__ void p0_mod_item(const Params& p, int item, LAS unsigned char* lds) {
    const int tid = opaque_tid(), lane = tid & 63, wave = tid >> 6, kq = lane >> 4, cq = lane & 15;
    const int l = item / 96, cb = item % 96;
    LAS float* sS = (LAS float*)lds;
    LAS float* sRed = sS + 3 * 2048;
    for (int e = tid; e < 3 * 2048; e += NTHREADS) { const int r = e >> 11, k = e & 2047; const float cv = r == 0 ? p.in[I_CCTX][k] : p.in[I_C][(r - 1) * 2048 + k]; sS[e] = siluf_(cv); }
    __syncthreads();
    const float* W = p.in[I_WADA] + (size_t)l * 2048 * 6144 + cb * 64 + 4 * cq;
    float4 a0 = {0, 0, 0, 0}, a1 = a0, a2 = a0;
#pragma unroll 16
    for (int i = 0; i < 64; ++i) { const int k = wave * 256 + i * 4 + kq; const float4 w = *(const float4*)(W + (size_t)k * 6144);
        const float s0 = sS[k], s1 = sS[2048 + k], s2 = sS[4096 + k];
        a0.x += s0 * w.x; a0.y += s0 * w.y; a0.z += s0 * w.z; a0.w += s0 * w.w;
        a1.x += s1 * w.x; a1.y += s1 * w.y; a1.z += s1 * w.z; a1.w += s1 * w.w;
        a2.x += s2 * w.x; a2.y += s2 * w.y; a2.z += s2 * w.z; a2.w += s2 * w.w; }
    float v[12] = {a0.x, a0.y, a0.z, a0.w, a1.x, a1.y, a1.z, a1.w, a2.x, a2.y, a2.z, a2.w};
#pragma unroll
    for (int i = 0; i < 12; ++i) { v[i] += __shfl_xor(v[i], 16); v[i] += __shfl_xor(v[i], 32); }
    if (kq == 0) {
#pragma unroll
        for (int r = 0; r < 3; ++r)
#pragma unroll
            for (int e = 0; e < 4; ++e) sRed[(wave * 3 + r) * 64 + 4 * cq + e] = v[r * 4 + e];
    }
    __syncthreads();
    if (tid < 192) { const int r = tid >> 6, c = tid & 63; float s = 0.f;
#pragma unroll
        for (int w = 0; w < 8; ++w) s += sRed[(w * 3 + r) * 64 + c];
        ((float*)(p.ws + WS_MOD))[(l * 3 + r) * 6144 + cb * 64 + c] = s + p.in[I_BADA][l * 6144 + cb * 64 + c]; }
}
template <bool MAPCOL> __device__ __forceinline__ void p0_transpose_item(const float* W, int N, int nblk, bf16_t* WT, LAS float* scr, int item, int lane) {
    const int kb = item / nblk, nb = item % nblk, k0 = 64 * kb, n0 = 32 * nb;
    const int n = n0 + (lane & 31); const int oc = MAPCOL ? win_src_col(n) : n;
    float tv[32];
    const float* wp = W + (size_t)(k0 + (lane >> 5)) * N + (oc >= 0 ? oc : 0);
#pragma unroll
    for (int i = 0; i < 32; ++i) tv[i] = wp[(size_t)(2 * i) * N];
#pragma unroll
    for (int i = 0; i < 32; ++i) scr[(2 * i + (lane >> 5)) * 33 + (lane & 31)] = oc >= 0 ? tv[i] : 0.f;
    LDS_FENCE();
    const int c = lane & 7;
#pragma unroll
    for (int j = 0; j < 4; ++j) { const int nn = (lane >> 3) + 8 * j; const LAS float* s = scr + (8 * c) * 33 + nn;
        u32x4v o; o.x = pk2(s[0 * 33], s[1 * 33]); o.y = pk2(s[2 * 33], s[3 * 33]); o.z = pk2(s[4 * 33], s[5 * 33]); o.w = pk2(s[6 * 33], s[7 * 33]);
        *(u32x4v*)(WT + (size_t)(n0 + nn) * 2048 + k0 + 8 * c) = o; }
    LDS_FENCE();
}
__device__ __forceinline__ void p0_phase(const Params& p, LAS unsigned char* lds, int rep) {
    const int tid = opaque_tid(), lane = tid & 63, wave = tid >> 6;
    unsigned* ctr = (unsigned*)(p.ws + WS_CTL) + 64 * 15 * rep;
    LAS int* slot = (LAS int*)(lds + LDS_SLOT);
    constexpr int NT_MOD = 192, NT_TR = 2816, NT_A = NT_MOD + 1 + NT_TR, NT_KC = 512, NT_VT = 512, NT_WU = 64, NT = NT_A + NT_KC + NT_VT + NT_WU;
    for (;;) {
        const int t = next_task(ctr, slot);
        if (t >= NT) break;
        if (t < NT_MOD) { p0_mod_item(p, t, lds); continue; }
        if (t == NT_MOD) {
            float* rope = (float*)(p.ws + WS_ROPE);
            for (int e = tid; e < 1024; e += NTHREADS) { const int pos = e >> 4, i = e & 15; const float inv = 1.0f / powf(10000.0f, (float)(2 * i) / 32.0f); const float ang = (float)pos * inv;
                rope[pos * 32 + i] = cosf(ang); rope[pos * 32 + 16 + i] = sinf(ang); }
            if (tid < 2) { const int l = tid; float d1 = 0.f, d2 = 0.f;
                for (int i = 0; i < 64; ++i) { d1 += p.in[I_LQ1][l * 64 + i] * p.in[I_LK1][l * 64 + i]; d2 += p.in[I_LQ2][l * 64 + i] * p.in[I_LK2][l * 64 + i]; }
                const float lam_init = 0.8f - 0.6f * expf(-0.3f * (float)l);
                ((float*)(p.ws + WS_LAM))[l] = expf(d1) - expf(d2) + lam_init; }
            continue;
        }
        if (t >= NT_A) {
            int u = t - NT_A;
            if (u < NT_KC) { const size_t o = ((size_t)u * 512 + tid) * 8; float x[8]; ld8f(p.in[I_CK] + o, x); *(u32x4v*)((bf16_t*)(p.ws + WS_KC) + o) = pack8(x); continue; }
            u -= NT_KC;
            if (u < NT_VT) { const int idx = u * 512 + tid, dv = idx & 127, m = (idx >> 7) & 63, bh = idx >> 13; float x[8];
#pragma unroll
                for (int e = 0; e < 8; ++e) x[e] = p.in[I_CV][((size_t)bh * 512 + 8 * m + e) * 128 + dv];
                *(u32x4v*)((bf16_t*)(p.ws + WS_VTC) + ((size_t)bh * 128 + dv) * 512 + 8 * m) = pack8(x); continue; }
            u -= NT_VT;
#pragma unroll
            for (int e = 0; e < 8; ++e) { const int f = u * 4096 + e * 512 + tid, c = f & 63, j = (f >> 6) & 63, h = (f >> 12) & 7, which = (f >> 15) & 1, ld = f >> 16;
                const float v = (which ? p.in[I_AUP] : p.in[I_WUP])[((size_t)ld * 64 + j) * 512 + h * 64 + c];
                ((bf16_t*)(p.ws + WS_WUPT))[(f & ~4095) + c * 64 + j] = f2bf(v); }
            continue;
        }
        int it = (t - NT_MOD - 1) * 8 + wave;
        LAS float* scr = (LAS float*)(lds + wave * 8704);
        const int l = it / 11264; it -= l * 11264;
        if (it < 9216) p0_transpose_item<true>(p.in[I_WIN] + (size_t)l * 2048 * PIN, PIN, 288, (bf16_t*)(p.ws + WS_WIN) + (size_t)l * NP * 2048, scr, it, lane);
        else p0_transpose_item<false>(p.in[I_WOUT] + (size_t)l * 2048 * 2048, 2048, 64, (bf16_t*)(p.ws + WS_WOUT) + (size_t)l * 2048 * 2048, scr, it - 9216, lane);
    }
}
__device__ __forceinline__ void modulate_row(const float* xrow, const float* mod, bf16_t* urow, int lane) {
#pragma unroll
    for (int j = 0; j < 4; ++j) { const int c = j * 512 + lane * 8; float x[8], sh[8], sc[8], o[8]; ld8f(xrow + c, x); ld8f(mod + c, sh); ld8f(mod + 2048 + c, sc);
#pragma unroll
        for (int e = 0; e < 8; ++e) o[e] = x[e] * (1.0f + sc[e]) + sh[e];
        *(u32x4v*)(urow + c) = pack8(o); }
}
__device__ __forceinline__ void p0b_phase(const Params& p) {
    const int tid_ = opaque_tid(); const int lane = tid_ & 63, gw = blockIdx.x * 8 + (tid_ >> 6), NGW = gridDim.x * 8;
    for (int tok = gw; tok < NTOK; tok += NGW) {
        const float* xrow = tok < NPT ? p.in[I_XP] + (size_t)tok * DM : p.in[I_XS] + (size_t)(tok - NPT) * DM;
        modulate_row(xrow, (const float*)(p.ws + WS_MOD) + mod_row(tok) * 6144, (bf16_t*)(p.ws + WS_UM) + (size_t)tok * DM, lane);
    }
}

struct EpiIn {
    static constexpr bool PERM = true, AFTER_DRAIN = false;
    bf16_t* proj; float* gates; float* newk; float* newv; const float* rope; int layer;
    __device__ __forceinline__ void operator()(const f32x4 (&acc)[2][2][4][2], const pg8::Unit& u, int wr, int wc, int fr, int fq) const {
        const int row0 = u.pm * 256 + wr * 64 + fr, col0 = u.pn * 256 + wc * 32 + 8 * fq;
        const bool samp = u.pm >= 32;
        const bool is_rope = samp && u.pn >= 19 && u.pn < 27;
        const bool is_k = !samp && u.pn >= 23 && u.pn < 27, is_v = !samp && u.pn >= 27 && u.pn < 31, is_g = u.pn == 35;
#pragma unroll
        for (int ai = 0; ai < 2; ++ai)
#pragma unroll
            for (int m = 0; m < 4; ++m) {
                const int row = row0 + ai * 128 + m * 16;
                float cs[8], sn[8];
                if (is_rope) { const int pos = (row - NPT) & 1023; const int pp = (wc & 1) ? (pos & 63) : (pos >> 6); const float* rp = rope + pp * 32 + 8 * (fq & 1); ld8f(rp, cs); ld8f(rp + 16, sn); }
#pragma unroll
                for (int bj = 0; bj < 2; ++bj) {
                    f32x4 v0 = acc[ai][bj][m][0], v1 = acc[ai][bj][m][1];
                    if (is_rope) {
                        const float sg = (fq & 2) ? 1.0f : -1.0f;
#pragma unroll
                        for (int e = 0; e < 4; ++e) { const float p0 = __shfl_xor(v0[e], 32), p1 = __shfl_xor(v1[e], 32);
                            v0[e] = v0[e] * cs[e] + sg * p0 * sn[e]; v1[e] = v1[e] * cs[4 + e] + sg * p1 * sn[4 + e]; }
                    }
                    const int col = col0 + bj * 128;
                    u32x4v w; w.x = pk2(v0[0], v0[1]); w.y = pk2(v0[2], v0[3]); w.z = pk2(v1[0], v1[1]); w.w = pk2(v1[2], v1[3]);
                    *(u32x4v*)(proj + (size_t)row * NP + col) = w;
                    if (is_k || is_v) { const int ck = col - (is_k ? C_K : C_V), h = ck >> 7, j = ck & 127, b = row >> 8, t = row & 255;
                        float* dst = (is_k ? newk : newv) + ((((size_t)(b * 2 + layer) * 8 + h) * 256 + t) * 128 + j);
                        *(f32x4*)dst = v0; *(f32x4*)(dst + 4) = v1; }
                    if (is_g && bj == 0 && wc == 0 && fq < 2) { float* dst = gates + (size_t)row * 16 + 8 * fq; *(f32x4*)dst = v0; *(f32x4*)(dst + 4) = v1; }
                }
            }
    }
};
struct EpiOut {
    static constexpr bool PERM = false, AFTER_DRAIN = false;
    const float* xp; const float* xs; const float* mod; float* y; int layer;
    __device__ __forceinline__ void operator()(const f32x4 (&acc)[2][2][4][2], const pg8::Unit& u, int wr, int wc, int fr, int fq) const {
        const int row0 = u.pm * 256 + wr * 64 + fr, col0 = u.pn * 256 + wc * 32 + 4 * fq;
#pragma unroll
        for (int ai = 0; ai < 2; ++ai)
#pragma unroll
            for (int m = 0; m < 4; ++m) {
                const int row = row0 + ai * 128 + m * 16;
                const float* xrow = layer == 0 ? (row < NPT ? xp + (size_t)row * DM : xs + (size_t)(row - NPT) * DM) : y + (size_t)row * DM;
                const float* g = mod + mod_row(row) * 6144 + 4096;
#pragma unroll
                for (int bj = 0; bj < 2; ++bj)
#pragma unroll
                    for (int n = 0; n < 2; ++n) { const int c = col0 + bj * 128 + n * 16;
                        const f32x4 xv = *(const f32x4*)(xrow + c), gv = *(const f32x4*)(g + c);
                        *(f32x4*)(y + (size_t)row * DM + c) = 1.41421356237f * xv + gv * acc[ai][bj][m][n]; }
            }
    }
};

#define XB_TMO      128
#define XB_XCNT(j)  (256  + 64 * (j))
#define XB_XSUB(j)  (1280 + 64 * (j))
#define XB_XGEN(j)  (2304 + 64 * (j))
#define XB_TOP      3328
#define XB_TOPGEN   3392
#define XCD_BAR_WORDS 3456
#define XB_SPIN_CAP (1u << 18)

__device__ __forceinline__ unsigned xb_ld(unsigned* p)              { return __hip_atomic_load(p, __ATOMIC_RELAXED, __HIP_MEMORY_SCOPE_AGENT); }
__device__ __forceinline__ unsigned xb_add(unsigned* p, unsigned v) { return __hip_atomic_fetch_add(p, v, __ATOMIC_RELAXED, __HIP_MEMORY_SCOPE_AGENT); }
__device__ __forceinline__ unsigned xb_xcc_id() { return (unsigned)__builtin_amdgcn_s_getreg((3 << 11) | 20) & 0xFu; }
#define XB_SPIN(cond, bar) do { unsigned _sp = 0; while (cond) { __builtin_amdgcn_s_sleep(1); \
    if ((++_sp & 255u) == 0u) { if (xb_ld(&(bar)[XB_TMO])) break; if (_sp > XB_SPIN_CAP) { atomicAdd(&(bar)[XB_TMO], 1u); break; } } } } while (0)

struct XcdBarrier {
    unsigned* bar; unsigned x;
    volatile LAS unsigned* st;
};

__device__ __forceinline__ XcdBarrier xcd_barrier_post(unsigned* bar, volatile LAS unsigned* st) {
    XcdBarrier b; b.bar = bar; b.x = xb_xcc_id(); b.st = st;
    if (threadIdx.x == 0) (void)xb_add(&bar[XB_XCNT(b.x)], 1u);
    return b;
}
__device__ __forceinline__ void xcd_barrier_complete(unsigned* bar, unsigned x, unsigned& nloc, unsigned& nx) {
    const unsigned G = gridDim.x * gridDim.y * gridDim.z;
    unsigned sum, cnt, mine, sp = 0u;
    for (;;) {
        sum = 0u; cnt = 0u; mine = 0u;
#pragma unroll
        for (unsigned j = 0; j < 16; ++j) { const unsigned c = xb_ld(&bar[XB_XCNT(j)]); sum += c; cnt += (c > 0u) ? 1u : 0u; mine = (j == x) ? c : mine; }
        if (sum == G) break;
        __builtin_amdgcn_s_sleep(1);
        if ((++sp & 255u) == 0u) { if (xb_ld(&bar[XB_TMO])) break; if (sp > XB_SPIN_CAP) { atomicAdd(&bar[XB_TMO], 1u); break; } }
    }
    nloc = mine > 0u ? mine : 1u; nx = cnt > 0u ? cnt : 1u;
}

__device__ __forceinline__ unsigned xb_xcc_id_v() { unsigned r; asm volatile("s_getreg_b32 %0, hwreg(20, 0, 4)" : "=s"(r)); return r & 0xFu; }
__device__ __forceinline__ void xcd_barrier(const XcdBarrier& b) {
    asm volatile("s_waitcnt vmcnt(0)" ::: "memory");
    __syncthreads();
    if (threadIdx.x == 0) {
        unsigned* bar = b.bar; const unsigned bx = xb_xcc_id_v();
        __builtin_amdgcn_s_waitcnt(0);
        unsigned nloc = b.st[0], nx = b.st[1];
        if (nloc == 0u) { xcd_barrier_complete(bar, bx, nloc, nx); b.st[0] = nloc; b.st[1] = nx; }
        const unsigned old = xb_add(&bar[XB_XSUB(bx)], 1u);
        const unsigned gen = old / nloc;
        if (old + 1u == (gen + 1u) * nloc) {
            __builtin_amdgcn_fence(__ATOMIC_RELEASE, "agent");
            asm volatile("s_waitcnt vmcnt(0)" ::: "memory");
            const unsigned og = xb_add(&bar[XB_TOP], 1u);
            const unsigned tg = og / nx;
            if (og + 1u == (tg + 1u) * nx) xb_add(&bar[XB_TOPGEN], 1u);
            else XB_SPIN(xb_ld(&bar[XB_TOPGEN]) == tg, bar);
            __builtin_amdgcn_fence(__ATOMIC_ACQUIRE, "agent");
            xb_add(&bar[XB_XGEN(bx)], 1u);
            asm volatile("s_waitcnt vmcnt(0)" ::: "memory");
        } else {
            XB_SPIN(xb_ld(&bar[XB_XGEN(bx)]) == gen, bar);
            __builtin_amdgcn_fence(__ATOMIC_ACQUIRE, "agent");
            asm volatile("s_waitcnt vmcnt(0)" ::: "memory");
        }
    }
    __syncthreads();
}


__device__ __forceinline__ void mlstm_task(const Params& p, int l, int s, int d, int h, LAS unsigned char* lds) {
    const int tid = opaque_tid(), lane = tid & 63, wave = tid >> 6, quad = lane >> 4, l15 = lane & 15;
    const int T = s < 32 ? 256 : 1024, tok0 = s < 32 ? s * 256 : NPT + (s - 32) * 1024, nch = T / 64;
    LAS bf16_t* sQ = (LAS bf16_t*)lds;
    LAS bf16_t* sK = sQ + 64 * 136;
    LAS bf16_t* sKt = sK + 64 * 136;
    LAS bf16_t* sVt = sKt + 128 * 72;
    LAS bf16_t* sP = sVt + 128 * 72;
    LAS bf16_t* sC = sP + 64 * 72;
    LAS float* sf = (LAS float*)(sC + 128 * 136);
    LAS float *sA = sf, *sB = sf + 64, *sPm = sf + 128, *sN = sf + 192, *sNq = sf + 320, *sPs = sf + 384;
    const bf16_t* proj = (const bf16_t*)(p.ws + WS_PROJ);
    const float* gates = (const float*)(p.ws + WS_GATES);
    float* hd = (float*)(p.ws + WS_HD) + (size_t)d * NTOK * 512;
    const float bi = p.in[I_BI][l * 8 + d * 4 + h], bfb = p.in[I_BF][l * 8 + d * 4 + h];
    f32x4 cacc[8];
    float m;
    float cw0[8], cw1[8], cw2[8], cbb[8];
    { const int g = tid & 31, ch = ((g >> 4) ? 512 : 0) + h * 128 + (g & 15) * 8; const float* cw = p.in[I_CBW] + (size_t)l * 3 * 1024 + ch;
        ld8f(cw, cw0); ld8f(cw + 1024, cw1); ld8f(cw + 2048, cw2); ld8f(p.in[I_CBB] + l * 1024 + ch, cbb); }
    __syncthreads();
    if (s >= 32) {
        const size_t sb = (((size_t)((s - 32) * 2 + l) * 2 + d) * 4 + h);
        const float* C0 = p.in[I_SMC] + sb * 128 * 128;
#pragma unroll
        for (int tn = 0; tn < 8; ++tn)
#pragma unroll
            for (int j = 0; j < 4; ++j) cacc[tn][j] = C0[(16 * wave + quad * 4 + j) * 128 + 16 * tn + l15];
        if (tid < 128) sN[tid] = p.in[I_SMN][sb * 128 + tid];
        m = p.in[I_SMM][sb];
    } else {
#pragma unroll
        for (int tn = 0; tn < 8; ++tn) cacc[tn] = (f32x4){0.f, 0.f, 0.f, 0.f};
        if (tid < 128) sN[tid] = 0.f;
        m = 0.f;
    }
#pragma unroll
    for (int tn = 0; tn < 8; ++tn)
#pragma unroll
        for (int j = 0; j < 4; ++j) sC[(16 * wave + quad * 4 + j) * 136 + 16 * tn + l15] = f2bf(cacc[tn][j]);

    float gi_n = 0.f, gf_n = 0.f;
    if (wave == 0) { const int tk = d == 0 ? tok0 + lane : tok0 + T - 1 - lane; gi_n = gates[(size_t)tk * 16 + d * 4 + h]; gf_n = gates[(size_t)tk * 16 + 8 + d * 4 + h]; }
    for (int c = 0; c < nch; ++c) {
        __syncthreads();
        if (wave == 0) {
            const float gi = gi_n + bi, gf = gf_n + bfb;
            if (c + 1 < nch) { const int ii = 64 * (c + 1) + lane; const int tk = d == 0 ? tok0 + ii : tok0 + T - 1 - ii; gi_n = gates[(size_t)tk * 16 + d * 4 + h]; gf_n = gates[(size_t)tk * 16 + 8 + d * 4 + h]; }
            const float lf = fminf(gf, 0.f) - log1pf(__expf(-fabsf(gf)));
            float b = lf;
#pragma unroll
            for (int off = 1; off < 64; off <<= 1) { const float t = __shfl_up(b, off); if (lane >= off) b += t; }
            const float a = gi - b; float pm = a;
#pragma unroll
            for (int off = 1; off < 64; off <<= 1) { const float t = __shfl_up(pm, off); if (lane >= off) pm = fmaxf(pm, t); }
            sB[lane] = b; sA[lane] = a; sPm[lane] = pm;
        }
        __syncthreads();
        const float mx = fmaxf(m, sPm[63]), bL = sB[63];
#pragma unroll
        for (int it = 0; it < 4; ++it) {
            const int idx = tid + 512 * it, i = idx >> 5, g = idx & 31, isK = g >> 4, j0 = (g & 15) * 8, ch = (isK ? 512 : 0) + h * 128 + j0;
            const int ii = 64 * c + i, pos = d == 0 ? ii : T - 1 - ii, tk = tok0 + pos;
            const bf16_t* src = proj + (size_t)tk * NP + B_Q + ch;
            float x0[8], x1[8], x2[8], y[8];
            unpack8(*(const u32x4v*)src, x1);
            unpack8(*(const u32x4v*)(pos > 0 ? src - NP : src), x0); unpack8(*(const u32x4v*)(pos < T - 1 ? src + NP : src), x2);
            const float m0 = pos > 0 ? 1.f : 0.f, m2 = pos < T - 1 ? 1.f : 0.f;
#pragma unroll
            for (int e = 0; e < 8; ++e) y[e] = siluf_(m0 * x0[e] * cw0[e] + x1[e] * cw1[e] + m2 * x2[e] * cw2[e] + cbb[e]);
            if (!isK) { *(LAS u32x4v*)(sQ + i * 136 + j0) = pack8(y); }
            else {
                const float wgi = __expf(sA[i] - mx);
#pragma unroll
                for (int e = 0; e < 8; ++e) y[e] *= 0.08838834764831845f;
                *(LAS u32x4v*)(sK + i * 136 + j0) = pack8(y);
#pragma unroll
                for (int e = 0; e < 8; ++e) sKt[(j0 + e) * 72 + (i ^ (8 * ((j0 >> 3) & 7)))] = f2bf(y[e] * wgi);
            }
        }
#pragma unroll
        for (int it = 0; it < 2; ++it) {
            const int idx = tid + 512 * it, i = idx >> 4, g = idx & 15;
            const int ii = 64 * c + i, tk = d == 0 ? tok0 + ii : tok0 + T - 1 - ii;
            const u32x4v w = *(const u32x4v*)(proj + (size_t)tk * NP + B_V + h * 128 + 8 * g);
            LAS bf16_t* dst = sVt + (8 * g) * 72 + (i ^ (8 * (g & 7)));
            dst[0] = (bf16_t)(w.x & 0xffff); dst[72] = (bf16_t)(w.x >> 16); dst[144] = (bf16_t)(w.y & 0xffff); dst[216] = (bf16_t)(w.y >> 16);
            dst[288] = (bf16_t)(w.z & 0xffff); dst[360] = (bf16_t)(w.z >> 16); dst[432] = (bf16_t)(w.w & 0xffff); dst[504] = (bf16_t)(w.w >> 16);
        }
        __syncthreads();
        const int tm = wave >> 1;
        {
            const int tn0 = (wave & 1) * 2;
#pragma unroll
            for (int tt = 0; tt < 2; ++tt) {
                f32x4 acc = {0.f, 0.f, 0.f, 0.f};
#pragma unroll
                for (int ks = 0; ks < 4; ++ks) acc = MFMA16(frag(sQ, 16 * tm, 136, 32 * ks, lane), frag(sK, 16 * (tn0 + tt), 136, 32 * ks, lane), acc);
                const int scol = 16 * (tn0 + tt) + l15; const float as = sA[scol];
#pragma unroll
                for (int j = 0; j < 4; ++j) { const int t = 16 * tm + quad * 4 + j;
                    float pv = scol <= t ? __expf(as - fmaxf(m, sPm[t])) * acc[j] : 0.f;
                    sP[t * 72 + scol] = f2bf(pv);
                    pv = red16_sum(pv);
                    if (l15 == 0) sPs[t * 4 + tn0 + tt] = pv; }
            }
        }
        const int tnb = (wave & 1) * 4;
        f32x4 accq[4];
#pragma unroll
        for (int tt = 0; tt < 4; ++tt) { accq[tt] = (f32x4){0.f, 0.f, 0.f, 0.f};
#pragma unroll
            for (int ks = 0; ks < 4; ++ks) accq[tt] = MFMA16(frag(sQ, 16 * tm, 136, 32 * ks, lane), frag(sC, 16 * (tnb + tt), 136, 32 * ks, lane), accq[tt]); }
        { const int t = tid >> 3, part = tid & 7; float sacc = 0.f;
#pragma unroll
            for (int e = 0; e < 16; ++e) sacc += sN[16 * part + e] * bf2f(sQ[t * 136 + 16 * part + e]);
            sacc += __shfl_xor(sacc, 1); sacc += __shfl_xor(sacc, 2); sacc += __shfl_xor(sacc, 4);
            if (part == 0) sNq[t] = sacc; }
        __syncthreads();
        {
            f32x4 accp[4];
#pragma unroll
            for (int tt = 0; tt < 4; ++tt) { accp[tt] = (f32x4){0.f, 0.f, 0.f, 0.f};
#pragma unroll
                for (int ks = 0; ks < 2; ++ks) accp[tt] = MFMA16(frag(sP, 16 * tm, 72, 32 * ks, lane), fragsw(sVt, 16 * (tnb + tt), 32 * ks, lane), accp[tt]); }
#pragma unroll
            for (int j = 0; j < 4; ++j) { const int t = 16 * tm + quad * 4 + j;
                const float mtm = fmaxf(m, sPm[t]), wi = __expf(m - mtm);
                const float den = wi * sNq[t] + ((sPs[t * 4] + sPs[t * 4 + 1]) + (sPs[t * 4 + 2] + sPs[t * 4 + 3]));
                const float mt = sB[t] + mtm; const float inv = 1.0f / fmaxf(fabsf(den), __expf(-mt));
                const int ii = 64 * c + t, tk = d == 0 ? tok0 + ii : tok0 + T - 1 - ii;
                float* dst = hd + (size_t)tk * 512 + h * 128 + 16 * tnb + l15;
#pragma unroll
                for (int tt = 0; tt < 4; ++tt) dst[16 * tt] = (wi * accq[tt][j] + accp[tt][j]) * inv; }
        }
        const float sc = __expf(m - mx);
        if (tid < 128) { float ns = 0.f;
#pragma unroll 8
            for (int e = 0; e < 64; ++e) ns += bf2f(sKt[tid * 72 + e]);
            sN[tid] = sc * sN[tid] + ns; }
#pragma unroll
        for (int tn = 0; tn < 8; ++tn) { f32x4 dc = {0.f, 0.f, 0.f, 0.f};
#pragma unroll
            for (int ks = 0; ks < 2; ++ks) dc = MFMA16(fragsw(sVt, 16 * wave, 32 * ks, lane), fragsw(sKt, 16 * tn, 32 * ks, lane), dc);
            cacc[tn] = sc * cacc[tn] + dc;
#pragma unroll
            for (int j = 0; j < 4; ++j) sC[(16 * wave + quad * 4 + j) * 136 + 16 * tn + l15] = f2bf(cacc[tn][j]); }
        m = bL + mx;
    }
    __syncthreads();
    if (s < 32) {
        const size_t sb = (((size_t)(s * 2 + l) * 2 + d) * 4 + h);
        float* Co = p.out + O_MC + sb * 128 * 128;
#pragma unroll
        for (int tn = 0; tn < 8; ++tn)
#pragma unroll
            for (int j = 0; j < 4; ++j) Co[(16 * wave + quad * 4 + j) * 128 + 16 * tn + l15] = cacc[tn][j];
        if (tid < 128) p.out[O_MN + sb * 128 + tid] = sN[tid];
        if (tid == 0) p.out[O_MM + sb] = m;
    }
}

__device__ __forceinline__ void attn_task(const Params& p, int l, int task, LAS unsigned char* lds) {
    const int tid = opaque_tid(), lane = tid & 63, wave = tid >> 6, quad = lane >> 4, l15 = lane & 15;
    const bool samp = task < 128;
    int b, h, qb;
    if (samp) { b = task >> 6; h = (task >> 3) & 7; qb = task & 7; } else { const int t2 = task - 128; b = t2 >> 4; h = (t2 >> 1) & 7; qb = t2 & 1; }
    const int tok0 = samp ? NPT + b * 1024 : b * 256, nkt = samp ? 24 : 4, nct = samp ? 8 : 0;
    LAS bf16_t* sK = (LAS bf16_t*)lds;
    LAS bf16_t* sVt = sK + 64 * 136;
    LAS bf16_t* sPw = sVt + 128 * 72 + wave * (16 * 72);
    const bf16_t* proj = (const bf16_t*)(p.ws + WS_PROJ);
    const bf16_t* ck = (const bf16_t*)(p.ws + WS_KC) + (((unsigned)(b * 2 + l) * 8 + h) * 512) * 128;
    const bf16_t* cv = (const bf16_t*)(p.ws + WS_VTC) + (((unsigned)(b * 2 + l) * 8 + h) * 128) * 512;
    const float lam = ((const float*)(p.ws + WS_LAM))[l];
    const float lam_init = 0.8f - 0.6f * expf(-0.3f * (float)l);
    const int q0 = 128 * qb + 16 * wave;
    bf16x8 aq1[2], aq2[2];
    { const bf16_t* qp = proj + (unsigned)(tok0 + q0 + l15) * NP + C_Q + h * 128 + quad * 8;
        aq1[0] = *(const bf16x8*)qp; aq1[1] = *(const bf16x8*)(qp + 32); aq2[0] = *(const bf16x8*)(qp + 64); aq2[1] = *(const bf16x8*)(qp + 96); }
    float mx1 = -INFINITY, mx2 = -INFINITY, sm1 = 0.f, sm2 = 0.f, mc1 = 0.f, mc2 = 0.f;
    constexpr float CS = 0.125f * 1.4426950408889634f;
    f32x4 o1[8], o2[8];
#pragma unroll
    for (int tn = 0; tn < 8; ++tn) { o1[tn] = (f32x4){0.f, 0.f, 0.f, 0.f}; o2[tn] = o1[tn]; }
    u32x4v kreg[2], vreg[2];
#define ATT_LOAD(KT, PASS) do { int ktv = (KT); asm volatile("" : "+v"(ktv));     \
    _Pragma("unroll") for (int it = 0; it < 2; ++it) { const int idx = tid + 512 * it, i = idx >> 4, g = idx & 15; \
        if ((KT) < nct) { kreg[it] = *(const u32x4v*)(ck + (unsigned)((64 * ktv + i) * 128 + 8 * g)); \
            if ((PASS) == 1) { const int dv = idx >> 3, mm = idx & 7; vreg[it] = *(const u32x4v*)(cv + (unsigned)(dv * 512 + 64 * ktv + 8 * mm)); } } \
        else { kreg[it] = *(const u32x4v*)(proj + (unsigned)((tok0 + 64 * (ktv - nct) + i) * NP + C_K + h * 128 + 8 * g)); \
            if ((PASS) == 1) vreg[it] = *(const u32x4v*)(proj + (unsigned)((tok0 + 64 * (ktv - nct) + (idx & 63)) * NP + C_V + h * 128 + 8 * (idx >> 6))); } } } while (0)
    for (int pass = 0; pass < 2; ++pass) {
        ATT_LOAD(0, pass);
        for (int kt = 0; kt < nkt; ++kt) {
            __syncthreads();
#pragma unroll
            for (int it = 0; it < 2; ++it) {
                const int idx = tid + 512 * it, i = idx >> 4, g = idx & 15;
                *(LAS u32x4v*)(sK + i * 136 + 8 * g) = kreg[it];
                if (pass == 1) {
                    if (kt < nct) { const int dv = idx >> 3, mm = idx & 7; *(LAS u32x4v*)(sVt + dv * 72 + 8 * mm) = vreg[it]; }
                    else { const u32x4v w = vreg[it]; LAS bf16_t* dst = sVt + (8 * (idx >> 6)) * 72 + (idx & 63);
                        dst[0] = (bf16_t)(w.x & 0xffff); dst[72] = (bf16_t)(w.x >> 16); dst[144] = (bf16_t)(w.y & 0xffff); dst[216] = (bf16_t)(w.y >> 16);
                        dst[288] = (bf16_t)(w.z & 0xffff); dst[360] = (bf16_t)(w.z >> 16); dst[432] = (bf16_t)(w.w & 0xffff); dst[504] = (bf16_t)(w.w >> 16); }
                }
            }
            if (kt + 1 < nkt) ATT_LOAD(kt + 1, pass);
            __syncthreads();
#pragma unroll
            for (int bb = 0; bb < 2; ++bb) {
                f32x4 s1[2], s2[2];
#pragma unroll
                for (int t = 0; t < 2; ++t) { s1[t] = (f32x4){0.f, 0.f, 0.f, 0.f}; s2[t] = s1[t];
#pragma unroll
                    for (int ks = 0; ks < 2; ++ks) { s1[t] = MFMA16(frag(sK, 32 * bb + 16 * t, 136, 32 * ks, lane), aq1[ks], s1[t]); s2[t] = MFMA16(frag(sK, 32 * bb + 16 * t, 136, 64 + 32 * ks, lane), aq2[ks], s2[t]); } }
                if (pass == 0) {
#pragma unroll
                    for (int t = 0; t < 2; ++t)
#pragma unroll
                        for (int j = 0; j < 4; ++j) { mx1 = fmaxf(mx1, s1[t][j]); mx2 = fmaxf(mx2, s2[t][j]); }
                } else {
                    bf16x8 pa1, pa2;
                    { float p1[8];
#pragma unroll
                        for (int jj = 0; jj < 8; ++jj) { p1[jj] = __builtin_amdgcn_exp2f(s1[jj >> 2][jj & 3] * CS - mc1); sm1 += p1[jj]; }
                        pa1 = __builtin_bit_cast(bf16x8, pack8(p1)); }
                    { float p2[8];
#pragma unroll
                        for (int jj = 0; jj < 8; ++jj) { p2[jj] = __builtin_amdgcn_exp2f(s2[jj >> 2][jj & 3] * CS - mc2); sm2 += p2[jj]; }
                        pa2 = __builtin_bit_cast(bf16x8, pack8(p2)); }
#pragma unroll
                    for (int tn2 = 0; tn2 < 8; ++tn2) { const LAS bf16_t* vrow = sVt + (16 * tn2 + l15) * 72 + 32 * bb + quad * 4;
                        const u32x2v lo = *(const LAS u32x2v*)vrow, hi = *(const LAS u32x2v*)(vrow + 16);
                        u32x4v vw; vw.x = lo.x; vw.y = lo.y; vw.z = hi.x; vw.w = hi.y;
                        const bf16x8 vb = __builtin_bit_cast(bf16x8, vw);
                        o1[tn2] = MFMA16(pa1, vb, o1[tn2]); o2[tn2] = MFMA16(pa2, vb, o2[tn2]); }
                }
                asm volatile("" ::: "memory");
            }
        }
        if (pass == 0) { mx1 = fmaxf(mx1, __shfl_xor(mx1, 16)); mx1 = fmaxf(mx1, __shfl_xor(mx1, 32)); mx2 = fmaxf(mx2, __shfl_xor(mx2, 16)); mx2 = fmaxf(mx2, __shfl_xor(mx2, 32)); mc1 = mx1 * CS; mc2 = mx2 * CS; }
    }
    sm1 += __shfl_xor(sm1, 16); sm1 += __shfl_xor(sm1, 32); sm2 += __shfl_xor(sm2, 16); sm2 += __shfl_xor(sm2, 32);
    const float il1 = 1.0f / sm1, il2 = lam / sm2;
    float f1[4], f2[4];
#pragma unroll
    for (int j = 0; j < 4; ++j) { f1[j] = __shfl(il1, quad * 4 + j); f2[j] = __shfl(il2, quad * 4 + j); }
#pragma unroll
    for (int tn = 0; tn < 8; ++tn)
#pragma unroll
        for (int j = 0; j < 4; ++j) o1[tn][j] = o1[tn][j] * f1[j] - o2[tn][j] * f2[j];
    asm volatile("" ::: "memory");
#define oacc o1
#undef ATT_LOAD
    bf16_t* mixed = (bf16_t*)(p.ws + WS_UM);
    const float* sg = p.in[I_SUBG] + l * 128;
#pragma unroll
    for (int j = 0; j < 4; ++j) {
        float ss = 0.f;
#pragma unroll
        for (int tn = 0; tn < 8; ++tn) ss += oacc[tn][j] * oacc[tn][j];
        ss = red16_sum(ss);
        const float r = rsqrtf(ss * (1.0f / 128.0f) + 1e-5f) * (1.0f - lam_init);
        const int tq = tok0 + q0 + quad * 4 + j;
#pragma unroll
        for (int tn = 0; tn < 8; ++tn) { const int dv = 16 * tn + l15;
            const float gt = bf2f(proj[(unsigned)tq * NP + C_G + h * 128 + dv]);
            mixed[(unsigned)tq * DM + 1024 + h * 128 + dv] = f2bf(oacc[tn][j] * r * sg[dv] * siluf_(gt)); }
    }
}

#undef oacc
__device__ __forceinline__ void rwkv_prep_task(const Params& p, int l, int task, LAS unsigned char* lds) {
    const int tid = opaque_tid(), lane = tid & 63, wave = tid >> 6, quad = lane >> 4, l15 = lane & 15;
    const int tile = task >> 3, h = task & 7, tb = 64 * tile;
    const int T = tb < NPT ? 256 : 1024, seq0 = tb < NPT ? (tb & ~255) : NPT + ((tb - NPT) & ~1023);
    LAS bf16_t* sTW = (LAS bf16_t*)lds;
    LAS bf16_t* sAD = sTW + 2 * 64 * 72;
    LAS bf16_t* sWup = sAD + 2 * 64 * 72;
    LAS bf16_t* sAup = sWup + 2 * 64 * 72;
    LAS float* sR = (LAS float*)(sAup + 2 * 64 * 72);
    LAS float* sKf = sR + 4096; LAS float* sVf = sKf + 4096; LAS float* sNrm = sVf + 4096; LAS float* sRK = sNrm + 64;
    const bf16_t* proj = (const bf16_t*)(p.ws + WS_PROJ);
    __syncthreads();
#pragma unroll
    for (int it = 0; it < 4; ++it) {
        const int idx = tid + 512 * it, arr = idx >> 9, i = (idx >> 3) & 63, g = idx & 7;
        const u32x4v w = *(const u32x4v*)(proj + (size_t)(tb + i) * NP + A_WD + 64 * arr + 8 * g);
        if (arr < 2) { float x[8]; unpack8(w, x);
#pragma unroll
            for (int e = 0; e < 8; ++e) x[e] = tanhf_(x[e]);
            *(LAS u32x4v*)(sTW + (arr * 64 + i) * 72 + 8 * g) = pack8(x); }
        else *(LAS u32x4v*)(sAD + ((arr - 2) * 64 + i) * 72 + 8 * g) = w;
    }
#pragma unroll
    for (int it = 0; it < 4; ++it) {
        const int dd2 = it >> 1, which = it & 1, c = tid >> 3, jg = tid & 7;
        const bf16_t* src = (const bf16_t*)(p.ws + WS_WUPT) + ((((size_t)(l * 2 + dd2) * 2 + which) * 8 + h) * 4096) + c * 64 + 8 * jg;
        *(LAS u32x4v*)((which ? sAup : sWup) + (dd2 * 64 + c) * 72 + 8 * jg) = *(const u32x4v*)src;
    }
#pragma unroll
    for (int it = 0; it < 3; ++it) {
        const int idx = tid + 512 * it, which = idx >> 9, i = (idx >> 3) & 63, g = idx & 7, ch = which * 512 + h * 64 + 8 * g;
        const int tk = tb + i, pos = tk - seq0;
        const bf16_t* src = proj + (size_t)tk * NP + ch;
        float x0[8], x1[8], x2[8], w0[8], w1[8], w2[8], bb[8];
        unpack8(*(const u32x4v*)src, x1);
        unpack8(*(const u32x4v*)(pos > 0 ? src - NP : src), x0); unpack8(*(const u32x4v*)(pos < T - 1 ? src + NP : src), x2);
        const float m0 = pos > 0 ? 1.f : 0.f, m2 = pos < T - 1 ? 1.f : 0.f;
        const float* cw = p.in[I_CAW] + (size_t)l * 3 * 1536 + ch;
        ld8f(cw, w0); ld8f(cw + 1536, w1); ld8f(cw + 3072, w2); ld8f(p.in[I_CAB] + l * 1536 + ch, bb);
        LAS float* dst = (which == 0 ? sR : (which == 1 ? sKf : sVf)) + i * 64 + 8 * g;
#pragma unroll
        for (int e = 0; e < 8; ++e) dst[e] = m0 * x0[e] * w0[e] + x1[e] * w1[e] + m2 * x2[e] * w2[e] + bb[e];
    }
    __syncthreads();
    { const int t = tid >> 3, part = tid & 7; float ss = 0.f;
#pragma unroll
        for (int e = 0; e < 8; ++e) { const float v = sKf[t * 64 + 8 * part + e] * p.in[I_KK][l * 512 + h * 64 + 8 * part + e]; ss += v * v; }
        ss += __shfl_xor(ss, 1); ss += __shfl_xor(ss, 2); ss += __shfl_xor(ss, 4);
        if (part == 0) sNrm[t] = rsqrtf(ss + 1e-12f); }
    const int dd = wave >> 2, tm = wave & 3;
    f32x4 aw[4], aa[4];
#pragma unroll
    for (int tn = 0; tn < 4; ++tn) { aw[tn] = (f32x4){0.f, 0.f, 0.f, 0.f}; aa[tn] = aw[tn];
#pragma unroll
        for (int ks = 0; ks < 2; ++ks) { aw[tn] = MFMA16(frag(sTW + dd * 64 * 72, 16 * tm, 72, 32 * ks, lane), frag(sWup + dd * 64 * 72, 16 * tn, 72, 32 * ks, lane), aw[tn]);
            aa[tn] = MFMA16(frag(sAD + dd * 64 * 72, 16 * tm, 72, 32 * ks, lane), frag(sAup + dd * 64 * 72, 16 * tn, 72, 32 * ks, lane), aa[tn]); } }
    __syncthreads();
    {
        LAS bf16_t* so = sTW + dd * (3 * 4096);
        float rk[4] = {0.f, 0.f, 0.f, 0.f};
#pragma unroll
        for (int tn = 0; tn < 4; ++tn) { const int c = 16 * tn + l15, ch = h * 64 + c;
            const float w0v = p.in[I_W0][(l * 2 + dd) * 512 + ch], a0v = p.in[I_A0][(l * 2 + dd) * 512 + ch], kav = p.in[I_KA][l * 512 + ch], kkv = p.in[I_KK][l * 512 + ch], rkv = p.in[I_RK][l * 512 + ch];
#pragma unroll
            for (int j = 0; j < 4; ++j) { const int t = 16 * tm + quad * 4 + j; const int o = t * 64 + c;
                const float z = w0v + aw[tn][j]; const float dec = __expf(-0.6065306597126334f * sigmoidf_(z));
                const float av = sigmoidf_(a0v + aa[tn][j]); const float kv = sKf[t * 64 + c];
                const float ktv = kv * (1.0f + (av - 1.0f) * kav); const float kk = kv * kkv * sNrm[t];
                so[o] = f2bf(ktv); so[4096 + o] = f2bf(kk * av); so[8192 + o] = f2bf(dec - 1.0f);
                rk[j] += sR[t * 64 + c] * ktv * rkv; } }
#pragma unroll
        for (int j = 0; j < 4; ++j) { const float s = red16_sum(rk[j]); if (l15 == 0) sRK[dd * 64 + 16 * tm + quad * 4 + j] = s; }
    }
    __syncthreads();
    { const int i = tid >> 3, g = tid & 7; const size_t o = (size_t)(tb + i) * 512 + h * 64 + 8 * g;
        float r[8], k[8], v[8], bn[8]; const float nr = sNrm[i], rks = sRK[i] + sRK[64 + i];
#pragma unroll
        for (int e = 0; e < 8; ++e) { r[e] = sR[i * 64 + 8 * g + e]; k[e] = sKf[i * 64 + 8 * g + e] * p.in[I_KK][l * 512 + h * 64 + 8 * g + e] * nr; v[e] = sVf[i * 64 + 8 * g + e]; bn[e] = rks * v[e]; }
        const size_t o2 = ((size_t)(tb + i) * 8 + h) * 320 + 8 * g; bf16_t* pk = (bf16_t*)(p.ws + WS_PK);
#pragma unroll
        for (int dd2 = 0; dd2 < 2; ++dd2)
#pragma unroll
            for (int ar = 0; ar < 3; ++ar) *(u32x4v*)(pk + (size_t)dd2 * NTOK * 2560 + o2 + 128 + 64 * ar) = *(const LAS u32x4v*)(sTW + dd2 * (3 * 4096) + ar * 4096 + i * 64 + 8 * g);
        const u32x4v rr = pack8(r), kk8 = pack8(k);
        *(u32x4v*)(pk + o2) = rr; *(u32x4v*)(pk + o2 + 64) = kk8; *(u32x4v*)(pk + (size_t)NTOK * 2560 + o2) = rr; *(u32x4v*)(pk + (size_t)NTOK * 2560 + o2 + 64) = kk8;
        *(u32x4v*)((bf16_t*)(p.ws + WS_SCV) + o) = pack8(v); *(u32x4v*)((bf16_t*)(p.ws + WS_SCBON) + o) = pack8(bn); }
}

__device__ __forceinline__ void m1_phase(const Params& p, int l, LAS unsigned char* lds, int rep, int mask) {
    unsigned* ctr = (unsigned*)(p.ws + WS_CTL) + 64 * (1 + 4 * l + 8 * rep);
    LAS int* slot = (LAS int*)(lds + LDS_SLOT);
#ifndef NO_MLSTM
    if (mask & 1) for (;;) { const int t = next_task(ctr, slot); if (t >= 272) break; const int u = t < 16 ? t + 256 : t - 16; mlstm_task(p, l, u >> 3, (u >> 2) & 1, u & 3, lds); }
#endif
#ifndef NO_ATTN
    if (mask & 2) for (;;) { const int t = next_task(ctr + 64, slot); if (t >= 640) break; attn_task(p, l, t, lds); }
#endif
#ifndef NO_PREP
    if (mask & 4) for (;;) { const int t = next_task(ctr + 128, slot); if (t >= 1280) break; rwkv_prep_task(p, l, t, lds); }
#endif
}

#ifdef EXP_LITE
#if EXP_LITE == 1
#define EXPY(v) (bf2f(sBt[(quad * 4 + j) * 24 + l15]) + bf2f(sGt[(16 + quad * 4 + j) * 24 + l15]) + sW[l15 + 16 * quad])
#elif EXP_LITE == 2
#define EXPY(v) (bf2f(sAt[(quad * 4 + j) * 72 + l15]) + bf2f(sX2[(quad * 4 + j) * 24 + l15]))
#else
#define EXPY(v) (bf2f(sPy[(quad * 4 + j) * 72 + 16 + l15]) + bf2f(sQy[(quad * 4 + j) * 24 + l15]))
#endif
#define EXPS(v) 0.f
#else
#define EXPY(v) (v)
#define EXPS(v) (v)
#endif
__device__ __forceinline__ bf16_t f2bf_sw(float f) { unsigned u = __float_as_uint(f); u += 0x7FFFu + ((u >> 16) & 1u); return (bf16_t)(u >> 16); }
__device__ __forceinline__ bf16x8 frag16(const LAS bf16_t* base, int row0, int ld, int lane) {
    bf16x8 z = {0, 0, 0, 0, 0, 0, 0, 0};
    if ((lane >> 4) < 2) z = *(const LAS bf16x8*)(base + (row0 + (lane & 15)) * ld + (lane >> 4) * 8);
    return z;
}
__device__ __forceinline__ void cp_task(const Params& p, int task, int lane, LAS unsigned char* wl) {
    int s, d, h, c, T;
    if (task < 8192) { s = task >> 8; d = (task >> 7) & 1; h = (task >> 4) & 7; c = task & 15; T = 256; }
    else { const int u = task - 8192; s = 32 + (u >> 10); d = (u >> 9) & 1; h = (u >> 6) & 7; c = u & 63; T = 1024; }
    const int tok0 = s < 32 ? s * 256 : NPT + (s - 32) * 1024, quad = lane >> 4, l15 = lane & 15;
    const long step = d == 0 ? 1 : -1; const int tfirst = d == 0 ? tok0 + 16 * c : tok0 + T - 1 - 16 * c;
    bf16_t* pk = (bf16_t*)(p.ws + WS_PK) + (size_t)d * NTOK * 2560 + ((size_t)tfirst * 8 + h) * 320;
    LAS bf16_t* sA = (LAS bf16_t*)wl;
    LAS bf16_t* sB = sA + 16 * 72, *sG = sB + 16 * 72, *sR = sG + 16 * 72;
    LAS float* mL1 = (LAS float*)(sR + 16 * 72);
    LAS bf16_t* sL2 = (LAS bf16_t*)(mL1 + 16 * 17);
    LAS bf16_t* sM1t = sL2 + 16 * 24;
    LAS bf16_t* sTt = sM1t + 16 * 24;
    LAS bf16_t* sAtil = sTt + 16 * 24;
    LAS bf16_t* sX2 = sTt;
    LAS bf16_t* oAt = sB;
    LAS bf16_t* oPy = sG;
    LAS bf16_t* oX2 = (LAS bf16_t*)mL1;
    LAS bf16_t* oQy = sL2;
    float bt[16], gt[16], W = 1.0f;
    { const int k = lane;
        float rr[16], kk[16], kt[16], ka[16], wm[16];
#pragma unroll
        for (int i = 0; i < 16; ++i) { const bf16_t* rec = pk + step * 2560 * i + k; rr[i] = bf2f(rec[0]); kk[i] = bf2f(rec[64]); kt[i] = bf2f(rec[128]); ka[i] = bf2f(rec[192]); wm[i] = bf2f(rec[256]); }
#pragma unroll
        for (int i = 0; i < 16; ++i) { const float Wp = W; W = W + W * wm[i]; const float iw = __builtin_amdgcn_rcpf(W);
            sA[i * 72 + k] = f2bf(Wp * kk[i]); bt[i] = ka[i] * iw; gt[i] = kt[i] * iw; sB[i * 72 + k] = f2bf(bt[i]); sG[i * 72 + k] = f2bf(gt[i]); sR[i * 72 + k] = f2bf(W * rr[i]); } }
    LDS_FENCE();
    f32x4 m2acc;
    { f32x4 a1 = {0.f, 0.f, 0.f, 0.f}, a2 = a1, a3 = a1, a4 = a1;
#pragma unroll
        for (int ks = 0; ks < 2; ++ks) { const bf16x8 fb = frag(sB, 0, 72, 32 * ks, lane), fg = frag(sG, 0, 72, 32 * ks, lane), fa = frag(sA, 0, 72, 32 * ks, lane), fr = frag(sR, 0, 72, 32 * ks, lane);
            a1 = MFMA16(fb, fa, a1); a2 = MFMA16(fg, fa, a2); a3 = MFMA16(fb, fr, a3); a4 = MFMA16(fg, fr, a4); }
#pragma unroll
        for (int j = 0; j < 4; ++j) { const int i = quad * 4 + j, t = l15;
            mL1[i * 17 + t] = i < t ? a1[j] : 0.f; sL2[i * 24 + t] = f2bf(i < t ? a2[j] : 0.f); sM1t[t * 24 + i] = f2bf(i <= t ? a3[j] : 0.f); m2acc[j] = i <= t ? a4[j] : 0.f; } }
    LDS_FENCE();
    { float Tr[16];
#pragma unroll
        for (int t = 0; t < 16; ++t) { float acc = (l15 == t) ? 1.0f : 0.0f;
#pragma unroll
            for (int i = 0; i < t; ++i) acc -= Tr[i] * mL1[i * 17 + t];
            Tr[t] = acc; }
        if (quad == 0) {
#pragma unroll
            for (int t = 0; t < 16; ++t) sTt[t * 24 + l15] = f2bf(Tr[t]); } }
    LDS_FENCE();
    const bf16x8 ftt = frag16(sTt, 0, 24, lane);
#pragma unroll
    for (int kt2 = 0; kt2 < 4; ++kt2) {
        u32x4v aw = {0u, 0u, 0u, 0u};
        if (quad < 2) { const LAS bf16_t* col = sA + (quad * 8) * 72 + 16 * kt2 + l15;
            aw.x = (unsigned)col[0] | ((unsigned)col[72] << 16); aw.y = (unsigned)col[144] | ((unsigned)col[216] << 16); aw.z = (unsigned)col[288] | ((unsigned)col[360] << 16); aw.w = (unsigned)col[432] | ((unsigned)col[504] << 16); }
        f32x4 acc = {0.f, 0.f, 0.f, 0.f};
        acc = MFMA16(__builtin_bit_cast(bf16x8, aw), ftt, acc);
#pragma unroll
        for (int j = 0; j < 4; ++j) { const int k = 16 * kt2 + quad * 4 + j; const bf16_t v = f2bf_sw(acc[j]); sAtil[k * 24 + l15] = v; oAt[l15 * 72 + k] = v; }
    }
    { f32x4 acc = {0.f, 0.f, 0.f, 0.f};
        acc = MFMA16(frag16(sL2, 0, 24, lane), ftt, acc);
#pragma unroll
        for (int j = 0; j < 4; ++j) { const bf16_t v = f2bf_sw(acc[j]); sX2[(quad * 4 + j) * 24 + l15] = v; oX2[l15 * 24 + quad * 4 + j] = v; } }
    LDS_FENCE();
    const bf16x8 fm1 = frag16(sM1t, 0, 24, lane);
#pragma unroll
    for (int kt2 = 0; kt2 < 4; ++kt2) { f32x4 acc = {0.f, 0.f, 0.f, 0.f};
        acc = MFMA16(frag16(sAtil, 16 * kt2, 24, lane), fm1, acc);
#pragma unroll
        for (int j = 0; j < 4; ++j) { const int k = 16 * kt2 + quad * 4 + j; oPy[l15 * 72 + k] = f2bf(bf2f(sR[l15 * 72 + k]) - acc[j]); } }
    { f32x4 acc = {0.f, 0.f, 0.f, 0.f};
        acc = MFMA16(frag16(sX2, 0, 24, lane), fm1, acc);
#pragma unroll
        for (int j = 0; j < 4; ++j) oQy[l15 * 24 + quad * 4 + j] = f2bf(m2acc[j] - acc[j]); }
    LDS_FENCE();
    { float bb8[8]; const int k = lane; bf16_t* rec = pk + step * 2560 * (k >> 2);
#pragma unroll
        for (int hh = 0; hh < 2; ++hh) {
#pragma unroll
            for (int e = 0; e < 8; ++e) bb8[e] = bt[8 * hh + e];
            *(u32x4v*)(rec + 128 + (k & 3) * 16 + 8 * hh) = pack8(bb8);
#pragma unroll
            for (int e = 0; e < 8; ++e) bb8[e] = gt[8 * hh + e];
            *(u32x4v*)(rec + 192 + (k & 3) * 16 + 8 * hh) = pack8(bb8); }
        ((float*)(rec + 288))[k & 3] = W; }
#pragma unroll
    for (int it = 0; it < 2; ++it) { const int f = lane + 64 * it, t = f >> 3, q = f & 7; bf16_t* rec = pk + step * 2560 * t;
        *(u32x4v*)(rec + 8 * q) = *(const LAS u32x4v*)(oAt + t * 72 + 8 * q); *(u32x4v*)(rec + 64 + 8 * q) = *(const LAS u32x4v*)(oPy + t * 72 + 8 * q); }
    if (lane < 32) { const int t = lane >> 1, q = lane & 1; bf16_t* rec = pk + step * 2560 * t;
        *(u32x4v*)(rec + 256 + 8 * q) = *(const LAS u32x4v*)(oX2 + t * 24 + 8 * q); *(u32x4v*)(rec + 272 + 8 * q) = *(const LAS u32x4v*)(oQy + t * 24 + 8 * q); }
    LDS_FENCE();
}
constexpr int CP_LDS = 16 * 72 * 2 * 4 + 16 * 17 * 4 + (16 * 24 * 3 + 64 * 24 + 16 * 24) * 2 + 16 * 72 * 2 * 2 + 16 * 24 * 2 * 2;

__device__ __forceinline__ void ap_task(const Params& p, int l, int task, int lane, LAS unsigned char* wl) {
    int s, d, h, rt;
    if (task < 128) { s = 32 + (task >> 6); d = (task >> 5) & 1; h = (task >> 2) & 7; rt = task & 3; }
    else { const int u = task - 128; s = u >> 6; d = (u >> 5) & 1; h = (u >> 2) & 7; rt = u & 3; }
    const int T = s < 32 ? 256 : 1024, nch = T / 16, tok0 = s < 32 ? s * 256 : NPT + (s - 32) * 1024, quad = lane >> 4, l15 = lane & 15;
    const long step = d == 0 ? 1 : -1; const int tstart = d == 0 ? tok0 : tok0 + T - 1;
    const bf16_t* pk = (const bf16_t*)(p.ws + WS_PK) + (size_t)d * NTOK * 2560 + ((size_t)tstart * 8 + h) * 320;
    const bf16_t* pv = (const bf16_t*)(p.ws + WS_SCV) + (size_t)tstart * 512 + h * 64 + 16 * rt;
    float* yd = (float*)(p.ws + WS_YD) + (size_t)d * NTOK * 512 + (size_t)tstart * 512 + h * 64 + 16 * rt;
    constexpr int IS = 328;
    LAS bf16_t* img = (LAS bf16_t*)wl;
    LAS bf16_t* sS = img + 16 * IS;
    LAS bf16_t* sCm = sS + 16 * 72;
    f32x4 S[4];
    if (s >= 32) { const float* s0 = p.in[I_SRW] + ((((size_t)((s - 32) * 2 + l) * 2 + d) * 8 + h) * 64 + 16 * rt) * 64;
#pragma unroll
        for (int tn = 0; tn < 4; ++tn)
#pragma unroll
            for (int j = 0; j < 4; ++j) S[tn][j] = s0[(quad * 4 + j) * 64 + 16 * tn + l15]; }
    else {
#pragma unroll
        for (int tn = 0; tn < 4; ++tn) S[tn] = (f32x4){0.f, 0.f, 0.f, 0.f}; }
    const bf16_t* gsrc = pk + step * 2560 * (lane >> 2) + 8 * (lane & 3);
    LAS bf16_t* ldst = img + (lane >> 2) * IS + 8 * (lane & 3);
    u32x4v rawA[10], rawB[10]; bf16_t vrA[8], vrB[8];
#define AP_LOAD(raw, vraw, CH) do { int chv = (CH); asm volatile("" : "+v"(chv)); const bf16_t* cb = gsrc + step * 2560 * (16 * chv); \
        _Pragma("unroll") for (int jj = 0; jj < 10; ++jj) raw[jj] = *(const u32x4v*)(cb + 32 * jj); \
        if (quad < 2) { _Pragma("unroll") for (int e = 0; e < 8; ++e) vraw[e] = pv[step * 512 * (16 * chv + quad * 8 + e) + l15]; } } while (0)
#define AP_STAGE(raw) do { _Pragma("unroll") for (int jj = 0; jj < 10; ++jj) *(LAS u32x4v*)(ldst + 32 * jj) = raw[jj]; } while (0)
    AP_LOAD(rawA, vrA, 0);
    if (nch > 1) AP_LOAD(rawB, vrB, 1);
    const LAS bf16_t* pBt = img + (l15 >> 2) * IS + 128 + (l15 & 3) * 16 + quad * 8;
    const LAS float* pW = (const LAS float*)(img + (l15 >> 2) * IS + 288) + (l15 & 3);
#define AP_CHUNK(raw, vraw, CC) do { const int c = (CC); \
        AP_STAGE(raw); \
        u32x4v vw = {0u, 0u, 0u, 0u}; \
        if (quad < 2) { vw.x = (unsigned)vraw[0] | ((unsigned)vraw[1] << 16); vw.y = (unsigned)vraw[2] | ((unsigned)vraw[3] << 16); vw.z = (unsigned)vraw[4] | ((unsigned)vraw[5] << 16); vw.w = (unsigned)vraw[6] | ((unsigned)vraw[7] << 16); } \
        asm volatile("" : "+v"(vw)); \
        if (c + 2 < nch) AP_LOAD(raw, vraw, c + 2); \
        ap_compute(c, vw); } while (0)
    auto ap_compute = [&](int c, u32x4v vw) {
        const bf16x8 va = __builtin_bit_cast(bf16x8, vw);
#pragma unroll
        for (int tn = 0; tn < 4; ++tn) { const unsigned w01 = pk2(S[tn][0], S[tn][1]), w23 = pk2(S[tn][2], S[tn][3]); LAS bf16_t* ds = sS + (quad * 4) * 72 + 16 * tn + l15;
            ds[0] = (bf16_t)(w01 & 0xffff); ds[72] = (bf16_t)(w01 >> 16); ds[144] = (bf16_t)(w23 & 0xffff); ds[216] = (bf16_t)(w23 >> 16); }
        LDS_FENCE();
        f32x4 cm = {0.f, 0.f, 0.f, 0.f}, yy = {0.f, 0.f, 0.f, 0.f};
#pragma unroll
        for (int ks = 0; ks < 2; ++ks) { const bf16x8 fs = frag(sS, 0, 72, 32 * ks, lane); cm = MFMA16(fs, frag(img, 0, IS, 32 * ks, lane), cm); yy = MFMA16(fs, frag(img + 64, 0, IS, 32 * ks, lane), yy); }
        cm = MFMA16(va, frag16(img + 256, 0, IS, lane), cm); yy = MFMA16(va, frag16(img + 272, 0, IS, lane), yy);
#pragma unroll
        for (int j = 0; j < 4; ++j) { yd[step * 512 * (16 * c + l15) + quad * 4 + j] = yy[j]; sCm[(quad * 4 + j) * 24 + l15] = f2bf_sw(cm[j]); }
        LDS_FENCE();
        const bf16x8 fc = frag16(sCm, 0, 24, lane);
#pragma unroll
        for (int tn = 0; tn < 4; ++tn) { f32x4 ab = {0.f, 0.f, 0.f, 0.f}, ag = ab;
            bf16x8 fb = {0, 0, 0, 0, 0, 0, 0, 0}, fg = fb;
            if (quad < 2) { fb = *(const LAS bf16x8*)(pBt + tn * 4 * IS); fg = *(const LAS bf16x8*)(pBt + tn * 4 * IS + 64); }
            ab = MFMA16(fc, fb, ab); ag = MFMA16(va, fg, ag);
            const float w16 = pW[tn * 2 * IS];
#pragma unroll
            for (int j = 0; j < 4; ++j) S[tn][j] = (S[tn][j] - ab[j] + ag[j]) * w16; }
        LDS_FENCE();
    };
    for (int c2 = 0; c2 < nch; c2 += 2) { AP_CHUNK(rawA, vrA, c2); AP_CHUNK(rawB, vrB, c2 + 1); }
#undef AP_CHUNK
#undef AP_LOAD
#undef AP_STAGE
    if (s < 32) { float* so = p.out + O_RW + ((((size_t)(s * 2 + l) * 2 + d) * 8 + h) * 64 + 16 * rt) * 64;
#pragma unroll
        for (int tn = 0; tn < 4; ++tn)
#pragma unroll
            for (int j = 0; j < 4; ++j) so[(quad * 4 + j) * 64 + 16 * tn + l15] = S[tn][j]; }
}
constexpr int AP_LDS = (16 * 72 * 2 + 64 * 24 * 2 + 16 * 24 * 2) * 2 + 64 * 4 + (16 * 72 + 16 * 24) * 2;

typedef float f32x2 __attribute__((ext_vector_type(2)));
__device__ __forceinline__ void m2_phase(const Params& p, int l, int rep, LAS unsigned char* lds, const XcdBarrier& xbar) {
    const int tid_ = opaque_tid(); const int lane = tid_ & 63, wave = tid_ >> 6;
    LAS unsigned char* wl = lds + wave * 16384;
    const int G = gridDim.x, b = blockIdx.x, slot = b * 8 + wave, NW = G * 8;
    for (int t = slot; t < 2048; t += NW) cp_task(p, 8192 + t, lane, wl);
    xcd_barrier(xbar);
    const bool chain_wave = wave == 0 && b < 128;
    if (chain_wave) { for (int t = b; t < 128; t += G) ap_task(p, l, t, lane, wl); }
    else { const int nchain = G < 128 ? G : 128;
        const int idx = b < nchain ? b * 7 + (wave - 1) : nchain * 7 + (b - nchain) * 8 + wave;
        for (int t = idx; t < 8192; t += NW - nchain) cp_task(p, t, lane, wl); }
    xcd_barrier(xbar);
    for (int t = slot; t < 2048; t += NW) ap_task(p, l, 128 + t, lane, wl);
}

__device__ __forceinline__ void m3_phase(const Params& p, int l) {
    const int tid_ = opaque_tid(); const int lane = tid_ & 63, gw = blockIdx.x * 8 + (tid_ >> 6), NGW = gridDim.x * 8;
    const bf16_t* proj = (const bf16_t*)(p.ws + WS_PROJ);
    bf16_t* mixed = (bf16_t*)(p.ws + WS_UM);
    const int c = lane * 8;
    for (int tok = gw; tok < NTOK; tok += NGW) {
        const size_t o = (size_t)tok * 512 + c;
        {
            float y0[8], y1[8], g[8], bb[8], bn[8], gt[8], out[8];
            ld8f((const float*)(p.ws + WS_YD) + o, y0); ld8f((const float*)(p.ws + WS_YD) + (size_t)NTOK * 512 + o, y1);
            float s = 0.f;
#pragma unroll
            for (int e = 0; e < 8; ++e) { y0[e] += y1[e]; s += y0[e]; }
            s += __shfl_xor(s, 1); s += __shfl_xor(s, 2); s += __shfl_xor(s, 4);
            const float mu = s * (1.0f / 64.0f); float q = 0.f;
#pragma unroll
            for (int e = 0; e < 8; ++e) { y0[e] -= mu; q += y0[e] * y0[e]; }
            q += __shfl_xor(q, 1); q += __shfl_xor(q, 2); q += __shfl_xor(q, 4);
            const float rs = rsqrtf(q * (1.0f / 64.0f) + 64e-5f);
            ld8f(p.in[I_RGG] + l * 512 + c, g); ld8f(p.in[I_RGB] + l * 512 + c, bb);
            unpack8(*(const u32x4v*)((const bf16_t*)(p.ws + WS_SCBON) + o), bn);
            unpack8(*(const u32x4v*)(proj + (size_t)tok * NP + A_GATE + c), gt);
#pragma unroll
            for (int e = 0; e < 8; ++e) out[e] = (y0[e] * rs * g[e] + bb[e] + bn[e]) * siluf_(gt[e]);
            *(u32x4v*)(mixed + (size_t)tok * DM + c) = pack8(out);
        }
        {
            float h0[8], h1[8], g[8], bb[8], og[8], gt[8], out[8];
            ld8f((const float*)(p.ws + WS_HD) + o, h0); ld8f((const float*)(p.ws + WS_HD) + (size_t)NTOK * 512 + o, h1);
            unpack8(*(const u32x4v*)(proj + (size_t)tok * NP + B_O + c), og);
            float s = 0.f;
#pragma unroll
            for (int e = 0; e < 8; ++e) { h0[e] = (h0[e] + h1[e]) * sigmoidf_(og[e]); s += h0[e]; }
            s += __shfl_xor(s, 1); s += __shfl_xor(s, 2); s += __shfl_xor(s, 4); s += __shfl_xor(s, 8);
            const float mu = s * (1.0f / 128.0f); float q = 0.f;
#pragma unroll
            for (int e = 0; e < 8; ++e) { h0[e] -= mu; q += h0[e] * h0[e]; }
            q += __shfl_xor(q, 1); q += __shfl_xor(q, 2); q += __shfl_xor(q, 4); q += __shfl_xor(q, 8);
            const float rs = rsqrtf(q * (1.0f / 128.0f) + 1e-5f);
            ld8f(p.in[I_MGG] + l * 512 + c, g); ld8f(p.in[I_MGB] + l * 512 + c, bb);
            unpack8(*(const u32x4v*)(proj + (size_t)tok * NP + B_GATE + c), gt);
#pragma unroll
            for (int e = 0; e < 8; ++e) out[e] = (h0[e] * rs * g[e] + bb[e]) * siluf_(gt[e]);
            *(u32x4v*)(mixed + (size_t)tok * DM + 512 + c) = pack8(out);
        }
    }
}

__device__ __forceinline__ void ln_phase(const Params& p, int l) {
    const int tid_ = opaque_tid(); const int lane = tid_ & 63, gw = blockIdx.x * 8 + (tid_ >> 6), NGW = gridDim.x * 8;
    for (int tok0 = gw; tok0 < NTOK; tok0 += 2 * NGW) {
        const int tok1 = tok0 + NGW; const bool has1 = tok1 < NTOK;
        float* zr0 = p.out + O_Y + (size_t)tok0 * DM; float* zr1 = p.out + O_Y + (size_t)(has1 ? tok1 : tok0) * DM;
        float v0[4][8], v1[4][8]; float s0 = 0.f, s1 = 0.f;
#pragma unroll
        for (int j = 0; j < 4; ++j) { ld8f(zr0 + j * 512 + lane * 8, v0[j]); ld8f(zr1 + j * 512 + lane * 8, v1[j]); }
#pragma unroll
        for (int j = 0; j < 4; ++j)
#pragma unroll
            for (int e = 0; e < 8; ++e) { s0 += v0[j][e]; s1 += v1[j][e]; }
#pragma unroll
        for (int o = 1; o < 64; o <<= 1) { s0 += __shfl_xor(s0, o); s1 += __shfl_xor(s1, o); }
        const float mu0 = s0 * (1.0f / 2048.0f), mu1 = s1 * (1.0f / 2048.0f); float q0 = 0.f, q1 = 0.f;
#pragma unroll
        for (int j = 0; j < 4; ++j)
#pragma unroll
            for (int e = 0; e < 8; ++e) { v0[j][e] -= mu0; q0 += v0[j][e] * v0[j][e]; v1[j][e] -= mu1; q1 += v1[j][e] * v1[j][e]; }
#pragma unroll
        for (int o = 1; o < 64; o <<= 1) { q0 += __shfl_xor(q0, o); q1 += __shfl_xor(q1, o); }
        const float rs0 = rsqrtf(q0 * (1.0f / 2048.0f) + 1e-5f), rs1 = rsqrtf(q1 * (1.0f / 2048.0f) + 1e-5f);
        const float* mod0 = (const float*)(p.ws + WS_MOD) + (size_t)(3 + mod_row(tok0)) * 6144;
        const float* mod1 = (const float*)(p.ws + WS_MOD) + (size_t)(3 + mod_row(has1 ? tok1 : tok0)) * 6144;
        bf16_t* ur0 = (bf16_t*)(p.ws + WS_UM) + (size_t)tok0 * DM; bf16_t* ur1 = (bf16_t*)(p.ws + WS_UM) + (size_t)(has1 ? tok1 : tok0) * DM;
#pragma unroll
        for (int j = 0; j < 4; ++j) { const int c = j * 512 + lane * 8; float g[8], bb[8], y0[8], y1[8];
            ld8f(p.in[I_LNG] + l * DM + c, g); ld8f(p.in[I_LNB] + l * DM + c, bb);
#pragma unroll
            for (int e = 0; e < 8; ++e) { y0[e] = v0[j][e] * rs0 * g[e] + bb[e]; y1[e] = v1[j][e] * rs1 * g[e] + bb[e]; }
            *(float4*)(zr0 + c) = make_float4(y0[0], y0[1], y0[2], y0[3]); *(float4*)(zr0 + c + 4) = make_float4(y0[4], y0[5], y0[6], y0[7]);
            if (has1) { *(float4*)(zr1 + c) = make_float4(y1[0], y1[1], y1[2], y1[3]); *(float4*)(zr1 + c + 4) = make_float4(y1[4], y1[5], y1[6], y1[7]); }
            if (l == 0) { float sh[8], sc[8], o[8]; ld8f(mod0 + c, sh); ld8f(mod0 + 2048 + c, sc);
#pragma unroll
                for (int e = 0; e < 8; ++e) o[e] = y0[e] * (1.0f + sc[e]) + sh[e];
                *(u32x4v*)(ur0 + c) = pack8(o);
                if (has1) { ld8f(mod1 + c, sh); ld8f(mod1 + 2048 + c, sc);
#pragma unroll
                    for (int e = 0; e < 8; ++e) o[e] = y1[e] * (1.0f + sc[e]) + sh[e];
                    *(u32x4v*)(ur1 + c) = pack8(o); } } }
    }
}

#ifndef DUP_P0B
#define DUP_P0B 0
#endif
#ifndef DUP_SYNC
#define DUP_SYNC 0
#endif
#ifndef DUP_M3
#define DUP_M3 0
#endif
#ifndef DUP_G2
#define DUP_G2 0
#endif
#ifndef DUP_P0
#define DUP_P0 0
#endif
#ifndef DUP_M1
#define DUP_M1 0
#endif
#ifndef DUP_M2
#define DUP_M2 0
#endif
#ifndef DUP_G1
#define DUP_G1 0
#endif
#ifndef DUP_MASK
#define DUP_MASK 7
#endif
#ifndef PH_ALL
#define PH_ALL 1
#endif
#ifndef PH_P0
#define PH_P0 PH_ALL
#endif
#ifndef PH_G1
#define PH_G1 PH_ALL
#endif
#ifndef PH_M1
#define PH_M1 PH_ALL
#endif
#ifndef PH_M2
#define PH_M2 PH_ALL
#endif
#ifndef PH_M3
#define PH_M3 PH_ALL
#endif
#ifndef PH_G2
#define PH_G2 PH_ALL
#endif
#ifndef PH_LN
#define PH_LN PH_ALL
#endif
__global__ void __launch_bounds__(NTHREADS) hybrid_fwd(Params p) {
    extern __shared__ __attribute__((aligned(16))) unsigned char smem[];
    LAS unsigned char* lds = (LAS unsigned char*)smem;
    cg::grid_group grid = cg::this_grid();
    volatile LAS unsigned* xst = (volatile LAS unsigned*)(lds + LDS_SLOT + 16);
    if (threadIdx.x == 0) { xst[0] = 0u; xst[1] = 0u; }
    __syncthreads();
    const XcdBarrier xbar = xcd_barrier_post((unsigned*)(p.ws + WS_BAR), xst);
#define GSYNC() xcd_barrier(xbar)
#if PH_P0
    for (int rep = 0; rep < 1 + DUP_P0; ++rep) { p0_phase(p, lds, rep); if (rep < DUP_P0) GSYNC(); }
#endif
    if (p.ws == nullptr) grid.sync();
    GSYNC();
#if PH_P0
    for (int rep = 0; rep < 1 + DUP_P0B; ++rep) p0b_phase(p);
#endif
    GSYNC();
    for (int i = 0; i < DUP_SYNC; ++i) GSYNC();
    for (int l = 0; l < 2; ++l) {
#if PH_G1
        for (int rep = 0; rep < 1 + DUP_G1; ++rep) {
            pg8::Gemm g; g.A = (const bf16_t*)(p.ws + WS_UM); g.Bt = (const bf16_t*)(p.ws + WS_WIN) + (size_t)l * NP * DM; g.M = NTOK; g.N = NP; g.K = DM;
            pg8::StaticOrder S; S.init(NTOK, NP, gridDim.x, blockIdx.x);
            EpiIn E; E.proj = (bf16_t*)(p.ws + WS_PROJ); E.gates = (float*)(p.ws + WS_GATES); E.newk = p.out + O_NK; E.newv = p.out + O_NV; E.rope = (const float*)(p.ws + WS_ROPE); E.layer = l;
            pg8::gemm_phase<EpiIn, pg8::StaticOrder, false>(lds, g, S, E, nullptr);
            if (rep < DUP_G1) GSYNC();
        }
#endif
        GSYNC();
#if PH_M1
        for (int rep = 0; rep < 1 + DUP_M1; ++rep) { m1_phase(p, l, lds, rep, rep == 0 ? 7 : DUP_MASK); if (rep < DUP_M1) GSYNC(); }
#endif
        GSYNC();
#if PH_M2
        for (int rep = 0; rep < 1 + DUP_M2; ++rep) { m2_phase(p, l, rep, lds, xbar); if (rep < DUP_M2) GSYNC(); }
#endif
        GSYNC();
#if PH_M3
        for (int rep = 0; rep < 1 + DUP_M3; ++rep) m3_phase(p, l);
#endif
        GSYNC();
#if PH_G2
        for (int rep = 0; rep < 1 + (l == 0 ? DUP_G2 : 0); ++rep) {
            pg8::Gemm g; g.A = (const bf16_t*)(p.ws + WS_UM); g.Bt = (const bf16_t*)(p.ws + WS_WOUT) + (size_t)l * DM * DM; g.M = NTOK; g.N = DM; g.K = DM;
            pg8::StaticOrder S; S.init(NTOK, DM, gridDim.x, blockIdx.x);
            EpiOut E; E.xp = p.in[I_XP]; E.xs = p.in[I_XS]; E.mod = (const float*)(p.ws + WS_MOD) + (size_t)l * 3 * 6144; E.y = p.out + O_Y; E.layer = l;
            pg8::gemm_phase<EpiOut, pg8::StaticOrder, false>(lds, g, S, E, nullptr);
            if (rep < (l == 0 ? DUP_G2 : 0)) GSYNC();
        }
#endif
        GSYNC();
#if PH_LN
        ln_phase(p, l);
#endif
        if (l == 0) GSYNC();
    }
}

extern "C" void kernel_launch(void* const* d_in, const int* in_sizes, int n_in, void* d_out, int out_size, void* d_ws, size_t ws_size, hipStream_t stream) {
    static int grid_blocks = 0;
    if (grid_blocks == 0) {
        if (n_in != 38 || ws_size < WS_END) { fprintf(stderr, "kernel_launch: unexpected n_in %d / ws_size %zu (need %zu)\n", n_in, ws_size, (size_t)WS_END); grid_blocks = -1; return; }
        int dev = 0, cus = 0, per_cu = 0;
        hipGetDevice(&dev);
        hipDeviceGetAttribute(&cus, hipDeviceAttributeMultiprocessorCount, dev);
        hipFuncSetAttribute((const void*)hybrid_fwd, hipFuncAttributeMaxDynamicSharedMemorySize, LDS_BYTES);
        hipOccupancyMaxActiveBlocksPerMultiprocessor(&per_cu, (const void*)hybrid_fwd, NTHREADS, LDS_BYTES);
        if (per_cu < 1) { fprintf(stderr, "kernel_launch: occupancy query gives %d blocks per CU\n", per_cu); per_cu = 1; }
        grid_blocks = cus * per_cu;
    }
    if (grid_blocks < 0) return;
    Params p{};
    for (int i = 0; i < 38; ++i) p.in[i] = (const float*)d_in[i];
    p.out = (float*)d_out; p.ws = (unsigned char*)d_ws;
    hipMemsetAsync(d_ws, 0, 32768, stream);
    void* args[] = {&p};
    hipError_t e = hipLaunchCooperativeKernel((const void*)hybrid_fwd, dim3(grid_blocks), dim3(NTHREADS), args, LDS_BYTES, stream);
    if (e != hipSuccess) fprintf(stderr, "cooperative launch failed: %s (grid %d)\n", hipGetErrorString(e), grid_blocks);
}
```

```cpp
#include <hip/hip_runtime.h>
#include <hip/hip_cooperative_groups.h>
#include <cstdio>
#include <cstdint>
namespace cg = cooperative_groups;
namespace pg8 {
#define PG8_LAS __attribute__((address_space(3)))
typedef unsigned short bf16_t;
typedef short bf16x8 __attribute__((ext_vector_type(8)));
typedef float f32x4 __attribute__((ext_vector_type(4)));
typedef unsigned u32x4 __attribute__((ext_vector_type(4)));
constexpr int BM = 256, BK = 64, HALF = 128, HTB = HALF * BK * 2  , STAGE_BYTES = 8 * HTB, NXCD = 8, WGM = 8;

__host__ __device__ __forceinline__ int lds_byte(int r, int c) { const int st = (r >> 4) * 2 + (c >> 5), rr = r & 15, cc = c & 31, ob = rr * 64 + cc * 2; return st * 1024 + (ob ^ (((ob >> 9) & 1) << 5)); }
__host__ __device__ __forceinline__ void stage_rc(int b, int& R, int& C) { const int st = b / 1024, sb = b % 1024, swz = sb ^ (((sb >> 9) & 1) << 5); R = (st >> 1) * 16 + swz / 64; C = (st & 1) * 32 + (swz % 64) / 2; }
__host__ __device__ __forceinline__ int perm32(int rho) { const int n = rho >> 4, i = rho & 15; return 8 * (i >> 2) + 4 * n + (i & 3); }

struct Unit { int pm, pn; };
struct Gemm { const bf16_t* A; const bf16_t* Bt; int M, N, K; };

struct StaticOrder {
    int nM, nN, nwg, G, c;
    __host__ __device__ void init(int M, int N, int G_, int c_) { nM = M / BM; nN = N / BM; nwg = nM * nN; G = G_; c = c_; }
    __host__ __device__ bool next(int i, Unit& u) const {
        const long L = (long)i * G + c; if (L >= nwg) return false;
        int wgid = (int)L; { const int q = nwg / NXCD, r = nwg % NXCD, xcd = wgid % NXCD, off = wgid / NXCD; wgid = (xcd < r ? xcd * (q + 1) : r * (q + 1) + (xcd - r) * q) + off; }
        const int nig = WGM * nN, gid = wgid / nig, fm = gid * WGM, gsz = (nM - fm) < WGM ? (nM - fm) : WGM;
        u.pm = fm + ((wgid % nig) % gsz); u.pn = (wgid % nig) / gsz; return true;
    }
    __device__ __forceinline__ void a_ready(const Unit&) const {}
    __device__ __forceinline__ void done(const Unit&) const {}
};
__device__ __forceinline__ unsigned cvt_pk_bf16(float lo, float hi) { unsigned r; asm volatile("v_cvt_pk_bf16_f32 %0, %1, %2" : "=v"(r) : "v"(lo), "v"(hi)); return r; }
template <class Epi, class Sched, bool STAMP = false>
__device__ __forceinline__ void gemm_phase(PG8_LAS unsigned char* lds, const Gemm g, const Sched& S, const Epi& E, unsigned long long* stamps) {
    int tid = threadIdx.x; asm volatile("" : "+v"(tid)); const int wid = __builtin_amdgcn_readfirstlane(tid >> 6), lane = tid & 63, wr = wid >> 2, wc = wid & 3, fr = lane & 15, fq = lane >> 4;
    const int K = g.K, nt = K / BK;
    int ts_lo = 0, ts_hi = 0, nts = 0; const unsigned long long rt_entry = STAMP ? (unsigned long long)wall_clock64() : 0ull;
#define PG8_STAMP() do { if (STAMP && wid == 0 && nts < 64) { const unsigned long long _c = (unsigned long long)clock64(); \
        ts_lo = (lane == nts) ? (int)(unsigned)_c : ts_lo; ts_hi = (lane == nts) ? (int)(unsigned)(_c >> 32) : ts_hi; ++nts; } } while (0)
    PG8_STAMP();
    unsigned voffA[2], voffB[2];
#pragma unroll
    for (int i = 0; i < 2; ++i) { int R, C; stage_rc(tid * 16 + i * 8192, R, C); const int Rb = Epi::PERM ? ((R & ~31) + perm32(R & 31)) : R;
        voffA[i] = (unsigned)(R * K + C) * 2u; voffB[i] = (unsigned)(Rb * K + C) * 2u; }
    const size_t kstep = (size_t)(BK * 2);
    const size_t hstep = (size_t)HALF * K * 2;
    const size_t tstep = 2 * hstep;
    const unsigned ldsw = (unsigned)wid * 1024u;
    const int aoff = lds_byte(wr * 64 + fr, fq * 8), boff = lds_byte(wc * 32 + fr, fq * 8);
#define PG8_SA(b, h) (((b) * 2 + (h)) * HTB)
#define PG8_SB(b, h) ((4 + (b) * 2 + (h)) * HTB)
#define PG8_STAGE(bufoff, gbase, voff) do { _Pragma("unroll") for (int _i = 0; _i < 2; ++_i) \
        __builtin_amdgcn_global_load_lds((const unsigned*)((const char*)(gbase) + (voff)[_i]), (PG8_LAS unsigned*)(lds + (bufoff) + ldsw + _i * 8192), 16, 0, 0); } while (0)
#define PG8_LDA(dst, b, h) do { _Pragma("unroll") for (int m = 0; m < 4; ++m) _Pragma("unroll") for (int k = 0; k < 2; ++k) dst[m][k] = *(const PG8_LAS bf16x8*)(lds + PG8_SA(b, h) + aoff + m * 2048 + k * 1024); } while (0)
#define PG8_LDB(dst, b, h) do { _Pragma("unroll") for (int n = 0; n < 2; ++n) _Pragma("unroll") for (int k = 0; k < 2; ++k) dst[n][k] = *(const PG8_LAS bf16x8*)(lds + PG8_SB(b, h) + boff + n * 2048 + k * 1024); } while (0)
#define PG8_MMA(ai, bj, At, Bt) do { __builtin_amdgcn_s_setprio(1); _Pragma("unroll") for (int m = 0; m < 4; ++m) _Pragma("unroll") for (int n = 0; n < 2; ++n) _Pragma("unroll") for (int k = 0; k < 2; ++k) \
        acc[ai][bj][m][n] = __builtin_amdgcn_mfma_f32_16x16x32_bf16(Bt[n][k], At[m][k], acc[ai][bj][m][n], 0, 0, 0); __builtin_amdgcn_s_setprio(0); } while (0)
#define PG8_WAIT_V(n) asm volatile("s_waitcnt vmcnt(" #n ")" ::: "memory")
#define PG8_WAIT_L(n) asm volatile("s_waitcnt lgkmcnt(" #n ")" ::: "memory")
#define PG8_BAR __builtin_amdgcn_s_barrier()
#define PG8_SCHED __builtin_amdgcn_sched_barrier(0)
    Unit cur, nxt; int ui = 0;
    if (!S.next(0, cur)) return;
    f32x4 acc[2][2][4][2];
#pragma unroll
    for (int a = 0; a < 2; ++a)
#pragma unroll
        for (int b = 0; b < 2; ++b)
#pragma unroll
            for (int m = 0; m < 4; ++m)
#pragma unroll
                for (int n = 0; n < 2; ++n) acc[a][b][m][n] = (f32x4){0.f, 0.f, 0.f, 0.f};
    bf16x8 At[4][2], B0[2][2], B1[2][2];
    const char* cA = (const char*)g.A + (size_t)cur.pm * tstep; const char* cB = (const char*)g.Bt + (size_t)cur.pn * tstep;
    S.a_ready(cur);
    PG8_STAGE(PG8_SB(0, 0), cB, voffB); PG8_STAGE(PG8_SA(0, 0), cA, voffA); PG8_STAGE(PG8_SB(0, 1), cB + hstep, voffB); PG8_STAGE(PG8_SA(0, 1), cA + hstep, voffA);
    if (wr == 1) PG8_BAR;
    PG8_WAIT_V(4); PG8_BAR;
    PG8_STAGE(PG8_SB(1, 0), cB + kstep, voffB); PG8_STAGE(PG8_SA(1, 0), cA + kstep, voffA); PG8_STAGE(PG8_SB(1, 1), cB + hstep + kstep, voffB);
    PG8_WAIT_V(6); PG8_BAR;
    PG8_STAMP();
    for (;;) {
        const bool has_next = S.next(ui + 1, nxt);
        const char* nA = has_next ? (const char*)g.A + (size_t)nxt.pm * tstep : cA; const char* nB = has_next ? (const char*)g.Bt + (size_t)nxt.pn * tstep : cB;
        for (int t = 0; t < nt; t += 2) {
            const bool last = (t == nt - 2);
            const char* a1 = cA + (size_t)(t + 1) * kstep;
            const char* a2 = last ? nA : cA + (size_t)(t + 2) * kstep; const char* b2 = last ? nB : cB + (size_t)(t + 2) * kstep;
            const char* a3 = a2 + kstep; const char* b3 = b2 + kstep;
            if (last && has_next) S.a_ready(nxt);
            PG8_LDB(B0, 0, 0); PG8_SCHED; PG8_LDA(At, 0, 0); PG8_STAGE(PG8_SA(1, 1), a1 + hstep, voffA);
            PG8_WAIT_L(8); PG8_BAR; PG8_WAIT_L(0); PG8_MMA(0, 0, At, B0); PG8_BAR; PG8_SCHED;
            PG8_LDB(B1, 0, 1); PG8_STAGE(PG8_SB(0, 0), b2, voffB);
            PG8_BAR; PG8_WAIT_L(0); PG8_MMA(0, 1, At, B1); PG8_BAR;
            PG8_LDA(At, 0, 1); PG8_STAGE(PG8_SA(0, 0), a2, voffA);
            PG8_BAR; PG8_WAIT_L(0); PG8_MMA(1, 0, At, B0); PG8_BAR; PG8_SCHED;
            PG8_STAGE(PG8_SB(0, 1), b2 + hstep, voffB);
            PG8_WAIT_V(6); PG8_BAR; PG8_MMA(1, 1, At, B1); PG8_BAR;
            PG8_LDB(B0, 1, 0); PG8_SCHED; PG8_LDA(At, 1, 0); PG8_STAGE(PG8_SA(0, 1), a2 + hstep, voffA);
            PG8_WAIT_L(8); PG8_BAR; PG8_WAIT_L(0); PG8_MMA(0, 0, At, B0); PG8_BAR; PG8_SCHED;
            PG8_LDB(B1, 1, 1); PG8_STAGE(PG8_SB(1, 0), b3, voffB);
            PG8_BAR; PG8_WAIT_L(0); PG8_MMA(0, 1, At, B1); PG8_BAR;
            PG8_LDA(At, 1, 1); PG8_STAGE(PG8_SA(1, 0), a3, voffA);
            PG8_BAR; PG8_WAIT_L(0); PG8_MMA(1, 0, At, B0); PG8_BAR; PG8_SCHED;
            PG8_STAGE(PG8_SB(1, 1), b3 + hstep, voffB);
            PG8_WAIT_V(6); PG8_BAR; PG8_MMA(1, 1, At, B1); PG8_BAR;
        }
        PG8_STAMP();
        if constexpr (!Epi::AFTER_DRAIN) { E(acc, cur, wr, wc, fr, fq); S.done(cur); }
        PG8_STAMP();
        if (!has_next) break;
#pragma unroll
        for (int a = 0; a < 2; ++a)
#pragma unroll
            for (int b = 0; b < 2; ++b)
#pragma unroll
                for (int m = 0; m < 4; ++m)
#pragma unroll
                    for (int n = 0; n < 2; ++n) acc[a][b][m][n] = (f32x4){0.f, 0.f, 0.f, 0.f};
        cur = nxt; cA = nA; cB = nB; ++ui;
    }
    PG8_WAIT_V(0);
    if (wr == 0) PG8_BAR;
    PG8_BAR;
    if constexpr (Epi::AFTER_DRAIN) { E.fused(acc, cur, wr, wc, fr, fq, lds, wid, lane); S.done(cur); }
    PG8_STAMP();
    if (STAMP && wid == 0) { stamps[lane] = lane < nts ? (((unsigned long long)(unsigned)ts_hi << 32) | (unsigned)ts_lo) : 0ull;
        if (lane == 62) stamps[62] = rt_entry; if (lane == 63) stamps[63] = (unsigned long long)wall_clock64(); }
#undef PG8_STAMP
#undef PG8_SA
#undef PG8_SB
#undef PG8_STAGE
#undef PG8_LDA
#undef PG8_LDB
#undef PG8_MMA
#undef PG8_WAIT_V
#undef PG8_WAIT_L
#undef PG8_BAR
#undef PG8_SCHED
}
}

#define LAS __attribute__((address_space(3)))
#ifndef DUP_M2MASK
#define DUP_M2MASK 3
#endif
typedef unsigned short bf16_t;
typedef short bf16x8 __attribute__((ext_vector_type(8)));
typedef float f32x4 __attribute__((ext_vector_type(4)));
typedef unsigned u32x4v __attribute__((ext_vector_type(4)));
typedef unsigned u32x2v __attribute__((ext_vector_type(2)));

constexpr int NTOK = 10240, NPT = 8192, DM = 2048, NP = 9216, PIN = 8976;
constexpr int C_Q = 4864, C_K = 5888, C_V = 6912, C_G = 7936, C_IF = 8960;
constexpr int A_WD = 1536, A_AD = 1664, A_GATE = 1792;
constexpr int B_Q = 2304, B_V = 3328, B_O = 3840, B_GATE = 4352;
constexpr int NTHREADS = 512;
constexpr int LDS_SLOT = 131072, LDS_BYTES = 131072 + 1024;

constexpr size_t WS_CTL = 0;
constexpr size_t WS_BAR = 8192;
constexpr size_t WS_MOD = 32768;
constexpr size_t WS_ROPE = WS_MOD + 147456;
constexpr size_t WS_LAM = WS_ROPE + 8192;
constexpr size_t WS_WIN = WS_LAM + 256;
constexpr size_t WS_WOUT = WS_WIN + 2ull * NP * DM * 2;
constexpr size_t WS_UM = WS_WOUT + 2ull * DM * DM * 2;
constexpr size_t WS_PROJ = WS_UM + (size_t)NTOK * DM * 2;
constexpr size_t WS_GATES = WS_PROJ + (size_t)NTOK * NP * 2;
constexpr size_t SZ16 = (size_t)NTOK * 512 * 2, SZ32 = (size_t)NTOK * 512 * 4;
constexpr size_t WS_SCV = WS_GATES + (size_t)NTOK * 16 * 4;
constexpr size_t WS_SCBON = WS_SCV + SZ16;
constexpr size_t WS_PK = WS_SCBON + SZ16;
constexpr size_t SZPK = (size_t)NTOK * 8 * 320 * 2;
constexpr size_t WS_YD = WS_PK + 2 * SZPK;
constexpr size_t WS_HD = WS_YD + 2 * SZ32;
constexpr size_t WS_KC = WS_HD + 2 * SZ32;
constexpr size_t WS_VTC = WS_KC + 4194304;
constexpr size_t WS_WUPT = WS_VTC + 4194304;
constexpr size_t WS_END = WS_WUPT + 524288;

constexpr size_t O_Y = 0, O_NK = 20971520, O_NV = 37748736, O_RW = 54525952, O_MC = 58720256, O_MN = 67108864, O_MM = 67174400;

struct Params { const float* in[38]; float* out; unsigned char* ws; };
enum { I_XP = 0, I_XS, I_CK, I_CV, I_SRW, I_SMC, I_SMN, I_SMM, I_C, I_CCTX, I_WADA, I_BADA, I_WIN, I_CAW, I_CAB, I_W0, I_WUP, I_A0, I_AUP, I_KK, I_KA, I_RK,
       I_RGG, I_RGB, I_CBW, I_CBB, I_BI, I_BF, I_MGG, I_MGB, I_LQ1, I_LK1, I_LQ2, I_LK2, I_SUBG, I_WOUT, I_LNG, I_LNB };

__device__ __forceinline__ float bf2f(bf16_t v) { return __uint_as_float(((unsigned)v) << 16); }
__device__ __forceinline__ float bflo(unsigned w) { return __uint_as_float(w << 16); }
__device__ __forceinline__ float bfhi(unsigned w) { return __uint_as_float(w & 0xffff0000u); }
__device__ __forceinline__ unsigned pk2(float lo, float hi) { return pg8::cvt_pk_bf16(lo, hi); }
__device__ __forceinline__ bf16_t f2bf(float f) { return (bf16_t)(pk2(f, 0.f) & 0xffffu); }
__device__ __forceinline__ void unpack8(const u32x4v w, float (&o)[8]) { o[0] = bflo(w.x); o[1] = bfhi(w.x); o[2] = bflo(w.y); o[3] = bfhi(w.y); o[4] = bflo(w.z); o[5] = bfhi(w.z); o[6] = bflo(w.w); o[7] = bfhi(w.w); }
__device__ __forceinline__ u32x4v pack8(const float (&o)[8]) { u32x4v w; w.x = pk2(o[0], o[1]); w.y = pk2(o[2], o[3]); w.z = pk2(o[4], o[5]); w.w = pk2(o[6], o[7]); return w; }
__device__ __forceinline__ void ld8f(const float* p, float (&o)[8]) { const float4 a = *(const float4*)p, b = *(const float4*)(p + 4); o[0] = a.x; o[1] = a.y; o[2] = a.z; o[3] = a.w; o[4] = b.x; o[5] = b.y; o[6] = b.z; o[7] = b.w; }
__device__ __forceinline__ float sigmoidf_(float x) { return __builtin_amdgcn_rcpf(1.0f + __expf(-x)); }
__device__ __forceinline__ float siluf_(float x) { return x * __builtin_amdgcn_rcpf(1.0f + __expf(-x)); }
__device__ __forceinline__ float tanhf_(float x) { return 1.0f - 2.0f * __builtin_amdgcn_rcpf(1.0f + __expf(2.0f * x)); }
__device__ __forceinline__ bf16x8 frag(const LAS bf16_t* base, int row0, int ld, int k0, int lane) { return *(const LAS bf16x8*)(base + (row0 + (lane & 15)) * ld + k0 + (lane >> 4) * 8); }
__device__ __forceinline__ bf16x8 fragsw(const LAS bf16_t* base, int row0, int k0, int lane) { const int r = row0 + (lane & 15), m = (k0 >> 3) + (lane >> 4); return *(const LAS bf16x8*)(base + r * 72 + 8 * (m ^ ((r >> 3) & 7))); }
#define MFMA16(a, b, c) __builtin_amdgcn_mfma_f32_16x16x32_bf16((a), (b), (c), 0, 0, 0)
#define LDS_FENCE() asm volatile("s_waitcnt lgkmcnt(0)" ::: "memory")
template <int CTRL> __device__ __forceinline__ float dppf(float x) { return __builtin_bit_cast(float, __builtin_amdgcn_mov_dpp(__builtin_bit_cast(int, x), CTRL, 0xf, 0xf, true)); }
__device__ __forceinline__ float red16_sum(float x) { x += dppf<0xB1>(x); x += dppf<0x4E>(x); x += dppf<0x124>(x); x += dppf<0x128>(x); return x; }
__device__ __forceinline__ float red4_sum(float x) { x += dppf<0xB1>(x); x += dppf<0x4E>(x); return x; }
__device__ __forceinline__ float red16_max(float x) { x = fmaxf(x, dppf<0xB1>(x)); x = fmaxf(x, dppf<0x4E>(x)); x = fmaxf(x, dppf<0x124>(x)); x = fmaxf(x, dppf<0x128>(x)); return x; }

__device__ __forceinline__ int opaque_tid() { int t = threadIdx.x; asm volatile("" : "+v"(t)); return t; }
__device__ __forceinline__ int next_task(unsigned* ctr, LAS int* slot) {
    __syncthreads();
    if (threadIdx.x == 0) *slot = (int)atomicAdd(ctr, 1u);
    __syncthreads();
    return *slot;
}
#define QNEXT_BEGIN(ctr) unsigned qn_ = 0u; if (threadIdx.x == 0) qn_ = atomicAdd((ctr), 1u)
#define QNEXT_END(slot, t) do { __syncthreads(); if (threadIdx.x == 0) *(slot) = (int)qn_; __syncthreads(); (t) = *(slot); } while (0)
__device__ __forceinline__ int win_src_col(int n) { return n < 4352 ? n : (n < 8960 ? n + 16 : (n < 8976 ? n - 8960 + 4352 : -1)); }
__device__ __forceinline__ int mod_row(int tok) { return tok < NPT ? 0 : 1 + ((tok - NPT) >> 10); }

__device__ __forceinline__ void p0_mod_item(const Params& p, int item, LAS unsigned char* lds) {
    const int tid = opaque_tid(), lane = tid & 63, wave = tid >> 6, kq = lane >> 4, cq = lane & 15;
    const int l = item / 96, cb = item % 96;
    LAS float* sS = (LAS float*)lds;
    LAS float* sRed = sS + 3 * 2048;
    for (int e = tid; e < 3 * 2048; e += NTHREADS) { const int r = e >> 11, k = e & 2047; const float cv = r == 0 ? p.in[I_CCTX][k] : p.in[I_C][(r - 1) * 2048 + k]; sS[e] = siluf_(cv); }
    __syncthreads();
    const float* W = p.in[I_WADA] + (size_t)l * 2048 * 6144 + cb * 64 + 4 * cq;
    float4 a0 = {0, 0, 0, 0}, a1 = a0, a2 = a0;
#pragma unroll 16
    for (int i = 0; i < 64; ++i) { const int k = wave * 256 + i * 4 + kq; const float4 w = *(const float4*)(W + (size_t)k * 6144);
        const float s0 = sS[k], s1 = sS[2048 + k], s2 = sS[4096 + k];
        a0.x += s0 * w.x; a0.y += s0 * w.y; a0.z += s0 * w.z; a0.w += s0 * w.w;
        a1.x += s1 * w.x; a1.y += s1 * w.y; a1.z += s1 * w.z; a1.w += s1 * w.w;
        a2.x += s2 * w.x; a2.y += s2 * w.y; a2.z += s2 * w.z; a2.w += s2 * w.w; }
    float v[12] = {a0.x, a0.y, a0.z, a0.w, a1.x, a1.y, a1.z, a1.w, a2.x, a2.y, a2.z, a2.w};
#pragma unroll
    for (int i = 0; i < 12; ++i) { v[i] += __shfl_xor(v[i], 16); v[i] += __shfl_xor(v[i], 32); }
    if (kq == 0) {
#pragma unroll
        for (int r = 0; r < 3; ++r)
#pragma unroll
            for (int e = 0; e < 4; ++e) sRed[(wave * 3 + r) * 64 + 4 * cq + e] = v[r * 4 + e];
    }
    __syncthreads();
    if (tid < 192) { const int r = tid >> 6, c = tid & 63; float s = 0.f;
#pragma unroll
        for (int w = 0; w < 8; ++w) s += sRed[(w * 3 + r) * 64 + c];
        ((float*)(p.ws + WS_MOD))[(l * 3 + r) * 6144 + cb * 64 + c] = s + p.in[I_BADA][l * 6144 + cb * 64 + c]; }
}
template <bool MAPCOL> __device__ __forceinline__ void p0_transpose_item(const float* W, int N, int nblk, bf16_t* WT, LAS float* scr, int item, int lane) {
    const int kb = item / nblk, nb = item % nblk, k0 = 64 * kb, n0 = 32 * nb;
    const int n = n0 + (lane & 31); const int oc = MAPCOL ? win_src_col(n) : n;
    float tv[32];
    const float* wp = W + (size_t)(k0 + (lane >> 5)) * N + (oc >= 0 ? oc : 0);
#pragma unroll
    for (int i = 0; i < 32; ++i) tv[i] = wp[(size_t)(2 * i) * N];
#pragma unroll
    for (int i = 0; i < 32; ++i) scr[(2 * i + (lane >> 5)) * 33 + (lane & 31)] = oc >= 0 ? tv[i] : 0.f;
    LDS_FENCE();
    const int c = lane & 7;
#pragma unroll
    for (int j = 0; j < 4; ++j) { const int nn = (lane >> 3) + 8 * j; const LAS float* s = scr + (8 * c) * 33 + nn;
        u32x4v o; o.x = pk2(s[0 * 33], s[1 * 33]); o.y = pk2(s[2 * 33], s[3 * 33]); o.z = pk2(s[4 * 33], s[5 * 33]); o.w = pk2(s[6 * 33], s[7 * 33]);
        *(u32x4v*)(WT + (size_t)(n0 + nn) * 2048 + k0 + 8 * c) = o; }
    LDS_FENCE();
}
__device__ __forceinline__ void p0_phase(const Params& p, LAS unsigned char* lds, int rep) {
    const int tid = opaque_tid(), lane = tid & 63, wave = tid >> 6;
    unsigned* ctr = (unsigned*)(p.ws + WS_CTL) + 64 * 15 * rep;
    LAS int* slot = (LAS int*)(lds + LDS_SLOT);
    constexpr int NT_MOD = 192, NT_TR = 2816, NT_A = NT_MOD + 1 + NT_TR, NT_KC = 512, NT_VT = 512, NT_WU = 64, NT = NT_A + NT_KC + NT_VT + NT_WU;
    for (;;) {
        const int t = next_task(ctr, slot);
        if (t >= NT) break;
        if (t < NT_MOD) { p0_mod_item(p, t, lds); continue; }
        if (t == NT_MOD) {
            float* rope = (float*)(p.ws + WS_ROPE);
            for (int e = tid; e < 1024; e += NTHREADS) { const int pos = e >> 4, i = e & 15; const float inv = 1.0f / powf(10000.0f, (float)(2 * i) / 32.0f); const float ang = (float)pos * inv;
                rope[pos * 32 + i] = cosf(ang); rope[pos * 32 + 16 + i] = sinf(ang); }
            if (tid < 2) { const int l = tid; float d1 = 0.f, d2 = 0.f;
                for (int i = 0; i < 64; ++i) { d1 += p.in[I_LQ1][l * 64 + i] * p.in[I_LK1][l * 64 + i]; d2 += p.in[I_LQ2][l * 64 + i] * p.in[I_LK2][l * 64 + i]; }
                const float lam_init = 0.8f - 0.6f * expf(-0.3f * (float)l);
                ((float*)(p.ws + WS_LAM))[l] = expf(d1) - expf(d2) + lam_init; }
            continue;
        }
        if (t >= NT_A) {
            int u = t - NT_A;
            if (u < NT_KC) { const size_t o = ((size_t)u * 512 + tid) * 8; float x[8]; ld8f(p.in[I_CK] + o, x); *(u32x4v*)((bf16_t*)(p.ws + WS_KC) + o) = pack8(x); continue; }
            u -= NT_KC;
            if (u < NT_VT) { const int idx = u * 512 + tid, dv = idx & 127, m = (idx >> 7) & 63, bh = idx >> 13; float x[8];
#pragma unroll
                for (int e = 0; e < 8; ++e) x[e] = p.in[I_CV][((size_t)bh * 512 + 8 * m + e) * 128 + dv];
                *(u32x4v*)((bf16_t*)(p.ws + WS_VTC) + ((size_t)bh * 128 + dv) * 512 + 8 * m) = pack8(x); continue; }
            u -= NT_VT;
#pragma unroll
            for (int e = 0; e < 8; ++e) { const int f = u * 4096 + e * 512 + tid, c = f & 63, j = (f >> 6) & 63, h = (f >> 12) & 7, which = (f >> 15) & 1, ld = f >> 16;
                const float v = (which ? p.in[I_AUP] : p.in[I_WUP])[((size_t)ld * 64 + j) * 512 + h * 64 + c];
                ((bf16_t*)(p.ws + WS_WUPT))[(f & ~4095) + c * 64 + j] = f2bf(v); }
            continue;
        }
        int it = (t - NT_MOD - 1) * 8 + wave;
        LAS float* scr = (LAS float*)(lds + wave * 8704);
        const int l = it / 11264; it -= l * 11264;
        if (it < 9216) p0_transpose_item<true>(p.in[I_WIN] + (size_t)l * 2048 * PIN, PIN, 288, (bf16_t*)(p.ws + WS_WIN) + (size_t)l * NP * 2048, scr, it, lane);
        else p0_transpose_item<false>(p.in[I_WOUT] + (size_t)l * 2048 * 2048, 2048, 64, (bf16_t*)(p.ws + WS_WOUT) + (size_t)l * 2048 * 2048, scr, it - 9216, lane);
    }
}
__device__ __forceinline__ void modulate_row(const float* xrow, const float* mod, bf16_t* urow, int lane) {
#pragma unroll
    for (int j = 0; j < 4; ++j) { const int c = j * 512 + lane * 8; float x[8], sh[8], sc[8], o[8]; ld8f(xrow + c, x); ld8f(mod + c, sh); ld8f(mod + 2048 + c, sc);
#pragma unroll
        for (int e = 0; e < 8; ++e) o[e] = x[e] * (1.0f + sc[e]) + sh[e];
        *(u32x4v*)(urow + c) = pack8(o); }
}
__device__ __forceinline__ void p0b_phase(const Params& p) {
    const int tid_ = opaque_tid(); const int lane = tid_ & 63, gw = blockIdx.x * 8 + (tid_ >> 6), NGW = gridDim.x * 8;
    for (int tok = gw; tok < NTOK; tok += NGW) {
        const float* xrow = tok < NPT ? p.in[I_XP] + (size_t)tok * DM : p.in[I_XS] + (size_t)(tok - NPT) * DM;
        modulate_row(xrow, (const float*)(p.ws + WS_MOD) + mod_row(tok) * 6144, (bf16_t*)(p.ws + WS_UM) + (size_t)tok * DM, lane);
    }
}

struct EpiIn {
    static constexpr bool PERM = true, AFTER_DRAIN = false;
    bf16_t* proj; float* gates; float* newk; float* newv; const float* rope; int layer;
    __device__ __forceinline__ void operator()(const f32x4 (&acc)[2][2][4][2], const pg8::Unit& u, int wr, int wc, int fr, int fq) const {
        const int row0 = u.pm * 256 + wr * 64 + fr, col0 = u.pn * 256 + wc * 32 + 8 * fq;
        const bool samp = u.pm >= 32;
        const bool is_rope = samp && u.pn >= 19 && u.pn < 27;
        const bool is_k = !samp && u.pn >= 23 && u.pn < 27, is_v = !samp && u.pn >= 27 && u.pn < 31, is_g = u.pn == 35;
#pragma unroll
        for (int ai = 0; ai < 2; ++ai)
#pragma unroll
            for (int m = 0; m < 4; ++m) {
                const int row = row0 + ai * 128 + m * 16;
                float cs[8], sn[8];
                if (is_rope) { const int pos = (row - NPT) & 1023; const int pp = (wc & 1) ? (pos & 63) : (pos >> 6); const float* rp = rope + pp * 32 + 8 * (fq & 1); ld8f(rp, cs); ld8f(rp + 16, sn); }
#pragma unroll
                for (int bj = 0; bj < 2; ++bj) {
                    f32x4 v0 = acc[ai][bj][m][0], v1 = acc[ai][bj][m][1];
                    if (is_rope) {
                        const float sg = (fq & 2) ? 1.0f : -1.0f;
#pragma unroll
                        for (int e = 0; e < 4; ++e) { const float p0 = __shfl_xor(v0[e], 32), p1 = __shfl_xor(v1[e], 32);
                            v0[e] = v0[e] * cs[e] + sg * p0 * sn[e]; v1[e] = v1[e] * cs[4 + e] + sg * p1 * sn[4 + e]; }
                    }
                    const int col = col0 + bj * 128;
                    u32x4v w; w.x = pk2(v0[0], v0[1]); w.y = pk2(v0[2], v0[3]); w.z = pk2(v1[0], v1[1]); w.w = pk2(v1[2], v1[3]);
                    *(u32x4v*)(proj + (size_t)row * NP + col) = w;
                    if (is_k || is_v) { const int ck = col - (is_k ? C_K : C_V), h = ck >> 7, j = ck & 127, b = row >> 8, t = row & 255;
                        float* dst = (is_k ? newk : newv) + ((((size_t)(b * 2 + layer) * 8 + h) * 256 + t) * 128 + j);
                        *(f32x4*)dst = v0; *(f32x4*)(dst + 4) = v1; }
                    if (is_g && bj == 0 && wc == 0 && fq < 2) { float* dst = gates + (size_t)row * 16 + 8 * fq; *(f32x4*)dst = v0; *(f32x4*)(dst + 4) = v1; }
                }
            }
    }
};
struct EpiOut {
    static constexpr bool PERM = false, AFTER_DRAIN = false;
    const float* xp; const float* xs; const float* mod; float* y; int layer;
    __device__ __forceinline__ void operator()(const f32x4 (&acc)[2][2][4][2], const pg8::Unit& u, int wr, int wc, int fr, int fq) const {
        const int row0 = u.pm * 256 + wr * 64 + fr, col0 = u.pn * 256 + wc * 32 + 4 * fq;
#pragma unroll
        for (int ai = 0; ai < 2; ++ai)
#pragma unroll
            for (int m = 0; m < 4; ++m) {
                const int row = row0 + ai * 128 + m * 16;
                const float* xrow = layer == 0 ? (row < NPT ? xp + (size_t)row * DM : xs + (size_t)(row - NPT) * DM) : y + (size_t)row * DM;
                const float* g = mod + mod_row(row) * 6144 + 4096;
#pragma unroll
                for (int bj = 0; bj < 2; ++bj)
#pragma unroll
                    for (int n = 0; n < 2; ++n) { const int c = col0 + bj * 128 + n * 16;
                        const f32x4 xv = *(const f32x4*)(xrow + c), gv = *(const f32x4*)(g + c);
                        *(f32x4*)(y + (size_t)row * DM + c) = 1.41421356237f * xv + gv * acc[ai][bj][m][n]; }
            }
    }
};

#define XB_TMO      128
#define XB_XCNT(j)  (256  + 64 * (j))
#define XB_XSUB(j)  (1280 + 64 * (j))
#define XB_XGEN(j)  (2304 + 64 * (j))
#define XB_TOP      3328
#define XB_TOPGEN   3392
#define XCD_BAR_WORDS 3456
#define XB_SPIN_CAP (1u << 18)

__device__ __forceinline__ unsigned xb_ld(unsigned* p)              { return __hip_atomic_load(p, __ATOMIC_RELAXED, __HIP_MEMORY_SCOPE_AGENT); }
__device__ __forceinline__ unsigned xb_add(unsigned* p, unsigned v) { return __hip_atomic_fetch_add(p, v, __ATOMIC_RELAXED, __HIP_MEMORY_SCOPE_AGENT); }
__device__ __forceinline__ unsigned xb_xcc_id() { return (unsigned)__builtin_amdgcn_s_getreg((3 << 11) | 20) & 0xFu; }
#define XB_SPIN(cond, bar) do { unsigned _sp = 0; while (cond) { __builtin_amdgcn_s_sleep(1); \
    if ((++_sp & 255u) == 0u) { if (xb_ld(&(bar)[XB_TMO])) break; if (_sp > XB_SPIN_CAP) { atomicAdd(&(bar)[XB_TMO], 1u); break; } } } } while (0)

struct XcdBarrier {
    unsigned* bar; unsigned x;
    volatile LAS unsigned* st;
};

__device__ __forceinline__ XcdBarrier xcd_barrier_post(unsigned* bar, volatile LAS unsigned* st) {
    XcdBarrier b; b.bar = bar; b.x = xb_xcc_id(); b.st = st;
    if (threadIdx.x == 0) (void)xb_add(&bar[XB_XCNT(b.x)], 1u);
    return b;
}
__device__ __forceinline__ void xcd_barrier_complete(unsigned* bar, unsigned x, unsigned& nloc, unsigned& nx) {
    const unsigned G = gridDim.x * gridDim.y * gridDim.z;
    unsigned sum, cnt, mine, sp = 0u;
    for (;;) {
        sum = 0u; cnt = 0u; mine = 0u;
#pragma unroll
        for (unsigned j = 0; j < 16; ++j) { const unsigned c = xb_ld(&bar[XB_XCNT(j)]); sum += c; cnt += (c > 0u) ? 1u : 0u; mine = (j == x) ? c : mine; }
        if (sum == G) break;
        __builtin_amdgcn_s_sleep(1);
        if ((++sp & 255u) == 0u) { if (xb_ld(&bar[XB_TMO])) break; if (sp > XB_SPIN_CAP) { atomicAdd(&bar[XB_TMO], 1u); break; } }
    }
    nloc = mine > 0u ? mine : 1u; nx = cnt > 0u ? cnt : 1u;
}

__device__ __forceinline__ unsigned xb_xcc_id_v() { unsigned r; asm volatile("s_getreg_b32 %0, hwreg(20, 0, 4)" : "=s"(r)); return r & 0xFu; }
__device__ __forceinline__ void xcd_barrier(const XcdBarrier& b) {
    asm volatile("s_waitcnt vmcnt(0)" ::: "memory");
    __syncthreads();
    if (threadIdx.x == 0) {
        unsigned* bar = b.bar; const unsigned bx = xb_xcc_id_v();
        __builtin_amdgcn_s_waitcnt(0);
        unsigned nloc = b.st[0], nx = b.st[1];
        if (nloc == 0u) { xcd_barrier_complete(bar, bx, nloc, nx); b.st[0] = nloc; b.st[1] = nx; }
        const unsigned old = xb_add(&bar[XB_XSUB(bx)], 1u);
        const unsigned gen = old / nloc;
        if (old + 1u == (gen + 1u) * nloc) {
            __builtin_amdgcn_fence(__ATOMIC_RELEASE, "agent");
            asm volatile("s_waitcnt vmcnt(0)" ::: "memory");
            const unsigned og = xb_add(&bar[XB_TOP], 1u);
            const unsigned tg = og / nx;
            if (og + 1u == (tg + 1u) * nx) xb_add(&bar[XB_TOPGEN], 1u);
            else XB_SPIN(xb_ld(&bar[XB_TOPGEN]) == tg, bar);
            __builtin_amdgcn_fence(__ATOMIC_ACQUIRE, "agent");
            xb_add(&bar[XB_XGEN(bx)], 1u);
            asm volatile("s_waitcnt vmcnt(0)" ::: "memory");
        } else {
            XB_SPIN(xb_ld(&bar[XB_XGEN(bx)]) == gen, bar);
            __builtin_amdgcn_fence(__ATOMIC_ACQUIRE, "agent");
            asm volatile("s_waitcnt vmcnt(0)" ::: "memory");
        }
    }
    __syncthreads();
}


__device__ __forceinline__ void mlstm_task(const Params& p, int l, int s, int d, int h, LAS unsigned char* lds) {
    const int tid = opaque_tid(), lane = tid & 63, wave = tid >> 6, quad = lane >> 4, l15 = lane & 15;
    const int T = s < 32 ? 256 : 1024, tok0 = s < 32 ? s * 256 : NPT + (s - 32) * 1024, nch = T / 64;
    LAS bf16_t* sQ = (LAS bf16_t*)lds;
    LAS bf16_t* sK = sQ + 64 * 136;
    LAS bf16_t* sKt = sK + 64 * 136;
    LAS bf16_t* sVt = sKt + 128 * 72;
    LAS bf16_t* sP = sVt + 128 * 72;
    LAS bf16_t* sC = sP + 64 * 72;
    LAS float* sf = (LAS float*)(sC + 128 * 136);
    LAS float *sA = sf, *sB = sf + 64, *sPm = sf + 128, *sN = sf + 192, *sNq = sf + 320, *sPs = sf + 384;
    const bf16_t* proj = (const bf16_t*)(p.ws + WS_PROJ);
    const float* gates = (const float*)(p.ws + WS_GATES);
    float* hd = (float*)(p.ws + WS_HD) + (size_t)d * NTOK * 512;
    const float bi = p.in[I_BI][l * 8 + d * 4 + h], bfb = p.in[I_BF][l * 8 + d * 4 + h];
    f32x4 cacc[8];
    float m;
    float cw0[8], cw1[8], cw2[8], cbb[8];
    { const int g = tid & 31, ch = ((g >> 4) ? 512 : 0) + h * 128 + (g & 15) * 8; const float* cw = p.in[I_CBW] + (size_t)l * 3 * 1024 + ch;
        ld8f(cw, cw0); ld8f(cw + 1024, cw1); ld8f(cw + 2048, cw2); ld8f(p.in[I_CBB] + l * 1024 + ch, cbb); }
    __syncthreads();
    if (s >= 32) {
        const size_t sb = (((size_t)((s - 32) * 2 + l) * 2 + d) * 4 + h);
        const float* C0 = p.in[I_SMC] + sb * 128 * 128;
#pragma unroll
        for (int tn = 0; tn < 8; ++tn)
#pragma unroll
            for (int j = 0; j < 4; ++j) cacc[tn][j] = C0[(16 * wave + quad * 4 + j) * 128 + 16 * tn + l15];
        if (tid < 128) sN[tid] = p.in[I_SMN][sb * 128 + tid];
        m = p.in[I_SMM][sb];
    } else {
#pragma unroll
        for (int tn = 0; tn < 8; ++tn) cacc[tn] = (f32x4){0.f, 0.f, 0.f, 0.f};
        if (tid < 128) sN[tid] = 0.f;
        m = 0.f;
    }
#pragma unroll
    for (int tn = 0; tn < 8; ++tn)
#pragma unroll
        for (int j = 0; j < 4; ++j) sC[(16 * wave + quad * 4 + j) * 136 + 16 * tn + l15] = f2bf(cacc[tn][j]);

    float gi_n = 0.f, gf_n = 0.f;
    if (wave == 0) { const int tk = d == 0 ? tok0 + lane : tok0 + T - 1 - lane; gi_n = gates[(size_t)tk * 16 + d * 4 + h]; gf_n = gates[(size_t)tk * 16 + 8 + d * 4 + h]; }
    for (int c = 0; c < nch; ++c) {
        __syncthreads();
        if (wave == 0) {
            const float gi = gi_n + bi, gf = gf_n + bfb;
            if (c + 1 < nch) { const int ii = 64 * (c + 1) + lane; const int tk = d == 0 ? tok0 + ii : tok0 + T - 1 - ii; gi_n = gates[(size_t)tk * 16 + d * 4 + h]; gf_n = gates[(size_t)tk * 16 + 8 + d * 4 + h]; }
            const float lf = fminf(gf, 0.f) - log1pf(__expf(-fabsf(gf)));
            float b = lf;
#pragma unroll
            for (int off = 1; off < 64; off <<= 1) { const float t = __shfl_up(b, off); if (lane >= off) b += t; }
            const float a = gi - b; float pm = a;
#pragma unroll
            for (int off = 1; off < 64; off <<= 1) { const float t = __shfl_up(pm, off); if (lane >= off) pm = fmaxf(pm, t); }
            sB[lane] = b; sA[lane] = a; sPm[lane] = pm;
        }
        __syncthreads();
        const float mx = fmaxf(m, sPm[63]), bL = sB[63];
#pragma unroll
        for (int it = 0; it < 4; ++it) {
            const int idx = tid + 512 * it, i = idx >> 5, g = idx & 31, isK = g >> 4, j0 = (g & 15) * 8, ch = (isK ? 512 : 0) + h * 128 + j0;
            const int ii = 64 * c + i, pos = d == 0 ? ii : T - 1 - ii, tk = tok0 + pos;
            const bf16_t* src = proj + (size_t)tk * NP + B_Q + ch;
            float x0[8], x1[8], x2[8], y[8];
            unpack8(*(const u32x4v*)src, x1);
            unpack8(*(const u32x4v*)(pos > 0 ? src - NP : src), x0); unpack8(*(const u32x4v*)(pos < T - 1 ? src + NP : src), x2);
            const float m0 = pos > 0 ? 1.f : 0.f, m2 = pos < T - 1 ? 1.f : 0.f;
#pragma unroll
            for (int e = 0; e < 8; ++e) y[e] = siluf_(m0 * x0[e] * cw0[e] + x1[e] * cw1[e] + m2 * x2[e] * cw2[e] + cbb[e]);
            if (!isK) { *(LAS u32x4v*)(sQ + i * 136 + j0) = pack8(y); }
            else {
                const float wgi = __expf(sA[i] - mx);
#pragma unroll
                for (int e = 0; e < 8; ++e) y[e] *= 0.08838834764831845f;
                *(LAS u32x4v*)(sK + i * 136 + j0) = pack8(y);
#pragma unroll
                for (int e = 0; e < 8; ++e) sKt[(j0 + e) * 72 + (i ^ (8 * ((j0 >> 3) & 7)))] = f2bf(y[e] * wgi);
            }
        }
#pragma unroll
        for (int it = 0; it < 2; ++it) {
            const int idx = tid + 512 * it, i = idx >> 4, g = idx & 15;
            const int ii = 64 * c + i, tk = d == 0 ? tok0 + ii : tok0 + T - 1 - ii;
            const u32x4v w = *(const u32x4v*)(proj + (size_t)tk * NP + B_V + h * 128 + 8 * g);
            LAS bf16_t* dst = sVt + (8 * g) * 72 + (i ^ (8 * (g & 7)));
            dst[0] = (bf16_t)(w.x & 0xffff); dst[72] = (bf16_t)(w.x >> 16); dst[144] = (bf16_t)(w.y & 0xffff); dst[216] = (bf16_t)(w.y >> 16);
            dst[288] = (bf16_t)(w.z & 0xffff); dst[360] = (bf16_t)(w.z >> 16); dst[432] = (bf16_t)(w.w & 0xffff); dst[504] = (bf16_t)(w.w >> 16);
        }
        __syncthreads();
        const int tm = wave >> 1;
        {
            const int tn0 = (wave & 1) * 2;
#pragma unroll
            for (int tt = 0; tt < 2; ++tt) {
                f32x4 acc = {0.f, 0.f, 0.f, 0.f};
#pragma unroll
                for (int ks = 0; ks < 4; ++ks) acc = MFMA16(frag(sQ, 16 * tm, 136, 32 * ks, lane), frag(sK, 16 * (tn0 + tt), 136, 32 * ks, lane), acc);
                const int scol = 16 * (tn0 + tt) + l15; const float as = sA[scol];
#pragma unroll
                for (int j = 0; j < 4; ++j) { const int t = 16 * tm + quad * 4 + j;
                    float pv = scol <= t ? __expf(as - fmaxf(m, sPm[t])) * acc[j] : 0.f;
                    sP[t * 72 + scol] = f2bf(pv);
                    pv = red16_sum(pv);
                    if (l15 == 0) sPs[t * 4 + tn0 + tt] = pv; }
            }
        }
        const int tnb = (wave & 1) * 4;
        f32x4 accq[4];
#pragma unroll
        for (int tt = 0; tt < 4; ++tt) { accq[tt] = (f32x4){0.f, 0.f, 0.f, 0.f};
#pragma unroll
            for (int ks = 0; ks < 4; ++ks) accq[tt] = MFMA16(frag(sQ, 16 * tm, 136, 32 * ks, lane), frag(sC, 16 * (tnb + tt), 136, 32 * ks, lane), accq[tt]); }
        { const int t = tid >> 3, part = tid & 7; float sacc = 0.f;
#pragma unroll
            for (int e = 0; e < 16; ++e) sacc += sN[16 * part + e] * bf2f(sQ[t * 136 + 16 * part + e]);
            sacc += __shfl_xor(sacc, 1); sacc += __shfl_xor(sacc, 2); sacc += __shfl_xor(sacc, 4);
            if (part == 0) sNq[t] = sacc; }
        __syncthreads();
        {
            f32x4 accp[4];
#pragma unroll
            for (int tt = 0; tt < 4; ++tt) { accp[tt] = (f32x4){0.f, 0.f, 0.f, 0.f};
#pragma unroll
                for (int ks = 0; ks < 2; ++ks) accp[tt] = MFMA16(frag(sP, 16 * tm, 72, 32 * ks, lane), fragsw(sVt, 16 * (tnb + tt), 32 * ks, lane), accp[tt]); }
#pragma unroll
            for (int j = 0; j < 4; ++j) { const int t = 16 * tm + quad * 4 + j;
                const float mtm = fmaxf(m, sPm[t]), wi = __expf(m - mtm);
                const float den = wi * sNq[t] + ((sPs[t * 4] + sPs[t * 4 + 1]) + (sPs[t * 4 + 2] + sPs[t * 4 + 3]));
                const float mt = sB[t] + mtm; const float inv = 1.0f / fmaxf(fabsf(den), __expf(-mt));
                const int ii = 64 * c + t, tk = d == 0 ? tok0 + ii : tok0 + T - 1 - ii;
                float* dst = hd + (size_t)tk * 512 + h * 128 + 16 * tnb + l15;
#pragma unroll
                for (int tt = 0; tt < 4; ++tt) dst[16 * tt] = (wi * accq[tt][j] + accp[tt][j]) * inv; }
        }
        const float sc = __expf(m - mx);
        if (tid < 128) { float ns = 0.f;
#pragma unroll 8
            for (int e = 0; e < 64; ++e) ns += bf2f(sKt[tid * 72 + e]);
            sN[tid] = sc * sN[tid] + ns; }
#pragma unroll
        for (int tn = 0; tn < 8; ++tn) { f32x4 dc = {0.f, 0.f, 0.f, 0.f};
#pragma unroll
            for (int ks = 0; ks < 2; ++ks) dc = MFMA16(fragsw(sVt, 16 * wave, 32 * ks, lane), fragsw(sKt, 16 * tn, 32 * ks, lane), dc);
            cacc[tn] = sc * cacc[tn] + dc;
#pragma unroll
            for (int j = 0; j < 4; ++j) sC[(16 * wave + quad * 4 + j) * 136 + 16 * tn + l15] = f2bf(cacc[tn][j]); }
        m = bL + mx;
    }
    __syncthreads();
    if (s < 32) {
        const size_t sb = (((size_t)(s * 2 + l) * 2 + d) * 4 + h);
        float* Co = p.out + O_MC + sb * 128 * 128;
#pragma unroll
        for (int tn = 0; tn < 8; ++tn)
#pragma unroll
            for (int j = 0; j < 4; ++j) Co[(16 * wave + quad * 4 + j) * 128 + 16 * tn + l15] = cacc[tn][j];
        if (tid < 128) p.out[O_MN + sb * 128 + tid] = sN[tid];
        if (tid == 0) p.out[O_MM + sb] = m;
    }
}

__device__ __forceinline__ void attn_task(const Params& p, int l, int task, LAS unsigned char* lds) {
    const int tid = opaque_tid(), lane = tid & 63, wave = tid >> 6, quad = lane >> 4, l15 = lane & 15;
    const bool samp = task < 128;
    int b, h, qb;
    if (samp) { b = task >> 6; h = (task >> 3) & 7; qb = task & 7; } else { const int t2 = task - 128; b = t2 >> 4; h = (t2 >> 1) & 7; qb = t2 & 1; }
    const int tok0 = samp ? NPT + b * 1024 : b * 256, nkt = samp ? 24 : 4, nct = samp ? 8 : 0;
    LAS bf16_t* sK = (LAS bf16_t*)lds;
    LAS bf16_t* sVt = sK + 64 * 136;
    LAS bf16_t* sPw = sVt + 128 * 72 + wave * (16 * 72);
    const bf16_t* proj = (const bf16_t*)(p.ws + WS_PROJ);
    const bf16_t* ck = (const bf16_t*)(p.ws + WS_KC) + (((unsigned)(b * 2 + l) * 8 + h) * 512) * 128;
    const bf16_t* cv = (const bf16_t*)(p.ws + WS_VTC) + (((unsigned)(b * 2 + l) * 8 + h) * 128) * 512;
    const float lam = ((const float*)(p.ws + WS_LAM))[l];
    const float lam_init = 0.8f - 0.6f * expf(-0.3f * (float)l);
    const int q0 = 128 * qb + 16 * wave;
    bf16x8 aq1[2], aq2[2];
    { const bf16_t* qp = proj + (unsigned)(tok0 + q0 + l15) * NP + C_Q + h * 128 + quad * 8;
        aq1[0] = *(const bf16x8*)qp; aq1[1] = *(const bf16x8*)(qp + 32); aq2[0] = *(const bf16x8*)(qp + 64); aq2[1] = *(const bf16x8*)(qp + 96); }
    float mx1 = -INFINITY, mx2 = -INFINITY, sm1 = 0.f, sm2 = 0.f, mc1 = 0.f, mc2 = 0.f;
    constexpr float CS = 0.125f * 1.4426950408889634f;
    f32x4 o1[8], o2[8];
#pragma unroll
    for (int tn = 0; tn < 8; ++tn) { o1[tn] = (f32x4){0.f, 0.f, 0.f, 0.f}; o2[tn] = o1[tn]; }
    u32x4v kreg[2], vreg[2];
#define ATT_LOAD(KT, PASS) do { int ktv = (KT); asm volatile("" : "+v"(ktv));     \
    _Pragma("unroll") for (int it = 0; it < 2; ++it) { const int idx = tid + 512 * it, i = idx >> 4, g = idx & 15; \
        if ((KT) < nct) { kreg[it] = *(const u32x4v*)(ck + (unsigned)((64 * ktv + i) * 128 + 8 * g)); \
            if ((PASS) == 1) { const int dv = idx >> 3, mm = idx & 7; vreg[it] = *(const u32x4v*)(cv + (unsigned)(dv * 512 + 64 * ktv + 8 * mm)); } } \
        else { kreg[it] = *(const u32x4v*)(proj + (unsigned)((tok0 + 64 * (ktv - nct) + i) * NP + C_K + h * 128 + 8 * g)); \
            if ((PASS) == 1) vreg[it] = *(const u32x4v*)(proj + (unsigned)((tok0 + 64 * (ktv - nct) + (idx & 63)) * NP + C_V + h * 128 + 8 * (idx >> 6))); } } } while (0)
#define ATT_LOADK(BUF, KT) do { int ktv = (KT); asm volatile("" : "+v"(ktv)); _Pragma("unroll") for (int it = 0; it < 2; ++it) { const int idx = tid + 512 * it, i = idx >> 4, g = idx & 15; \
        if ((KT) < nct) BUF[it] = *(const u32x4v*)(ck + (unsigned)((64 * ktv + i) * 128 + 8 * g)); \
        else BUF[it] = *(const u32x4v*)(proj + (unsigned)((tok0 + 64 * (ktv - nct) + i) * NP + C_K + h * 128 + 8 * g)); } } while (0)
#define ATT_P0TILE(BUF, KT) do { __syncthreads(); \
        _Pragma("unroll") for (int it = 0; it < 2; ++it) { const int idx = tid + 512 * it, i = idx >> 4, g = idx & 15; *(LAS u32x4v*)(sK + i * 136 + 8 * g) = BUF[it]; } \
        if ((KT) + 2 < nkt) ATT_LOADK(BUF, (KT) + 2); \
        __syncthreads(); \
        _Pragma("unroll") for (int tn = 0; tn < 4; ++tn) { f32x4 a_ = {0.f, 0.f, 0.f, 0.f}, b_ = a_; \
            _Pragma("unroll") for (int ks = 0; ks < 2; ++ks) { a_ = MFMA16(frag(sK, 16 * tn, 136, 32 * ks, lane), aq1[ks], a_); b_ = MFMA16(frag(sK, 16 * tn, 136, 64 + 32 * ks, lane), aq2[ks], b_); } \
            _Pragma("unroll") for (int j = 0; j < 4; ++j) { mx1 = fmaxf(mx1, a_[j]); mx2 = fmaxf(mx2, b_[j]); } } } while (0)
    ATT_LOADK(kreg, 0); ATT_LOADK(vreg, 1);
    for (int kt = 0; kt < nkt; kt += 2) { ATT_P0TILE(kreg, kt); ATT_P0TILE(vreg, kt + 1); }
#undef ATT_LOADK
#undef ATT_P0TILE
    mx1 = fmaxf(mx1, __shfl_xor(mx1, 16)); mx1 = fmaxf(mx1, __shfl_xor(mx1, 32)); mx2 = fmaxf(mx2, __shfl_xor(mx2, 16)); mx2 = fmaxf(mx2, __shfl_xor(mx2, 32)); mc1 = mx1 * CS; mc2 = mx2 * CS;
    for (int pass = 1; pass < 2; ++pass) {
        ATT_LOAD(0, pass);
        for (int kt = 0; kt < nkt; ++kt) {
            __syncthreads();
#pragma unroll
            for (int it = 0; it < 2; ++it) {
                const int idx = tid + 512 * it, i = idx >> 4, g = idx & 15;
                *(LAS u32x4v*)(sK + i * 136 + 8 * g) = kreg[it];
                if (pass == 1) {
                    if (kt < nct) { const int dv = idx >> 3, mm = idx & 7; *(LAS u32x4v*)(sVt + dv * 72 + 8 * mm) = vreg[it]; }
                    else { const u32x4v w = vreg[it]; LAS bf16_t* dst = sVt + (8 * (idx >> 6)) * 72 + (idx & 63);
                        dst[0] = (bf16_t)(w.x & 0xffff); dst[72] = (bf16_t)(w.x >> 16); dst[144] = (bf16_t)(w.y & 0xffff); dst[216] = (bf16_t)(w.y >> 16);
                        dst[288] = (bf16_t)(w.z & 0xffff); dst[360] = (bf16_t)(w.z >> 16); dst[432] = (bf16_t)(w.w & 0xffff); dst[504] = (bf16_t)(w.w >> 16); }
                }
            }
            if (kt + 1 < nkt) ATT_LOAD(kt + 1, pass);
            __syncthreads();
#pragma unroll
            for (int bb = 0; bb < 2; ++bb) {
                f32x4 s1[2], s2[2];
#pragma unroll
                for (int t = 0; t < 2; ++t) { s1[t] = (f32x4){0.f, 0.f, 0.f, 0.f}; s2[t] = s1[t];
#pragma unroll
                    for (int ks = 0; ks < 2; ++ks) { s1[t] = MFMA16(frag(sK, 32 * bb + 16 * t, 136, 32 * ks, lane), aq1[ks], s1[t]); s2[t] = MFMA16(frag(sK, 32 * bb + 16 * t, 136, 64 + 32 * ks, lane), aq2[ks], s2[t]); } }
                if (pass == 0) {
#pragma unroll
                    for (int t = 0; t < 2; ++t)
#pragma unroll
                        for (int j = 0; j < 4; ++j) { mx1 = fmaxf(mx1, s1[t][j]); mx2 = fmaxf(mx2, s2[t][j]); }
                } else {
                    bf16x8 pa1, pa2;
                    { float p1[8];
#pragma unroll
                        for (int jj = 0; jj < 8; ++jj) { p1[jj] = __builtin_amdgcn_exp2f(s1[jj >> 2][jj & 3] * CS - mc1); sm1 += p1[jj]; }
                        pa1 = __builtin_bit_cast(bf16x8, pack8(p1)); }
                    { float p2[8];
#pragma unroll
                        for (int jj = 0; jj < 8; ++jj) { p2[jj] = __builtin_amdgcn_exp2f(s2[jj >> 2][jj & 3] * CS - mc2); sm2 += p2[jj]; }
                        pa2 = __builtin_bit_cast(bf16x8, pack8(p2)); }
#pragma unroll
                    for (int tn2 = 0; tn2 < 8; ++tn2) { const LAS bf16_t* vrow = sVt + (16 * tn2 + l15) * 72 + 32 * bb + quad * 4;
                        const u32x2v lo = *(const LAS u32x2v*)vrow, hi = *(const LAS u32x2v*)(vrow + 16);
                        u32x4v vw; vw.x = lo.x; vw.y = lo.y; vw.z = hi.x; vw.w = hi.y;
                        const bf16x8 vb = __builtin_bit_cast(bf16x8, vw);
                        o1[tn2] = MFMA16(pa1, vb, o1[tn2]); o2[tn2] = MFMA16(pa2, vb, o2[tn2]); }
                }
                asm volatile("" ::: "memory");
            }
        }
        if (pass == 0) { mx1 = fmaxf(mx1, __shfl_xor(mx1, 16)); mx1 = fmaxf(mx1, __shfl_xor(mx1, 32)); mx2 = fmaxf(mx2, __shfl_xor(mx2, 16)); mx2 = fmaxf(mx2, __shfl_xor(mx2, 32)); mc1 = mx1 * CS; mc2 = mx2 * CS; }
    }
    sm1 += __shfl_xor(sm1, 16); sm1 += __shfl_xor(sm1, 32); sm2 += __shfl_xor(sm2, 16); sm2 += __shfl_xor(sm2, 32);
    const float il1 = 1.0f / sm1, il2 = lam / sm2;
    float f1[4], f2[4];
#pragma unroll
    for (int j = 0; j < 4; ++j) { f1[j] = __shfl(il1, quad * 4 + j); f2[j] = __shfl(il2, quad * 4 + j); }
#pragma unroll
    for (int tn = 0; tn < 8; ++tn)
#pragma unroll
        for (int j = 0; j < 4; ++j) o1[tn][j] = o1[tn][j] * f1[j] - o2[tn][j] * f2[j];
    asm volatile("" ::: "memory");
#define oacc o1
#undef ATT_LOAD
    bf16_t* mixed = (bf16_t*)(p.ws + WS_UM);
    const float* sg = p.in[I_SUBG] + l * 128;
#pragma unroll
    for (int j = 0; j < 4; ++j) {
        float ss = 0.f;
#pragma unroll
        for (int tn = 0; tn < 8; ++tn) ss += oacc[tn][j] * oacc[tn][j];
        ss = red16_sum(ss);
        const float r = rsqrtf(ss * (1.0f / 128.0f) + 1e-5f) * (1.0f - lam_init);
        const int tq = tok0 + q0 + quad * 4 + j;
#pragma unroll
        for (int tn = 0; tn < 8; ++tn) { const int dv = 16 * tn + l15;
            const float gt = bf2f(proj[(unsigned)tq * NP + C_G + h * 128 + dv]);
            mixed[(unsigned)tq * DM + 1024 + h * 128 + dv] = f2bf(oacc[tn][j] * r * sg[dv] * siluf_(gt)); }
    }
}

#undef oacc
__device__ __forceinline__ void rwkv_prep_task(const Params& p, int l, int task, LAS unsigned char* lds) {
    const int tid = opaque_tid(), lane = tid & 63, wave = tid >> 6, quad = lane >> 4, l15 = lane & 15;
    const int tile = task >> 3, h = task & 7, tb = 64 * tile;
    const int T = tb < NPT ? 256 : 1024, seq0 = tb < NPT ? (tb & ~255) : NPT + ((tb - NPT) & ~1023);
    LAS bf16_t* sTW = (LAS bf16_t*)lds;
    LAS bf16_t* sAD = sTW + 2 * 64 * 72;
    LAS bf16_t* sWup = sAD + 2 * 64 * 72;
    LAS bf16_t* sAup = sWup + 2 * 64 * 72;
    LAS float* sR = (LAS float*)(sAup + 2 * 64 * 72);
    LAS float* sKf = sR + 4096; LAS float* sVf = sKf + 4096; LAS float* sNrm = sVf + 4096; LAS float* sRK = sNrm + 64;
    const bf16_t* proj = (const bf16_t*)(p.ws + WS_PROJ);
    __syncthreads();
#pragma unroll
    for (int it = 0; it < 4; ++it) {
        const int idx = tid + 512 * it, arr = idx >> 9, i = (idx >> 3) & 63, g = idx & 7;
        const u32x4v w = *(const u32x4v*)(proj + (size_t)(tb + i) * NP + A_WD + 64 * arr + 8 * g);
        if (arr < 2) { float x[8]; unpack8(w, x);
#pragma unroll
            for (int e = 0; e < 8; ++e) x[e] = tanhf_(x[e]);
            *(LAS u32x4v*)(sTW + (arr * 64 + i) * 72 + 8 * g) = pack8(x); }
        else *(LAS u32x4v*)(sAD + ((arr - 2) * 64 + i) * 72 + 8 * g) = w;
    }
#pragma unroll
    for (int it = 0; it < 4; ++it) {
        const int dd2 = it >> 1, which = it & 1, c = tid >> 3, jg = tid & 7;
        const bf16_t* src = (const bf16_t*)(p.ws + WS_WUPT) + ((((size_t)(l * 2 + dd2) * 2 + which) * 8 + h) * 4096) + c * 64 + 8 * jg;
        *(LAS u32x4v*)((which ? sAup : sWup) + (dd2 * 64 + c) * 72 + 8 * jg) = *(const u32x4v*)src;
    }
#pragma unroll
    for (int it = 0; it < 3; ++it) {
        const int idx = tid + 512 * it, which = idx >> 9, i = (idx >> 3) & 63, g = idx & 7, ch = which * 512 + h * 64 + 8 * g;
        const int tk = tb + i, pos = tk - seq0;
        const bf16_t* src = proj + (size_t)tk * NP + ch;
        float x0[8], x1[8], x2[8], w0[8], w1[8], w2[8], bb[8];
        unpack8(*(const u32x4v*)src, x1);
        unpack8(*(const u32x4v*)(pos > 0 ? src - NP : src), x0); unpack8(*(const u32x4v*)(pos < T - 1 ? src + NP : src), x2);
        const float m0 = pos > 0 ? 1.f : 0.f, m2 = pos < T - 1 ? 1.f : 0.f;
        const float* cw = p.in[I_CAW] + (size_t)l * 3 * 1536 + ch;
        ld8f(cw, w0); ld8f(cw + 1536, w1); ld8f(cw + 3072, w2); ld8f(p.in[I_CAB] + l * 1536 + ch, bb);
        LAS float* dst = (which == 0 ? sR : (which == 1 ? sKf : sVf)) + i * 64 + 8 * g;
#pragma unroll
        for (int e = 0; e < 8; ++e) dst[e] = m0 * x0[e] * w0[e] + x1[e] * w1[e] + m2 * x2[e] * w2[e] + bb[e];
    }
    __syncthreads();
    { const int t = tid >> 3, part = tid & 7; float ss = 0.f;
#pragma unroll
        for (int e = 0; e < 8; ++e) { const float v = sKf[t * 64 + 8 * part + e] * p.in[I_KK][l * 512 + h * 64 + 8 * part + e]; ss += v * v; }
        ss += __shfl_xor(ss, 1); ss += __shfl_xor(ss, 2); ss += __shfl_xor(ss, 4);
        if (part == 0) sNrm[t] = rsqrtf(ss + 1e-12f); }
    const int dd = wave >> 2, tm = wave & 3;
    f32x4 aw[4], aa[4];
#pragma unroll
    for (int tn = 0; tn < 4; ++tn) { aw[tn] = (f32x4){0.f, 0.f, 0.f, 0.f}; aa[tn] = aw[tn];
#pragma unroll
        for (int ks = 0; ks < 2; ++ks) { aw[tn] = MFMA16(frag(sTW + dd * 64 * 72, 16 * tm, 72, 32 * ks, lane), frag(sWup + dd * 64 * 72, 16 * tn, 72, 32 * ks, lane), aw[tn]);
            aa[tn] = MFMA16(frag(sAD + dd * 64 * 72, 16 * tm, 72, 32 * ks, lane), frag(sAup + dd * 64 * 72, 16 * tn, 72, 32 * ks, lane), aa[tn]); } }
    __syncthreads();
    {
        LAS bf16_t* so = sTW + dd * (3 * 4096);
        float rk[4] = {0.f, 0.f, 0.f, 0.f};
#pragma unroll
        for (int tn = 0; tn < 4; ++tn) { const int c = 16 * tn + l15, ch = h * 64 + c;
            const float w0v = p.in[I_W0][(l * 2 + dd) * 512 + ch], a0v = p.in[I_A0][(l * 2 + dd) * 512 + ch], kav = p.in[I_KA][l * 512 + ch], kkv = p.in[I_KK][l * 512 + ch], rkv = p.in[I_RK][l * 512 + ch];
#pragma unroll
            for (int j = 0; j < 4; ++j) { const int t = 16 * tm + quad * 4 + j; const int o = t * 64 + c;
                const float z = w0v + aw[tn][j]; const float dec = __expf(-0.6065306597126334f * sigmoidf_(z));
                const float av = sigmoidf_(a0v + aa[tn][j]); const float kv = sKf[t * 64 + c];
                const float ktv = kv * (1.0f + (av - 1.0f) * kav); const float kk = kv * kkv * sNrm[t];
                so[o] = f2bf(ktv); so[4096 + o] = f2bf(kk * av); so[8192 + o] = f2bf(dec - 1.0f);
                rk[j] += sR[t * 64 + c] * ktv * rkv; } }
#pragma unroll
        for (int j = 0; j < 4; ++j) { const float s = red16_sum(rk[j]); if (l15 == 0) sRK[dd * 64 + 16 * tm + quad * 4 + j] = s; }
    }
    __syncthreads();
    { const int i = tid >> 3, g = tid & 7; const size_t o = (size_t)(tb + i) * 512 + h * 64 + 8 * g;
        float r[8], k[8], v[8], bn[8]; const float nr = sNrm[i], rks = sRK[i] + sRK[64 + i];
#pragma unroll
        for (int e = 0; e < 8; ++e) { r[e] = sR[i * 64 + 8 * g + e]; k[e] = sKf[i * 64 + 8 * g + e] * p.in[I_KK][l * 512 + h * 64 + 8 * g + e] * nr; v[e] = sVf[i * 64 + 8 * g + e]; bn[e] = rks * v[e]; }
        const size_t o2 = ((size_t)(tb + i) * 8 + h) * 320 + 8 * g; bf16_t* pk = (bf16_t*)(p.ws + WS_PK);
#pragma unroll
        for (int dd2 = 0; dd2 < 2; ++dd2)
#pragma unroll
            for (int ar = 0; ar < 3; ++ar) *(u32x4v*)(pk + (size_t)dd2 * NTOK * 2560 + o2 + 128 + 64 * ar) = *(const LAS u32x4v*)(sTW + dd2 * (3 * 4096) + ar * 4096 + i * 64 + 8 * g);
        const u32x4v rr = pack8(r), kk8 = pack8(k);
        *(u32x4v*)(pk + o2) = rr; *(u32x4v*)(pk + o2 + 64) = kk8; *(u32x4v*)(pk + (size_t)NTOK * 2560 + o2) = rr; *(u32x4v*)(pk + (size_t)NTOK * 2560 + o2 + 64) = kk8;
        *(u32x4v*)((bf16_t*)(p.ws + WS_SCV) + o) = pack8(v); *(u32x4v*)((bf16_t*)(p.ws + WS_SCBON) + o) = pack8(bn); }
}

__device__ __forceinline__ void m1_phase(const Params& p, int l, LAS unsigned char* lds, int rep, int mask) {
    unsigned* ctr = (unsigned*)(p.ws + WS_CTL) + 64 * (1 + 4 * l + 8 * rep);
    LAS int* slot = (LAS int*)(lds + LDS_SLOT);
#ifndef NO_MLSTM
    if (mask & 1) for (;;) { const int t = next_task(ctr, slot); if (t >= 272) break; const int u = t < 16 ? t + 256 : t - 16; mlstm_task(p, l, u >> 3, (u >> 2) & 1, u & 3, lds); }
#endif
#ifndef NO_ATTN
    if (mask & 2) for (;;) { const int t = next_task(ctr + 64, slot); if (t >= 640) break; attn_task(p, l, t, lds); }
#endif
#ifndef NO_PREP
    if (mask & 4) for (;;) { const int t = next_task(ctr + 128, slot); if (t >= 1280) break; rwkv_prep_task(p, l, t, lds); }
#endif
}

#ifdef EXP_LITE
#if EXP_LITE == 1
#define EXPY(v) (bf2f(sBt[(quad * 4 + j) * 24 + l15]) + bf2f(sGt[(16 + quad * 4 + j) * 24 + l15]) + sW[l15 + 16 * quad])
#elif EXP_LITE == 2
#define EXPY(v) (bf2f(sAt[(quad * 4 + j) * 72 + l15]) + bf2f(sX2[(quad * 4 + j) * 24 + l15]))
#else
#define EXPY(v) (bf2f(sPy[(quad * 4 + j) * 72 + 16 + l15]) + bf2f(sQy[(quad * 4 + j) * 24 + l15]))
#endif
#define EXPS(v) 0.f
#else
#define EXPY(v) (v)
#define EXPS(v) (v)
#endif
__device__ __forceinline__ bf16_t f2bf_sw(float f) { unsigned u = __float_as_uint(f); u += 0x7FFFu + ((u >> 16) & 1u); return (bf16_t)(u >> 16); }
__device__ __forceinline__ bf16x8 frag16(const LAS bf16_t* base, int row0, int ld, int lane) {
    bf16x8 z = {0, 0, 0, 0, 0, 0, 0, 0};
    if ((lane >> 4) < 2) z = *(const LAS bf16x8*)(base + (row0 + (lane & 15)) * ld + (lane >> 4) * 8);
    return z;
}
__device__ __forceinline__ void cp_task(const Params& p, int task, int lane, LAS unsigned char* wl) {
    int s, d, h, c, T;
    if (task < 8192) { s = task >> 8; d = (task >> 7) & 1; h = (task >> 4) & 7; c = task & 15; T = 256; }
    else { const int u = task - 8192; s = 32 + (u >> 10); d = (u >> 9) & 1; h = (u >> 6) & 7; c = u & 63; T = 1024; }
    const int tok0 = s < 32 ? s * 256 : NPT + (s - 32) * 1024, quad = lane >> 4, l15 = lane & 15;
    const long step = d == 0 ? 1 : -1; const int tfirst = d == 0 ? tok0 + 16 * c : tok0 + T - 1 - 16 * c;
    bf16_t* pk = (bf16_t*)(p.ws + WS_PK) + (size_t)d * NTOK * 2560 + ((size_t)tfirst * 8 + h) * 320;
    LAS bf16_t* sA = (LAS bf16_t*)wl;
    LAS bf16_t* sB = sA + 16 * 72, *sG = sB + 16 * 72, *sR = sG + 16 * 72;
    LAS float* mL1 = (LAS float*)(sR + 16 * 72);
    LAS bf16_t* sL2 = (LAS bf16_t*)(mL1 + 16 * 17);
    LAS bf16_t* sM1t = sL2 + 16 * 24;
    LAS bf16_t* sTt = sM1t + 16 * 24;
    LAS bf16_t* sAtil = sTt + 16 * 24;
    LAS bf16_t* sX2 = sTt;
    LAS bf16_t* oAt = sB;
    LAS bf16_t* oPy = sG;
    LAS bf16_t* oX2 = (LAS bf16_t*)mL1;
    LAS bf16_t* oQy = sL2;
    float bt[16], gt[16], W = 1.0f;
    { const int k = lane;
        float rr[16], kk[16], kt[16], ka[16], wm[16];
#pragma unroll
        for (int i = 0; i < 16; ++i) { const bf16_t* rec = pk + step * 2560 * i + k; rr[i] = bf2f(rec[0]); kk[i] = bf2f(rec[64]); kt[i] = bf2f(rec[128]); ka[i] = bf2f(rec[192]); wm[i] = bf2f(rec[256]); }
#pragma unroll
        for (int i = 0; i < 16; ++i) { const float Wp = W; W = W + W * wm[i]; const float iw = __builtin_amdgcn_rcpf(W);
            sA[i * 72 + k] = f2bf(Wp * kk[i]); bt[i] = ka[i] * iw; gt[i] = kt[i] * iw; sB[i * 72 + k] = f2bf(bt[i]); sG[i * 72 + k] = f2bf(gt[i]); sR[i * 72 + k] = f2bf(W * rr[i]); } }
    LDS_FENCE();
    f32x4 m2acc;
    { f32x4 a1 = {0.f, 0.f, 0.f, 0.f}, a2 = a1, a3 = a1, a4 = a1;
#pragma unroll
        for (int ks = 0; ks < 2; ++ks) { const bf16x8 fb = frag(sB, 0, 72, 32 * ks, lane), fg = frag(sG, 0, 72, 32 * ks, lane), fa = frag(sA, 0, 72, 32 * ks, lane), fr = frag(sR, 0, 72, 32 * ks, lane);
            a1 = MFMA16(fb, fa, a1); a2 = MFMA16(fg, fa, a2); a3 = MFMA16(fb, fr, a3); a4 = MFMA16(fg, fr, a4); }
#pragma unroll
        for (int j = 0; j < 4; ++j) { const int i = quad * 4 + j, t = l15;
            mL1[i * 17 + t] = i < t ? a1[j] : 0.f; sL2[i * 24 + t] = f2bf(i < t ? a2[j] : 0.f); sM1t[t * 24 + i] = f2bf(i <= t ? a3[j] : 0.f); m2acc[j] = i <= t ? a4[j] : 0.f; } }
    LDS_FENCE();
    { float Tr[16];
#pragma unroll
        for (int t = 0; t < 16; ++t) { float acc = (l15 == t) ? 1.0f : 0.0f;
#pragma unroll
            for (int i = 0; i < t; ++i) acc -= Tr[i] * mL1[i * 17 + t];
            Tr[t] = acc; }
        if (quad == 0) {
#pragma unroll
            for (int t = 0; t < 16; ++t) sTt[t * 24 + l15] = f2bf(Tr[t]); } }
    LDS_FENCE();
    const bf16x8 ftt = frag16(sTt, 0, 24, lane);
#pragma unroll
    for (int kt2 = 0; kt2 < 4; ++kt2) {
        u32x4v aw = {0u, 0u, 0u, 0u};
        if (quad < 2) { const LAS bf16_t* col = sA + (quad * 8) * 72 + 16 * kt2 + l15;
            aw.x = (unsigned)col[0] | ((unsigned)col[72] << 16); aw.y = (unsigned)col[144] | ((unsigned)col[216] << 16); aw.z = (unsigned)col[288] | ((unsigned)col[360] << 16); aw.w = (unsigned)col[432] | ((unsigned)col[504] << 16); }
        f32x4 acc = {0.f, 0.f, 0.f, 0.f};
        acc = MFMA16(__builtin_bit_cast(bf16x8, aw), ftt, acc);
#pragma unroll
        for (int j = 0; j < 4; ++j) { const int k = 16 * kt2 + quad * 4 + j; const bf16_t v = f2bf_sw(acc[j]); sAtil[k * 24 + l15] = v; oAt[l15 * 72 + k] = v; }
    }
    { f32x4 acc = {0.f, 0.f, 0.f, 0.f};
        acc = MFMA16(frag16(sL2, 0, 24, lane), ftt, acc);
#pragma unroll
        for (int j = 0; j < 4; ++j) { const bf16_t v = f2bf_sw(acc[j]); sX2[(quad * 4 + j) * 24 + l15] = v; oX2[l15 * 24 + quad * 4 + j] = v; } }
    LDS_FENCE();
    const bf16x8 fm1 = frag16(sM1t, 0, 24, lane);
#pragma unroll
    for (int kt2 = 0; kt2 < 4; ++kt2) { f32x4 acc = {0.f, 0.f, 0.f, 0.f};
        acc = MFMA16(frag16(sAtil, 16 * kt2, 24, lane), fm1, acc);
#pragma unroll
        for (int j = 0; j < 4; ++j) { const int k = 16 * kt2 + quad * 4 + j; oPy[l15 * 72 + k] = f2bf(bf2f(sR[l15 * 72 + k]) - acc[j]); } }
    { f32x4 acc = {0.f, 0.f, 0.f, 0.f};
        acc = MFMA16(frag16(sX2, 0, 24, lane), fm1, acc);
#pragma unroll
        for (int j = 0; j < 4; ++j) oQy[l15 * 24 + quad * 4 + j] = f2bf(m2acc[j] - acc[j]); }
    LDS_FENCE();
    { float bb8[8]; const int k = lane; bf16_t* rec = pk + step * 2560 * (k >> 2);
#pragma unroll
        for (int hh = 0; hh < 2; ++hh) {
#pragma unroll
            for (int e = 0; e < 8; ++e) bb8[e] = bt[8 * hh + e];
            *(u32x4v*)(rec + 128 + (k & 3) * 16 + 8 * hh) = pack8(bb8);
#pragma unroll
            for (int e = 0; e < 8; ++e) bb8[e] = gt[8 * hh + e];
            *(u32x4v*)(rec + 192 + (k & 3) * 16 + 8 * hh) = pack8(bb8); }
        ((float*)(rec + 288))[k & 3] = W; }
#pragma unroll
    for (int it = 0; it < 2; ++it) { const int f = lane + 64 * it, t = f >> 3, q = f & 7; bf16_t* rec = pk + step * 2560 * t;
        *(u32x4v*)(rec + 8 * q) = *(const LAS u32x4v*)(oAt + t * 72 + 8 * q); *(u32x4v*)(rec + 64 + 8 * q) = *(const LAS u32x4v*)(oPy + t * 72 + 8 * q); }
    if (lane < 32) { const int t = lane >> 1, q = lane & 1; bf16_t* rec = pk + step * 2560 * t;
        *(u32x4v*)(rec + 256 + 8 * q) = *(const LAS u32x4v*)(oX2 + t * 24 + 8 * q); *(u32x4v*)(rec + 272 + 8 * q) = *(const LAS u32x4v*)(oQy + t * 24 + 8 * q); }
    LDS_FENCE();
}
constexpr int CP_LDS = 16 * 72 * 2 * 4 + 16 * 17 * 4 + (16 * 24 * 3 + 64 * 24 + 16 * 24) * 2 + 16 * 72 * 2 * 2 + 16 * 24 * 2 * 2;

__device__ __forceinline__ void ap_task(const Params& p, int l, int task, int lane, LAS unsigned char* wl) {
    int s, d, h, rt;
    if (task < 128) { s = 32 + (task >> 6); d = (task >> 5) & 1; h = (task >> 2) & 7; rt = task & 3; }
    else { const int u = task - 128; s = u >> 6; d = (u >> 5) & 1; h = (u >> 2) & 7; rt = u & 3; }
    const int T = s < 32 ? 256 : 1024, nch = T / 16, tok0 = s < 32 ? s * 256 : NPT + (s - 32) * 1024, quad = lane >> 4, l15 = lane & 15;
    const long step = d == 0 ? 1 : -1; const int tstart = d == 0 ? tok0 : tok0 + T - 1;
    const bf16_t* pk = (const bf16_t*)(p.ws + WS_PK) + (size_t)d * NTOK * 2560 + ((size_t)tstart * 8 + h) * 320;
    const bf16_t* pv = (const bf16_t*)(p.ws + WS_SCV) + (size_t)tstart * 512 + h * 64 + 16 * rt;
    float* yd = (float*)(p.ws + WS_YD) + (size_t)d * NTOK * 512 + (size_t)tstart * 512 + h * 64 + 16 * rt;
    constexpr int IS = 328;
    LAS bf16_t* img = (LAS bf16_t*)wl;
    LAS bf16_t* sS = img + 16 * IS;
    LAS bf16_t* sCm = sS + 16 * 72;
    f32x4 S[4];
    if (s >= 32) { const float* s0 = p.in[I_SRW] + ((((size_t)((s - 32) * 2 + l) * 2 + d) * 8 + h) * 64 + 16 * rt) * 64;
#pragma unroll
        for (int tn = 0; tn < 4; ++tn)
#pragma unroll
            for (int j = 0; j < 4; ++j) S[tn][j] = s0[(quad * 4 + j) * 64 + 16 * tn + l15]; }
    else {
#pragma unroll
        for (int tn = 0; tn < 4; ++tn) S[tn] = (f32x4){0.f, 0.f, 0.f, 0.f}; }
    const bf16_t* gsrc = pk + step * 2560 * (lane >> 2) + 8 * (lane & 3);
    LAS bf16_t* ldst = img + (lane >> 2) * IS + 8 * (lane & 3);
    u32x4v rawA[10], rawB[10]; bf16_t vrA[8], vrB[8];
#define AP_LOAD(raw, vraw, CH) do { int chv = (CH); asm volatile("" : "+v"(chv)); const bf16_t* cb = gsrc + step * 2560 * (16 * chv); \
        _Pragma("unroll") for (int jj = 0; jj < 10; ++jj) raw[jj] = *(const u32x4v*)(cb + 32 * jj); \
        if (quad < 2) { _Pragma("unroll") for (int e = 0; e < 8; ++e) vraw[e] = pv[step * 512 * (16 * chv + quad * 8 + e) + l15]; } } while (0)
#define AP_STAGE(raw) do { _Pragma("unroll") for (int jj = 0; jj < 10; ++jj) *(LAS u32x4v*)(ldst + 32 * jj) = raw[jj]; } while (0)
    AP_LOAD(rawA, vrA, 0);
    if (nch > 1) AP_LOAD(rawB, vrB, 1);
    const LAS bf16_t* pBt = img + (l15 >> 2) * IS + 128 + (l15 & 3) * 16 + quad * 8;
    const LAS float* pW = (const LAS float*)(img + (l15 >> 2) * IS + 288) + (l15 & 3);
#define AP_CHUNK(raw, vraw, CC) do { const int c = (CC); \
        AP_STAGE(raw); \
        u32x4v vw = {0u, 0u, 0u, 0u}; \
        if (quad < 2) { vw.x = (unsigned)vraw[0] | ((unsigned)vraw[1] << 16); vw.y = (unsigned)vraw[2] | ((unsigned)vraw[3] << 16); vw.z = (unsigned)vraw[4] | ((unsigned)vraw[5] << 16); vw.w = (unsigned)vraw[6] | ((unsigned)vraw[7] << 16); } \
        asm volatile("" : "+v"(vw)); \
        if (c + 2 < nch) AP_LOAD(raw, vraw, c + 2); \
        ap_compute(c, vw); } while (0)
    auto ap_compute = [&](int c, u32x4v vw) {
        const bf16x8 va = __builtin_bit_cast(bf16x8, vw);
#pragma unroll
        for (int tn = 0; tn < 4; ++tn) { const unsigned w01 = pk2(S[tn][0], S[tn][1]), w23 = pk2(S[tn][2], S[tn][3]); LAS bf16_t* ds = sS + (quad * 4) * 72 + 16 * tn + l15;
            ds[0] = (bf16_t)(w01 & 0xffff); ds[72] = (bf16_t)(w01 >> 16); ds[144] = (bf16_t)(w23 & 0xffff); ds[216] = (bf16_t)(w23 >> 16); }
        LDS_FENCE();
        f32x4 cm = {0.f, 0.f, 0.f, 0.f}, yy = {0.f, 0.f, 0.f, 0.f};
#pragma unroll
        for (int ks = 0; ks < 2; ++ks) { const bf16x8 fs = frag(sS, 0, 72, 32 * ks, lane); cm = MFMA16(fs, frag(img, 0, IS, 32 * ks, lane), cm); yy = MFMA16(fs, frag(img + 64, 0, IS, 32 * ks, lane), yy); }
        cm = MFMA16(va, frag16(img + 256, 0, IS, lane), cm); yy = MFMA16(va, frag16(img + 272, 0, IS, lane), yy);
#pragma unroll
        for (int j = 0; j < 4; ++j) { yd[step * 512 * (16 * c + l15) + quad * 4 + j] = yy[j]; sCm[(quad * 4 + j) * 24 + l15] = f2bf_sw(cm[j]); }
        LDS_FENCE();
        const bf16x8 fc = frag16(sCm, 0, 24, lane);
#pragma unroll
        for (int tn = 0; tn < 4; ++tn) { f32x4 ab = {0.f, 0.f, 0.f, 0.f}, ag = ab;
            bf16x8 fb = {0, 0, 0, 0, 0, 0, 0, 0}, fg = fb;
            if (quad < 2) { fb = *(const LAS bf16x8*)(pBt + tn * 4 * IS); fg = *(const LAS bf16x8*)(pBt + tn * 4 * IS + 64); }
            ab = MFMA16(fc, fb, ab); ag = MFMA16(va, fg, ag);
            const float w16 = pW[tn * 2 * IS];
#pragma unroll
            for (int j = 0; j < 4; ++j) S[tn][j] = (S[tn][j] - ab[j] + ag[j]) * w16; }
        LDS_FENCE();
    };
    for (int c2 = 0; c2 < nch; c2 += 2) { AP_CHUNK(rawA, vrA, c2); AP_CHUNK(rawB, vrB, c2 + 1); }
#undef AP_CHUNK
#undef AP_LOAD
#undef AP_STAGE
    if (s < 32) { float* so = p.out + O_RW + ((((size_t)(s * 2 + l) * 2 + d) * 8 + h) * 64 + 16 * rt) * 64;
#pragma unroll
        for (int tn = 0; tn < 4; ++tn)
#pragma unroll
            for (int j = 0; j < 4; ++j) so[(quad * 4 + j) * 64 + 16 * tn + l15] = S[tn][j]; }
}
constexpr int AP_LDS = (16 * 72 * 2 + 64 * 24 * 2 + 16 * 24 * 2) * 2 + 64 * 4 + (16 * 72 + 16 * 24) * 2;

typedef float f32x2 __attribute__((ext_vector_type(2)));
__device__ __forceinline__ void m2_phase(const Params& p, int l, int rep, LAS unsigned char* lds, const XcdBarrier& xbar) {
    const int tid_ = opaque_tid(); const int lane = tid_ & 63, wave = tid_ >> 6;
    LAS unsigned char* wl = lds + wave * 16384;
    const int G = gridDim.x, b = blockIdx.x, slot = b * 8 + wave, NW = G * 8;
    for (int t = slot; t < 2048; t += NW) cp_task(p, 8192 + t, lane, wl);
    xcd_barrier(xbar);
    const bool chain_wave = wave == 0 && b < 128;
    if (chain_wave) { for (int t = b; t < 128; t += G) ap_task(p, l, t, lane, wl); }
    else { const int nchain = G < 128 ? G : 128;
        const int idx = b < nchain ? b * 7 + (wave - 1) : nchain * 7 + (b - nchain) * 8 + wave;
        for (int t = idx; t < 8192; t += NW - nchain) cp_task(p, t, lane, wl); }
    xcd_barrier(xbar);
    for (int t = slot; t < 2048; t += NW) ap_task(p, l, 128 + t, lane, wl);
}

__device__ __forceinline__ void m3_phase(const Params& p, int l) {
    const int tid_ = opaque_tid(); const int lane = tid_ & 63, gw = blockIdx.x * 8 + (tid_ >> 6), NGW = gridDim.x * 8;
    const bf16_t* proj = (const bf16_t*)(p.ws + WS_PROJ);
    bf16_t* mixed = (bf16_t*)(p.ws + WS_UM);
    const int c = lane * 8;
    for (int tok = gw; tok < NTOK; tok += NGW) {
        const size_t o = (size_t)tok * 512 + c;
        {
            float y0[8], y1[8], g[8], bb[8], bn[8], gt[8], out[8];
            ld8f((const float*)(p.ws + WS_YD) + o, y0); ld8f((const float*)(p.ws + WS_YD) + (size_t)NTOK * 512 + o, y1);
            float s = 0.f;
#pragma unroll
            for (int e = 0; e < 8; ++e) { y0[e] += y1[e]; s += y0[e]; }
            s += __shfl_xor(s, 1); s += __shfl_xor(s, 2); s += __shfl_xor(s, 4);
            const float mu = s * (1.0f / 64.0f); float q = 0.f;
#pragma unroll
            for (int e = 0; e < 8; ++e) { y0[e] -= mu; q += y0[e] * y0[e]; }
            q += __shfl_xor(q, 1); q += __shfl_xor(q, 2); q += __shfl_xor(q, 4);
            const float rs = rsqrtf(q * (1.0f / 64.0f) + 64e-5f);
            ld8f(p.in[I_RGG] + l * 512 + c, g); ld8f(p.in[I_RGB] + l * 512 + c, bb);
            unpack8(*(const u32x4v*)((const bf16_t*)(p.ws + WS_SCBON) + o), bn);
            unpack8(*(const u32x4v*)(proj + (size_t)tok * NP + A_GATE + c), gt);
#pragma unroll
            for (int e = 0; e < 8; ++e) out[e] = (y0[e] * rs * g[e] + bb[e] + bn[e]) * siluf_(gt[e]);
            *(u32x4v*)(mixed + (size_t)tok * DM + c) = pack8(out);
        }
        {
            float h0[8], h1[8], g[8], bb[8], og[8], gt[8], out[8];
            ld8f((const float*)(p.ws + WS_HD) + o, h0); ld8f((const float*)(p.ws + WS_HD) + (size_t)NTOK * 512 + o, h1);
            unpack8(*(const u32x4v*)(proj + (size_t)tok * NP + B_O + c), og);
            float s = 0.f;
#pragma unroll
            for (int e = 0; e < 8; ++e) { h0[e] = (h0[e] + h1[e]) * sigmoidf_(og[e]); s += h0[e]; }
            s += __shfl_xor(s, 1); s += __shfl_xor(s, 2); s += __shfl_xor(s, 4); s += __shfl_xor(s, 8);
            const float mu = s * (1.0f / 128.0f); float q = 0.f;
#pragma unroll
            for (int e = 0; e < 8; ++e) { h0[e] -= mu; q += h0[e] * h0[e]; }
            q += __shfl_xor(q, 1); q += __shfl_xor(q, 2); q += __shfl_xor(q, 4); q += __shfl_xor(q, 8);
            const float rs = rsqrtf(q * (1.0f / 128.0f) + 1e-5f);
            ld8f(p.in[I_MGG] + l * 512 + c, g); ld8f(p.in[I_MGB] + l * 512 + c, bb);
            unpack8(*(const u32x4v*)(proj + (size_t)tok * NP + B_GATE + c), gt);
#pragma unroll
            for (int e = 0; e < 8; ++e) out[e] = (h0[e] * rs * g[e] + bb[e]) * siluf_(gt[e]);
            *(u32x4v*)(mixed + (size_t)tok * DM + 512 + c) = pack8(out);
        }
    }
}

__device__ __forceinline__ void ln_phase(const Params& p, int l) {
    const int tid_ = opaque_tid(); const int lane = tid_ & 63, gw = blockIdx.x * 8 + (tid_ >> 6), NGW = gridDim.x * 8;
    for (int tok0 = gw; tok0 < NTOK; tok0 += 2 * NGW) {
        const int tok1 = tok0 + NGW; const bool has1 = tok1 < NTOK;
        float* zr0 = p.out + O_Y + (size_t)tok0 * DM; float* zr1 = p.out + O_Y + (size_t)(has1 ? tok1 : tok0) * DM;
        float v0[4][8], v1[4][8]; float s0 = 0.f, s1 = 0.f;
#pragma unroll
        for (int j = 0; j < 4; ++j) { ld8f(zr0 + j * 512 + lane * 8, v0[j]); ld8f(zr1 + j * 512 + lane * 8, v1[j]); }
#pragma unroll
        for (int j = 0; j < 4; ++j)
#pragma unroll
            for (int e = 0; e < 8; ++e) { s0 += v0[j][e]; s1 += v1[j][e]; }
#pragma unroll
        for (int o = 1; o < 64; o <<= 1) { s0 += __shfl_xor(s0, o); s1 += __shfl_xor(s1, o); }
        const float mu0 = s0 * (1.0f / 2048.0f), mu1 = s1 * (1.0f / 2048.0f); float q0 = 0.f, q1 = 0.f;
#pragma unroll
        for (int j = 0; j < 4; ++j)
#pragma unroll
            for (int e = 0; e < 8; ++e) { v0[j][e] -= mu0; q0 += v0[j][e] * v0[j][e]; v1[j][e] -= mu1; q1 += v1[j][e] * v1[j][e]; }
#pragma unroll
        for (int o = 1; o < 64; o <<= 1) { q0 += __shfl_xor(q0, o); q1 += __shfl_xor(q1, o); }
        const float rs0 = rsqrtf(q0 * (1.0f / 2048.0f) + 1e-5f), rs1 = rsqrtf(q1 * (1.0f / 2048.0f) + 1e-5f);
        const float* mod0 = (const float*)(p.ws + WS_MOD) + (size_t)(3 + mod_row(tok0)) * 6144;
        const float* mod1 = (const float*)(p.ws + WS_MOD) + (size_t)(3 + mod_row(has1 ? tok1 : tok0)) * 6144;
        bf16_t* ur0 = (bf16_t*)(p.ws + WS_UM) + (size_t)tok0 * DM; bf16_t* ur1 = (bf16_t*)(p.ws + WS_UM) + (size_t)(has1 ? tok1 : tok0) * DM;
#pragma unroll
        for (int j = 0; j < 4; ++j) { const int c = j * 512 + lane * 8; float g[8], bb[8], y0[8], y1[8];
            ld8f(p.in[I_LNG] + l * DM + c, g); ld8f(p.in[I_LNB] + l * DM + c, bb);
#pragma unroll
            for (int e = 0; e < 8; ++e) { y0[e] = v0[j][e] * rs0 * g[e] + bb[e]; y1[e] = v1[j][e] * rs1 * g[e] + bb[e]; }
            *(float4*)(zr0 + c) = make_float4(y0[0], y0[1], y0[2], y0[3]); *(float4*)(zr0 + c + 4) = make_float4(y0[4], y0[5], y0[6], y0[7]);
            if (has1) { *(float4*)(zr1 + c) = make_float4(y1[0], y1[1], y1[2], y1[3]); *(float4*)(zr1 + c + 4) = make_float4(y1[4], y1[5], y1[6], y1[7]); }
            if (l == 0) { float sh[8], sc[8], o[8]; ld8f(mod0 + c, sh); ld8f(mod0 + 2048 + c, sc);
#pragma unroll
                for (int e = 0; e < 8; ++e) o[e] = y0[e] * (1.0f + sc[e]) + sh[e];
                *(u32x4v*)(ur0 + c) = pack8(o);
                if (has1) { ld8f(mod1 + c, sh); ld8f(mod1 + 2048 + c, sc);
#pragma unroll
                    for (int e = 0; e < 8; ++e) o[e] = y1[e] * (1.0f + sc[e]) + sh[e];
                    *(u32x4v*)(ur1 + c) = pack8(o); } } }
    }
}

#ifndef DUP_P0B
#define DUP_P0B 0
#endif
#ifndef DUP_SYNC
#define DUP_SYNC 0
#endif
#ifndef DUP_M3
#define DUP_M3 0
#endif
#ifndef DUP_G2
#define DUP_G2 0
#endif
#ifndef DUP_P0
#define DUP_P0 0
#endif
#ifndef DUP_M1
#define DUP_M1 0
#endif
#ifndef DUP_M2
#define DUP_M2 0
#endif
#ifndef DUP_G1
#define DUP_G1 0
#endif
#ifndef DUP_MASK
#define DUP_MASK 7
#endif
#ifndef PH_ALL
#define PH_ALL 1
#endif
#ifndef PH_P0
#define PH_P0 PH_ALL
#endif
#ifndef PH_G1
#define PH_G1 PH_ALL
#endif
#ifndef PH_M1
#define PH_M1 PH_ALL
#endif
#ifndef PH_M2
#define PH_M2 PH_ALL
#endif
#ifndef PH_M3
#define PH_M3 PH_ALL
#endif
#ifndef PH_G2
#define PH_G2 PH_ALL
#endif
#ifndef PH_LN
#define PH_LN PH_ALL
#endif
__global__ void __launch_bounds__(NTHREADS) hybrid_fwd(Params p) {
    extern __shared__ __attribute__((aligned(16))) unsigned char smem[];
    LAS unsigned char* lds = (LAS unsigned char*)smem;
    cg::grid_group grid = cg::this_grid();
    volatile LAS unsigned* xst = (volatile LAS unsigned*)(lds + LDS_SLOT + 16);
    if (threadIdx.x == 0) { xst[0] = 0u; xst[1] = 0u; }
    __syncthreads();
    const XcdBarrier xbar = xcd_barrier_post((unsigned*)(p.ws + WS_BAR), xst);
#define GSYNC() xcd_barrier(xbar)
#if PH_P0
    for (int rep = 0; rep < 1 + DUP_P0; ++rep) { p0_phase(p, lds, rep); if (rep < DUP_P0) GSYNC(); }
#endif
    if (p.ws == nullptr) grid.sync();
    GSYNC();
#if PH_P0
    for (int rep = 0; rep < 1 + DUP_P0B; ++rep) p0b_phase(p);
#endif
    GSYNC();
    for (int i = 0; i < DUP_SYNC; ++i) GSYNC();
    for (int l = 0; l < 2; ++l) {
#if PH_G1
        for (int rep = 0; rep < 1 + DUP_G1; ++rep) {
            pg8::Gemm g; g.A = (const bf16_t*)(p.ws + WS_UM); g.Bt = (const bf16_t*)(p.ws + WS_WIN) + (size_t)l * NP * DM; g.M = NTOK; g.N = NP; g.K = DM;
            pg8::StaticOrder S; S.init(NTOK, NP, gridDim.x, blockIdx.x);
            EpiIn E; E.proj = (bf16_t*)(p.ws + WS_PROJ); E.gates = (float*)(p.ws + WS_GATES); E.newk = p.out + O_NK; E.newv = p.out + O_NV; E.rope = (const float*)(p.ws + WS_ROPE); E.layer = l;
            pg8::gemm_phase<EpiIn, pg8::StaticOrder, false>(lds, g, S, E, nullptr);
            if (rep < DUP_G1) GSYNC();
        }
#endif
        GSYNC();
#if PH_M1
        for (int rep = 0; rep < 1 + DUP_M1; ++rep) { m1_phase(p, l, lds, rep, rep == 0 ? 7 : DUP_MASK); if (rep < DUP_M1) GSYNC(); }
#endif
        GSYNC();
#if PH_M2
        for (int rep = 0; rep < 1 + DUP_M2; ++rep) { m2_phase(p, l, rep, lds, xbar); if (rep < DUP_M2) GSYNC(); }
#endif
        GSYNC();
#if PH_M3
        for (int rep = 0; rep < 1 + DUP_M3; ++rep) m3_phase(p, l);
#endif
        GSYNC();
#if PH_G2
        for (int rep = 0; rep < 1 + (l == 0 ? DUP_G2 : 0); ++rep) {
            pg8::Gemm g; g.A = (const bf16_t*)(p.ws + WS_UM); g.Bt = (const bf16_t*)(p.ws + WS_WOUT) + (size_t)l * DM * DM; g.M = NTOK; g.N = DM; g.K = DM;
            pg8::StaticOrder S; S.init(NTOK, DM, gridDim.x, blockIdx.x);
            EpiOut E; E.xp = p.in[I_XP]; E.xs = p.in[I_XS]; E.mod = (const float*)(p.ws + WS_MOD) + (size_t)l * 3 * 6144; E.y = p.out + O_Y; E.layer = l;
            pg8::gemm_phase<EpiOut, pg8::StaticOrder, false>(lds, g, S, E, nullptr);
            if (rep < (l == 0 ? DUP_G2 : 0)) GSYNC();
        }
#endif
        GSYNC();
#if PH_LN
        ln_phase(p, l);
#endif
        if (l == 0) GSYNC();
    }
}

extern "C" void kernel_launch(void* const* d_in, const int* in_sizes, int n_in, void* d_out, int out_size, void* d_ws, size_t ws_size, hipStream_t stream) {
    static int grid_blocks = 0;
    if (grid_blocks == 0) {
        if (n_in != 38 || ws_size < WS_END) { fprintf(stderr, "kernel_launch: unexpected n_in %d / ws_size %zu (need %zu)\n", n_in, ws_size, (size_t)WS_END); grid_blocks = -1; return; }
        int dev = 0, cus = 0, per_cu = 0;
        hipGetDevice(&dev);
        hipDeviceGetAttribute(&cus, hipDeviceAttributeMultiprocessorCount, dev);
        hipFuncSetAttribute((const void*)hybrid_fwd, hipFuncAttributeMaxDynamicSharedMemorySize, LDS_BYTES);
        hipOccupancyMaxActiveBlocksPerMultiprocessor(&per_cu, (const void*)hybrid_fwd, NTHREADS, LDS_BYTES);
        if (per_cu < 1) { fprintf(stderr, "kernel_launch: occupancy query gives %d blocks per CU\n", per_cu); per_cu = 1; }
        grid_blocks = cus * per_cu;
    }
    if (grid_blocks < 0) return;
    Params p{};
    for (int i = 0; i < 38; ++i) p.in[i] = (const float*)d_in[i];
    p.out = (float*)d_out; p.ws = (unsigned char*)d_ws;
    hipMemsetAsync(d_ws, 0, 32768, stream);
    void* args[] = {&p};
    hipError_t e = hipLaunchCooperativeKernel((const void*)hybrid_fwd, dim3(grid_blocks), dim3(NTHREADS), args, LDS_BYTES, stream);
    if (e != hipSuccess) fprintf(stderr, "cooperative launch failed: %s (grid %d)\n", hipGetErrorString(e), grid_blocks);
}
```

```cpp
#include <hip/hip_runtime.h>
#include <hip/hip_cooperative_groups.h>
#include <cstdio>
#include <cstdint>
namespace cg = cooperative_groups;
namespace pg8 {
#define PG8_LAS __attribute__((address_space(3)))
typedef unsigned short bf16_t;
typedef short bf16x8 __attribute__((ext_vector_type(8)));
typedef float f32x4 __attribute__((ext_vector_type(4)));
typedef unsigned u32x4 __attribute__((ext_vector_type(4)));
constexpr int BM = 256, BK = 64, HALF = 128, HTB = HALF * BK * 2  , STAGE_BYTES = 8 * HTB, NXCD = 8, WGM = 8;

__host__ __device__ __forceinline__ int lds_byte(int r, int c) { const int st = (r >> 4) * 2 + (c >> 5), rr = r & 15, cc = c & 31, ob = rr * 64 + cc * 2; return st * 1024 + (ob ^ (((ob >> 9) & 1) << 5)); }
__host__ __device__ __forceinline__ void stage_rc(int b, int& R, int& C) { const int st = b / 1024, sb = b % 1024, swz = sb ^ (((sb >> 9) & 1) << 5); R = (st >> 1) * 16 + swz / 64; C = (st & 1) * 32 + (swz % 64) / 2; }
__host__ __device__ __forceinline__ int perm32(int rho) { const int n = rho >> 4, i = rho & 15; return 8 * (i >> 2) + 4 * n + (i & 3); }

struct Unit { int pm, pn; };
struct Gemm { const bf16_t* A; const bf16_t* Bt; int M, N, K; };

struct StaticOrder {
    int nM, nN, nwg, G, c;
    __host__ __device__ void init(int M, int N, int G_, int c_) { nM = M / BM; nN = N / BM; nwg = nM * nN; G = G_; c = c_; }
    __host__ __device__ bool next(int i, Unit& u) const {
        const long L = (long)i * G + c; if (L >= nwg) return false;
        int wgid = (int)L; { const int q = nwg / NXCD, r = nwg % NXCD, xcd = wgid % NXCD, off = wgid / NXCD; wgid = (xcd < r ? xcd * (q + 1) : r * (q + 1) + (xcd - r) * q) + off; }
        const int nig = WGM * nN, gid = wgid / nig, fm = gid * WGM, gsz = (nM - fm) < WGM ? (nM - fm) : WGM;
        u.pm = fm + ((wgid % nig) % gsz); u.pn = (wgid % nig) / gsz; return true;
    }
    __device__ __forceinline__ void a_ready(const Unit&) const {}
    __device__ __forceinline__ void done(const Unit&) const {}
};
__device__ __forceinline__ unsigned cvt_pk_bf16(float lo, float hi) { unsigned r; asm volatile("v_cvt_pk_bf16_f32 %0, %1, %2" : "=v"(r) : "v"(lo), "v"(hi)); return r; }

template <class Epi, class Sched, bool ALIGN_EPI = false, bool SP2 = false>
__device__ __forceinline__ void gemm_phase(PG8_LAS unsigned char* lds, const Gemm g, const Sched& S, const Epi& E) {
    int tid = threadIdx.x; asm volatile("" : "+v"(tid)); const int wid = __builtin_amdgcn_readfirstlane(tid >> 6), lane = tid & 63, wr = wid >> 2, wc = wid & 3, fr = lane & 15, fq = lane >> 4;
    const int K = g.K, nt = K / BK;
    unsigned voffA[2], voffB[2];
#pragma unroll
    for (int i = 0; i < 2; ++i) { int R, C; stage_rc(tid * 16 + i * 8192, R, C); const int Rb = Epi::PERM ? ((R & ~31) + perm32(R & 31)) : R;
        voffA[i] = (unsigned)(R * K + C) * 2u; voffB[i] = (unsigned)(Rb * K + C) * 2u; }
    const size_t kstep = (size_t)(BK * 2);
    const size_t hstep = (size_t)HALF * K * 2;
    const size_t tstep = 2 * hstep;
    const unsigned ldsw = (unsigned)wid * 1024u;
    const int aoff = lds_byte(wr * 64 + fr, fq * 8), boff = lds_byte(wc * 32 + fr, fq * 8);
#define PG8_SA(b, h) (((b) * 2 + (h)) * HTB)
#define PG8_SB(b, h) ((4 + (b) * 2 + (h)) * HTB)
#define PG8_STAGE(bufoff, gbase, voff) do { _Pragma("unroll") for (int _i = 0; _i < 2; ++_i) \
        __builtin_amdgcn_global_load_lds((const unsigned*)((const char*)(gbase) + (voff)[_i]), (PG8_LAS unsigned*)(lds + (bufoff) + ldsw + _i * 8192), 16, 0, 0); } while (0)
#define PG8_LDA(dst, b, h) do { _Pragma("unroll") for (int m = 0; m < 4; ++m) _Pragma("unroll") for (int k = 0; k < 2; ++k) dst[m][k] = *(const PG8_LAS bf16x8*)(lds + PG8_SA(b, h) + aoff + m * 2048 + k * 1024); } while (0)
#define PG8_LDB(dst, b, h) do { _Pragma("unroll") for (int n = 0; n < 2; ++n) _Pragma("unroll") for (int k = 0; k < 2; ++k) dst[n][k] = *(const PG8_LAS bf16x8*)(lds + PG8_SB(b, h) + boff + n * 2048 + k * 1024); } while (0)
#define PG8_MMA(ai, bj, At, Bt) do { __builtin_amdgcn_s_setprio(1); _Pragma("unroll") for (int m = 0; m < 4; ++m) _Pragma("unroll") for (int n = 0; n < 2; ++n) _Pragma("unroll") for (int k = 0; k < 2; ++k) \
        acc[ai][bj][m][n] = __builtin_amdgcn_mfma_f32_16x16x32_bf16(Bt[n][k], At[m][k], acc[ai][bj][m][n], 0, 0, 0); __builtin_amdgcn_s_setprio(0); } while (0)
#define PG8_WAIT_V(n) asm volatile("s_waitcnt vmcnt(" #n ")" ::: "memory")
#define PG8_WAIT_L(n) asm volatile("s_waitcnt lgkmcnt(" #n ")" ::: "memory")
#define PG8_BAR __builtin_amdgcn_s_barrier()
#define PG8_SCHED __builtin_amdgcn_sched_barrier(0)
    Unit cur, nxt; int ui = 0;
    if (!S.next(0, cur)) return;
    f32x4 acc[2][2][4][2];
#pragma unroll
    for (int a = 0; a < 2; ++a)
#pragma unroll
        for (int b = 0; b < 2; ++b)
#pragma unroll
            for (int m = 0; m < 4; ++m)
#pragma unroll
                for (int n = 0; n < 2; ++n) acc[a][b][m][n] = (f32x4){0.f, 0.f, 0.f, 0.f};
    bf16x8 At[4][2], B0[2][2], B1[2][2];
    const char* cA = (const char*)g.A + (size_t)cur.pm * tstep; const char* cB = (const char*)g.Bt + (size_t)cur.pn * tstep;
    S.a_ready(cur);
    if constexpr (SP2) {
        PG8_STAGE(PG8_SB(0, 0), cB, voffB); PG8_STAGE(PG8_SB(0, 1), cB + hstep, voffB); PG8_STAGE(PG8_SA(0, 0), cA, voffA); PG8_STAGE(PG8_SA(0, 1), cA + hstep, voffA);
        if (wr == 1) PG8_BAR;
        PG8_WAIT_V(2); PG8_BAR;
        PG8_STAGE(PG8_SB(1, 0), cB + kstep, voffB); PG8_STAGE(PG8_SA(1, 0), cA + kstep, voffA); PG8_STAGE(PG8_SB(1, 1), cB + hstep + kstep, voffB);
        PG8_WAIT_V(6); PG8_BAR;
    } else {
        PG8_STAGE(PG8_SB(0, 0), cB, voffB); PG8_STAGE(PG8_SA(0, 0), cA, voffA); PG8_STAGE(PG8_SB(0, 1), cB + hstep, voffB); PG8_STAGE(PG8_SA(0, 1), cA + hstep, voffA);
        if (wr == 1) PG8_BAR;
        PG8_WAIT_V(4); PG8_BAR;
        PG8_STAGE(PG8_SB(1, 0), cB + kstep, voffB); PG8_STAGE(PG8_SA(1, 0), cA + kstep, voffA); PG8_STAGE(PG8_SB(1, 1), cB + hstep + kstep, voffB);
        PG8_WAIT_V(6); PG8_BAR;
    }
    for (;;) {
        const bool has_next = S.next(ui + 1, nxt);
        const char* nA = has_next ? (const char*)g.A + (size_t)nxt.pm * tstep : cA; const char* nB = has_next ? (const char*)g.Bt + (size_t)nxt.pn * tstep : cB;
        for (int t = 0; t < nt; t += 2) {
            const bool last = (t == nt - 2);
            const char* a1 = cA + (size_t)(t + 1) * kstep;
            const char* a2 = last ? nA : cA + (size_t)(t + 2) * kstep; const char* b2 = last ? nB : cB + (size_t)(t + 2) * kstep;
            const char* a3 = a2 + kstep; const char* b3 = b2 + kstep;
            if (last && has_next) S.a_ready(nxt);
            if constexpr (SP2) {
            PG8_LDB(B0, 0, 0); PG8_LDB(B1, 0, 1); PG8_SCHED; PG8_LDA(At, 0, 0); PG8_STAGE(PG8_SA(1, 1), a1 + hstep, voffA);
            PG8_WAIT_V(8); PG8_WAIT_L(0); PG8_BAR; PG8_MMA(0, 0, At, B0); PG8_MMA(0, 1, At, B1); PG8_BAR; PG8_SCHED;
            PG8_LDA(At, 0, 1); PG8_STAGE(PG8_SB(0, 0), b2, voffB); PG8_STAGE(PG8_SB(0, 1), b2 + hstep, voffB); PG8_STAGE(PG8_SA(0, 0), a2, voffA);
            PG8_WAIT_V(8); PG8_WAIT_L(0); PG8_BAR; PG8_MMA(1, 0, At, B0); PG8_MMA(1, 1, At, B1); PG8_BAR; PG8_SCHED;
            PG8_LDB(B0, 1, 0); PG8_LDB(B1, 1, 1); PG8_SCHED; PG8_LDA(At, 1, 0); PG8_STAGE(PG8_SA(0, 1), a2 + hstep, voffA);
            PG8_WAIT_V(8); PG8_WAIT_L(0); PG8_BAR; PG8_MMA(0, 0, At, B0); PG8_MMA(0, 1, At, B1); PG8_BAR; PG8_SCHED;
            PG8_LDA(At, 1, 1); PG8_STAGE(PG8_SB(1, 0), b3, voffB); PG8_STAGE(PG8_SB(1, 1), b3 + hstep, voffB); PG8_STAGE(PG8_SA(1, 0), a3, voffA);
            PG8_WAIT_V(8); PG8_WAIT_L(0); PG8_BAR; PG8_MMA(1, 0, At, B0); PG8_MMA(1, 1, At, B1); PG8_BAR; PG8_SCHED;
            } else {
            PG8_LDB(B0, 0, 0); PG8_SCHED; PG8_LDA(At, 0, 0); PG8_STAGE(PG8_SA(1, 1), a1 + hstep, voffA);
            PG8_WAIT_L(8); PG8_BAR; PG8_WAIT_L(0); PG8_MMA(0, 0, At, B0); PG8_BAR; PG8_SCHED;
            PG8_LDB(B1, 0, 1); PG8_STAGE(PG8_SB(0, 0), b2, voffB);
            PG8_BAR; PG8_WAIT_L(0); PG8_MMA(0, 1, At, B1); PG8_BAR;
            PG8_LDA(At, 0, 1); PG8_STAGE(PG8_SA(0, 0), a2, voffA);
            PG8_BAR; PG8_WAIT_L(0); PG8_MMA(1, 0, At, B0); PG8_BAR; PG8_SCHED;
            PG8_STAGE(PG8_SB(0, 1), b2 + hstep, voffB);
            PG8_WAIT_V(6); PG8_BAR; PG8_MMA(1, 1, At, B1); PG8_BAR;
            PG8_LDB(B0, 1, 0); PG8_SCHED; PG8_LDA(At, 1, 0); PG8_STAGE(PG8_SA(0, 1), a2 + hstep, voffA);
            PG8_WAIT_L(8); PG8_BAR; PG8_WAIT_L(0); PG8_MMA(0, 0, At, B0); PG8_BAR; PG8_SCHED;
            PG8_LDB(B1, 1, 1); PG8_STAGE(PG8_SB(1, 0), b3, voffB);
            PG8_BAR; PG8_WAIT_L(0); PG8_MMA(0, 1, At, B1); PG8_BAR;
            PG8_LDA(At, 1, 1); PG8_STAGE(PG8_SA(1, 0), a3, voffA);
            PG8_BAR; PG8_WAIT_L(0); PG8_MMA(1, 0, At, B0); PG8_BAR; PG8_SCHED;
            PG8_STAGE(PG8_SB(1, 1), b3 + hstep, voffB);
            PG8_WAIT_V(6); PG8_BAR; PG8_MMA(1, 1, At, B1); PG8_BAR;
            }
        }
        if constexpr (ALIGN_EPI) { if (wr == 0) PG8_BAR; }
        if constexpr (!Epi::AFTER_DRAIN) { E(acc, cur, wr, wc, fr, fq); S.done(cur); }
        if (!has_next) break;
#pragma unroll
        for (int a = 0; a < 2; ++a)
#pragma unroll
            for (int b = 0; b < 2; ++b)
#pragma unroll
                for (int m = 0; m < 4; ++m)
#pragma unroll
                    for (int n = 0; n < 2; ++n) acc[a][b][m][n] = (f32x4){0.f, 0.f, 0.f, 0.f};
        cur = nxt; cA = nA; cB = nB; ++ui;
        if constexpr (ALIGN_EPI) { if (wr == 1) PG8_BAR; }
    }
    PG8_WAIT_V(0);
    if constexpr (!ALIGN_EPI) { if (wr == 0) PG8_BAR; }
    PG8_BAR;
    if constexpr (Epi::AFTER_DRAIN) { E.fused(acc, cur, wr, wc, fr, fq, lds, wid, lane); S.done(cur); }
#undef PG8_SA
#undef PG8_SB
#undef PG8_STAGE
#undef PG8_LDA
#undef PG8_LDB
#undef PG8_MMA
#undef PG8_WAIT_V
#undef PG8_WAIT_L
#undef PG8_BAR
#undef PG8_SCHED
}
}

#define LAS __attribute__((address_space(3)))
#ifndef DUP_M2MASK
#define DUP_M2MASK 3
#endif
typedef unsigned short bf16_t;
typedef short bf16x8 __attribute__((ext_vector_type(8)));
typedef float f32x4 __attribute__((ext_vector_type(4)));
typedef unsigned u32x4v __attribute__((ext_vector_type(4)));
typedef unsigned u32x2v __attribute__((ext_vector_type(2)));

constexpr int NTOK = 10240, NPT = 8192, DM = 2048, NP = 9216, PIN = 8976;
constexpr int C_Q = 4864, C_K = 5888, C_V = 6912, C_G = 7936, C_IF = 8960;
constexpr int A_WD = 1536, A_AD = 1664, A_GATE = 1792;
constexpr int B_Q = 2304, B_V = 3328, B_O = 3840, B_GATE = 4352;
constexpr int NTHREADS = 512;
constexpr int LDS_SLOT = 131072, LDS_BYTES = 131072 + 1024;

constexpr size_t WS_CTL = 0;
constexpr size_t WS_BAR = 8192;
constexpr size_t WS_MOD = 32768;
constexpr size_t WS_ROPE = WS_MOD + 147456;
constexpr size_t WS_LAM = WS_ROPE + 8192;
constexpr size_t WS_WIN = WS_LAM + 256;
constexpr size_t WS_WOUT = WS_WIN + 2ull * NP * DM * 2;
constexpr size_t WS_UM = WS_WOUT + 2ull * DM * DM * 2;
constexpr size_t WS_PROJ = WS_UM + (size_t)NTOK * DM * 2;
constexpr size_t WS_GATES = WS_PROJ + (size_t)NTOK * NP * 2;
constexpr size_t SZ16 = (size_t)NTOK * 512 * 2, SZ32 = (size_t)NTOK * 512 * 4;
constexpr size_t WS_SCV = WS_GATES + (size_t)NTOK * 16 * 4;
constexpr size_t WS_SCBON = WS_SCV + SZ16;
constexpr size_t WS_PK = WS_SCBON + SZ16;
constexpr size_t SZPK = (size_t)NTOK * 8 * 320 * 2;
constexpr size_t WS_YD = WS_PK + 2 * SZPK;
constexpr size_t WS_HD = WS_YD + 2 * SZ32;
constexpr size_t WS_KC = WS_HD + 2 * SZ32;
constexpr size_t WS_VTC = WS_KC + 4194304;
constexpr size_t WS_WUPT = WS_VTC + 4194304;
constexpr size_t WS_END = WS_WUPT + 524288;

constexpr size_t O_Y = 0, O_NK = 20971520, O_NV = 37748736, O_RW = 54525952, O_MC = 58720256, O_MN = 67108864, O_MM = 67174400;

struct Params { const float* in[38]; float* out; unsigned char* ws; };
enum { I_XP = 0, I_XS, I_CK, I_CV, I_SRW, I_SMC, I_SMN, I_SMM, I_C, I_CCTX, I_WADA, I_BADA, I_WIN, I_CAW, I_CAB, I_W0, I_WUP, I_A0, I_AUP, I_KK, I_KA, I_RK,
       I_RGG, I_RGB, I_CBW, I_CBB, I_BI, I_BF, I_MGG, I_MGB, I_LQ1, I_LK1, I_LQ2, I_LK2, I_SUBG, I_WOUT, I_LNG, I_LNB };

__device__ __forceinline__ float bf2f(bf16_t v) { return __uint_as_float(((unsigned)v) << 16); }
__device__ __forceinline__ float bflo(unsigned w) { return __uint_as_float(w << 16); }
__device__ __forceinline__ float bfhi(unsigned w) { return __uint_as_float(w & 0xffff0000u); }
__device__ __forceinline__ unsigned pk2(float lo, float hi) { return pg8::cvt_pk_bf16(lo, hi); }
__device__ __forceinline__ bf16_t f2bf(float f) { return (bf16_t)(pk2(f, 0.f) & 0xffffu); }
__device__ __forceinline__ void unpack8(const u32x4v w, float (&o)[8]) { o[0] = bflo(w.x); o[1] = bfhi(w.x); o[2] = bflo(w.y); o[3] = bfhi(w.y); o[4] = bflo(w.z); o[5] = bfhi(w.z); o[6] = bflo(w.w); o[7] = bfhi(w.w); }
__device__ __forceinline__ u32x4v pack8(const float (&o)[8]) { u32x4v w; w.x = pk2(o[0], o[1]); w.y = pk2(o[2], o[3]); w.z = pk2(o[4], o[5]); w.w = pk2(o[6], o[7]); return w; }
__device__ __forceinline__ void ld8f(const float* p, float (&o)[8]) { const float4 a = *(const float4*)p, b = *(const float4*)(p + 4); o[0] = a.x; o[1] = a.y; o[2] = a.z; o[3] = a.w; o[4] = b.x; o[5] = b.y; o[6] = b.z; o[7] = b.w; }
__device__ __forceinline__ float sigmoidf_(float x) { return __builtin_amdgcn_rcpf(1.0f + __expf(-x)); }
__device__ __forceinline__ float siluf_(float x) { return x * __builtin_amdgcn_rcpf(1.0f + __expf(-x)); }
__device__ __forceinline__ float tanhf_(float x) { return 1.0f - 2.0f * __builtin_amdgcn_rcpf(1.0f + __expf(2.0f * x)); }
__device__ __forceinline__ bf16x8 frag(const LAS bf16_t* base, int row0, int ld, int k0, int lane) { return *(const LAS bf16x8*)(base + (row0 + (lane & 15)) * ld + k0 + (lane >> 4) * 8); }
__device__ __forceinline__ bf16x8 fragsw(const LAS bf16_t* base, int row0, int k0, int lane) { const int r = row0 + (lane & 15), m = (k0 >> 3) + (lane >> 4); return *(const LAS bf16x8*)(base + r * 72 + 8 * (m ^ ((r >> 3) & 7))); }
#define MFMA16(a, b, c) __builtin_amdgcn_mfma_f32_16x16x32_bf16((a), (b), (c), 0, 0, 0)
#define LDS_FENCE() asm volatile("s_waitcnt lgkmcnt(0)" ::: "memory")
template <int CTRL> __device__ __forceinline__ float dppf(float x) { return __builtin_bit_cast(float, __builtin_amdgcn_mov_dpp(__builtin_bit_cast(int, x), CTRL, 0xf, 0xf, true)); }
__device__ __forceinline__ float red16_sum(float x) { x += dppf<0xB1>(x); x += dppf<0x4E>(x); x += dppf<0x124>(x); x += dppf<0x128>(x); return x; }
__device__ __forceinline__ float red4_sum(float x) { x += dppf<0xB1>(x); x += dppf<0x4E>(x); return x; }
__device__ __forceinline__ float red16_max(float x) { x = fmaxf(x, dppf<0xB1>(x)); x = fmaxf(x, dppf<0x4E>(x)); x = fmaxf(x, dppf<0x124>(x)); x = fmaxf(x, dppf<0x128>(x)); return x; }

__device__ __forceinline__ int opaque_tid() { int t = threadIdx.x; asm volatile("" : "+v"(t)); return t; }
__device__ __forceinline__ int next_task(unsigned* ctr, LAS int* slot) {
    __syncthreads();
    if (threadIdx.x == 0) *slot = (int)atomicAdd(ctr, 1u);
    __syncthreads();
    return *slot;
}
#define QNEXT_BEGIN(ctr) unsigned qn_ = 0u; if (threadIdx.x == 0) qn_ = atomicAdd((ctr), 1u)
#define QNEXT_END(slot, t) do { __syncthreads(); if (threadIdx.x == 0) *(slot) = (int)qn_; __syncthreads(); (t) = *(slot); } while (0)
__device__ __forceinline__ int win_src_col(int n) { return n < 4352 ? n : (n < 8960 ? n + 16 : (n < 8976 ? n - 8960 + 4352 : -1)); }
__device__ __forceinline__ int mod_row(int tok) { return tok < NPT ? 0 : 1 + ((tok - NPT) >> 10); }

__device__ __forceinline__ void p0_mod_item(const Params& p, int item, LAS unsigned char* lds) {
    const int tid = opaque_tid(), lane = tid & 63, wave = tid >> 6, kq = lane >> 4, cq = lane & 15;
    const int l = item / 96, cb = item % 96;
    LAS float* sS = (LAS float*)lds;
    LAS float* sRed = sS + 3 * 2048;
    for (int e = tid; e < 3 * 2048; e += NTHREADS) { const int r = e >> 11, k = e & 2047; const float cv = r == 0 ? p.in[I_CCTX][k] : p.in[I_C][(r - 1) * 2048 + k]; sS[e] = siluf_(cv); }
    __syncthreads();
    const float* W = p.in[I_WADA] + (size_t)l * 2048 * 6144 + cb * 64 + 4 * cq;
    float4 a0 = {0, 0, 0, 0}, a1 = a0, a2 = a0;
#pragma unroll 16
    for (int i = 0; i < 64; ++i) { const int k = wave * 256 + i * 4 + kq; const float4 w = *(const float4*)(W + (size_t)k * 6144);
        const float s0 = sS[k], s1 = sS[2048 + k], s2 = sS[4096 + k];
        a0.x += s0 * w.x; a0.y += s0 * w.y; a0.z += s0 * w.z; a0.w += s0 * w.w;
        a1.x += s1 * w.x; a1.y += s1 * w.y; a1.z += s1 * w.z; a1.w += s1 * w.w;
        a2.x += s2 * w.x; a2.y += s2 * w.y; a2.z += s2 * w.z; a2.w += s2 * w.w; }
    float v[12] = {a0.x, a0.y, a0.z, a0.w, a1.x, a1.y, a1.z, a1.w, a2.x, a2.y, a2.z, a2.w};
#pragma unroll
    for (int i = 0; i < 12; ++i) { v[i] += __shfl_xor(v[i], 16); v[i] += __shfl_xor(v[i], 32); }
    if (kq == 0) {
#pragma unroll
        for (int r = 0; r < 3; ++r)
#pragma unroll
            for (int e = 0; e < 4; ++e) sRed[(wave * 3 + r) * 64 + 4 * cq + e] = v[r * 4 + e];
    }
    __syncthreads();
    if (tid < 192) { const int r = tid >> 6, c = tid & 63; float s = 0.f;
#pragma unroll
        for (int w = 0; w < 8; ++w) s += sRed[(w * 3 + r) * 64 + c];
        ((float*)(p.ws + WS_MOD))[(l * 3 + r) * 6144 + cb * 64 + c] = s + p.in[I_BADA][l * 6144 + cb * 64 + c]; }
}
template <bool MAPCOL> __device__ __forceinline__ void p0_transpose_item(const float* W, int N, int nblk, bf16_t* WT, LAS float* scr, int item, int lane) {
    const int kb = item / nblk, nb = item % nblk, k0 = 64 * kb, n0 = 32 * nb;
    const int n = n0 + (lane & 31); const int oc = MAPCOL ? win_src_col(n) : n;
    float tv[32];
    const float* wp = W + (size_t)(k0 + (lane >> 5)) * N + (oc >= 0 ? oc : 0);
#pragma unroll
    for (int i = 0; i < 32; ++i) tv[i] = wp[(size_t)(2 * i) * N];
#pragma unroll
    for (int i = 0; i < 32; ++i) scr[(2 * i + (lane >> 5)) * 33 + (lane & 31)] = oc >= 0 ? tv[i] : 0.f;
    LDS_FENCE();
    const int c = lane & 7;
#pragma unroll
    for (int j = 0; j < 4; ++j) { const int nn = (lane >> 3) + 8 * j; const LAS float* s = scr + (8 * c) * 33 + nn;
        u32x4v o; o.x = pk2(s[0 * 33], s[1 * 33]); o.y = pk2(s[2 * 33], s[3 * 33]); o.z = pk2(s[4 * 33], s[5 * 33]); o.w = pk2(s[6 * 33], s[7 * 33]);
        *(u32x4v*)(WT + (size_t)(n0 + nn) * 2048 + k0 + 8 * c) = o; }
    LDS_FENCE();
}
__device__ __forceinline__ void p0_phase(const Params& p, LAS unsigned char* lds, int rep) {
    const int tid = opaque_tid(), lane = tid & 63, wave = tid >> 6;
    unsigned* ctr = (unsigned*)(p.ws + WS_CTL) + 64 * 15 * rep;
    LAS int* slot = (LAS int*)(lds + LDS_SLOT);
    constexpr int NT_MOD = 192, NT_TR = 2816, NT_A = NT_MOD + 1 + NT_TR, NT_KC = 512, NT_VT = 512, NT_WU = 64, NT = NT_A + NT_KC + NT_VT + NT_WU;
    for (;;) {
        const int t = next_task(ctr, slot);
        if (t >= NT) break;
        if (t < NT_MOD) { p0_mod_item(p, t, lds); continue; }
        if (t == NT_MOD) {
            float* rope = (float*)(p.ws + WS_ROPE);
            for (int e = tid; e < 1024; e += NTHREADS) { const int pos = e >> 4, i = e & 15; const float inv = 1.0f / powf(10000.0f, (float)(2 * i) / 32.0f); const float ang = (float)pos * inv;
                rope[pos * 32 + i] = cosf(ang); rope[pos * 32 + 16 + i] = sinf(ang); }
            if (tid < 2) { const int l = tid; float d1 = 0.f, d2 = 0.f;
                for (int i = 0; i < 64; ++i) { d1 += p.in[I_LQ1][l * 64 + i] * p.in[I_LK1][l * 64 + i]; d2 += p.in[I_LQ2][l * 64 + i] * p.in[I_LK2][l * 64 + i]; }
                const float lam_init = 0.8f - 0.6f * expf(-0.3f * (float)l);
                ((float*)(p.ws + WS_LAM))[l] = expf(d1) - expf(d2) + lam_init; }
            continue;
        }
        if (t >= NT_A) {
            int u = t - NT_A;
            if (u < NT_KC) { const size_t o = ((size_t)u * 512 + tid) * 8; float x[8]; ld8f(p.in[I_CK] + o, x); *(u32x4v*)((bf16_t*)(p.ws + WS_KC) + o) = pack8(x); continue; }
            u -= NT_KC;
            if (u < NT_VT) { const int idx = u * 512 + tid, dv = idx & 127, m = (idx >> 7) & 63, bh = idx >> 13; float x[8];
#pragma unroll
                for (int e = 0; e < 8; ++e) x[e] = p.in[I_CV][((size_t)bh * 512 + 8 * m + e) * 128 + dv];
                *(u32x4v*)((bf16_t*)(p.ws + WS_VTC) + ((size_t)bh * 128 + dv) * 512 + 8 * m) = pack8(x); continue; }
            u -= NT_VT;
#pragma unroll
            for (int e = 0; e < 8; ++e) { const int f = u * 4096 + e * 512 + tid, c = f & 63, j = (f >> 6) & 63, h = (f >> 12) & 7, which = (f >> 15) & 1, ld = f >> 16;
                const float v = (which ? p.in[I_AUP] : p.in[I_WUP])[((size_t)ld * 64 + j) * 512 + h * 64 + c];
                ((bf16_t*)(p.ws + WS_WUPT))[(f & ~4095) + c * 64 + j] = f2bf(v); }
            continue;
        }
        int it = (t - NT_MOD - 1) * 8 + wave;
        LAS float* scr = (LAS float*)(lds + wave * 8704);
        const int l = it / 11264; it -= l * 11264;
        if (it < 9216) p0_transpose_item<true>(p.in[I_WIN] + (size_t)l * 2048 * PIN, PIN, 288, (bf16_t*)(p.ws + WS_WIN) + (size_t)l * NP * 2048, scr, it, lane);
        else p0_transpose_item<false>(p.in[I_WOUT] + (size_t)l * 2048 * 2048, 2048, 64, (bf16_t*)(p.ws + WS_WOUT) + (size_t)l * 2048 * 2048, scr, it - 9216, lane);
    }
}
__device__ __forceinline__ void modulate_row(const float* xrow, const float* mod, bf16_t* urow, int lane) {
#pragma unroll
    for (int j = 0; j < 4; ++j) { const int c = j * 512 + lane * 8; float x[8], sh[8], sc[8], o[8]; ld8f(xrow + c, x); ld8f(mod + c, sh); ld8f(mod + 2048 + c, sc);
#pragma unroll
        for (int e = 0; e < 8; ++e) o[e] = x[e] * (1.0f + sc[e]) + sh[e];
        *(u32x4v*)(urow + c) = pack8(o); }
}
__device__ __forceinline__ void p0b_phase(const Params& p) {
    const int tid_ = opaque_tid(); const int lane = tid_ & 63, gw = blockIdx.x * 8 + (tid_ >> 6), NGW = gridDim.x * 8;
    for (int tok = gw; tok < NTOK; tok += NGW) {
        const float* xrow = tok < NPT ? p.in[I_XP] + (size_t)tok * DM : p.in[I_XS] + (size_t)(tok - NPT) * DM;
        modulate_row(xrow, (const float*)(p.ws + WS_MOD) + mod_row(tok) * 6144, (bf16_t*)(p.ws + WS_UM) + (size_t)tok * DM, lane);
    }
}

struct EpiIn {
    static constexpr bool PERM = true, AFTER_DRAIN = false;
    bf16_t* proj; float* gates; float* newk; float* newv; const float* rope; int layer;
    __device__ __forceinline__ void operator()(const f32x4 (&acc)[2][2][4][2], const pg8::Unit& u, int wr, int wc, int fr, int fq) const {
        const int row0 = u.pm * 256 + wr * 64 + fr, col0 = u.pn * 256 + wc * 32 + 8 * fq;
        const bool samp = u.pm >= 32;
        const bool is_rope = samp && u.pn >= 19 && u.pn < 27;
        const bool is_k = !samp && u.pn >= 23 && u.pn < 27, is_v = !samp && u.pn >= 27 && u.pn < 31, is_g = u.pn == 35;
#pragma unroll
        for (int ai = 0; ai < 2; ++ai)
#pragma unroll
            for (int m = 0; m < 4; ++m) {
                const int row = row0 + ai * 128 + m * 16;
                float cs[8], sn[8];
                if (is_rope) { const int pos = (row - NPT) & 1023; const int pp = (wc & 1) ? (pos & 63) : (pos >> 6); const float* rp = rope + pp * 32 + 8 * (fq & 1); ld8f(rp, cs); ld8f(rp + 16, sn); }
#pragma unroll
                for (int bj = 0; bj < 2; ++bj) {
                    f32x4 v0 = acc[ai][bj][m][0], v1 = acc[ai][bj][m][1];
                    if (is_rope) {
                        const float sg = (fq & 2) ? 1.0f : -1.0f;
#pragma unroll
                        for (int e = 0; e < 4; ++e) { const float p0 = __shfl_xor(v0[e], 32), p1 = __shfl_xor(v1[e], 32);
                            v0[e] = v0[e] * cs[e] + sg * p0 * sn[e]; v1[e] = v1[e] * cs[4 + e] + sg * p1 * sn[4 + e]; }
                    }
                    const int col = col0 + bj * 128;
                    u32x4v w; w.x = pk2(v0[0], v0[1]); w.y = pk2(v0[2], v0[3]); w.z = pk2(v1[0], v1[1]); w.w = pk2(v1[2], v1[3]);
                    *(u32x4v*)(proj + (size_t)row * NP + col) = w;
                    if (is_k || is_v) { const int ck = col - (is_k ? C_K : C_V), h = ck >> 7, j = ck & 127, b = row >> 8, t = row & 255;
                        float* dst = (is_k ? newk : newv) + ((((size_t)(b * 2 + layer) * 8 + h) * 256 + t) * 128 + j);
                        *(f32x4*)dst = v0; *(f32x4*)(dst + 4) = v1; }
                    if (is_g && bj == 0 && wc == 0 && fq < 2) { float* dst = gates + (size_t)row * 16 + 8 * fq; *(f32x4*)dst = v0; *(f32x4*)(dst + 4) = v1; }
                }
            }
    }
};
struct EpiOut {
    static constexpr bool PERM = false, AFTER_DRAIN = false;
    const float* xp; const float* xs; const float* mod; float* y; int layer;
    __device__ __forceinline__ void operator()(const f32x4 (&acc)[2][2][4][2], const pg8::Unit& u, int wr, int wc, int fr, int fq) const {
        const int row0 = u.pm * 256 + wr * 64 + fr, col0 = u.pn * 256 + wc * 32 + 4 * fq;
#pragma unroll
        for (int ai = 0; ai < 2; ++ai)
#pragma unroll
            for (int m = 0; m < 4; ++m) {
                const int row = row0 + ai * 128 + m * 16;
                const float* xrow = layer == 0 ? (row < NPT ? xp + (size_t)row * DM : xs + (size_t)(row - NPT) * DM) : y + (size_t)row * DM;
                const float* g = mod + mod_row(row) * 6144 + 4096;
#pragma unroll
                for (int bj = 0; bj < 2; ++bj)
#pragma unroll
                    for (int n = 0; n < 2; ++n) { const int c = col0 + bj * 128 + n * 16;
                        const f32x4 xv = *(const f32x4*)(xrow + c), gv = *(const f32x4*)(g + c);
                        *(f32x4*)(y + (size_t)row * DM + c) = 1.41421356237f * xv + gv * acc[ai][bj][m][n]; }
            }
    }
};

#define XB_TMO      128
#define XB_XCNT(j)  (256  + 64 * (j))
#define XB_XSUB(j)  (1280 + 64 * (j))
#define XB_XGEN(j)  (2304 + 64 * (j))
#define XB_TOP      3328
#define XB_TOPGEN   3392
#define XCD_BAR_WORDS 3456
#define XB_SPIN_CAP (1u << 18)

__device__ __forceinline__ unsigned xb_ld(unsigned* p)              { return __hip_atomic_load(p, __ATOMIC_RELAXED, __HIP_MEMORY_SCOPE_AGENT); }
__device__ __forceinline__ unsigned xb_add(unsigned* p, unsigned v) { return __hip_atomic_fetch_add(p, v, __ATOMIC_RELAXED, __HIP_MEMORY_SCOPE_AGENT); }
__device__ __forceinline__ unsigned xb_xcc_id() { return (unsigned)__builtin_amdgcn_s_getreg((3 << 11) | 20) & 0xFu; }
#define XB_SPIN(cond, bar) do { unsigned _sp = 0; while (cond) { __builtin_amdgcn_s_sleep(1); \
    if ((++_sp & 255u) == 0u) { if (xb_ld(&(bar)[XB_TMO])) break; if (_sp > XB_SPIN_CAP) { atomicAdd(&(bar)[XB_TMO], 1u); break; } } } } while (0)

struct XcdBarrier {
    unsigned* bar; unsigned x;
    volatile LAS unsigned* st;
};

__device__ __forceinline__ XcdBarrier xcd_barrier_post(unsigned* bar, volatile LAS unsigned* st) {
    XcdBarrier b; b.bar = bar; b.x = xb_xcc_id(); b.st = st;
    if (threadIdx.x == 0) (void)xb_add(&bar[XB_XCNT(b.x)], 1u);
    return b;
}
__device__ __forceinline__ void xcd_barrier_complete(unsigned* bar, unsigned x, unsigned& nloc, unsigned& nx) {
    const unsigned G = gridDim.x * gridDim.y * gridDim.z;
    unsigned sum, cnt, mine, sp = 0u;
    for (;;) {
        sum = 0u; cnt = 0u; mine = 0u;
#pragma unroll
        for (unsigned j = 0; j < 16; ++j) { const unsigned c = xb_ld(&bar[XB_XCNT(j)]); sum += c; cnt += (c > 0u) ? 1u : 0u; mine = (j == x) ? c : mine; }
        if (sum == G) break;
        __builtin_amdgcn_s_sleep(1);
        if ((++sp & 255u) == 0u) { if (xb_ld(&bar[XB_TMO])) break; if (sp > XB_SPIN_CAP) { atomicAdd(&bar[XB_TMO], 1u); break; } }
    }
    nloc = mine > 0u ? mine : 1u; nx = cnt > 0u ? cnt : 1u;
}

__device__ __forceinline__ unsigned xb_xcc_id_v() { unsigned r; asm volatile("s_getreg_b32 %0, hwreg(20, 0, 4)" : "=s"(r)); return r & 0xFu; }
__device__ __forceinline__ void xcd_barrier(const XcdBarrier& b) {
    asm volatile("s_waitcnt vmcnt(0)" ::: "memory");
    __syncthreads();
    if (threadIdx.x == 0) {
        unsigned* bar = b.bar; const unsigned bx = xb_xcc_id_v();
        __builtin_amdgcn_s_waitcnt(0);
        unsigned nloc = b.st[0], nx = b.st[1];
        if (nloc == 0u) { xcd_barrier_complete(bar, bx, nloc, nx); b.st[0] = nloc; b.st[1] = nx; }
        const unsigned old = xb_add(&bar[XB_XSUB(bx)], 1u);
        const unsigned gen = old / nloc;
        if (old + 1u == (gen + 1u) * nloc) {
            __builtin_amdgcn_fence(__ATOMIC_RELEASE, "agent");
            asm volatile("s_waitcnt vmcnt(0)" ::: "memory");
            const unsigned og = xb_add(&bar[XB_TOP], 1u);
            const unsigned tg = og / nx;
            if (og + 1u == (tg + 1u) * nx) xb_add(&bar[XB_TOPGEN], 1u);
            else XB_SPIN(xb_ld(&bar[XB_TOPGEN]) == tg, bar);
            __builtin_amdgcn_fence(__ATOMIC_ACQUIRE, "agent");
            xb_add(&bar[XB_XGEN(bx)], 1u);
            asm volatile("s_waitcnt vmcnt(0)" ::: "memory");
        } else {
            XB_SPIN(xb_ld(&bar[XB_XGEN(bx)]) == gen, bar);
            __builtin_amdgcn_fence(__ATOMIC_ACQUIRE, "agent");
            asm volatile("s_waitcnt vmcnt(0)" ::: "memory");
        }
    }
    __syncthreads();
}


__device__ __forceinline__ void mlstm_task(const Params& p, int l, int s, int d, int h, LAS unsigned char* lds) {
    const int tid = opaque_tid(), lane = tid & 63, wave = tid >> 6, quad = lane >> 4, l15 = lane & 15;
    const int T = s < 32 ? 256 : 1024, tok0 = s < 32 ? s * 256 : NPT + (s - 32) * 1024, nch = T / 64;
    LAS bf16_t* sQ = (LAS bf16_t*)lds;
    LAS bf16_t* sK = sQ + 64 * 136;
    LAS bf16_t* sKt = sK + 64 * 136;
    LAS bf16_t* sVt = sKt + 128 * 72;
    LAS bf16_t* sP = sVt + 128 * 72;
    LAS bf16_t* sC = sP + 64 * 72;
    LAS float* sf = (LAS float*)(sC + 128 * 136);
    LAS float *sA = sf, *sB = sf + 64, *sPm = sf + 128, *sN = sf + 192, *sNq = sf + 320, *sPs = sf + 384;
    const bf16_t* proj = (const bf16_t*)(p.ws + WS_PROJ);
    const float* gates = (const float*)(p.ws + WS_GATES);
    float* hd = (float*)(p.ws + WS_HD) + (size_t)d * NTOK * 512;
    const float bi = p.in[I_BI][l * 8 + d * 4 + h], bfb = p.in[I_BF][l * 8 + d * 4 + h];
    f32x4 cacc[8];
    float m;
    float cw0[8], cw1[8], cw2[8], cbb[8];
    { const int g = tid & 31, ch = ((g >> 4) ? 512 : 0) + h * 128 + (g & 15) * 8; const float* cw = p.in[I_CBW] + (size_t)l * 3 * 1024 + ch;
        ld8f(cw, cw0); ld8f(cw + 1024, cw1); ld8f(cw + 2048, cw2); ld8f(p.in[I_CBB] + l * 1024 + ch, cbb); }
    __syncthreads();
    if (s >= 32) {
        const size_t sb = (((size_t)((s - 32) * 2 + l) * 2 + d) * 4 + h);
        const float* C0 = p.in[I_SMC] + sb * 128 * 128;
#pragma unroll
        for (int tn = 0; tn < 8; ++tn)
#pragma unroll
            for (int j = 0; j < 4; ++j) cacc[tn][j] = C0[(16 * wave + quad * 4 + j) * 128 + 16 * tn + l15];
        if (tid < 128) sN[tid] = p.in[I_SMN][sb * 128 + tid];
        m = p.in[I_SMM][sb];
    } else {
#pragma unroll
        for (int tn = 0; tn < 8; ++tn) cacc[tn] = (f32x4){0.f, 0.f, 0.f, 0.f};
        if (tid < 128) sN[tid] = 0.f;
        m = 0.f;
    }
#pragma unroll
    for (int tn = 0; tn < 8; ++tn)
#pragma unroll
        for (int j = 0; j < 4; ++j) sC[(16 * wave + quad * 4 + j) * 136 + 16 * tn + l15] = f2bf(cacc[tn][j]);

    u32x4v px1[4], pvv[2];
#define ML_PREFETCH(CC) do { _Pragma("unroll") for (int it = 0; it < 4; ++it) { const int idx = tid + 512 * it, i = idx >> 5, g = idx & 31, ch = ((g >> 4) ? 512 : 0) + h * 128 + (g & 15) * 8; \
            const int ii = 64 * (CC) + i, pos = d == 0 ? ii : T - 1 - ii; px1[it] = *(const u32x4v*)(proj + (size_t)(tok0 + pos) * NP + B_Q + ch); } \
        _Pragma("unroll") for (int it = 0; it < 2; ++it) { const int idx = tid + 512 * it, i = idx >> 4, g = idx & 15; const int ii = 64 * (CC) + i, tk = d == 0 ? tok0 + ii : tok0 + T - 1 - ii; \
            pvv[it] = *(const u32x4v*)(proj + (size_t)tk * NP + B_V + h * 128 + 8 * g); } } while (0)
    ML_PREFETCH(0);
    float gi_n = 0.f, gf_n = 0.f;
    if (wave == 0) { const int tk = d == 0 ? tok0 + lane : tok0 + T - 1 - lane; gi_n = gates[(size_t)tk * 16 + d * 4 + h]; gf_n = gates[(size_t)tk * 16 + 8 + d * 4 + h]; }
    for (int c = 0; c < nch; ++c) {
        __syncthreads();
        if (wave == 0) {
            const float gi = gi_n + bi, gf = gf_n + bfb;
            if (c + 1 < nch) { const int ii = 64 * (c + 1) + lane; const int tk = d == 0 ? tok0 + ii : tok0 + T - 1 - ii; gi_n = gates[(size_t)tk * 16 + d * 4 + h]; gf_n = gates[(size_t)tk * 16 + 8 + d * 4 + h]; }
            const float lf = fminf(gf, 0.f) - log1pf(__expf(-fabsf(gf)));
            float b = lf;
#pragma unroll
            for (int off = 1; off < 64; off <<= 1) { const float t = __shfl_up(b, off); if (lane >= off) b += t; }
            const float a = gi - b; float pm = a;
#pragma unroll
            for (int off = 1; off < 64; off <<= 1) { const float t = __shfl_up(pm, off); if (lane >= off) pm = fmaxf(pm, t); }
            sB[lane] = b; sA[lane] = a; sPm[lane] = pm;
        }
        __syncthreads();
        const float mx = fmaxf(m, sPm[63]), bL = sB[63];
#pragma unroll
        for (int it = 0; it < 4; ++it) {
            const int idx = tid + 512 * it, i = idx >> 5, g = idx & 31, isK = g >> 4, j0 = (g & 15) * 8, ch = (isK ? 512 : 0) + h * 128 + j0;
            const int ii = 64 * c + i, pos = d == 0 ? ii : T - 1 - ii, tk = tok0 + pos;
            const bf16_t* src = proj + (size_t)tk * NP + B_Q + ch;
            float x0[8], x1[8], x2[8], y[8];
            unpack8(px1[it], x1);
            unpack8(*(const u32x4v*)(pos > 0 ? src - NP : src), x0); unpack8(*(const u32x4v*)(pos < T - 1 ? src + NP : src), x2);
            const float m0 = pos > 0 ? 1.f : 0.f, m2 = pos < T - 1 ? 1.f : 0.f;
#pragma unroll
            for (int e = 0; e < 8; ++e) y[e] = siluf_(m0 * x0[e] * cw0[e] + x1[e] * cw1[e] + m2 * x2[e] * cw2[e] + cbb[e]);
            if (!isK) { *(LAS u32x4v*)(sQ + i * 136 + j0) = pack8(y); }
            else {
                const float wgi = __expf(sA[i] - mx);
#pragma unroll
                for (int e = 0; e < 8; ++e) y[e] *= 0.08838834764831845f;
                *(LAS u32x4v*)(sK + i * 136 + j0) = pack8(y);
#pragma unroll
                for (int e = 0; e < 8; ++e) sKt[(j0 + e) * 72 + (i ^ (8 * ((j0 >> 3) & 7)))] = f2bf(y[e] * wgi);
            }
        }
#pragma unroll
        for (int it = 0; it < 2; ++it) {
            const int idx = tid + 512 * it, i = idx >> 4, g = idx & 15;
            const int ii = 64 * c + i, tk = d == 0 ? tok0 + ii : tok0 + T - 1 - ii;
            const u32x4v w = pvv[it];
            LAS bf16_t* dst = sVt + (8 * g) * 72 + (i ^ (8 * (g & 7)));
            dst[0] = (bf16_t)(w.x & 0xffff); dst[72] = (bf16_t)(w.x >> 16); dst[144] = (bf16_t)(w.y & 0xffff); dst[216] = (bf16_t)(w.y >> 16);
            dst[288] = (bf16_t)(w.z & 0xffff); dst[360] = (bf16_t)(w.z >> 16); dst[432] = (bf16_t)(w.w & 0xffff); dst[504] = (bf16_t)(w.w >> 16);
        }
        if (c + 1 < nch) ML_PREFETCH(c + 1);
        __syncthreads();
        const int tm = wave >> 1;
        {
            const int tn0 = (wave & 1) * 2;
#pragma unroll
            for (int tt = 0; tt < 2; ++tt) {
                f32x4 acc = {0.f, 0.f, 0.f, 0.f};
#pragma unroll
                for (int ks = 0; ks < 4; ++ks) acc = MFMA16(frag(sQ, 16 * tm, 136, 32 * ks, lane), frag(sK, 16 * (tn0 + tt), 136, 32 * ks, lane), acc);
                const int scol = 16 * (tn0 + tt) + l15; const float as = sA[scol];
#pragma unroll
                for (int j = 0; j < 4; ++j) { const int t = 16 * tm + quad * 4 + j;
                    float pv = scol <= t ? __expf(as - fmaxf(m, sPm[t])) * acc[j] : 0.f;
                    sP[t * 72 + scol] = f2bf(pv);
                    pv = red16_sum(pv);
                    if (l15 == 0) sPs[t * 4 + tn0 + tt] = pv; }
            }
        }
        const int tnb = (wave & 1) * 4;
        f32x4 accq[4];
#pragma unroll
        for (int tt = 0; tt < 4; ++tt) { accq[tt] = (f32x4){0.f, 0.f, 0.f, 0.f};
#pragma unroll
            for (int ks = 0; ks < 4; ++ks) accq[tt] = MFMA16(frag(sQ, 16 * tm, 136, 32 * ks, lane), frag(sC, 16 * (tnb + tt), 136, 32 * ks, lane), accq[tt]); }
        { const int t = tid >> 3, part = tid & 7; float sacc = 0.f;
#pragma unroll
            for (int e = 0; e < 16; ++e) sacc += sN[16 * part + e] * bf2f(sQ[t * 136 + 16 * part + e]);
            sacc += __shfl_xor(sacc, 1); sacc += __shfl_xor(sacc, 2); sacc += __shfl_xor(sacc, 4);
            if (part == 0) sNq[t] = sacc; }
        __syncthreads();
        {
            f32x4 accp[4];
#pragma unroll
            for (int tt = 0; tt < 4; ++tt) { accp[tt] = (f32x4){0.f, 0.f, 0.f, 0.f};
#pragma unroll
                for (int ks = 0; ks < 2; ++ks) accp[tt] = MFMA16(frag(sP, 16 * tm, 72, 32 * ks, lane), fragsw(sVt, 16 * (tnb + tt), 32 * ks, lane), accp[tt]); }
#pragma unroll
            for (int j = 0; j < 4; ++j) { const int t = 16 * tm + quad * 4 + j;
                const float mtm = fmaxf(m, sPm[t]), wi = __expf(m - mtm);
                const float den = wi * sNq[t] + ((sPs[t * 4] + sPs[t * 4 + 1]) + (sPs[t * 4 + 2] + sPs[t * 4 + 3]));
                const float mt = sB[t] + mtm; const float inv = 1.0f / fmaxf(fabsf(den), __expf(-mt));
                const int ii = 64 * c + t, tk = d == 0 ? tok0 + ii : tok0 + T - 1 - ii;
                float* dst = hd + (size_t)tk * 512 + h * 128 + 16 * tnb + l15;
#pragma unroll
                for (int tt = 0; tt < 4; ++tt) dst[16 * tt] = (wi * accq[tt][j] + accp[tt][j]) * inv; }
        }
        const float sc = __expf(m - mx);
        if (tid < 128) { float ns = 0.f;
#pragma unroll 8
            for (int e = 0; e < 64; ++e) ns += bf2f(sKt[tid * 72 + e]);
            sN[tid] = sc * sN[tid] + ns; }
#pragma unroll
        for (int tn = 0; tn < 8; ++tn) { f32x4 dc = {0.f, 0.f, 0.f, 0.f};
#pragma unroll
            for (int ks = 0; ks < 2; ++ks) dc = MFMA16(fragsw(sVt, 16 * wave, 32 * ks, lane), fragsw(sKt, 16 * tn, 32 * ks, lane), dc);
            cacc[tn] = sc * cacc[tn] + dc;
#pragma unroll
            for (int j = 0; j < 4; ++j) sC[(16 * wave + quad * 4 + j) * 136 + 16 * tn + l15] = f2bf(cacc[tn][j]); }
        m = bL + mx;
    }
    __syncthreads();
    if (s < 32) {
        const size_t sb = (((size_t)(s * 2 + l) * 2 + d) * 4 + h);
        float* Co = p.out + O_MC + sb * 128 * 128;
#pragma unroll
        for (int tn = 0; tn < 8; ++tn)
#pragma unroll
            for (int j = 0; j < 4; ++j) Co[(16 * wave + quad * 4 + j) * 128 + 16 * tn + l15] = cacc[tn][j];
        if (tid < 128) p.out[O_MN + sb * 128 + tid] = sN[tid];
        if (tid == 0) p.out[O_MM + sb] = m;
    }
}

#undef ML_PREFETCH
__device__ __forceinline__ void attn_task(const Params& p, int l, int task, LAS unsigned char* lds) {
    const int tid = opaque_tid(), lane = tid & 63, wave = tid >> 6, quad = lane >> 4, l15 = lane & 15;
    const bool samp = task < 128;
    int b, h, qb;
    if (samp) { b = task >> 6; h = (task >> 3) & 7; qb = task & 7; } else { const int t2 = task - 128; b = t2 >> 4; h = (t2 >> 1) & 7; qb = t2 & 1; }
    const int tok0 = samp ? NPT + b * 1024 : b * 256, nkt = samp ? 24 : 4, nct = samp ? 8 : 0;
    LAS bf16_t* sK = (LAS bf16_t*)lds;
    LAS bf16_t* sVt = sK + 64 * 136;
    LAS bf16_t* sPw = sVt + 128 * 72 + wave * (16 * 72);
    const bf16_t* proj = (const bf16_t*)(p.ws + WS_PROJ);
    const bf16_t* ck = (const bf16_t*)(p.ws + WS_KC) + (((unsigned)(b * 2 + l) * 8 + h) * 512) * 128;
    const bf16_t* cv = (const bf16_t*)(p.ws + WS_VTC) + (((unsigned)(b * 2 + l) * 8 + h) * 128) * 512;
    const float lam = ((const float*)(p.ws + WS_LAM))[l];
    const float lam_init = 0.8f - 0.6f * expf(-0.3f * (float)l);
    const int q0 = 128 * qb + 16 * wave;
    bf16x8 aq1[2], aq2[2];
    { const bf16_t* qp = proj + (unsigned)(tok0 + q0 + l15) * NP + C_Q + h * 128 + quad * 8;
        aq1[0] = *(const bf16x8*)qp; aq1[1] = *(const bf16x8*)(qp + 32); aq2[0] = *(const bf16x8*)(qp + 64); aq2[1] = *(const bf16x8*)(qp + 96); }
    LAS bf16_t* sQw = sVt + 128 * 72 + wave * (16 * 136);
    { LAS bf16_t* qd = sQw + l15 * 136 + quad * 8;
        *(LAS bf16x8*)qd = aq1[0]; *(LAS bf16x8*)(qd + 32) = aq1[1]; *(LAS bf16x8*)(qd + 64) = aq2[0]; *(LAS bf16x8*)(qd + 96) = aq2[1]; }
    LDS_FENCE();
    float mx1 = -INFINITY, mx2 = -INFINITY, sm1 = 0.f, sm2 = 0.f, mc1 = 0.f, mc2 = 0.f;
    constexpr float CS = 0.125f * 1.4426950408889634f;
    f32x4 o1[8], o2[8];
#pragma unroll
    for (int tn = 0; tn < 8; ++tn) { o1[tn] = (f32x4){0.f, 0.f, 0.f, 0.f}; o2[tn] = o1[tn]; }
    u32x4v kreg[2], vreg[2];
#define ATT_LOAD(KT, PASS) do { int ktv = (KT); asm volatile("" : "+v"(ktv));     \
    _Pragma("unroll") for (int it = 0; it < 2; ++it) { const int idx = tid + 512 * it, i = idx >> 4, g = idx & 15; \
        if ((KT) < nct) { kreg[it] = *(const u32x4v*)(ck + (unsigned)((64 * ktv + i) * 128 + 8 * g)); \
            if ((PASS) == 1) { const int dv = idx >> 3, mm = idx & 7; vreg[it] = *(const u32x4v*)(cv + (unsigned)(dv * 512 + 64 * ktv + 8 * mm)); } } \
        else { kreg[it] = *(const u32x4v*)(proj + (unsigned)((tok0 + 64 * (ktv - nct) + i) * NP + C_K + h * 128 + 8 * g)); \
            if ((PASS) == 1) vreg[it] = *(const u32x4v*)(proj + (unsigned)((tok0 + 64 * (ktv - nct) + (idx & 63)) * NP + C_V + h * 128 + 8 * (idx >> 6))); } } } while (0)
#define ATT_LOADK(BUF, KT) do { int ktv = (KT); asm volatile("" : "+v"(ktv)); _Pragma("unroll") for (int it = 0; it < 2; ++it) { const int idx = tid + 512 * it, i = idx >> 4, g = idx & 15; \
        if ((KT) < nct) BUF[it] = *(const u32x4v*)(ck + (unsigned)((64 * ktv + i) * 128 + 8 * g)); \
        else BUF[it] = *(const u32x4v*)(proj + (unsigned)((tok0 + 64 * (ktv - nct) + i) * NP + C_K + h * 128 + 8 * g)); } } while (0)
#define ATT_P0TILE(BUF, KT) do { __syncthreads(); \
        _Pragma("unroll") for (int it = 0; it < 2; ++it) { const int idx = tid + 512 * it, i = idx >> 4, g = idx & 15; *(LAS u32x4v*)(sK + i * 136 + 8 * g) = BUF[it]; } \
        if ((KT) + 2 < nkt) ATT_LOADK(BUF, (KT) + 2); \
        __syncthreads(); \
        _Pragma("unroll") for (int tn = 0; tn < 4; ++tn) { f32x4 a_ = {0.f, 0.f, 0.f, 0.f}, b_ = a_; \
            _Pragma("unroll") for (int ks = 0; ks < 2; ++ks) { a_ = MFMA16(frag(sK, 16 * tn, 136, 32 * ks, lane), aq1[ks], a_); b_ = MFMA16(frag(sK, 16 * tn, 136, 64 + 32 * ks, lane), aq2[ks], b_); } \
            _Pragma("unroll") for (int j = 0; j < 4; ++j) { mx1 = fmaxf(mx1, a_[j]); mx2 = fmaxf(mx2, b_[j]); } } } while (0)
    ATT_LOADK(kreg, 0); ATT_LOADK(vreg, 1);
    for (int kt = 0; kt < nkt; kt += 2) { ATT_P0TILE(kreg, kt); ATT_P0TILE(vreg, kt + 1); }
#undef ATT_LOADK
#undef ATT_P0TILE
    mx1 = fmaxf(mx1, __shfl_xor(mx1, 16)); mx1 = fmaxf(mx1, __shfl_xor(mx1, 32)); mx2 = fmaxf(mx2, __shfl_xor(mx2, 16)); mx2 = fmaxf(mx2, __shfl_xor(mx2, 32)); mc1 = mx1 * CS; mc2 = mx2 * CS;
    u32x4v kreg2[2], vreg2[2];
#define ATT_LOADKV(KB, VB, KT) do { int ktv = (KT); asm volatile("" : "+v"(ktv)); _Pragma("unroll") for (int it = 0; it < 2; ++it) { const int idx = tid + 512 * it, i = idx >> 4, g = idx & 15; \
        if ((KT) < nct) { KB[it] = *(const u32x4v*)(ck + (unsigned)((64 * ktv + i) * 128 + 8 * g)); const int dv = idx >> 3, mm = idx & 7; VB[it] = *(const u32x4v*)(cv + (unsigned)(dv * 512 + 64 * ktv + 8 * mm)); } \
        else { KB[it] = *(const u32x4v*)(proj + (unsigned)((tok0 + 64 * (ktv - nct) + i) * NP + C_K + h * 128 + 8 * g)); \
            VB[it] = *(const u32x4v*)(proj + (unsigned)((tok0 + 64 * (ktv - nct) + (idx & 63)) * NP + C_V + h * 128 + 8 * (idx >> 6))); } } } while (0)
#define ATT_STAGEKV(KB, VB, KT) do { _Pragma("unroll") for (int it = 0; it < 2; ++it) { const int idx = tid + 512 * it, i = idx >> 4, g = idx & 15; \
        *(LAS u32x4v*)(sK + i * 136 + 8 * g) = KB[it]; \
        if ((KT) < nct) { const int dv = idx >> 3, mm = idx & 7; *(LAS u32x4v*)(sVt + dv * 72 + 8 * mm) = VB[it]; } \
        else { const u32x4v w = VB[it]; LAS bf16_t* dst = sVt + (8 * (idx >> 6)) * 72 + (idx & 63); \
            dst[0] = (bf16_t)(w.x & 0xffff); dst[72] = (bf16_t)(w.x >> 16); dst[144] = (bf16_t)(w.y & 0xffff); dst[216] = (bf16_t)(w.y >> 16); \
            dst[288] = (bf16_t)(w.z & 0xffff); dst[360] = (bf16_t)(w.z >> 16); dst[432] = (bf16_t)(w.w & 0xffff); dst[504] = (bf16_t)(w.w >> 16); } } } while (0)
    auto p1_compute = [&]() {
#pragma unroll
            for (int bb = 0; bb < 2; ++bb) {
                f32x4 s1[2], s2[2];
#pragma unroll
                for (int t = 0; t < 2; ++t) { s1[t] = (f32x4){0.f, 0.f, 0.f, 0.f}; s2[t] = s1[t];
#pragma unroll
                    for (int ks = 0; ks < 2; ++ks) { s1[t] = MFMA16(frag(sK, 32 * bb + 16 * t, 136, 32 * ks, lane), aq1[ks], s1[t]); s2[t] = MFMA16(frag(sK, 32 * bb + 16 * t, 136, 64 + 32 * ks, lane), aq2[ks], s2[t]); } }
                {
                    bf16x8 pa1, pa2;
                    { float p1[8];
#pragma unroll
                        for (int jj = 0; jj < 8; ++jj) { p1[jj] = __builtin_amdgcn_exp2f(s1[jj >> 2][jj & 3] * CS - mc1); sm1 += p1[jj]; }
                        pa1 = __builtin_bit_cast(bf16x8, pack8(p1)); }
                    { float p2[8];
#pragma unroll
                        for (int jj = 0; jj < 8; ++jj) { p2[jj] = __builtin_amdgcn_exp2f(s2[jj >> 2][jj & 3] * CS - mc2); sm2 += p2[jj]; }
                        pa2 = __builtin_bit_cast(bf16x8, pack8(p2)); }
#pragma unroll
                    for (int tn2 = 0; tn2 < 8; ++tn2) { const LAS bf16_t* vrow = sVt + (16 * tn2 + l15) * 72 + 32 * bb + quad * 4;
                        const u32x2v lo = *(const LAS u32x2v*)vrow, hi = *(const LAS u32x2v*)(vrow + 16);
                        u32x4v vw; vw.x = lo.x; vw.y = lo.y; vw.z = hi.x; vw.w = hi.y;
                        const bf16x8 vb = __builtin_bit_cast(bf16x8, vw);
                        o1[tn2] = MFMA16(pa1, vb, o1[tn2]); o2[tn2] = MFMA16(pa2, vb, o2[tn2]); }
                }
                asm volatile("" ::: "memory");
            }
    };
#define ATT_P1TILE(KB, VB, KT) do { __syncthreads(); ATT_STAGEKV(KB, VB, KT); if ((KT) + 2 < nkt) ATT_LOADKV(KB, VB, (KT) + 2); __syncthreads(); p1_compute(); } while (0)
    ATT_LOADKV(kreg, vreg, 0); ATT_LOADKV(kreg2, vreg2, 1);
    for (int kt = 0; kt < nkt; kt += 2) { ATT_P1TILE(kreg, vreg, kt); ATT_P1TILE(kreg2, vreg2, kt + 1); }
#undef ATT_LOADKV
#undef ATT_STAGEKV
#undef ATT_P1TILE
    sm1 += __shfl_xor(sm1, 16); sm1 += __shfl_xor(sm1, 32); sm2 += __shfl_xor(sm2, 16); sm2 += __shfl_xor(sm2, 32);
    const float il1 = 1.0f / sm1, il2 = lam / sm2;
    float f1[4], f2[4];
#pragma unroll
    for (int j = 0; j < 4; ++j) { f1[j] = __shfl(il1, quad * 4 + j); f2[j] = __shfl(il2, quad * 4 + j); }
#pragma unroll
    for (int tn = 0; tn < 8; ++tn)
#pragma unroll
        for (int j = 0; j < 4; ++j) o1[tn][j] = o1[tn][j] * f1[j] - o2[tn][j] * f2[j];
    asm volatile("" ::: "memory");
#define oacc o1
#undef ATT_LOAD
    bf16_t* mixed = (bf16_t*)(p.ws + WS_UM);
    const float* sg = p.in[I_SUBG] + l * 128;
#pragma unroll
    for (int j = 0; j < 4; ++j) {
        float ss = 0.f;
#pragma unroll
        for (int tn = 0; tn < 8; ++tn) ss += oacc[tn][j] * oacc[tn][j];
        ss = red16_sum(ss);
        const float r = rsqrtf(ss * (1.0f / 128.0f) + 1e-5f) * (1.0f - lam_init);
        const int tq = tok0 + q0 + quad * 4 + j;
#pragma unroll
        for (int tn = 0; tn < 8; ++tn) { const int dv = 16 * tn + l15;
            const float gt = bf2f(proj[(unsigned)tq * NP + C_G + h * 128 + dv]);
            mixed[(unsigned)tq * DM + 1024 + h * 128 + dv] = f2bf(oacc[tn][j] * r * sg[dv] * siluf_(gt)); }
    }
}

#undef oacc
__device__ __forceinline__ void rwkv_prep_task(const Params& p, int l, int task, LAS unsigned char* lds) {
    const int tid = opaque_tid(), lane = tid & 63, wave = tid >> 6, quad = lane >> 4, l15 = lane & 15;
    const int tile = task >> 3, h = task & 7, tb = 64 * tile;
    const int T = tb < NPT ? 256 : 1024, seq0 = tb < NPT ? (tb & ~255) : NPT + ((tb - NPT) & ~1023);
    LAS bf16_t* sTW = (LAS bf16_t*)lds;
    LAS bf16_t* sAD = sTW + 2 * 64 * 72;
    LAS bf16_t* sWup = sAD + 2 * 64 * 72;
    LAS bf16_t* sAup = sWup + 2 * 64 * 72;
    LAS float* sR = (LAS float*)(sAup + 2 * 64 * 72);
    LAS float* sKf = sR + 4096; LAS float* sVf = sKf + 4096; LAS float* sNrm = sVf + 4096; LAS float* sRK = sNrm + 64;
    const bf16_t* proj = (const bf16_t*)(p.ws + WS_PROJ);
    __syncthreads();
#pragma unroll
    for (int it = 0; it < 4; ++it) {
        const int idx = tid + 512 * it, arr = idx >> 9, i = (idx >> 3) & 63, g = idx & 7;
        const u32x4v w = *(const u32x4v*)(proj + (size_t)(tb + i) * NP + A_WD + 64 * arr + 8 * g);
        if (arr < 2) { float x[8]; unpack8(w, x);
#pragma unroll
            for (int e = 0; e < 8; ++e) x[e] = tanhf_(x[e]);
            *(LAS u32x4v*)(sTW + (arr * 64 + i) * 72 + 8 * g) = pack8(x); }
        else *(LAS u32x4v*)(sAD + ((arr - 2) * 64 + i) * 72 + 8 * g) = w;
    }
#pragma unroll
    for (int it = 0; it < 4; ++it) {
        const int dd2 = it >> 1, which = it & 1, c = tid >> 3, jg = tid & 7;
        const bf16_t* src = (const bf16_t*)(p.ws + WS_WUPT) + ((((size_t)(l * 2 + dd2) * 2 + which) * 8 + h) * 4096) + c * 64 + 8 * jg;
        *(LAS u32x4v*)((which ? sAup : sWup) + (dd2 * 64 + c) * 72 + 8 * jg) = *(const u32x4v*)src;
    }
#pragma unroll
    for (int it = 0; it < 3; ++it) {
        const int idx = tid + 512 * it, which = idx >> 9, i = (idx >> 3) & 63, g = idx & 7, ch = which * 512 + h * 64 + 8 * g;
        const int tk = tb + i, pos = tk - seq0;
        const bf16_t* src = proj + (size_t)tk * NP + ch;
        float x0[8], x1[8], x2[8], w0[8], w1[8], w2[8], bb[8];
        unpack8(*(const u32x4v*)src, x1);
        unpack8(*(const u32x4v*)(pos > 0 ? src - NP : src), x0); unpack8(*(const u32x4v*)(pos < T - 1 ? src + NP : src), x2);
        const float m0 = pos > 0 ? 1.f : 0.f, m2 = pos < T - 1 ? 1.f : 0.f;
        const float* cw = p.in[I_CAW] + (size_t)l * 3 * 1536 + ch;
        ld8f(cw, w0); ld8f(cw + 1536, w1); ld8f(cw + 3072, w2); ld8f(p.in[I_CAB] + l * 1536 + ch, bb);
        LAS float* dst = (which == 0 ? sR : (which == 1 ? sKf : sVf)) + i * 64 + 8 * g;
#pragma unroll
        for (int e = 0; e < 8; ++e) dst[e] = m0 * x0[e] * w0[e] + x1[e] * w1[e] + m2 * x2[e] * w2[e] + bb[e];
    }
    __syncthreads();
    { const int t = tid >> 3, part = tid & 7; float ss = 0.f;
#pragma unroll
        for (int e = 0; e < 8; ++e) { const float v = sKf[t * 64 + 8 * part + e] * p.in[I_KK][l * 512 + h * 64 + 8 * part + e]; ss += v * v; }
        ss += __shfl_xor(ss, 1); ss += __shfl_xor(ss, 2); ss += __shfl_xor(ss, 4);
        if (part == 0) sNrm[t] = rsqrtf(ss + 1e-12f); }
    const int dd = wave >> 2, tm = wave & 3;
    f32x4 aw[4], aa[4];
#pragma unroll
    for (int tn = 0; tn < 4; ++tn) { aw[tn] = (f32x4){0.f, 0.f, 0.f, 0.f}; aa[tn] = aw[tn];
#pragma unroll
        for (int ks = 0; ks < 2; ++ks) { aw[tn] = MFMA16(frag(sTW + dd * 64 * 72, 16 * tm, 72, 32 * ks, lane), frag(sWup + dd * 64 * 72, 16 * tn, 72, 32 * ks, lane), aw[tn]);
            aa[tn] = MFMA16(frag(sAD + dd * 64 * 72, 16 * tm, 72, 32 * ks, lane), frag(sAup + dd * 64 * 72, 16 * tn, 72, 32 * ks, lane), aa[tn]); } }
    __syncthreads();
    {
        LAS bf16_t* so = sTW + dd * (3 * 4096);
        float rk[4] = {0.f, 0.f, 0.f, 0.f};
#pragma unroll
        for (int tn = 0; tn < 4; ++tn) { const int c = 16 * tn + l15, ch = h * 64 + c;
            const float w0v = p.in[I_W0][(l * 2 + dd) * 512 + ch], a0v = p.in[I_A0][(l * 2 + dd) * 512 + ch], kav = p.in[I_KA][l * 512 + ch], kkv = p.in[I_KK][l * 512 + ch], rkv = p.in[I_RK][l * 512 + ch];
#pragma unroll
            for (int j = 0; j < 4; ++j) { const int t = 16 * tm + quad * 4 + j; const int o = t * 64 + c;
                const float z = w0v + aw[tn][j]; const float dec = __expf(-0.6065306597126334f * sigmoidf_(z));
                const float av = sigmoidf_(a0v + aa[tn][j]); const float kv = sKf[t * 64 + c];
                const float ktv = kv * (1.0f + (av - 1.0f) * kav); const float kk = kv * kkv * sNrm[t];
                so[o] = f2bf(ktv); so[4096 + o] = f2bf(kk * av); so[8192 + o] = f2bf(dec - 1.0f);
                rk[j] += sR[t * 64 + c] * ktv * rkv; } }
#pragma unroll
        for (int j = 0; j < 4; ++j) { const float s = red16_sum(rk[j]); if (l15 == 0) sRK[dd * 64 + 16 * tm + quad * 4 + j] = s; }
    }
    __syncthreads();
    { const int i = tid >> 3, g = tid & 7; const size_t o = (size_t)(tb + i) * 512 + h * 64 + 8 * g;
        float r[8], k[8], v[8], bn[8]; const float nr = sNrm[i], rks = sRK[i] + sRK[64 + i];
#pragma unroll
        for (int e = 0; e < 8; ++e) { r[e] = sR[i * 64 + 8 * g + e]; k[e] = sKf[i * 64 + 8 * g + e] * p.in[I_KK][l * 512 + h * 64 + 8 * g + e] * nr; v[e] = sVf[i * 64 + 8 * g + e]; bn[e] = rks * v[e]; }
        const size_t o2 = ((size_t)(tb + i) * 8 + h) * 320 + 8 * g; bf16_t* pk = (bf16_t*)(p.ws + WS_PK);
#pragma unroll
        for (int dd2 = 0; dd2 < 2; ++dd2)
#pragma unroll
            for (int ar = 0; ar < 3; ++ar) *(u32x4v*)(pk + (size_t)dd2 * NTOK * 2560 + o2 + 128 + 64 * ar) = *(const LAS u32x4v*)(sTW + dd2 * (3 * 4096) + ar * 4096 + i * 64 + 8 * g);
        const u32x4v rr = pack8(r), kk8 = pack8(k);
        *(u32x4v*)(pk + o2) = rr; *(u32x4v*)(pk + o2 + 64) = kk8; *(u32x4v*)(pk + (size_t)NTOK * 2560 + o2) = rr; *(u32x4v*)(pk + (size_t)NTOK * 2560 + o2 + 64) = kk8;
        *(u32x4v*)((bf16_t*)(p.ws + WS_SCV) + o) = pack8(v); *(u32x4v*)((bf16_t*)(p.ws + WS_SCBON) + o) = pack8(bn); }
}

__device__ __forceinline__ void m1_phase(const Params& p, int l, LAS unsigned char* lds, int rep, int mask) {
    unsigned* ctr = (unsigned*)(p.ws + WS_CTL) + 64 * (1 + 4 * l + 8 * rep);
    LAS int* slot = (LAS int*)(lds + LDS_SLOT);
#ifndef NO_MLSTM
    if (mask & 1) for (;;) { const int t = next_task(ctr, slot); if (t >= 272) break; const int u = t < 16 ? t + 256 : t - 16; mlstm_task(p, l, u >> 3, (u >> 2) & 1, u & 3, lds); }
#endif
#ifndef NO_ATTN
    if (mask & 2) for (;;) { const int t = next_task(ctr + 64, slot); if (t >= 640) break; attn_task(p, l, t, lds); }
#endif
#ifndef NO_PREP
    if (mask & 4) for (;;) { const int t = next_task(ctr + 128, slot); if (t >= 1280) break; rwkv_prep_task(p, l, t, lds); }
#endif
}

#ifdef EXP_LITE
#if EXP_LITE == 1
#define EXPY(v) (bf2f(sBt[(quad * 4 + j) * 24 + l15]) + bf2f(sGt[(16 + quad * 4 + j) * 24 + l15]) + sW[l15 + 16 * quad])
#elif EXP_LITE == 2
#define EXPY(v) (bf2f(sAt[(quad * 4 + j) * 72 + l15]) + bf2f(sX2[(quad * 4 + j) * 24 + l15]))
#else
#define EXPY(v) (bf2f(sPy[(quad * 4 + j) * 72 + 16 + l15]) + bf2f(sQy[(quad * 4 + j) * 24 + l15]))
#endif
#define EXPS(v) 0.f
#else
#define EXPY(v) (v)
#define EXPS(v) (v)
#endif
__device__ __forceinline__ bf16_t f2bf_sw(float f) { unsigned u = __float_as_uint(f); u += 0x7FFFu + ((u >> 16) & 1u); return (bf16_t)(u >> 16); }
__device__ __forceinline__ bf16x8 frag16(const LAS bf16_t* base, int row0, int ld, int lane) {
    bf16x8 z = {0, 0, 0, 0, 0, 0, 0, 0};
    if ((lane >> 4) < 2) z = *(const LAS bf16x8*)(base + (row0 + (lane & 15)) * ld + (lane >> 4) * 8);
    return z;
}
__device__ __forceinline__ void cp_task(const Params& p, int task, int lane, LAS unsigned char* wl) {
    int s, d, h, c, T;
    if (task < 8192) { s = task >> 8; d = (task >> 7) & 1; h = (task >> 4) & 7; c = task & 15; T = 256; }
    else { const int u = task - 8192; s = 32 + (u >> 10); d = (u >> 9) & 1; h = (u >> 6) & 7; c = u & 63; T = 1024; }
    const int tok0 = s < 32 ? s * 256 : NPT + (s - 32) * 1024, quad = lane >> 4, l15 = lane & 15;
    const long step = d == 0 ? 1 : -1; const int tfirst = d == 0 ? tok0 + 16 * c : tok0 + T - 1 - 16 * c;
    bf16_t* pk = (bf16_t*)(p.ws + WS_PK) + (size_t)d * NTOK * 2560 + ((size_t)tfirst * 8 + h) * 320;
    LAS bf16_t* sA = (LAS bf16_t*)wl;
    LAS bf16_t* sB = sA + 16 * 72, *sG = sB + 16 * 72, *sR = sG + 16 * 72;
    LAS float* mL1 = (LAS float*)(sR + 16 * 72);
    LAS bf16_t* sL2 = (LAS bf16_t*)(mL1 + 16 * 17);
    LAS bf16_t* sM1t = sL2 + 16 * 24;
    LAS bf16_t* sTt = sM1t + 16 * 24;
    LAS bf16_t* sAtil = sTt + 16 * 24;
    LAS bf16_t* sX2 = sTt;
    LAS bf16_t* oAt = sB;
    LAS bf16_t* oPy = sG;
    LAS bf16_t* oX2 = (LAS bf16_t*)mL1;
    LAS bf16_t* oQy = sL2;
    float bt[16], gt[16], W = 1.0f;
    { const int k = lane;
        float rr[16], kk[16], kt[16], ka[16], wm[16];
#pragma unroll
        for (int i = 0; i < 16; ++i) { const bf16_t* rec = pk + step * 2560 * i + k; rr[i] = bf2f(rec[0]); kk[i] = bf2f(rec[64]); kt[i] = bf2f(rec[128]); ka[i] = bf2f(rec[192]); wm[i] = bf2f(rec[256]); }
#pragma unroll
        for (int i = 0; i < 16; ++i) { const float Wp = W; W = W + W * wm[i]; const float iw = __builtin_amdgcn_rcpf(W);
            sA[i * 72 + k] = f2bf(Wp * kk[i]); bt[i] = ka[i] * iw; gt[i] = kt[i] * iw; sB[i * 72 + k] = f2bf(bt[i]); sG[i * 72 + k] = f2bf(gt[i]); sR[i * 72 + k] = f2bf(W * rr[i]); } }
    LDS_FENCE();
    f32x4 m2acc;
    { f32x4 a1 = {0.f, 0.f, 0.f, 0.f}, a2 = a1, a3 = a1, a4 = a1;
#pragma unroll
        for (int ks = 0; ks < 2; ++ks) { const bf16x8 fb = frag(sB, 0, 72, 32 * ks, lane), fg = frag(sG, 0, 72, 32 * ks, lane), fa = frag(sA, 0, 72, 32 * ks, lane), fr = frag(sR, 0, 72, 32 * ks, lane);
            a1 = MFMA16(fb, fa, a1); a2 = MFMA16(fg, fa, a2); a3 = MFMA16(fb, fr, a3); a4 = MFMA16(fg, fr, a4); }
#pragma unroll
        for (int j = 0; j < 4; ++j) { const int i = quad * 4 + j, t = l15;
            mL1[i * 17 + t] = i < t ? a1[j] : 0.f; sL2[i * 24 + t] = f2bf(i < t ? a2[j] : 0.f); sM1t[t * 24 + i] = f2bf(i <= t ? a3[j] : 0.f); m2acc[j] = i <= t ? a4[j] : 0.f; } }
    LDS_FENCE();
    { float Tr[16];
#pragma unroll
        for (int t = 0; t < 16; ++t) { float acc = (l15 == t) ? 1.0f : 0.0f;
#pragma unroll
            for (int i = 0; i < t; ++i) acc -= Tr[i] * mL1[i * 17 + t];
            Tr[t] = acc; }
        if (quad == 0) {
#pragma unroll
            for (int t = 0; t < 16; ++t) sTt[t * 24 + l15] = f2bf(Tr[t]); } }
    LDS_FENCE();
    const bf16x8 ftt = frag16(sTt, 0, 24, lane);
#pragma unroll
    for (int kt2 = 0; kt2 < 4; ++kt2) {
        u32x4v aw = {0u, 0u, 0u, 0u};
        if (quad < 2) { const LAS bf16_t* col = sA + (quad * 8) * 72 + 16 * kt2 + l15;
            aw.x = (unsigned)col[0] | ((unsigned)col[72] << 16); aw.y = (unsigned)col[144] | ((unsigned)col[216] << 16); aw.z = (unsigned)col[288] | ((unsigned)col[360] << 16); aw.w = (unsigned)col[432] | ((unsigned)col[504] << 16); }
        f32x4 acc = {0.f, 0.f, 0.f, 0.f};
        acc = MFMA16(__builtin_bit_cast(bf16x8, aw), ftt, acc);
#pragma unroll
        for (int j = 0; j < 4; ++j) { const int k = 16 * kt2 + quad * 4 + j; const bf16_t v = f2bf_sw(acc[j]); sAtil[k * 24 + l15] = v; oAt[l15 * 72 + k] = v; }
    }
    { f32x4 acc = {0.f, 0.f, 0.f, 0.f};
        acc = MFMA16(frag16(sL2, 0, 24, lane), ftt, acc);
#pragma unroll
        for (int j = 0; j < 4; ++j) { const bf16_t v = f2bf_sw(acc[j]); sX2[(quad * 4 + j) * 24 + l15] = v; oX2[l15 * 24 + quad * 4 + j] = v; } }
    LDS_FENCE();
    const bf16x8 fm1 = frag16(sM1t, 0, 24, lane);
#pragma unroll
    for (int kt2 = 0; kt2 < 4; ++kt2) { f32x4 acc = {0.f, 0.f, 0.f, 0.f};
        acc = MFMA16(frag16(sAtil, 16 * kt2, 24, lane), fm1, acc);
#pragma unroll
        for (int j = 0; j < 4; ++j) { const int k = 16 * kt2 + quad * 4 + j; oPy[l15 * 72 + k] = f2bf(bf2f(sR[l15 * 72 + k]) - acc[j]); } }
    { f32x4 acc = {0.f, 0.f, 0.f, 0.f};
        acc = MFMA16(frag16(sX2, 0, 24, lane), fm1, acc);
#pragma unroll
        for (int j = 0; j < 4; ++j) oQy[l15 * 24 + quad * 4 + j] = f2bf(m2acc[j] - acc[j]); }
    LDS_FENCE();
    { float bb8[8]; const int k = lane; bf16_t* rec = pk + step * 2560 * (k >> 2);
#pragma unroll
        for (int hh = 0; hh < 2; ++hh) {
#pragma unroll
            for (int e = 0; e < 8; ++e) bb8[e] = bt[8 * hh + e];
            *(u32x4v*)(rec + 128 + (k & 3) * 16 + 8 * hh) = pack8(bb8);
#pragma unroll
            for (int e = 0; e < 8; ++e) bb8[e] = gt[8 * hh + e];
            *(u32x4v*)(rec + 192 + (k & 3) * 16 + 8 * hh) = pack8(bb8); }
        ((float*)(rec + 288))[k & 3] = W; }
#pragma unroll
    for (int it = 0; it < 2; ++it) { const int f = lane + 64 * it, t = f >> 3, q = f & 7; bf16_t* rec = pk + step * 2560 * t;
        *(u32x4v*)(rec + 8 * q) = *(const LAS u32x4v*)(oAt + t * 72 + 8 * q); *(u32x4v*)(rec + 64 + 8 * q) = *(const LAS u32x4v*)(oPy + t * 72 + 8 * q); }
    if (lane < 32) { const int t = lane >> 1, q = lane & 1; bf16_t* rec = pk + step * 2560 * t;
        *(u32x4v*)(rec + 256 + 8 * q) = *(const LAS u32x4v*)(oX2 + t * 24 + 8 * q); *(u32x4v*)(rec + 272 + 8 * q) = *(const LAS u32x4v*)(oQy + t * 24 + 8 * q); }
    LDS_FENCE();
}
constexpr int CP_LDS = 16 * 72 * 2 * 4 + 16 * 17 * 4 + (16 * 24 * 3 + 64 * 24 + 16 * 24) * 2 + 16 * 72 * 2 * 2 + 16 * 24 * 2 * 2;

__device__ __forceinline__ void ap_task(const Params& p, int l, int task, int lane, LAS unsigned char* wl) {
    int s, d, h, rt;
    if (task < 128) { s = 32 + (task >> 6); d = (task >> 5) & 1; h = (task >> 2) & 7; rt = task & 3; }
    else { const int u = task - 128; s = u >> 6; d = (u >> 5) & 1; h = (u >> 2) & 7; rt = u & 3; }
    const int T = s < 32 ? 256 : 1024, nch = T / 16, tok0 = s < 32 ? s * 256 : NPT + (s - 32) * 1024, quad = lane >> 4, l15 = lane & 15;
    const long step = d == 0 ? 1 : -1; const int tstart = d == 0 ? tok0 : tok0 + T - 1;
    const bf16_t* pk = (const bf16_t*)(p.ws + WS_PK) + (size_t)d * NTOK * 2560 + ((size_t)tstart * 8 + h) * 320;
    const bf16_t* pv = (const bf16_t*)(p.ws + WS_SCV) + (size_t)tstart * 512 + h * 64 + 16 * rt;
    float* yd = (float*)(p.ws + WS_YD) + (size_t)d * NTOK * 512 + (size_t)tstart * 512 + h * 64 + 16 * rt;
    constexpr int IS = 328;
    LAS bf16_t* img = (LAS bf16_t*)wl;
    LAS bf16_t* sS = img + 16 * IS;
    LAS bf16_t* sCm = sS + 16 * 72;
    f32x4 S[4];
    if (s >= 32) { const float* s0 = p.in[I_SRW] + ((((size_t)((s - 32) * 2 + l) * 2 + d) * 8 + h) * 64 + 16 * rt) * 64;
#pragma unroll
        for (int tn = 0; tn < 4; ++tn)
#pragma unroll
            for (int j = 0; j < 4; ++j) S[tn][j] = s0[(quad * 4 + j) * 64 + 16 * tn + l15]; }
    else {
#pragma unroll
        for (int tn = 0; tn < 4; ++tn) S[tn] = (f32x4){0.f, 0.f, 0.f, 0.f}; }
    const bf16_t* gsrc = pk + step * 2560 * (lane >> 2) + 8 * (lane & 3);
    LAS bf16_t* ldst = img + (lane >> 2) * IS + 8 * (lane & 3);
    u32x4v rawA[10], rawB[10]; bf16_t vrA[8], vrB[8];
#define AP_LOAD(raw, vraw, CH) do { int chv = (CH); asm volatile("" : "+v"(chv)); const bf16_t* cb = gsrc + step * 2560 * (16 * chv); \
        _Pragma("unroll") for (int jj = 0; jj < 10; ++jj) raw[jj] = *(const u32x4v*)(cb + 32 * jj); \
        if (quad < 2) { _Pragma("unroll") for (int e = 0; e < 8; ++e) vraw[e] = pv[step * 512 * (16 * chv + quad * 8 + e) + l15]; } } while (0)
#define AP_STAGE(raw) do { _Pragma("unroll") for (int jj = 0; jj < 10; ++jj) *(LAS u32x4v*)(ldst + 32 * jj) = raw[jj]; } while (0)
    AP_LOAD(rawA, vrA, 0);
    if (nch > 1) AP_LOAD(rawB, vrB, 1);
    const LAS bf16_t* pBt = img + (l15 >> 2) * IS + 128 + (l15 & 3) * 16 + quad * 8;
    const LAS float* pW = (const LAS float*)(img + (l15 >> 2) * IS + 288) + (l15 & 3);
#define AP_CHUNK(raw, vraw, CC) do { const int c = (CC); \
        AP_STAGE(raw); \
        u32x4v vw = {0u, 0u, 0u, 0u}; \
        if (quad < 2) { vw.x = (unsigned)vraw[0] | ((unsigned)vraw[1] << 16); vw.y = (unsigned)vraw[2] | ((unsigned)vraw[3] << 16); vw.z = (unsigned)vraw[4] | ((unsigned)vraw[5] << 16); vw.w = (unsigned)vraw[6] | ((unsigned)vraw[7] << 16); } \
        asm volatile("" : "+v"(vw)); \
        if (c + 2 < nch) AP_LOAD(raw, vraw, c + 2); \
        ap_compute(c, vw); } while (0)
    auto ap_compute = [&](int c, u32x4v vw) {
        const bf16x8 va = __builtin_bit_cast(bf16x8, vw);
#pragma unroll
        for (int tn = 0; tn < 4; ++tn) { const unsigned w01 = pk2(S[tn][0], S[tn][1]), w23 = pk2(S[tn][2], S[tn][3]); LAS bf16_t* ds = sS + (quad * 4) * 72 + 16 * tn + l15;
            ds[0] = (bf16_t)(w01 & 0xffff); ds[72] = (bf16_t)(w01 >> 16); ds[144] = (bf16_t)(w23 & 0xffff); ds[216] = (bf16_t)(w23 >> 16); }
        LDS_FENCE();
        f32x4 cm = {0.f, 0.f, 0.f, 0.f}, yy = {0.f, 0.f, 0.f, 0.f};
#pragma unroll
        for (int ks = 0; ks < 2; ++ks) { const bf16x8 fs = frag(sS, 0, 72, 32 * ks, lane); cm = MFMA16(fs, frag(img, 0, IS, 32 * ks, lane), cm); yy = MFMA16(fs, frag(img + 64, 0, IS, 32 * ks, lane), yy); }
        cm = MFMA16(va, frag16(img + 256, 0, IS, lane), cm); yy = MFMA16(va, frag16(img + 272, 0, IS, lane), yy);
#pragma unroll
        for (int j = 0; j < 4; ++j) { yd[step * 512 * (16 * c + l15) + quad * 4 + j] = yy[j]; sCm[(quad * 4 + j) * 24 + l15] = f2bf_sw(cm[j]); }
        LDS_FENCE();
        const bf16x8 fc = frag16(sCm, 0, 24, lane);
#pragma unroll
        for (int tn = 0; tn < 4; ++tn) { f32x4 ab = {0.f, 0.f, 0.f, 0.f}, ag = ab;
            bf16x8 fb = {0, 0, 0, 0, 0, 0, 0, 0}, fg = fb;
            if (quad < 2) { fb = *(const LAS bf16x8*)(pBt + tn * 4 * IS); fg = *(const LAS bf16x8*)(pBt + tn * 4 * IS + 64); }
            ab = MFMA16(fc, fb, ab); ag = MFMA16(va, fg, ag);
            const float w16 = pW[tn * 2 * IS];
#pragma unroll
            for (int j = 0; j < 4; ++j) S[tn][j] = (S[tn][j] - ab[j] + ag[j]) * w16; }
        LDS_FENCE();
    };
    for (int c2 = 0; c2 < nch; c2 += 2) { AP_CHUNK(rawA, vrA, c2); AP_CHUNK(rawB, vrB, c2 + 1); }
#undef AP_CHUNK
#undef AP_LOAD
#undef AP_STAGE
    if (s < 32) { float* so = p.out + O_RW + ((((size_t)(s * 2 + l) * 2 + d) * 8 + h) * 64 + 16 * rt) * 64;
#pragma unroll
        for (int tn = 0; tn < 4; ++tn)
#pragma unroll
            for (int j = 0; j < 4; ++j) so[(quad * 4 + j) * 64 + 16 * tn + l15] = S[tn][j]; }
}
constexpr int AP_LDS = (16 * 72 * 2 + 64 * 24 * 2 + 16 * 24 * 2) * 2 + 64 * 4 + (16 * 72 + 16 * 24) * 2;

typedef float f32x2 __attribute__((ext_vector_type(2)));
__device__ __forceinline__ void m2_phase(const Params& p, int l, int rep, LAS unsigned char* lds, const XcdBarrier& xbar) {
    const int tid_ = opaque_tid(); const int lane = tid_ & 63, wave = tid_ >> 6;
    LAS unsigned char* wl = lds + wave * 16384;
    const int G = gridDim.x, b = blockIdx.x, slot = b * 8 + wave, NW = G * 8;
    for (int t = slot; t < 2048; t += NW) cp_task(p, 8192 + t, lane, wl);
    xcd_barrier(xbar);
    const bool chain_wave = wave == 0 && b < 128;
    if (chain_wave) { for (int t = b; t < 128; t += G) ap_task(p, l, t, lane, wl); }
    else { const int nchain = G < 128 ? G : 128;
        const int idx = b < nchain ? b * 7 + (wave - 1) : nchain * 7 + (b - nchain) * 8 + wave;
        for (int t = idx; t < 8192; t += NW - nchain) cp_task(p, t, lane, wl); }
    xcd_barrier(xbar);
    for (int t = slot; t < 2048; t += NW) ap_task(p, l, 128 + t, lane, wl);
}

__device__ __forceinline__ void m3_phase(const Params& p, int l) {
    const int tid_ = opaque_tid(); const int lane = tid_ & 63, gw = blockIdx.x * 8 + (tid_ >> 6), NGW = gridDim.x * 8;
    const bf16_t* proj = (const bf16_t*)(p.ws + WS_PROJ);
    bf16_t* mixed = (bf16_t*)(p.ws + WS_UM);
    const int c = lane * 8;
    for (int tok = gw; tok < NTOK; tok += NGW) {
        const size_t o = (size_t)tok * 512 + c;
        {
            float y0[8], y1[8], g[8], bb[8], bn[8], gt[8], out[8];
            ld8f((const float*)(p.ws + WS_YD) + o, y0); ld8f((const float*)(p.ws + WS_YD) + (size_t)NTOK * 512 + o, y1);
            float s = 0.f;
#pragma unroll
            for (int e = 0; e < 8; ++e) { y0[e] += y1[e]; s += y0[e]; }
            s += __shfl_xor(s, 1); s += __shfl_xor(s, 2); s += __shfl_xor(s, 4);
            const float mu = s * (1.0f / 64.0f); float q = 0.f;
#pragma unroll
            for (int e = 0; e < 8; ++e) { y0[e] -= mu; q += y0[e] * y0[e]; }
            q += __shfl_xor(q, 1); q += __shfl_xor(q, 2); q += __shfl_xor(q, 4);
            const float rs = rsqrtf(q * (1.0f / 64.0f) + 64e-5f);
            ld8f(p.in[I_RGG] + l * 512 + c, g); ld8f(p.in[I_RGB] + l * 512 + c, bb);
            unpack8(*(const u32x4v*)((const bf16_t*)(p.ws + WS_SCBON) + o), bn);
            unpack8(*(const u32x4v*)(proj + (size_t)tok * NP + A_GATE + c), gt);
#pragma unroll
            for (int e = 0; e < 8; ++e) out[e] = (y0[e] * rs * g[e] + bb[e] + bn[e]) * siluf_(gt[e]);
            *(u32x4v*)(mixed + (size_t)tok * DM + c) = pack8(out);
        }
        {
            float h0[8], h1[8], g[8], bb[8], og[8], gt[8], out[8];
            ld8f((const float*)(p.ws + WS_HD) + o, h0); ld8f((const float*)(p.ws + WS_HD) + (size_t)NTOK * 512 + o, h1);
            unpack8(*(const u32x4v*)(proj + (size_t)tok * NP + B_O + c), og);
            float s = 0.f;
#pragma unroll
            for (int e = 0; e < 8; ++e) { h0[e] = (h0[e] + h1[e]) * sigmoidf_(og[e]); s += h0[e]; }
            s += __shfl_xor(s, 1); s += __shfl_xor(s, 2); s += __shfl_xor(s, 4); s += __shfl_xor(s, 8);
            const float mu = s * (1.0f / 128.0f); float q = 0.f;
#pragma unroll
            for (int e = 0; e < 8; ++e) { h0[e] -= mu; q += h0[e] * h0[e]; }
            q += __shfl_xor(q, 1); q += __shfl_xor(q, 2); q += __shfl_xor(q, 4); q += __shfl_xor(q, 8);
            const float rs = rsqrtf(q * (1.0f / 128.0f) + 1e-5f);
            ld8f(p.in[I_MGG] + l * 512 + c, g); ld8f(p.in[I_MGB] + l * 512 + c, bb);
            unpack8(*(const u32x4v*)(proj + (size_t)tok * NP + B_GATE + c), gt);
#pragma unroll
            for (int e = 0; e < 8; ++e) out[e] = (h0[e] * rs * g[e] + bb[e]) * siluf_(gt[e]);
            *(u32x4v*)(mixed + (size_t)tok * DM + 512 + c) = pack8(out);
        }
    }
}

__device__ __forceinline__ void ln_phase(const Params& p, int l) {
    const int tid_ = opaque_tid(); const int lane = tid_ & 63, gw = blockIdx.x * 8 + (tid_ >> 6), NGW = gridDim.x * 8;
    for (int tok0 = gw; tok0 < NTOK; tok0 += 2 * NGW) {
        const int tok1 = tok0 + NGW; const bool has1 = tok1 < NTOK;
        float* zr0 = p.out + O_Y + (size_t)tok0 * DM; float* zr1 = p.out + O_Y + (size_t)(has1 ? tok1 : tok0) * DM;
        float v0[4][8], v1[4][8]; float s0 = 0.f, s1 = 0.f;
#pragma unroll
        for (int j = 0; j < 4; ++j) { ld8f(zr0 + j * 512 + lane * 8, v0[j]); ld8f(zr1 + j * 512 + lane * 8, v1[j]); }
#pragma unroll
        for (int j = 0; j < 4; ++j)
#pragma unroll
            for (int e = 0; e < 8; ++e) { s0 += v0[j][e]; s1 += v1[j][e]; }
#pragma unroll
        for (int o = 1; o < 64; o <<= 1) { s0 += __shfl_xor(s0, o); s1 += __shfl_xor(s1, o); }
        const float mu0 = s0 * (1.0f / 2048.0f), mu1 = s1 * (1.0f / 2048.0f); float q0 = 0.f, q1 = 0.f;
#pragma unroll
        for (int j = 0; j < 4; ++j)
#pragma unroll
            for (int e = 0; e < 8; ++e) { v0[j][e] -= mu0; q0 += v0[j][e] * v0[j][e]; v1[j][e] -= mu1; q1 += v1[j][e] * v1[j][e]; }
#pragma unroll
        for (int o = 1; o < 64; o <<= 1) { q0 += __shfl_xor(q0, o); q1 += __shfl_xor(q1, o); }
        const float rs0 = rsqrtf(q0 * (1.0f / 2048.0f) + 1e-5f), rs1 = rsqrtf(q1 * (1.0f / 2048.0f) + 1e-5f);
        const float* mod0 = (const float*)(p.ws + WS_MOD) + (size_t)(3 + mod_row(tok0)) * 6144;
        const float* mod1 = (const float*)(p.ws + WS_MOD) + (size_t)(3 + mod_row(has1 ? tok1 : tok0)) * 6144;
        bf16_t* ur0 = (bf16_t*)(p.ws + WS_UM) + (size_t)tok0 * DM; bf16_t* ur1 = (bf16_t*)(p.ws + WS_UM) + (size_t)(has1 ? tok1 : tok0) * DM;
#pragma unroll
        for (int j = 0; j < 4; ++j) { const int c = j * 512 + lane * 8; float g[8], bb[8], y0[8], y1[8];
            ld8f(p.in[I_LNG] + l * DM + c, g); ld8f(p.in[I_LNB] + l * DM + c, bb);
#pragma unroll
            for (int e = 0; e < 8; ++e) { y0[e] = v0[j][e] * rs0 * g[e] + bb[e]; y1[e] = v1[j][e] * rs1 * g[e] + bb[e]; }
            *(float4*)(zr0 + c) = make_float4(y0[0], y0[1], y0[2], y0[3]); *(float4*)(zr0 + c + 4) = make_float4(y0[4], y0[5], y0[6], y0[7]);
            if (has1) { *(float4*)(zr1 + c) = make_float4(y1[0], y1[1], y1[2], y1[3]); *(float4*)(zr1 + c + 4) = make_float4(y1[4], y1[5], y1[6], y1[7]); }
            if (l == 0) { float sh[8], sc[8], o[8]; ld8f(mod0 + c, sh); ld8f(mod0 + 2048 + c, sc);
#pragma unroll
                for (int e = 0; e < 8; ++e) o[e] = y0[e] * (1.0f + sc[e]) + sh[e];
                *(u32x4v*)(ur0 + c) = pack8(o);
                if (has1) { ld8f(mod1 + c, sh); ld8f(mod1 + 2048 + c, sc);
#pragma unroll
                    for (int e = 0; e < 8; ++e) o[e] = y1[e] * (1.0f + sc[e]) + sh[e];
                    *(u32x4v*)(ur1 + c) = pack8(o); } } }
    }
}

#ifndef GEMM_ALIGN
#define GEMM_ALIGN true
#endif
#ifndef GEMM_SP2
#define GEMM_SP2 true
#endif
#ifndef DUP_P0B
#define DUP_P0B 0
#endif
#ifndef DUP_SYNC
#define DUP_SYNC 0
#endif
#ifndef DUP_M3
#define DUP_M3 0
#endif
#ifndef DUP_G2
#define DUP_G2 0
#endif
#ifndef DUP_P0
#define DUP_P0 0
#endif
#ifndef DUP_M1
#define DUP_M1 0
#endif
#ifndef DUP_M2
#define DUP_M2 0
#endif
#ifndef DUP_G1
#define DUP_G1 0
#endif
#ifndef DUP_MASK
#define DUP_MASK 7
#endif
#ifndef PH_ALL
#define PH_ALL 1
#endif
#ifndef PH_P0
#define PH_P0 PH_ALL
#endif
#ifndef PH_G1
#define PH_G1 PH_ALL
#endif
#ifndef PH_M1
#define PH_M1 PH_ALL
#endif
#ifndef PH_M2
#define PH_M2 PH_ALL
#endif
#ifndef PH_M3
#define PH_M3 PH_ALL
#endif
#ifndef PH_G2
#define PH_G2 PH_ALL
#endif
#ifndef PH_LN
#define PH_LN PH_ALL
#endif
__global__ void __launch_bounds__(NTHREADS) hybrid_fwd(Params p) {
    extern __shared__ __attribute__((aligned(16))) unsigned char smem[];
    LAS unsigned char* lds = (LAS unsigned char*)smem;
    cg::grid_group grid = cg::this_grid();
    volatile LAS unsigned* xst = (volatile LAS unsigned*)(lds + LDS_SLOT + 16);
    if (threadIdx.x == 0) { xst[0] = 0u; xst[1] = 0u; }
    __syncthreads();
    const XcdBarrier xbar = xcd_barrier_post((unsigned*)(p.ws + WS_BAR), xst);
#define GSYNC() xcd_barrier(xbar)
#if PH_P0
    for (int rep = 0; rep < 1 + DUP_P0; ++rep) { p0_phase(p, lds, rep); if (rep < DUP_P0) GSYNC(); }
#endif
    if (p.ws == nullptr) grid.sync();
    GSYNC();
#if PH_P0
    for (int rep = 0; rep < 1 + DUP_P0B; ++rep) p0b_phase(p);
#endif
    GSYNC();
    for (int i = 0; i < DUP_SYNC; ++i) GSYNC();
    for (int l = 0; l < 2; ++l) {
#if PH_G1
        for (int rep = 0; rep < 1 + DUP_G1; ++rep) {
            pg8::Gemm g; g.A = (const bf16_t*)(p.ws + WS_UM); g.Bt = (const bf16_t*)(p.ws + WS_WIN) + (size_t)l * NP * DM; g.M = NTOK; g.N = NP; g.K = DM;
            pg8::StaticOrder S; S.init(NTOK, NP, gridDim.x, blockIdx.x);
            EpiIn E; E.proj = (bf16_t*)(p.ws + WS_PROJ); E.gates = (float*)(p.ws + WS_GATES); E.newk = p.out + O_NK; E.newv = p.out + O_NV; E.rope = (const float*)(p.ws + WS_ROPE); E.layer = l;
            pg8::gemm_phase<EpiIn, pg8::StaticOrder, GEMM_ALIGN, GEMM_SP2>(lds, g, S, E);
            if (rep < DUP_G1) GSYNC();
        }
#endif
        GSYNC();
#if PH_M1
        for (int rep = 0; rep < 1 + DUP_M1; ++rep) { m1_phase(p, l, lds, rep, rep == 0 ? 7 : DUP_MASK); if (rep < DUP_M1) GSYNC(); }
#endif
        GSYNC();
#if PH_M2
        for (int rep = 0; rep < 1 + DUP_M2; ++rep) { m2_phase(p, l, rep, lds, xbar); if (rep < DUP_M2) GSYNC(); }
#endif
        GSYNC();
#if PH_M3
        for (int rep = 0; rep < 1 + DUP_M3; ++rep) m3_phase(p, l);
#endif
        GSYNC();
#if PH_G2
        for (int rep = 0; rep < 1 + (l == 0 ? DUP_G2 : 0); ++rep) {
            pg8::Gemm g; g.A = (const bf16_t*)(p.ws + WS_UM); g.Bt = (const bf16_t*)(p.ws + WS_WOUT) + (size_t)l * DM * DM; g.M = NTOK; g.N = DM; g.K = DM;
            pg8::StaticOrder S; S.init(NTOK, DM, gridDim.x, blockIdx.x);
            EpiOut E; E.xp = p.in[I_XP]; E.xs = p.in[I_XS]; E.mod = (const float*)(p.ws + WS_MOD) + (size_t)l * 3 * 6144; E.y = p.out + O_Y; E.layer = l;
            pg8::gemm_phase<EpiOut, pg8::StaticOrder, GEMM_ALIGN, GEMM_SP2>(lds, g, S, E);
            if (rep < (l == 0 ? DUP_G2 : 0)) GSYNC();
        }
#endif
        GSYNC();
#if PH_LN
        ln_phase(p, l);
#endif
        if (l == 0) GSYNC();
    }
}

extern "C" void kernel_launch(void* const* d_in, const int* in_sizes, int n_in, void* d_out, int out_size, void* d_ws, size_t ws_size, hipStream_t stream) {
    static int grid_blocks = 0;
    if (grid_blocks == 0) {
        if (n_in != 38 || ws_size < WS_END) { fprintf(stderr, "kernel_launch: unexpected n_in %d / ws_size %zu (need %zu)\n", n_in, ws_size, (size_t)WS_END); grid_blocks = -1; return; }
        int dev = 0, cus = 0, per_cu = 0;
        hipGetDevice(&dev);
        hipDeviceGetAttribute(&cus, hipDeviceAttributeMultiprocessorCount, dev);
        hipFuncSetAttribute((const void*)hybrid_fwd, hipFuncAttributeMaxDynamicSharedMemorySize, LDS_BYTES);
        hipOccupancyMaxActiveBlocksPerMultiprocessor(&per_cu, (const void*)hybrid_fwd, NTHREADS, LDS_BYTES);
        if (per_cu < 1) { fprintf(stderr, "kernel_launch: occupancy query gives %d blocks per CU\n", per_cu); per_cu = 1; }
        grid_blocks = cus * per_cu;
    }
    if (grid_blocks < 0) return;
    Params p{};
    for (int i = 0; i < 38; ++i) p.in[i] = (const float*)d_in[i];
    p.out = (float*)d_out; p.ws = (unsigned char*)d_ws;
    hipMemsetAsync(d_ws, 0, 32768, stream);
    void* args[] = {&p};
    hipError_t e = hipLaunchCooperativeKernel((const void*)hybrid_fwd, dim3(grid_blocks), dim3(NTHREADS), args, LDS_BYTES, stream);
    if (e != hipSuccess) fprintf(stderr, "cooperative launch failed: %s (grid %d)\n", hipGetErrorString(e), grid_blocks);
}
```

```cpp
#include <hip/hip_runtime.h>
#include <hip/hip_cooperative_groups.h>
#include <cstdio>
#include <cstdint>
namespace cg = cooperative_groups;
namespace pg8 {
#define PG8_LAS __attribute__((address_space(3)))
typedef unsigned short bf16_t;
typedef short bf16x8 __attribute__((ext_vector_type(8)));
typedef float f32x4 __attribute__((ext_vector_type(4)));
typedef unsigned u32x4 __attribute__((ext_vector_type(4)));
constexpr int BM = 256, BK = 64, HALF = 128, HTB = HALF * BK * 2  , STAGE_BYTES = 8 * HTB, NXCD = 8, WGM = 8;

__host__ __device__ __forceinline__ int lds_byte(int r, int c) { const int st = (r >> 4) * 2 + (c >> 5), rr = r & 15, cc = c & 31, ob = rr * 64 + cc * 2; return st * 1024 + (ob ^ (((ob >> 9) & 1) << 5)); }
__host__ __device__ __forceinline__ void stage_rc(int b, int& R, int& C) { const int st = b / 1024, sb = b % 1024, swz = sb ^ (((sb >> 9) & 1) << 5); R = (st >> 1) * 16 + swz / 64; C = (st & 1) * 32 + (swz % 64) / 2; }
__host__ __device__ __forceinline__ int perm32(int rho) { const int n = rho >> 4, i = rho & 15; return 8 * (i >> 2) + 4 * n + (i & 3); }

struct Unit { int pm, pn; };
struct Gemm { const bf16_t* A; const bf16_t* Bt; int M, N, K; };

struct StaticOrder {
    int nM, nN, nwg, G, c;
    __host__ __device__ void init(int M, int N, int G_, int c_) { nM = M / BM; nN = N / BM; nwg = nM * nN; G = G_; c = c_; }
    __host__ __device__ bool next(int i, Unit& u) const {
        const long L = (long)i * G + c; if (L >= nwg) return false;
        int wgid = (int)L; { const int q = nwg / NXCD, r = nwg % NXCD, xcd = wgid % NXCD, off = wgid / NXCD; wgid = (xcd < r ? xcd * (q + 1) : r * (q + 1) + (xcd - r) * q) + off; }
        const int nig = WGM * nN, gid = wgid / nig, fm = gid * WGM, gsz = (nM - fm) < WGM ? (nM - fm) : WGM;
        u.pm = fm + ((wgid % nig) % gsz); u.pn = (wgid % nig) / gsz; return true;
    }
    __device__ __forceinline__ void a_ready(const Unit&) const {}
    __device__ __forceinline__ void done(const Unit&) const {}
};
__device__ __forceinline__ unsigned cvt_pk_bf16(float lo, float hi) { unsigned r; asm volatile("v_cvt_pk_bf16_f32 %0, %1, %2" : "=v"(r) : "v"(lo), "v"(hi)); return r; }

template <class Epi, class Sched, bool ALIGN_EPI = false, bool SP2 = false>
__device__ __forceinline__ void gemm_phase(PG8_LAS unsigned char* lds, const Gemm g, const Sched& S, const Epi& E) {
    int tid = threadIdx.x; asm volatile("" : "+v"(tid)); const int wid = __builtin_amdgcn_readfirstlane(tid >> 6), lane = tid & 63, wr = wid >> 2, wc = wid & 3, fr = lane & 15, fq = lane >> 4;
    const int K = g.K, nt = K / BK;
    unsigned voffA[2], voffB[2];
#pragma unroll
    for (int i = 0; i < 2; ++i) { int R, C; stage_rc(tid * 16 + i * 8192, R, C); const int Rb = Epi::PERM ? ((R & ~31) + perm32(R & 31)) : R;
        voffA[i] = (unsigned)(R * K + C) * 2u; voffB[i] = (unsigned)(Rb * K + C) * 2u; }
    const size_t kstep = (size_t)(BK * 2);
    const size_t hstep = (size_t)HALF * K * 2;
    const size_t tstep = 2 * hstep;
    const unsigned ldsw = (unsigned)wid * 1024u;
    const int aoff = lds_byte(wr * 64 + fr, fq * 8), boff = lds_byte(wc * 32 + fr, fq * 8);
#define PG8_SA(b, h) (((b) * 2 + (h)) * HTB)
#define PG8_SB(b, h) ((4 + (b) * 2 + (h)) * HTB)
#define PG8_STAGE(bufoff, gbase, voff) do { _Pragma("unroll") for (int _i = 0; _i < 2; ++_i) \
        __builtin_amdgcn_global_load_lds((const unsigned*)((const char*)(gbase) + (voff)[_i]), (PG8_LAS unsigned*)(lds + (bufoff) + ldsw + _i * 8192), 16, 0, 0); } while (0)
#define PG8_LDA(dst, b, h) do { _Pragma("unroll") for (int m = 0; m < 4; ++m) _Pragma("unroll") for (int k = 0; k < 2; ++k) dst[m][k] = *(const PG8_LAS bf16x8*)(lds + PG8_SA(b, h) + aoff + m * 2048 + k * 1024); } while (0)
#define PG8_LDB(dst, b, h) do { _Pragma("unroll") for (int n = 0; n < 2; ++n) _Pragma("unroll") for (int k = 0; k < 2; ++k) dst[n][k] = *(const PG8_LAS bf16x8*)(lds + PG8_SB(b, h) + boff + n * 2048 + k * 1024); } while (0)
#define PG8_MMA(ai, bj, At, Bt) do { __builtin_amdgcn_s_setprio(1); _Pragma("unroll") for (int m = 0; m < 4; ++m) _Pragma("unroll") for (int n = 0; n < 2; ++n) _Pragma("unroll") for (int k = 0; k < 2; ++k) \
        acc[ai][bj][m][n] = __builtin_amdgcn_mfma_f32_16x16x32_bf16(Bt[n][k], At[m][k], acc[ai][bj][m][n], 0, 0, 0); __builtin_amdgcn_s_setprio(0); } while (0)
#define PG8_WAIT_V(n) asm volatile("s_waitcnt vmcnt(" #n ")" ::: "memory")
#define PG8_WAIT_L(n) asm volatile("s_waitcnt lgkmcnt(" #n ")" ::: "memory")
#define PG8_BAR __builtin_amdgcn_s_barrier()
#define PG8_SCHED __builtin_amdgcn_sched_barrier(0)
    Unit cur, nxt; int ui = 0;
    if (!S.next(0, cur)) return;
    f32x4 acc[2][2][4][2];
#pragma unroll
    for (int a = 0; a < 2; ++a)
#pragma unroll
        for (int b = 0; b < 2; ++b)
#pragma unroll
            for (int m = 0; m < 4; ++m)
#pragma unroll
                for (int n = 0; n < 2; ++n) acc[a][b][m][n] = (f32x4){0.f, 0.f, 0.f, 0.f};
    bf16x8 At[4][2], B0[2][2], B1[2][2];
    const char* cA = (const char*)g.A + (size_t)cur.pm * tstep; const char* cB = (const char*)g.Bt + (size_t)cur.pn * tstep;
    S.a_ready(cur);
    if constexpr (SP2) {
        PG8_STAGE(PG8_SB(0, 0), cB, voffB); PG8_STAGE(PG8_SB(0, 1), cB + hstep, voffB); PG8_STAGE(PG8_SA(0, 0), cA, voffA); PG8_STAGE(PG8_SA(0, 1), cA + hstep, voffA);
        if (wr == 1) PG8_BAR;
        PG8_WAIT_V(2); PG8_BAR;
        PG8_STAGE(PG8_SB(1, 0), cB + kstep, voffB); PG8_STAGE(PG8_SA(1, 0), cA + kstep, voffA); PG8_STAGE(PG8_SB(1, 1), cB + hstep + kstep, voffB);
        PG8_WAIT_V(6); PG8_BAR;
    } else {
        PG8_STAGE(PG8_SB(0, 0), cB, voffB); PG8_STAGE(PG8_SA(0, 0), cA, voffA); PG8_STAGE(PG8_SB(0, 1), cB + hstep, voffB); PG8_STAGE(PG8_SA(0, 1), cA + hstep, voffA);
        if (wr == 1) PG8_BAR;
        PG8_WAIT_V(4); PG8_BAR;
        PG8_STAGE(PG8_SB(1, 0), cB + kstep, voffB); PG8_STAGE(PG8_SA(1, 0), cA + kstep, voffA); PG8_STAGE(PG8_SB(1, 1), cB + hstep + kstep, voffB);
        PG8_WAIT_V(6); PG8_BAR;
    }
    for (;;) {
        const bool has_next = S.next(ui + 1, nxt);
        const char* nA = has_next ? (const char*)g.A + (size_t)nxt.pm * tstep : cA; const char* nB = has_next ? (const char*)g.Bt + (size_t)nxt.pn * tstep : cB;
        for (int t = 0; t < nt; t += 2) {
            const bool last = (t == nt - 2);
            const char* a1 = cA + (size_t)(t + 1) * kstep;
            const char* a2 = last ? nA : cA + (size_t)(t + 2) * kstep; const char* b2 = last ? nB : cB + (size_t)(t + 2) * kstep;
            const char* a3 = a2 + kstep; const char* b3 = b2 + kstep;
            if (last && has_next) S.a_ready(nxt);
            if constexpr (SP2) {
            PG8_LDB(B0, 0, 0); PG8_LDB(B1, 0, 1); PG8_SCHED; PG8_LDA(At, 0, 0); PG8_STAGE(PG8_SA(1, 1), a1 + hstep, voffA);
            PG8_WAIT_V(8); PG8_WAIT_L(0); PG8_BAR; PG8_MMA(0, 0, At, B0); PG8_MMA(0, 1, At, B1); PG8_BAR; PG8_SCHED;
            PG8_LDA(At, 0, 1); PG8_STAGE(PG8_SB(0, 0), b2, voffB); PG8_STAGE(PG8_SB(0, 1), b2 + hstep, voffB); PG8_STAGE(PG8_SA(0, 0), a2, voffA);
            PG8_WAIT_V(8); PG8_WAIT_L(0); PG8_BAR; PG8_MMA(1, 0, At, B0); PG8_MMA(1, 1, At, B1); PG8_BAR; PG8_SCHED;
            PG8_LDB(B0, 1, 0); PG8_LDB(B1, 1, 1); PG8_SCHED; PG8_LDA(At, 1, 0); PG8_STAGE(PG8_SA(0, 1), a2 + hstep, voffA);
            PG8_WAIT_V(8); PG8_WAIT_L(0); PG8_BAR; PG8_MMA(0, 0, At, B0); PG8_MMA(0, 1, At, B1); PG8_BAR; PG8_SCHED;
            PG8_LDA(At, 1, 1); PG8_STAGE(PG8_SB(1, 0), b3, voffB); PG8_STAGE(PG8_SB(1, 1), b3 + hstep, voffB); PG8_STAGE(PG8_SA(1, 0), a3, voffA);
            PG8_WAIT_V(8); PG8_WAIT_L(0); PG8_BAR; PG8_MMA(1, 0, At, B0); PG8_MMA(1, 1, At, B1); PG8_BAR; PG8_SCHED;
            } else {
            PG8_LDB(B0, 0, 0); PG8_SCHED; PG8_LDA(At, 0, 0); PG8_STAGE(PG8_SA(1, 1), a1 + hstep, voffA);
            PG8_WAIT_L(8); PG8_BAR; PG8_WAIT_L(0); PG8_MMA(0, 0, At, B0); PG8_BAR; PG8_SCHED;
            PG8_LDB(B1, 0, 1); PG8_STAGE(PG8_SB(0, 0), b2, voffB);
            PG8_BAR; PG8_WAIT_L(0); PG8_MMA(0, 1, At, B1); PG8_BAR;
            PG8_LDA(At, 0, 1); PG8_STAGE(PG8_SA(0, 0), a2, voffA);
            PG8_BAR; PG8_WAIT_L(0); PG8_MMA(1, 0, At, B0); PG8_BAR; PG8_SCHED;
            PG8_STAGE(PG8_SB(0, 1), b2 + hstep, voffB);
            PG8_WAIT_V(6); PG8_BAR; PG8_MMA(1, 1, At, B1); PG8_BAR;
            PG8_LDB(B0, 1, 0); PG8_SCHED; PG8_LDA(At, 1, 0); PG8_STAGE(PG8_SA(0, 1), a2 + hstep, voffA);
            PG8_WAIT_L(8); PG8_BAR; PG8_WAIT_L(0); PG8_MMA(0, 0, At, B0); PG8_BAR; PG8_SCHED;
            PG8_LDB(B1, 1, 1); PG8_STAGE(PG8_SB(1, 0), b3, voffB);
            PG8_BAR; PG8_WAIT_L(0); PG8_MMA(0, 1, At, B1); PG8_BAR;
            PG8_LDA(At, 1, 1); PG8_STAGE(PG8_SA(1, 0), a3, voffA);
            PG8_BAR; PG8_WAIT_L(0); PG8_MMA(1, 0, At, B0); PG8_BAR; PG8_SCHED;
            PG8_STAGE(PG8_SB(1, 1), b3 + hstep, voffB);
            PG8_WAIT_V(6); PG8_BAR; PG8_MMA(1, 1, At, B1); PG8_BAR;
            }
        }
        if constexpr (ALIGN_EPI) { if (wr == 0) PG8_BAR; }
        if constexpr (!Epi::AFTER_DRAIN) { E(acc, cur, wr, wc, fr, fq); S.done(cur); }
        if (!has_next) break;
#pragma unroll
        for (int a = 0; a < 2; ++a)
#pragma unroll
            for (int b = 0; b < 2; ++b)
#pragma unroll
                for (int m = 0; m < 4; ++m)
#pragma unroll
                    for (int n = 0; n < 2; ++n) acc[a][b][m][n] = (f32x4){0.f, 0.f, 0.f, 0.f};
        cur = nxt; cA = nA; cB = nB; ++ui;
        if constexpr (ALIGN_EPI) { if (wr == 1) PG8_BAR; }
    }
    PG8_WAIT_V(0);
    if constexpr (!ALIGN_EPI) { if (wr == 0) PG8_BAR; }
    PG8_BAR;
    if constexpr (Epi::AFTER_DRAIN) { E.fused(acc, cur, wr, wc, fr, fq, lds, wid, lane); S.done(cur); }
#undef PG8_SA
#undef PG8_SB
#undef PG8_STAGE
#undef PG8_LDA
#undef PG8_LDB
#undef PG8_MMA
#undef PG8_WAIT_V
#undef PG8_WAIT_L
#undef PG8_BAR
#undef PG8_SCHED
}
}

#define LAS __attribute__((address_space(3)))
#ifndef DUP_M2MASK
#define DUP_M2MASK 3
#endif
typedef unsigned short bf16_t;
typedef short bf16x8 __attribute__((ext_vector_type(8)));
typedef float f32x4 __attribute__((ext_vector_type(4)));
typedef unsigned u32x4v __attribute__((ext_vector_type(4)));
typedef unsigned u32x2v __attribute__((ext_vector_type(2)));

constexpr int NTOK = 10240, NPT = 8192, DM = 2048, NP = 9216, PIN = 8976;
constexpr int C_Q = 4864, C_K = 5888, C_V = 6912, C_G = 7936, C_IF = 8960;
constexpr int A_WD = 1536, A_AD = 1664, A_GATE = 1792;
constexpr int B_Q = 2304, B_V = 3328, B_O = 3840, B_GATE = 4352;
constexpr int NTHREADS = 512;
constexpr int LDS_SLOT = 131072, LDS_BYTES = 131072 + 1024;

constexpr size_t WS_CTL = 0;
constexpr size_t WS_BAR = 8192;
constexpr size_t WS_MOD = 32768;
constexpr size_t WS_ROPE = WS_MOD + 147456;
constexpr size_t WS_LAM = WS_ROPE + 8192;
constexpr size_t WS_WIN = WS_LAM + 256;
constexpr size_t WS_WOUT = WS_WIN + 2ull * NP * DM * 2;
constexpr size_t WS_UM = WS_WOUT + 2ull * DM * DM * 2;
constexpr size_t WS_PROJ = WS_UM + (size_t)NTOK * DM * 2;
constexpr size_t WS_GATES = WS_PROJ + (size_t)NTOK * NP * 2;
constexpr size_t SZ16 = (size_t)NTOK * 512 * 2, SZ32 = (size_t)NTOK * 512 * 4;
constexpr size_t WS_SCV = WS_GATES + (size_t)NTOK * 16 * 4;
constexpr size_t WS_SCBON = WS_SCV + SZ16;
constexpr size_t WS_PK = WS_SCBON + SZ16;
constexpr size_t SZPK = (size_t)NTOK * 8 * 320 * 2;
constexpr size_t WS_YD = WS_PK + 2 * SZPK;
constexpr size_t WS_HD = WS_YD + 2 * SZ32;
constexpr size_t WS_KC = WS_HD + 2 * SZ32;
constexpr size_t WS_VTC = WS_KC + 4194304;
constexpr size_t WS_WUPT = WS_VTC + 4194304;
constexpr size_t WS_END = WS_WUPT + 524288;

constexpr size_t O_Y = 0, O_NK = 20971520, O_NV = 37748736, O_RW = 54525952, O_MC = 58720256, O_MN = 67108864, O_MM = 67174400;

struct Params { const float* in[38]; float* out; unsigned char* ws; };
enum { I_XP = 0, I_XS, I_CK, I_CV, I_SRW, I_SMC, I_SMN, I_SMM, I_C, I_CCTX, I_WADA, I_BADA, I_WIN, I_CAW, I_CAB, I_W0, I_WUP, I_A0, I_AUP, I_KK, I_KA, I_RK,
       I_RGG, I_RGB, I_CBW, I_CBB, I_BI, I_BF, I_MGG, I_MGB, I_LQ1, I_LK1, I_LQ2, I_LK2, I_SUBG, I_WOUT, I_LNG, I_LNB };

__device__ __forceinline__ float bf2f(bf16_t v) { return __uint_as_float(((unsigned)v) << 16); }
__device__ __forceinline__ float bflo(unsigned w) { return __uint_as_float(w << 16); }
__device__ __forceinline__ float bfhi(unsigned w) { return __uint_as_float(w & 0xffff0000u); }
__device__ __forceinline__ unsigned pk2(float lo, float hi) { return pg8::cvt_pk_bf16(lo, hi); }
__device__ __forceinline__ bf16_t f2bf(float f) { return (bf16_t)(pk2(f, 0.f) & 0xffffu); }
__device__ __forceinline__ void unpack8(const u32x4v w, float (&o)[8]) { o[0] = bflo(w.x); o[1] = bfhi(w.x); o[2] = bflo(w.y); o[3] = bfhi(w.y); o[4] = bflo(w.z); o[5] = bfhi(w.z); o[6] = bflo(w.w); o[7] = bfhi(w.w); }
__device__ __forceinline__ u32x4v pack8(const float (&o)[8]) { u32x4v w; w.x = pk2(o[0], o[1]); w.y = pk2(o[2], o[3]); w.z = pk2(o[4], o[5]); w.w = pk2(o[6], o[7]); return w; }
__device__ __forceinline__ void ld8f(const float* p, float (&o)[8]) { const float4 a = *(const float4*)p, b = *(const float4*)(p + 4); o[0] = a.x; o[1] = a.y; o[2] = a.z; o[3] = a.w; o[4] = b.x; o[5] = b.y; o[6] = b.z; o[7] = b.w; }
__device__ __forceinline__ float sigmoidf_(float x) { return __builtin_amdgcn_rcpf(1.0f + __expf(-x)); }
__device__ __forceinline__ float siluf_(float x) { return x * __builtin_amdgcn_rcpf(1.0f + __expf(-x)); }
__device__ __forceinline__ float tanhf_(float x) { return 1.0f - 2.0f * __builtin_amdgcn_rcpf(1.0f + __expf(2.0f * x)); }
__device__ __forceinline__ bf16x8 frag(const LAS bf16_t* base, int row0, int ld, int k0, int lane) { return *(const LAS bf16x8*)(base + (row0 + (lane & 15)) * ld + k0 + (lane >> 4) * 8); }
__device__ __forceinline__ bf16x8 fragsw(const LAS bf16_t* base, int row0, int k0, int lane) { const int r = row0 + (lane & 15), m = (k0 >> 3) + (lane >> 4); return *(const LAS bf16x8*)(base + r * 72 + 8 * (m ^ ((r >> 3) & 7))); }
#define MFMA16(a, b, c) __builtin_amdgcn_mfma_f32_16x16x32_bf16((a), (b), (c), 0, 0, 0)
#define LDS_FENCE() asm volatile("s_waitcnt lgkmcnt(0)" ::: "memory")
template <int CTRL> __device__ __forceinline__ float dppf(float x) { return __builtin_bit_cast(float, __builtin_amdgcn_mov_dpp(__builtin_bit_cast(int, x), CTRL, 0xf, 0xf, true)); }
__device__ __forceinline__ float red16_sum(float x) { x += dppf<0xB1>(x); x += dppf<0x4E>(x); x += dppf<0x124>(x); x += dppf<0x128>(x); return x; }
__device__ __forceinline__ float red4_sum(float x) { x += dppf<0xB1>(x); x += dppf<0x4E>(x); return x; }
__device__ __forceinline__ float red16_max(float x) { x = fmaxf(x, dppf<0xB1>(x)); x = fmaxf(x, dppf<0x4E>(x)); x = fmaxf(x, dppf<0x124>(x)); x = fmaxf(x, dppf<0x128>(x)); return x; }

__device__ __forceinline__ int opaque_tid() { int t = threadIdx.x; asm volatile("" : "+v"(t)); return t; }
__device__ __forceinline__ int next_task(unsigned* ctr, LAS int* slot) {
    __syncthreads();
    if (threadIdx.x == 0) *slot = (int)atomicAdd(ctr, 1u);
    __syncthreads();
    return *slot;
}
#define QNEXT_BEGIN(ctr) unsigned qn_ = 0u; if (threadIdx.x == 0) qn_ = atomicAdd((ctr), 1u)
#define QNEXT_END(slot, t) do { __syncthreads(); if (threadIdx.x == 0) *(slot) = (int)qn_; __syncthreads(); (t) = *(slot); } while (0)
__device__ __forceinline__ int win_src_col(int n) { return n < 4352 ? n : (n < 8960 ? n + 16 : (n < 8976 ? n - 8960 + 4352 : -1)); }
__device__ __forceinline__ int mod_row(int tok) { return tok < NPT ? 0 : 1 + ((tok - NPT) >> 10); }

__device__ __forceinline__ void p0_mod_item(const Params& p, int item, LAS unsigned char* lds) {
    const int tid = opaque_tid(), lane = tid & 63, wave = tid >> 6, kq = lane >> 4, cq = lane & 15;
    const int l = item / 96, cb = item % 96;
    LAS float* sS = (LAS float*)lds;
    LAS float* sRed = sS + 3 * 2048;
    for (int e = tid; e < 3 * 2048; e += NTHREADS) { const int r = e >> 11, k = e & 2047; const float cv = r == 0 ? p.in[I_CCTX][k] : p.in[I_C][(r - 1) * 2048 + k]; sS[e] = siluf_(cv); }
    __syncthreads();
    const float* W = p.in[I_WADA] + (size_t)l * 2048 * 6144 + cb * 64 + 4 * cq;
    float4 a0 = {0, 0, 0, 0}, a1 = a0, a2 = a0;
#pragma unroll 16
    for (int i = 0; i < 64; ++i) { const int k = wave * 256 + i * 4 + kq; const float4 w = *(const float4*)(W + (size_t)k * 6144);
        const float s0 = sS[k], s1 = sS[2048 + k], s2 = sS[4096 + k];
        a0.x += s0 * w.x; a0.y += s0 * w.y; a0.z += s0 * w.z; a0.w += s0 * w.w;
        a1.x += s1 * w.x; a1.y += s1 * w.y; a1.z += s1 * w.z; a1.w += s1 * w.w;
        a2.x += s2 * w.x; a2.y += s2 * w.y; a2.z += s2 * w.z; a2.w += s2 * w.w; }
    float v[12] = {a0.x, a0.y, a0.z, a0.w, a1.x, a1.y, a1.z, a1.w, a2.x, a2.y, a2.z, a2.w};
#pragma unroll
    for (int i = 0; i < 12; ++i) { v[i] += __shfl_xor(v[i], 16); v[i] += __shfl_xor(v[i], 32); }
    if (kq == 0) {
#pragma unroll
        for (int r = 0; r < 3; ++r)
#pragma unroll
            for (int e = 0; e < 4; ++e) sRed[(wave * 3 + r) * 64 + 4 * cq + e] = v[r * 4 + e];
    }
    __syncthreads();
    if (tid < 192) { const int r = tid >> 6, c = tid & 63; float s = 0.f;
#pragma unroll
        for (int w = 0; w < 8; ++w) s += sRed[(w * 3 + r) * 64 + c];
        ((float*)(p.ws + WS_MOD))[(l * 3 + r) * 6144 + cb * 64 + c] = s + p.in[I_BADA][l * 6144 + cb * 64 + c]; }
}
template <bool MAPCOL> __device__ __forceinline__ void p0_transpose_item(const float* W, int N, int nblk, bf16_t* WT, LAS float* scr, int item, int lane) {
    const int kb = item / nblk, nb = item % nblk, k0 = 64 * kb, n0 = 32 * nb;
    const int n = n0 + (lane & 31); const int oc = MAPCOL ? win_src_col(n) : n;
    float tv[32];
    const float* wp = W + (size_t)(k0 + (lane >> 5)) * N + (oc >= 0 ? oc : 0);
#pragma unroll
    for (int i = 0; i < 32; ++i) tv[i] = wp[(size_t)(2 * i) * N];
#pragma unroll
    for (int i = 0; i < 32; ++i) scr[(2 * i + (lane >> 5)) * 33 + (lane & 31)] = oc >= 0 ? tv[i] : 0.f;
    LDS_FENCE();
    const int c = lane & 7;
#pragma unroll
    for (int j = 0; j < 4; ++j) { const int nn = (lane >> 3) + 8 * j; const LAS float* s = scr + (8 * c) * 33 + nn;
        u32x4v o; o.x = pk2(s[0 * 33], s[1 * 33]); o.y = pk2(s[2 * 33], s[3 * 33]); o.z = pk2(s[4 * 33], s[5 * 33]); o.w = pk2(s[6 * 33], s[7 * 33]);
        *(u32x4v*)(WT + (size_t)(n0 + nn) * 2048 + k0 + 8 * c) = o; }
    LDS_FENCE();
}
__device__ __forceinline__ void p0_phase(const Params& p, LAS unsigned char* lds, int rep) {
    const int tid = opaque_tid(), lane = tid & 63, wave = tid >> 6;
    unsigned* ctr = (unsigned*)(p.ws + WS_CTL) + 64 * 15 * rep;
    LAS int* slot = (LAS int*)(lds + LDS_SLOT);
    constexpr int NT_MOD = 192, NT_TR = 1408  , NT_A = NT_MOD + 1 + NT_TR, NT_KC = 512, NT_VT = 512, NT_WU = 64, NT = NT_A + NT_KC + NT_VT + NT_WU;
    for (;;) {
        const int t = next_task(ctr, slot);
        if (t >= NT) break;
        if (t < NT_MOD) { p0_mod_item(p, t, lds); continue; }
        if (t == NT_MOD) {
            float* rope = (float*)(p.ws + WS_ROPE);
            for (int e = tid; e < 1024; e += NTHREADS) { const int pos = e >> 4, i = e & 15; const float inv = 1.0f / powf(10000.0f, (float)(2 * i) / 32.0f); const float ang = (float)pos * inv;
                rope[pos * 32 + i] = cosf(ang); rope[pos * 32 + 16 + i] = sinf(ang); }
            if (tid < 2) { const int l = tid; float d1 = 0.f, d2 = 0.f;
                for (int i = 0; i < 64; ++i) { d1 += p.in[I_LQ1][l * 64 + i] * p.in[I_LK1][l * 64 + i]; d2 += p.in[I_LQ2][l * 64 + i] * p.in[I_LK2][l * 64 + i]; }
                const float lam_init = 0.8f - 0.6f * expf(-0.3f * (float)l);
                ((float*)(p.ws + WS_LAM))[l] = expf(d1) - expf(d2) + lam_init; }
            continue;
        }
        if (t >= NT_A) {
            int u = t - NT_A;
            if (u < NT_KC) { const size_t o = ((size_t)u * 512 + tid) * 8; float x[8]; ld8f(p.in[I_CK] + o, x); *(u32x4v*)((bf16_t*)(p.ws + WS_KC) + o) = pack8(x); continue; }
            u -= NT_KC;
            if (u < NT_VT) { const int idx = u * 512 + tid, dv = idx & 127, m = (idx >> 7) & 63, bh = idx >> 13; float x[8];
#pragma unroll
                for (int e = 0; e < 8; ++e) x[e] = p.in[I_CV][((size_t)bh * 512 + 8 * m + e) * 128 + dv];
                *(u32x4v*)((bf16_t*)(p.ws + WS_VTC) + ((size_t)bh * 128 + dv) * 512 + 8 * m) = pack8(x); continue; }
            u -= NT_VT;
#pragma unroll
            for (int e = 0; e < 8; ++e) { const int f = u * 4096 + e * 512 + tid, c = f & 63, j = (f >> 6) & 63, h = (f >> 12) & 7, which = (f >> 15) & 1, ld = f >> 16;
                const float v = (which ? p.in[I_AUP] : p.in[I_WUP])[((size_t)ld * 64 + j) * 512 + h * 64 + c];
                ((bf16_t*)(p.ws + WS_WUPT))[(f & ~4095) + c * 64 + j] = f2bf(v); }
            continue;
        }
        int it = (t - NT_MOD - 1) * 8 + wave;
        LAS float* scr = (LAS float*)(lds + wave * 8704);
        const int l = it / 11264; it -= l * 11264;
        if (it < 9216) p0_transpose_item<true>(p.in[I_WIN] + (size_t)l * 2048 * PIN, PIN, 288, (bf16_t*)(p.ws + WS_WIN) + (size_t)l * NP * 2048, scr, it, lane);
        else p0_transpose_item<false>(p.in[I_WOUT] + (size_t)l * 2048 * 2048, 2048, 64, (bf16_t*)(p.ws + WS_WOUT) + (size_t)l * 2048 * 2048, scr, it - 9216, lane);
    }
}
__device__ __forceinline__ void tr_tail_phase(const Params& p, LAS unsigned char* lds) {
    const int tid = opaque_tid(), lane = tid & 63, wave = tid >> 6;
    unsigned* ctr = (unsigned*)(p.ws + WS_CTL) + 64 * 12;
    LAS int* slot = (LAS int*)(lds + LDS_SLOT);
    for (;;) {
        const int t = next_task(ctr, slot);
        if (t >= 1408) break;
        int it = t * 8 + wave;
        LAS float* scr = (LAS float*)(lds + wave * 8704);
        if (it < 9216) p0_transpose_item<true>(p.in[I_WIN] + (size_t)2048 * PIN, PIN, 288, (bf16_t*)(p.ws + WS_WIN) + (size_t)NP * 2048, scr, it, lane);
        else p0_transpose_item<false>(p.in[I_WOUT] + (size_t)2048 * 2048, 2048, 64, (bf16_t*)(p.ws + WS_WOUT) + (size_t)2048 * 2048, scr, it - 9216, lane);
    }
}
__device__ __forceinline__ void modulate_row(const float* xrow, const float* mod, bf16_t* urow, int lane) {
#pragma unroll
    for (int j = 0; j < 4; ++j) { const int c = j * 512 + lane * 8; float x[8], sh[8], sc[8], o[8]; ld8f(xrow + c, x); ld8f(mod + c, sh); ld8f(mod + 2048 + c, sc);
#pragma unroll
        for (int e = 0; e < 8; ++e) o[e] = x[e] * (1.0f + sc[e]) + sh[e];
        *(u32x4v*)(urow + c) = pack8(o); }
}
__device__ __forceinline__ void p0b_phase(const Params& p) {
    const int tid_ = opaque_tid(); const int lane = tid_ & 63, gw = blockIdx.x * 8 + (tid_ >> 6), NGW = gridDim.x * 8;
    for (int tok = gw; tok < NTOK; tok += NGW) {
        const float* xrow = tok < NPT ? p.in[I_XP] + (size_t)tok * DM : p.in[I_XS] + (size_t)(tok - NPT) * DM;
        modulate_row(xrow, (const float*)(p.ws + WS_MOD) + mod_row(tok) * 6144, (bf16_t*)(p.ws + WS_UM) + (size_t)tok * DM, lane);
    }
}

struct EpiIn {
    static constexpr bool PERM = true, AFTER_DRAIN = false;
    bf16_t* proj; float* gates; float* newk; float* newv; const float* rope; int layer;
    __device__ __forceinline__ void operator()(const f32x4 (&acc)[2][2][4][2], const pg8::Unit& u, int wr, int wc, int fr, int fq) const {
        const int row0 = u.pm * 256 + wr * 64 + fr, col0 = u.pn * 256 + wc * 32 + 8 * fq;
        const bool samp = u.pm >= 32;
        const bool is_rope = samp && u.pn >= 19 && u.pn < 27;
        const bool is_k = !samp && u.pn >= 23 && u.pn < 27, is_v = !samp && u.pn >= 27 && u.pn < 31, is_g = u.pn == 35;
#pragma unroll
        for (int ai = 0; ai < 2; ++ai)
#pragma unroll
            for (int m = 0; m < 4; ++m) {
                const int row = row0 + ai * 128 + m * 16;
                float cs[8], sn[8];
                if (is_rope) { const int pos = (row - NPT) & 1023; const int pp = (wc & 1) ? (pos & 63) : (pos >> 6); const float* rp = rope + pp * 32 + 8 * (fq & 1); ld8f(rp, cs); ld8f(rp + 16, sn); }
#pragma unroll
                for (int bj = 0; bj < 2; ++bj) {
                    f32x4 v0 = acc[ai][bj][m][0], v1 = acc[ai][bj][m][1];
                    if (is_rope) {
                        const float sg = (fq & 2) ? 1.0f : -1.0f;
#pragma unroll
                        for (int e = 0; e < 4; ++e) { const float p0 = __shfl_xor(v0[e], 32), p1 = __shfl_xor(v1[e], 32);
                            v0[e] = v0[e] * cs[e] + sg * p0 * sn[e]; v1[e] = v1[e] * cs[4 + e] + sg * p1 * sn[4 + e]; }
                    }
                    const int col = col0 + bj * 128;
                    u32x4v w; w.x = pk2(v0[0], v0[1]); w.y = pk2(v0[2], v0[3]); w.z = pk2(v1[0], v1[1]); w.w = pk2(v1[2], v1[3]);
                    *(u32x4v*)(proj + (size_t)row * NP + col) = w;
                    if (is_k || is_v) { const int ck = col - (is_k ? C_K : C_V), h = ck >> 7, j = ck & 127, b = row >> 8, t = row & 255;
                        float* dst = (is_k ? newk : newv) + ((((size_t)(b * 2 + layer) * 8 + h) * 256 + t) * 128 + j);
                        *(f32x4*)dst = v0; *(f32x4*)(dst + 4) = v1; }
                    if (is_g && bj == 0 && wc == 0 && fq < 2) { float* dst = gates + (size_t)row * 16 + 8 * fq; *(f32x4*)dst = v0; *(f32x4*)(dst + 4) = v1; }
                }
            }
    }
};
struct EpiOut {
    static constexpr bool PERM = false, AFTER_DRAIN = false;
    const float* xp; const float* xs; const float* mod; float* y; int layer;
    __device__ __forceinline__ void operator()(const f32x4 (&acc)[2][2][4][2], const pg8::Unit& u, int wr, int wc, int fr, int fq) const {
        const int row0 = u.pm * 256 + wr * 64 + fr, col0 = u.pn * 256 + wc * 32 + 4 * fq;
#pragma unroll
        for (int ai = 0; ai < 2; ++ai)
#pragma unroll
            for (int m = 0; m < 4; ++m) {
                const int row = row0 + ai * 128 + m * 16;
                const float* xrow = layer == 0 ? (row < NPT ? xp + (size_t)row * DM : xs + (size_t)(row - NPT) * DM) : y + (size_t)row * DM;
                const float* g = mod + mod_row(row) * 6144 + 4096;
#pragma unroll
                for (int bj = 0; bj < 2; ++bj)
#pragma unroll
                    for (int n = 0; n < 2; ++n) { const int c = col0 + bj * 128 + n * 16;
                        const f32x4 xv = *(const f32x4*)(xrow + c), gv = *(const f32x4*)(g + c);
                        *(f32x4*)(y + (size_t)row * DM + c) = 1.41421356237f * xv + gv * acc[ai][bj][m][n]; }
            }
    }
};

#define XB_TMO      128
#define XB_XCNT(j)  (256  + 64 * (j))
#define XB_XSUB(j)  (1280 + 64 * (j))
#define XB_XGEN(j)  (2304 + 64 * (j))
#define XB_TOP      3328
#define XB_TOPGEN   3392
#define XCD_BAR_WORDS 3456
#define XB_SPIN_CAP (1u << 18)

__device__ __forceinline__ unsigned xb_ld(unsigned* p)              { return __hip_atomic_load(p, __ATOMIC_RELAXED, __HIP_MEMORY_SCOPE_AGENT); }
__device__ __forceinline__ unsigned xb_add(unsigned* p, unsigned v) { return __hip_atomic_fetch_add(p, v, __ATOMIC_RELAXED, __HIP_MEMORY_SCOPE_AGENT); }
__device__ __forceinline__ unsigned xb_xcc_id() { return (unsigned)__builtin_amdgcn_s_getreg((3 << 11) | 20) & 0xFu; }
#define XB_SPIN(cond, bar) do { unsigned _sp = 0; while (cond) { __builtin_amdgcn_s_sleep(1); \
    if ((++_sp & 255u) == 0u) { if (xb_ld(&(bar)[XB_TMO])) break; if (_sp > XB_SPIN_CAP) { atomicAdd(&(bar)[XB_TMO], 1u); break; } } } } while (0)

struct XcdBarrier {
    unsigned* bar; unsigned x;
    volatile LAS unsigned* st;
};

__device__ __forceinline__ XcdBarrier xcd_barrier_post(unsigned* bar, volatile LAS unsigned* st) {
    XcdBarrier b; b.bar = bar; b.x = xb_xcc_id(); b.st = st;
    if (threadIdx.x == 0) (void)xb_add(&bar[XB_XCNT(b.x)], 1u);
    return b;
}
__device__ __forceinline__ void xcd_barrier_complete(unsigned* bar, unsigned x, unsigned& nloc, unsigned& nx) {
    const unsigned G = gridDim.x * gridDim.y * gridDim.z;
    unsigned sum, cnt, mine, sp = 0u;
    for (;;) {
        sum = 0u; cnt = 0u; mine = 0u;
#pragma unroll
        for (unsigned j = 0; j < 16; ++j) { const unsigned c = xb_ld(&bar[XB_XCNT(j)]); sum += c; cnt += (c > 0u) ? 1u : 0u; mine = (j == x) ? c : mine; }
        if (sum == G) break;
        __builtin_amdgcn_s_sleep(1);
        if ((++sp & 255u) == 0u) { if (xb_ld(&bar[XB_TMO])) break; if (sp > XB_SPIN_CAP) { atomicAdd(&bar[XB_TMO], 1u); break; } }
    }
    nloc = mine > 0u ? mine : 1u; nx = cnt > 0u ? cnt : 1u;
}

__device__ __forceinline__ unsigned xb_xcc_id_v() { unsigned r; asm volatile("s_getreg_b32 %0, hwreg(20, 0, 4)" : "=s"(r)); return r & 0xFu; }
__device__ __forceinline__ void xcd_barrier(const XcdBarrier& b) {
    asm volatile("s_waitcnt vmcnt(0)" ::: "memory");
    __syncthreads();
    if (threadIdx.x == 0) {
        unsigned* bar = b.bar; const unsigned bx = xb_xcc_id_v();
        __builtin_amdgcn_s_waitcnt(0);
        unsigned nloc = b.st[0], nx = b.st[1];
        if (nloc == 0u) { xcd_barrier_complete(bar, bx, nloc, nx); b.st[0] = nloc; b.st[1] = nx; }
        const unsigned old = xb_add(&bar[XB_XSUB(bx)], 1u);
        const unsigned gen = old / nloc;
        if (old + 1u == (gen + 1u) * nloc) {
            __builtin_amdgcn_fence(__ATOMIC_RELEASE, "agent");
            asm volatile("s_waitcnt vmcnt(0)" ::: "memory");
            const unsigned og = xb_add(&bar[XB_TOP], 1u);
            const unsigned tg = og / nx;
            if (og + 1u == (tg + 1u) * nx) xb_add(&bar[XB_TOPGEN], 1u);
            else XB_SPIN(xb_ld(&bar[XB_TOPGEN]) == tg, bar);
            __builtin_amdgcn_fence(__ATOMIC_ACQUIRE, "agent");
            xb_add(&bar[XB_XGEN(bx)], 1u);
            asm volatile("s_waitcnt vmcnt(0)" ::: "memory");
        } else {
            XB_SPIN(xb_ld(&bar[XB_XGEN(bx)]) == gen, bar);
            __builtin_amdgcn_fence(__ATOMIC_ACQUIRE, "agent");
            asm volatile("s_waitcnt vmcnt(0)" ::: "memory");
        }
    }
    __syncthreads();
}


__device__ __forceinline__ void mlstm_task(const Params& p, int l, int s, int d, int h, LAS unsigned char* lds) {
    const int tid = opaque_tid(), lane = tid & 63, wave = tid >> 6, quad = lane >> 4, l15 = lane & 15;
    const int T = s < 32 ? 256 : 1024, tok0 = s < 32 ? s * 256 : NPT + (s - 32) * 1024, nch = T / 64;
    LAS bf16_t* sQ = (LAS bf16_t*)lds;
    LAS bf16_t* sK = sQ + 64 * 136;
    LAS bf16_t* sKt = sK + 64 * 136;
    LAS bf16_t* sVt = sKt + 128 * 72;
    LAS bf16_t* sP = sVt + 128 * 72;
    LAS bf16_t* sC = sP + 64 * 72;
    LAS float* sf = (LAS float*)(sC + 128 * 136);
    LAS float *sA = sf, *sB = sf + 64, *sPm = sf + 128, *sN = sf + 192, *sNq = sf + 320, *sPs = sf + 384;
    const bf16_t* proj = (const bf16_t*)(p.ws + WS_PROJ);
    const float* gates = (const float*)(p.ws + WS_GATES);
    float* hd = (float*)(p.ws + WS_HD) + (size_t)d * NTOK * 512;
    const float bi = p.in[I_BI][l * 8 + d * 4 + h], bfb = p.in[I_BF][l * 8 + d * 4 + h];
    f32x4 cacc[8];
    float m;
    float cw0[8], cw1[8], cw2[8], cbb[8];
    { const int g = tid & 31, ch = ((g >> 4) ? 512 : 0) + h * 128 + (g & 15) * 8; const float* cw = p.in[I_CBW] + (size_t)l * 3 * 1024 + ch;
        ld8f(cw, cw0); ld8f(cw + 1024, cw1); ld8f(cw + 2048, cw2); ld8f(p.in[I_CBB] + l * 1024 + ch, cbb); }
    __syncthreads();
    if (s >= 32) {
        const size_t sb = (((size_t)((s - 32) * 2 + l) * 2 + d) * 4 + h);
        const float* C0 = p.in[I_SMC] + sb * 128 * 128;
#pragma unroll
        for (int tn = 0; tn < 8; ++tn)
#pragma unroll
            for (int j = 0; j < 4; ++j) cacc[tn][j] = C0[(16 * wave + quad * 4 + j) * 128 + 16 * tn + l15];
        if (tid < 128) sN[tid] = p.in[I_SMN][sb * 128 + tid];
        m = p.in[I_SMM][sb];
    } else {
#pragma unroll
        for (int tn = 0; tn < 8; ++tn) cacc[tn] = (f32x4){0.f, 0.f, 0.f, 0.f};
        if (tid < 128) sN[tid] = 0.f;
        m = 0.f;
    }
#pragma unroll
    for (int tn = 0; tn < 8; ++tn)
#pragma unroll
        for (int j = 0; j < 4; ++j) sC[(16 * wave + quad * 4 + j) * 136 + 16 * tn + l15] = f2bf(cacc[tn][j]);

    u32x4v px1[4], pvv[2];
#define ML_PREFETCH(CC) do { _Pragma("unroll") for (int it = 0; it < 4; ++it) { const int idx = tid + 512 * it, i = idx >> 5, g = idx & 31, ch = ((g >> 4) ? 512 : 0) + h * 128 + (g & 15) * 8; \
            const int ii = 64 * (CC) + i, pos = d == 0 ? ii : T - 1 - ii; px1[it] = *(const u32x4v*)(proj + (size_t)(tok0 + pos) * NP + B_Q + ch); } \
        _Pragma("unroll") for (int it = 0; it < 2; ++it) { const int idx = tid + 512 * it, i = idx >> 4, g = idx & 15; const int ii = 64 * (CC) + i, tk = d == 0 ? tok0 + ii : tok0 + T - 1 - ii; \
            pvv[it] = *(const u32x4v*)(proj + (size_t)tk * NP + B_V + h * 128 + 8 * g); } } while (0)
    ML_PREFETCH(0);
    float gi_n = 0.f, gf_n = 0.f;
    if (wave == 0) { const int tk = d == 0 ? tok0 + lane : tok0 + T - 1 - lane; gi_n = gates[(size_t)tk * 16 + d * 4 + h]; gf_n = gates[(size_t)tk * 16 + 8 + d * 4 + h]; }
    for (int c = 0; c < nch; ++c) {
        __syncthreads();
        if (wave == 0) {
            const float gi = gi_n + bi, gf = gf_n + bfb;
            if (c + 1 < nch) { const int ii = 64 * (c + 1) + lane; const int tk = d == 0 ? tok0 + ii : tok0 + T - 1 - ii; gi_n = gates[(size_t)tk * 16 + d * 4 + h]; gf_n = gates[(size_t)tk * 16 + 8 + d * 4 + h]; }
            const float lf = fminf(gf, 0.f) - log1pf(__expf(-fabsf(gf)));
            float b = lf;
#pragma unroll
            for (int off = 1; off < 64; off <<= 1) { const float t = __shfl_up(b, off); if (lane >= off) b += t; }
            const float a = gi - b; float pm = a;
#pragma unroll
            for (int off = 1; off < 64; off <<= 1) { const float t = __shfl_up(pm, off); if (lane >= off) pm = fmaxf(pm, t); }
            sB[lane] = b; sA[lane] = a; sPm[lane] = pm;
        }
        __syncthreads();
        const float mx = fmaxf(m, sPm[63]), bL = sB[63];
#pragma unroll
        for (int it = 0; it < 4; ++it) {
            const int idx = tid + 512 * it, i = idx >> 5, g = idx & 31, isK = g >> 4, j0 = (g & 15) * 8, ch = (isK ? 512 : 0) + h * 128 + j0;
            const int ii = 64 * c + i, pos = d == 0 ? ii : T - 1 - ii, tk = tok0 + pos;
            const bf16_t* src = proj + (size_t)tk * NP + B_Q + ch;
            float x0[8], x1[8], x2[8], y[8];
            unpack8(px1[it], x1);
            unpack8(*(const u32x4v*)(pos > 0 ? src - NP : src), x0); unpack8(*(const u32x4v*)(pos < T - 1 ? src + NP : src), x2);
            const float m0 = pos > 0 ? 1.f : 0.f, m2 = pos < T - 1 ? 1.f : 0.f;
#pragma unroll
            for (int e = 0; e < 8; ++e) y[e] = siluf_(m0 * x0[e] * cw0[e] + x1[e] * cw1[e] + m2 * x2[e] * cw2[e] + cbb[e]);
            if (!isK) { *(LAS u32x4v*)(sQ + i * 136 + j0) = pack8(y); }
            else {
                const float wgi = __expf(sA[i] - mx);
#pragma unroll
                for (int e = 0; e < 8; ++e) y[e] *= 0.08838834764831845f;
                *(LAS u32x4v*)(sK + i * 136 + j0) = pack8(y);
#pragma unroll
                for (int e = 0; e < 8; ++e) sKt[(j0 + e) * 72 + (i ^ (8 * ((j0 >> 3) & 7)))] = f2bf(y[e] * wgi);
            }
        }
#pragma unroll
        for (int it = 0; it < 2; ++it) {
            const int idx = tid + 512 * it, i = idx >> 4, g = idx & 15;
            const int ii = 64 * c + i, tk = d == 0 ? tok0 + ii : tok0 + T - 1 - ii;
            const u32x4v w = pvv[it];
            LAS bf16_t* dst = sVt + (8 * g) * 72 + (i ^ (8 * (g & 7)));
            dst[0] = (bf16_t)(w.x & 0xffff); dst[72] = (bf16_t)(w.x >> 16); dst[144] = (bf16_t)(w.y & 0xffff); dst[216] = (bf16_t)(w.y >> 16);
            dst[288] = (bf16_t)(w.z & 0xffff); dst[360] = (bf16_t)(w.z >> 16); dst[432] = (bf16_t)(w.w & 0xffff); dst[504] = (bf16_t)(w.w >> 16);
        }
        if (c + 1 < nch) ML_PREFETCH(c + 1);
        __syncthreads();
        const int tm = wave >> 1;
        {
            const int tn0 = (wave & 1) * 2;
#pragma unroll
            for (int tt = 0; tt < 2; ++tt) {
                f32x4 acc = {0.f, 0.f, 0.f, 0.f};
#pragma unroll
                for (int ks = 0; ks < 4; ++ks) acc = MFMA16(frag(sQ, 16 * tm, 136, 32 * ks, lane), frag(sK, 16 * (tn0 + tt), 136, 32 * ks, lane), acc);
                const int scol = 16 * (tn0 + tt) + l15; const float as = sA[scol];
#pragma unroll
                for (int j = 0; j < 4; ++j) { const int t = 16 * tm + quad * 4 + j;
                    float pv = scol <= t ? __expf(as - fmaxf(m, sPm[t])) * acc[j] : 0.f;
                    sP[t * 72 + scol] = f2bf(pv);
                    pv = red16_sum(pv);
                    if (l15 == 0) sPs[t * 4 + tn0 + tt] = pv; }
            }
        }
        const int tnb = (wave & 1) * 4;
        f32x4 accq[4];
#pragma unroll
        for (int tt = 0; tt < 4; ++tt) { accq[tt] = (f32x4){0.f, 0.f, 0.f, 0.f};
#pragma unroll
            for (int ks = 0; ks < 4; ++ks) accq[tt] = MFMA16(frag(sQ, 16 * tm, 136, 32 * ks, lane), frag(sC, 16 * (tnb + tt), 136, 32 * ks, lane), accq[tt]); }
        { const int t = tid >> 3, part = tid & 7; float sacc = 0.f;
#pragma unroll
            for (int e = 0; e < 16; ++e) sacc += sN[16 * part + e] * bf2f(sQ[t * 136 + 16 * part + e]);
            sacc += __shfl_xor(sacc, 1); sacc += __shfl_xor(sacc, 2); sacc += __shfl_xor(sacc, 4);
            if (part == 0) sNq[t] = sacc; }
        __syncthreads();
        {
            f32x4 accp[4];
#pragma unroll
            for (int tt = 0; tt < 4; ++tt) { accp[tt] = (f32x4){0.f, 0.f, 0.f, 0.f};
#pragma unroll
                for (int ks = 0; ks < 2; ++ks) accp[tt] = MFMA16(frag(sP, 16 * tm, 72, 32 * ks, lane), fragsw(sVt, 16 * (tnb + tt), 32 * ks, lane), accp[tt]); }
#pragma unroll
            for (int j = 0; j < 4; ++j) { const int t = 16 * tm + quad * 4 + j;
                const float mtm = fmaxf(m, sPm[t]), wi = __expf(m - mtm);
                const float den = wi * sNq[t] + ((sPs[t * 4] + sPs[t * 4 + 1]) + (sPs[t * 4 + 2] + sPs[t * 4 + 3]));
                const float mt = sB[t] + mtm; const float inv = 1.0f / fmaxf(fabsf(den), __expf(-mt));
                const int ii = 64 * c + t, tk = d == 0 ? tok0 + ii : tok0 + T - 1 - ii;
                float* dst = hd + (size_t)tk * 512 + h * 128 + 16 * tnb + l15;
#pragma unroll
                for (int tt = 0; tt < 4; ++tt) dst[16 * tt] = (wi * accq[tt][j] + accp[tt][j]) * inv; }
        }
        const float sc = __expf(m - mx);
        if (tid < 128) { float ns = 0.f;
#pragma unroll 8
            for (int e = 0; e < 64; ++e) ns += bf2f(sKt[tid * 72 + e]);
            sN[tid] = sc * sN[tid] + ns; }
#pragma unroll
        for (int tn = 0; tn < 8; ++tn) { f32x4 dc = {0.f, 0.f, 0.f, 0.f};
#pragma unroll
            for (int ks = 0; ks < 2; ++ks) dc = MFMA16(fragsw(sVt, 16 * wave, 32 * ks, lane), fragsw(sKt, 16 * tn, 32 * ks, lane), dc);
            cacc[tn] = sc * cacc[tn] + dc;
#pragma unroll
            for (int j = 0; j < 4; ++j) sC[(16 * wave + quad * 4 + j) * 136 + 16 * tn + l15] = f2bf(cacc[tn][j]); }
        m = bL + mx;
    }
    __syncthreads();
    if (s < 32) {
        const size_t sb = (((size_t)(s * 2 + l) * 2 + d) * 4 + h);
        float* Co = p.out + O_MC + sb * 128 * 128;
#pragma unroll
        for (int tn = 0; tn < 8; ++tn)
#pragma unroll
            for (int j = 0; j < 4; ++j) Co[(16 * wave + quad * 4 + j) * 128 + 16 * tn + l15] = cacc[tn][j];
        if (tid < 128) p.out[O_MN + sb * 128 + tid] = sN[tid];
        if (tid == 0) p.out[O_MM + sb] = m;
    }
}

#undef ML_PREFETCH
__device__ __forceinline__ void attn_task(const Params& p, int l, int task, LAS unsigned char* lds) {
    const int tid = opaque_tid(), lane = tid & 63, wave = tid >> 6, quad = lane >> 4, l15 = lane & 15;
    const bool samp = task < 128;
    int b, h, qb;
    if (samp) { b = task >> 6; h = (task >> 3) & 7; qb = task & 7; } else { const int t2 = task - 128; b = t2 >> 4; h = (t2 >> 1) & 7; qb = t2 & 1; }
    const int tok0 = samp ? NPT + b * 1024 : b * 256, nkt = samp ? 24 : 4, nct = samp ? 8 : 0;
    LAS bf16_t* sK = (LAS bf16_t*)lds;
    LAS bf16_t* sVt = sK + 64 * 136;
    LAS bf16_t* sPw = sVt + 128 * 72 + wave * (16 * 72);
    const bf16_t* proj = (const bf16_t*)(p.ws + WS_PROJ);
    const bf16_t* ck = (const bf16_t*)(p.ws + WS_KC) + (((unsigned)(b * 2 + l) * 8 + h) * 512) * 128;
    const bf16_t* cv = (const bf16_t*)(p.ws + WS_VTC) + (((unsigned)(b * 2 + l) * 8 + h) * 128) * 512;
    const float lam = ((const float*)(p.ws + WS_LAM))[l];
    const float lam_init = 0.8f - 0.6f * expf(-0.3f * (float)l);
    const int q0 = 128 * qb + 16 * wave;
    bf16x8 aq1[2], aq2[2];
    { const bf16_t* qp = proj + (unsigned)(tok0 + q0 + l15) * NP + C_Q + h * 128 + quad * 8;
        aq1[0] = *(const bf16x8*)qp; aq1[1] = *(const bf16x8*)(qp + 32); aq2[0] = *(const bf16x8*)(qp + 64); aq2[1] = *(const bf16x8*)(qp + 96); }
    LAS bf16_t* sQw = sVt + 128 * 72 + wave * (16 * 136);
    { LAS bf16_t* qd = sQw + l15 * 136 + quad * 8;
        *(LAS bf16x8*)qd = aq1[0]; *(LAS bf16x8*)(qd + 32) = aq1[1]; *(LAS bf16x8*)(qd + 64) = aq2[0]; *(LAS bf16x8*)(qd + 96) = aq2[1]; }
    LDS_FENCE();
    float mx1 = -INFINITY, mx2 = -INFINITY, sm1 = 0.f, sm2 = 0.f, mc1 = 0.f, mc2 = 0.f;
    constexpr float CS = 0.125f * 1.4426950408889634f;
    f32x4 o1[8], o2[8];
#pragma unroll
    for (int tn = 0; tn < 8; ++tn) { o1[tn] = (f32x4){0.f, 0.f, 0.f, 0.f}; o2[tn] = o1[tn]; }
    u32x4v kreg[2], vreg[2];
#define ATT_LOAD(KT, PASS) do { int ktv = (KT); asm volatile("" : "+v"(ktv));     \
    _Pragma("unroll") for (int it = 0; it < 2; ++it) { const int idx = tid + 512 * it, i = idx >> 4, g = idx & 15; \
        if ((KT) < nct) { kreg[it] = *(const u32x4v*)(ck + (unsigned)((64 * ktv + i) * 128 + 8 * g)); \
            if ((PASS) == 1) { const int dv = idx >> 3, mm = idx & 7; vreg[it] = *(const u32x4v*)(cv + (unsigned)(dv * 512 + 64 * ktv + 8 * mm)); } } \
        else { kreg[it] = *(const u32x4v*)(proj + (unsigned)((tok0 + 64 * (ktv - nct) + i) * NP + C_K + h * 128 + 8 * g)); \
            if ((PASS) == 1) vreg[it] = *(const u32x4v*)(proj + (unsigned)((tok0 + 64 * (ktv - nct) + (idx & 63)) * NP + C_V + h * 128 + 8 * (idx >> 6))); } } } while (0)
#define ATT_LOADK(BUF, KT) do { int ktv = (KT); asm volatile("" : "+v"(ktv)); _Pragma("unroll") for (int it = 0; it < 2; ++it) { const int idx = tid + 512 * it, i = idx >> 4, g = idx & 15; \
        if ((KT) < nct) BUF[it] = *(const u32x4v*)(ck + (unsigned)((64 * ktv + i) * 128 + 8 * g)); \
        else BUF[it] = *(const u32x4v*)(proj + (unsigned)((tok0 + 64 * (ktv - nct) + i) * NP + C_K + h * 128 + 8 * g)); } } while (0)
#define ATT_P0TILE(BUF, KT) do { __syncthreads(); \
        _Pragma("unroll") for (int it = 0; it < 2; ++it) { const int idx = tid + 512 * it, i = idx >> 4, g = idx & 15; *(LAS u32x4v*)(sK + i * 136 + 8 * g) = BUF[it]; } \
        if ((KT) + 2 < nkt) ATT_LOADK(BUF, (KT) + 2); \
        __syncthreads(); \
        _Pragma("unroll") for (int tn = 0; tn < 4; ++tn) { f32x4 a_ = {0.f, 0.f, 0.f, 0.f}, b_ = a_; \
            _Pragma("unroll") for (int ks = 0; ks < 2; ++ks) { a_ = MFMA16(frag(sK, 16 * tn, 136, 32 * ks, lane), aq1[ks], a_); b_ = MFMA16(frag(sK, 16 * tn, 136, 64 + 32 * ks, lane), aq2[ks], b_); } \
            _Pragma("unroll") for (int j = 0; j < 4; ++j) { mx1 = fmaxf(mx1, a_[j]); mx2 = fmaxf(mx2, b_[j]); } } } while (0)
    ATT_LOADK(kreg, 0); ATT_LOADK(vreg, 1);
    for (int kt = 0; kt < nkt; kt += 2) { ATT_P0TILE(kreg, kt); ATT_P0TILE(vreg, kt + 1); }
#undef ATT_LOADK
#undef ATT_P0TILE
    mx1 = fmaxf(mx1, __shfl_xor(mx1, 16)); mx1 = fmaxf(mx1, __shfl_xor(mx1, 32)); mx2 = fmaxf(mx2, __shfl_xor(mx2, 16)); mx2 = fmaxf(mx2, __shfl_xor(mx2, 32)); mc1 = mx1 * CS; mc2 = mx2 * CS;
    u32x4v kreg2[2], vreg2[2];
#define ATT_LOADKV(KB, VB, KT) do { int ktv = (KT); asm volatile("" : "+v"(ktv)); _Pragma("unroll") for (int it = 0; it < 2; ++it) { const int idx = tid + 512 * it, i = idx >> 4, g = idx & 15; \
        if ((KT) < nct) { KB[it] = *(const u32x4v*)(ck + (unsigned)((64 * ktv + i) * 128 + 8 * g)); const int dv = idx >> 3, mm = idx & 7; VB[it] = *(const u32x4v*)(cv + (unsigned)(dv * 512 + 64 * ktv + 8 * mm)); } \
        else { KB[it] = *(const u32x4v*)(proj + (unsigned)((tok0 + 64 * (ktv - nct) + i) * NP + C_K + h * 128 + 8 * g)); \
            VB[it] = *(const u32x4v*)(proj + (unsigned)((tok0 + 64 * (ktv - nct) + (idx & 63)) * NP + C_V + h * 128 + 8 * (idx >> 6))); } } } while (0)
#define ATT_STAGEKV(KB, VB, KT) do { _Pragma("unroll") for (int it = 0; it < 2; ++it) { const int idx = tid + 512 * it, i = idx >> 4, g = idx & 15; \
        *(LAS u32x4v*)(sK + i * 136 + 8 * g) = KB[it]; \
        if ((KT) < nct) { const int dv = idx >> 3, mm = idx & 7; *(LAS u32x4v*)(sVt + dv * 72 + 8 * mm) = VB[it]; } \
        else { const u32x4v w = VB[it]; LAS bf16_t* dst = sVt + (8 * (idx >> 6)) * 72 + (idx & 63); \
            dst[0] = (bf16_t)(w.x & 0xffff); dst[72] = (bf16_t)(w.x >> 16); dst[144] = (bf16_t)(w.y & 0xffff); dst[216] = (bf16_t)(w.y >> 16); \
            dst[288] = (bf16_t)(w.z & 0xffff); dst[360] = (bf16_t)(w.z >> 16); dst[432] = (bf16_t)(w.w & 0xffff); dst[504] = (bf16_t)(w.w >> 16); } } } while (0)
    auto p1_compute = [&]() {
#pragma unroll
            for (int bb = 0; bb < 2; ++bb) {
                f32x4 s1[2], s2[2];
#pragma unroll
                for (int t = 0; t < 2; ++t) { s1[t] = (f32x4){0.f, 0.f, 0.f, 0.f}; s2[t] = s1[t];
#pragma unroll
                    for (int ks = 0; ks < 2; ++ks) { s1[t] = MFMA16(frag(sK, 32 * bb + 16 * t, 136, 32 * ks, lane), aq1[ks], s1[t]); s2[t] = MFMA16(frag(sK, 32 * bb + 16 * t, 136, 64 + 32 * ks, lane), aq2[ks], s2[t]); } }
                {
                    bf16x8 pa1, pa2;
                    { float p1[8];
#pragma unroll
                        for (int jj = 0; jj < 8; ++jj) { p1[jj] = __builtin_amdgcn_exp2f(s1[jj >> 2][jj & 3] * CS - mc1); sm1 += p1[jj]; }
                        pa1 = __builtin_bit_cast(bf16x8, pack8(p1)); }
                    { float p2[8];
#pragma unroll
                        for (int jj = 0; jj < 8; ++jj) { p2[jj] = __builtin_amdgcn_exp2f(s2[jj >> 2][jj & 3] * CS - mc2); sm2 += p2[jj]; }
                        pa2 = __builtin_bit_cast(bf16x8, pack8(p2)); }
#pragma unroll
                    for (int tn2 = 0; tn2 < 8; ++tn2) { const LAS bf16_t* vrow = sVt + (16 * tn2 + l15) * 72 + 32 * bb + quad * 4;
                        const u32x2v lo = *(const LAS u32x2v*)vrow, hi = *(const LAS u32x2v*)(vrow + 16);
                        u32x4v vw; vw.x = lo.x; vw.y = lo.y; vw.z = hi.x; vw.w = hi.y;
                        const bf16x8 vb = __builtin_bit_cast(bf16x8, vw);
                        o1[tn2] = MFMA16(pa1, vb, o1[tn2]); o2[tn2] = MFMA16(pa2, vb, o2[tn2]); }
                }
                asm volatile("" ::: "memory");
            }
    };
#define ATT_P1TILE(KB, VB, KT) do { __syncthreads(); ATT_STAGEKV(KB, VB, KT); if ((KT) + 2 < nkt) ATT_LOADKV(KB, VB, (KT) + 2); __syncthreads(); p1_compute(); } while (0)
    ATT_LOADKV(kreg, vreg, 0); ATT_LOADKV(kreg2, vreg2, 1);
    for (int kt = 0; kt < nkt; kt += 2) { ATT_P1TILE(kreg, vreg, kt); ATT_P1TILE(kreg2, vreg2, kt + 1); }
#undef ATT_LOADKV
#undef ATT_STAGEKV
#undef ATT_P1TILE
    sm1 += __shfl_xor(sm1, 16); sm1 += __shfl_xor(sm1, 32); sm2 += __shfl_xor(sm2, 16); sm2 += __shfl_xor(sm2, 32);
    const float il1 = 1.0f / sm1, il2 = lam / sm2;
    float f1[4], f2[4];
#pragma unroll
    for (int j = 0; j < 4; ++j) { f1[j] = __shfl(il1, quad * 4 + j); f2[j] = __shfl(il2, quad * 4 + j); }
#pragma unroll
    for (int tn = 0; tn < 8; ++tn)
#pragma unroll
        for (int j = 0; j < 4; ++j) o1[tn][j] = o1[tn][j] * f1[j] - o2[tn][j] * f2[j];
    asm volatile("" ::: "memory");
#define oacc o1
#undef ATT_LOAD
    bf16_t* mixed = (bf16_t*)(p.ws + WS_UM);
    const float* sg = p.in[I_SUBG] + l * 128;
#pragma unroll
    for (int j = 0; j < 4; ++j) {
        float ss = 0.f;
#pragma unroll
        for (int tn = 0; tn < 8; ++tn) ss += oacc[tn][j] * oacc[tn][j];
        ss = red16_sum(ss);
        const float r = rsqrtf(ss * (1.0f / 128.0f) + 1e-5f) * (1.0f - lam_init);
        const int tq = tok0 + q0 + quad * 4 + j;
#pragma unroll
        for (int tn = 0; tn < 8; ++tn) { const int dv = 16 * tn + l15;
            const float gt = bf2f(proj[(unsigned)tq * NP + C_G + h * 128 + dv]);
            mixed[(unsigned)tq * DM + 1024 + h * 128 + dv] = f2bf(oacc[tn][j] * r * sg[dv] * siluf_(gt)); }
    }
}

#undef oacc
__device__ __forceinline__ void rwkv_prep_task(const Params& p, int l, int task, LAS unsigned char* lds) {
    const int tid = opaque_tid(), lane = tid & 63, wave = tid >> 6, quad = lane >> 4, l15 = lane & 15;
    const int tile = task >> 3, h = task & 7, tb = 64 * tile;
    const int T = tb < NPT ? 256 : 1024, seq0 = tb < NPT ? (tb & ~255) : NPT + ((tb - NPT) & ~1023);
    LAS bf16_t* sTW = (LAS bf16_t*)lds;
    LAS bf16_t* sAD = sTW + 2 * 64 * 72;
    LAS bf16_t* sWup = sAD + 2 * 64 * 72;
    LAS bf16_t* sAup = sWup + 2 * 64 * 72;
    LAS float* sR = (LAS float*)(sAup + 2 * 64 * 72);
    LAS float* sKf = sR + 4096; LAS float* sVf = sKf + 4096; LAS float* sNrm = sVf + 4096; LAS float* sRK = sNrm + 64;
    const bf16_t* proj = (const bf16_t*)(p.ws + WS_PROJ);
    __syncthreads();
#pragma unroll
    for (int it = 0; it < 4; ++it) {
        const int idx = tid + 512 * it, arr = idx >> 9, i = (idx >> 3) & 63, g = idx & 7;
        const u32x4v w = *(const u32x4v*)(proj + (size_t)(tb + i) * NP + A_WD + 64 * arr + 8 * g);
        if (arr < 2) { float x[8]; unpack8(w, x);
#pragma unroll
            for (int e = 0; e < 8; ++e) x[e] = tanhf_(x[e]);
            *(LAS u32x4v*)(sTW + (arr * 64 + i) * 72 + 8 * g) = pack8(x); }
        else *(LAS u32x4v*)(sAD + ((arr - 2) * 64 + i) * 72 + 8 * g) = w;
    }
#pragma unroll
    for (int it = 0; it < 4; ++it) {
        const int dd2 = it >> 1, which = it & 1, c = tid >> 3, jg = tid & 7;
        const bf16_t* src = (const bf16_t*)(p.ws + WS_WUPT) + ((((size_t)(l * 2 + dd2) * 2 + which) * 8 + h) * 4096) + c * 64 + 8 * jg;
        *(LAS u32x4v*)((which ? sAup : sWup) + (dd2 * 64 + c) * 72 + 8 * jg) = *(const u32x4v*)src;
    }
#pragma unroll
    for (int it = 0; it < 3; ++it) {
        const int idx = tid + 512 * it, which = idx >> 9, i = (idx >> 3) & 63, g = idx & 7, ch = which * 512 + h * 64 + 8 * g;
        const int tk = tb + i, pos = tk - seq0;
        const bf16_t* src = proj + (size_t)tk * NP + ch;
        float x0[8], x1[8], x2[8], w0[8], w1[8], w2[8], bb[8];
        unpack8(*(const u32x4v*)src, x1);
        unpack8(*(const u32x4v*)(pos > 0 ? src - NP : src), x0); unpack8(*(const u32x4v*)(pos < T - 1 ? src + NP : src), x2);
        const float m0 = pos > 0 ? 1.f : 0.f, m2 = pos < T - 1 ? 1.f : 0.f;
        const float* cw = p.in[I_CAW] + (size_t)l * 3 * 1536 + ch;
        ld8f(cw, w0); ld8f(cw + 1536, w1); ld8f(cw + 3072, w2); ld8f(p.in[I_CAB] + l * 1536 + ch, bb);
        LAS float* dst = (which == 0 ? sR : (which == 1 ? sKf : sVf)) + i * 64 + 8 * g;
#pragma unroll
        for (int e = 0; e < 8; ++e) dst[e] = m0 * x0[e] * w0[e] + x1[e] * w1[e] + m2 * x2[e] * w2[e] + bb[e];
    }
    __syncthreads();
    { const int t = tid >> 3, part = tid & 7; float ss = 0.f;
#pragma unroll
        for (int e = 0; e < 8; ++e) { const float v = sKf[t * 64 + 8 * part + e] * p.in[I_KK][l * 512 + h * 64 + 8 * part + e]; ss += v * v; }
        ss += __shfl_xor(ss, 1); ss += __shfl_xor(ss, 2); ss += __shfl_xor(ss, 4);
        if (part == 0) sNrm[t] = rsqrtf(ss + 1e-12f); }
    const int dd = wave >> 2, tm = wave & 3;
    f32x4 aw[4], aa[4];
#pragma unroll
    for (int tn = 0; tn < 4; ++tn) { aw[tn] = (f32x4){0.f, 0.f, 0.f, 0.f}; aa[tn] = aw[tn];
#pragma unroll
        for (int ks = 0; ks < 2; ++ks) { aw[tn] = MFMA16(frag(sTW + dd * 64 * 72, 16 * tm, 72, 32 * ks, lane), frag(sWup + dd * 64 * 72, 16 * tn, 72, 32 * ks, lane), aw[tn]);
            aa[tn] = MFMA16(frag(sAD + dd * 64 * 72, 16 * tm, 72, 32 * ks, lane), frag(sAup + dd * 64 * 72, 16 * tn, 72, 32 * ks, lane), aa[tn]); } }
    __syncthreads();
    {
        LAS bf16_t* so = sTW + dd * (3 * 4096);
        float rk[4] = {0.f, 0.f, 0.f, 0.f};
#pragma unroll
        for (int tn = 0; tn < 4; ++tn) { const int c = 16 * tn + l15, ch = h * 64 + c;
            const float w0v = p.in[I_W0][(l * 2 + dd) * 512 + ch], a0v = p.in[I_A0][(l * 2 + dd) * 512 + ch], kav = p.in[I_KA][l * 512 + ch], kkv = p.in[I_KK][l * 512 + ch], rkv = p.in[I_RK][l * 512 + ch];
#pragma unroll
            for (int j = 0; j < 4; ++j) { const int t = 16 * tm + quad * 4 + j; const int o = t * 64 + c;
                const float z = w0v + aw[tn][j]; const float dec = __expf(-0.6065306597126334f * sigmoidf_(z));
                const float av = sigmoidf_(a0v + aa[tn][j]); const float kv = sKf[t * 64 + c];
                const float ktv = kv * (1.0f + (av - 1.0f) * kav); const float kk = kv * kkv * sNrm[t];
                so[o] = f2bf(ktv); so[4096 + o] = f2bf(kk * av); so[8192 + o] = f2bf(dec - 1.0f);
                rk[j] += sR[t * 64 + c] * ktv * rkv; } }
#pragma unroll
        for (int j = 0; j < 4; ++j) { const float s = red16_sum(rk[j]); if (l15 == 0) sRK[dd * 64 + 16 * tm + quad * 4 + j] = s; }
    }
    __syncthreads();
    { const int i = tid >> 3, g = tid & 7; const size_t o = (size_t)(tb + i) * 512 + h * 64 + 8 * g;
        float r[8], k[8], v[8], bn[8]; const float nr = sNrm[i], rks = sRK[i] + sRK[64 + i];
#pragma unroll
        for (int e = 0; e < 8; ++e) { r[e] = sR[i * 64 + 8 * g + e]; k[e] = sKf[i * 64 + 8 * g + e] * p.in[I_KK][l * 512 + h * 64 + 8 * g + e] * nr; v[e] = sVf[i * 64 + 8 * g + e]; bn[e] = rks * v[e]; }
        const size_t o2 = ((size_t)(tb + i) * 8 + h) * 320 + 8 * g; bf16_t* pk = (bf16_t*)(p.ws + WS_PK);
#pragma unroll
        for (int dd2 = 0; dd2 < 2; ++dd2)
#pragma unroll
            for (int ar = 0; ar < 3; ++ar) *(u32x4v*)(pk + (size_t)dd2 * NTOK * 2560 + o2 + 128 + 64 * ar) = *(const LAS u32x4v*)(sTW + dd2 * (3 * 4096) + ar * 4096 + i * 64 + 8 * g);
        const u32x4v rr = pack8(r), kk8 = pack8(k);
        *(u32x4v*)(pk + o2) = rr; *(u32x4v*)(pk + o2 + 64) = kk8; *(u32x4v*)(pk + (size_t)NTOK * 2560 + o2) = rr; *(u32x4v*)(pk + (size_t)NTOK * 2560 + o2 + 64) = kk8;
        *(u32x4v*)((bf16_t*)(p.ws + WS_SCV) + o) = pack8(v); *(u32x4v*)((bf16_t*)(p.ws + WS_SCBON) + o) = pack8(bn); }
}

__device__ __forceinline__ void m1_phase(const Params& p, int l, LAS unsigned char* lds, int rep, int mask) {
    unsigned* ctr = (unsigned*)(p.ws + WS_CTL) + 64 * (1 + 4 * l + 8 * rep);
    LAS int* slot = (LAS int*)(lds + LDS_SLOT);
#ifndef NO_MLSTM
    if (mask & 1) for (;;) { const int t = next_task(ctr, slot); if (t >= 272) break; const int u = t < 16 ? t + 256 : t - 16; mlstm_task(p, l, u >> 3, (u >> 2) & 1, u & 3, lds); }
#endif
#ifndef NO_ATTN
    if (mask & 2) for (;;) { const int t = next_task(ctr + 64, slot); if (t >= 640) break; attn_task(p, l, t, lds); }
#endif
#ifndef NO_PREP
    if (mask & 4) for (;;) { const int t = next_task(ctr + 128, slot); if (t >= 1280) break; rwkv_prep_task(p, l, t, lds); }
#endif
}

#ifdef EXP_LITE
#if EXP_LITE == 1
#define EXPY(v) (bf2f(sBt[(quad * 4 + j) * 24 + l15]) + bf2f(sGt[(16 + quad * 4 + j) * 24 + l15]) + sW[l15 + 16 * quad])
#elif EXP_LITE == 2
#define EXPY(v) (bf2f(sAt[(quad * 4 + j) * 72 + l15]) + bf2f(sX2[(quad * 4 + j) * 24 + l15]))
#else
#define EXPY(v) (bf2f(sPy[(quad * 4 + j) * 72 + 16 + l15]) + bf2f(sQy[(quad * 4 + j) * 24 + l15]))
#endif
#define EXPS(v) 0.f
#else
#define EXPY(v) (v)
#define EXPS(v) (v)
#endif
__device__ __forceinline__ bf16_t f2bf_sw(float f) { unsigned u = __float_as_uint(f); u += 0x7FFFu + ((u >> 16) & 1u); return (bf16_t)(u >> 16); }
__device__ __forceinline__ bf16x8 frag16(const LAS bf16_t* base, int row0, int ld, int lane) {
    bf16x8 z = {0, 0, 0, 0, 0, 0, 0, 0};
    if ((lane >> 4) < 2) z = *(const LAS bf16x8*)(base + (row0 + (lane & 15)) * ld + (lane >> 4) * 8);
    return z;
}
__device__ __forceinline__ void cp_task(const Params& p, int task, int lane, LAS unsigned char* wl) {
    int s, d, h, c, T;
    if (task < 8192) { s = task >> 8; d = (task >> 7) & 1; h = (task >> 4) & 7; c = task & 15; T = 256; }
    else { const int u = task - 8192; s = 32 + (u >> 10); d = (u >> 9) & 1; h = (u >> 6) & 7; c = u & 63; T = 1024; }
    const int tok0 = s < 32 ? s * 256 : NPT + (s - 32) * 1024, quad = lane >> 4, l15 = lane & 15;
    const long step = d == 0 ? 1 : -1; const int tfirst = d == 0 ? tok0 + 16 * c : tok0 + T - 1 - 16 * c;
    bf16_t* pk = (bf16_t*)(p.ws + WS_PK) + (size_t)d * NTOK * 2560 + ((size_t)tfirst * 8 + h) * 320;
    LAS bf16_t* sA = (LAS bf16_t*)wl;
    LAS bf16_t* sB = sA + 16 * 72, *sG = sB + 16 * 72, *sR = sG + 16 * 72;
    LAS float* mL1 = (LAS float*)(sR + 16 * 72);
    LAS bf16_t* sL2 = (LAS bf16_t*)(mL1 + 16 * 17);
    LAS bf16_t* sM1t = sL2 + 16 * 24;
    LAS bf16_t* sTt = sM1t + 16 * 24;
    LAS bf16_t* sAtil = sTt + 16 * 24;
    LAS bf16_t* sX2 = sTt;
    LAS bf16_t* oAt = sB;
    LAS bf16_t* oPy = sG;
    LAS bf16_t* oX2 = (LAS bf16_t*)mL1;
    LAS bf16_t* oQy = sL2;
    float bt[16], gt[16], W = 1.0f;
    { const int k = lane;
        float rr[16], kk[16], kt[16], ka[16], wm[16];
#pragma unroll
        for (int i = 0; i < 16; ++i) { const bf16_t* rec = pk + step * 2560 * i + k; rr[i] = bf2f(rec[0]); kk[i] = bf2f(rec[64]); kt[i] = bf2f(rec[128]); ka[i] = bf2f(rec[192]); wm[i] = bf2f(rec[256]); }
#pragma unroll
        for (int i = 0; i < 16; ++i) { const float Wp = W; W = W + W * wm[i]; const float iw = __builtin_amdgcn_rcpf(W);
            sA[i * 72 + k] = f2bf(Wp * kk[i]); bt[i] = ka[i] * iw; gt[i] = kt[i] * iw; sB[i * 72 + k] = f2bf(bt[i]); sG[i * 72 + k] = f2bf(gt[i]); sR[i * 72 + k] = f2bf(W * rr[i]); } }
    LDS_FENCE();
    f32x4 m2acc;
    { f32x4 a1 = {0.f, 0.f, 0.f, 0.f}, a2 = a1, a3 = a1, a4 = a1;
#pragma unroll
        for (int ks = 0; ks < 2; ++ks) { const bf16x8 fb = frag(sB, 0, 72, 32 * ks, lane), fg = frag(sG, 0, 72, 32 * ks, lane), fa = frag(sA, 0, 72, 32 * ks, lane), fr = frag(sR, 0, 72, 32 * ks, lane);
            a1 = MFMA16(fb, fa, a1); a2 = MFMA16(fg, fa, a2); a3 = MFMA16(fb, fr, a3); a4 = MFMA16(fg, fr, a4); }
#pragma unroll
        for (int j = 0; j < 4; ++j) { const int i = quad * 4 + j, t = l15;
            mL1[i * 17 + t] = i < t ? a1[j] : 0.f; sL2[i * 24 + t] = f2bf(i < t ? a2[j] : 0.f); sM1t[t * 24 + i] = f2bf(i <= t ? a3[j] : 0.f); m2acc[j] = i <= t ? a4[j] : 0.f; } }
    LDS_FENCE();
    { float Tr[16];
#pragma unroll
        for (int t = 0; t < 16; ++t) { float acc = (l15 == t) ? 1.0f : 0.0f;
#pragma unroll
            for (int i = 0; i < t; ++i) acc -= Tr[i] * mL1[i * 17 + t];
            Tr[t] = acc; }
        if (quad == 0) {
#pragma unroll
            for (int t = 0; t < 16; ++t) sTt[t * 24 + l15] = f2bf(Tr[t]); } }
    LDS_FENCE();
    const bf16x8 ftt = frag16(sTt, 0, 24, lane);
#pragma unroll
    for (int kt2 = 0; kt2 < 4; ++kt2) {
        u32x4v aw = {0u, 0u, 0u, 0u};
        if (quad < 2) { const LAS bf16_t* col = sA + (quad * 8) * 72 + 16 * kt2 + l15;
            aw.x = (unsigned)col[0] | ((unsigned)col[72] << 16); aw.y = (unsigned)col[144] | ((unsigned)col[216] << 16); aw.z = (unsigned)col[288] | ((unsigned)col[360] << 16); aw.w = (unsigned)col[432] | ((unsigned)col[504] << 16); }
        f32x4 acc = {0.f, 0.f, 0.f, 0.f};
        acc = MFMA16(__builtin_bit_cast(bf16x8, aw), ftt, acc);
#pragma unroll
        for (int j = 0; j < 4; ++j) { const int k = 16 * kt2 + quad * 4 + j; const bf16_t v = f2bf_sw(acc[j]); sAtil[k * 24 + l15] = v; oAt[l15 * 72 + k] = v; }
    }
    { f32x4 acc = {0.f, 0.f, 0.f, 0.f};
        acc = MFMA16(frag16(sL2, 0, 24, lane), ftt, acc);
#pragma unroll
        for (int j = 0; j < 4; ++j) { const bf16_t v = f2bf_sw(acc[j]); sX2[(quad * 4 + j) * 24 + l15] = v; oX2[l15 * 24 + quad * 4 + j] = v; } }
    LDS_FENCE();
    const bf16x8 fm1 = frag16(sM1t, 0, 24, lane);
#pragma unroll
    for (int kt2 = 0; kt2 < 4; ++kt2) { f32x4 acc = {0.f, 0.f, 0.f, 0.f};
        acc = MFMA16(frag16(sAtil, 16 * kt2, 24, lane), fm1, acc);
#pragma unroll
        for (int j = 0; j < 4; ++j) { const int k = 16 * kt2 + quad * 4 + j; oPy[l15 * 72 + k] = f2bf(bf2f(sR[l15 * 72 + k]) - acc[j]); } }
    { f32x4 acc = {0.f, 0.f, 0.f, 0.f};
        acc = MFMA16(frag16(sX2, 0, 24, lane), fm1, acc);
#pragma unroll
        for (int j = 0; j < 4; ++j) oQy[l15 * 24 + quad * 4 + j] = f2bf(m2acc[j] - acc[j]); }
    LDS_FENCE();
    { float bb8[8]; const int k = lane; bf16_t* rec = pk + step * 2560 * (k >> 2);
#pragma unroll
        for (int hh = 0; hh < 2; ++hh) {
#pragma unroll
            for (int e = 0; e < 8; ++e) bb8[e] = bt[8 * hh + e];
            *(u32x4v*)(rec + 128 + (k & 3) * 16 + 8 * hh) = pack8(bb8);
#pragma unroll
            for (int e = 0; e < 8; ++e) bb8[e] = gt[8 * hh + e];
            *(u32x4v*)(rec + 192 + (k & 3) * 16 + 8 * hh) = pack8(bb8); }
        ((float*)(rec + 288))[k & 3] = W; }
#pragma unroll
    for (int it = 0; it < 2; ++it) { const int f = lane + 64 * it, t = f >> 3, q = f & 7; bf16_t* rec = pk + step * 2560 * t;
        *(u32x4v*)(rec + 8 * q) = *(const LAS u32x4v*)(oAt + t * 72 + 8 * q); *(u32x4v*)(rec + 64 + 8 * q) = *(const LAS u32x4v*)(oPy + t * 72 + 8 * q); }
    if (lane < 32) { const int t = lane >> 1, q = lane & 1; bf16_t* rec = pk + step * 2560 * t;
        *(u32x4v*)(rec + 256 + 8 * q) = *(const LAS u32x4v*)(oX2 + t * 24 + 8 * q); *(u32x4v*)(rec + 272 + 8 * q) = *(const LAS u32x4v*)(oQy + t * 24 + 8 * q); }
    LDS_FENCE();
}
constexpr int CP_LDS = 16 * 72 * 2 * 4 + 16 * 17 * 4 + (16 * 24 * 3 + 64 * 24 + 16 * 24) * 2 + 16 * 72 * 2 * 2 + 16 * 24 * 2 * 2;

__device__ __forceinline__ void ap_task(const Params& p, int l, int task, int lane, LAS unsigned char* wl) {
    int s, d, h, rt;
    if (task < 128) { s = 32 + (task >> 6); d = (task >> 5) & 1; h = (task >> 2) & 7; rt = task & 3; }
    else { const int u = task - 128; s = u >> 6; d = (u >> 5) & 1; h = (u >> 2) & 7; rt = u & 3; }
    const int T = s < 32 ? 256 : 1024, nch = T / 16, tok0 = s < 32 ? s * 256 : NPT + (s - 32) * 1024, quad = lane >> 4, l15 = lane & 15;
    const long step = d == 0 ? 1 : -1; const int tstart = d == 0 ? tok0 : tok0 + T - 1;
    const bf16_t* pk = (const bf16_t*)(p.ws + WS_PK) + (size_t)d * NTOK * 2560 + ((size_t)tstart * 8 + h) * 320;
    const bf16_t* pv = (const bf16_t*)(p.ws + WS_SCV) + (size_t)tstart * 512 + h * 64 + 16 * rt;
    float* yd = (float*)(p.ws + WS_YD) + (size_t)d * NTOK * 512 + (size_t)tstart * 512 + h * 64 + 16 * rt;
    constexpr int IS = 328;
    LAS bf16_t* img = (LAS bf16_t*)wl;
    LAS bf16_t* sS = img + 16 * IS;
    LAS bf16_t* sCm = sS + 16 * 72;
    f32x4 S[4];
    if (s >= 32) { const float* s0 = p.in[I_SRW] + ((((size_t)((s - 32) * 2 + l) * 2 + d) * 8 + h) * 64 + 16 * rt) * 64;
#pragma unroll
        for (int tn = 0; tn < 4; ++tn)
#pragma unroll
            for (int j = 0; j < 4; ++j) S[tn][j] = s0[(quad * 4 + j) * 64 + 16 * tn + l15]; }
    else {
#pragma unroll
        for (int tn = 0; tn < 4; ++tn) S[tn] = (f32x4){0.f, 0.f, 0.f, 0.f}; }
    const bf16_t* gsrc = pk + step * 2560 * (lane >> 2) + 8 * (lane & 3);
    LAS bf16_t* ldst = img + (lane >> 2) * IS + 8 * (lane & 3);
    u32x4v rawA[10], rawB[10]; bf16_t vrA[8], vrB[8];
#define AP_LOAD(raw, vraw, CH) do { int chv = (CH); asm volatile("" : "+v"(chv)); const bf16_t* cb = gsrc + step * 2560 * (16 * chv); \
        _Pragma("unroll") for (int jj = 0; jj < 10; ++jj) raw[jj] = *(const u32x4v*)(cb + 32 * jj); \
        if (quad < 2) { _Pragma("unroll") for (int e = 0; e < 8; ++e) vraw[e] = pv[step * 512 * (16 * chv + quad * 8 + e) + l15]; } } while (0)
#define AP_STAGE(raw) do { _Pragma("unroll") for (int jj = 0; jj < 10; ++jj) *(LAS u32x4v*)(ldst + 32 * jj) = raw[jj]; } while (0)
    AP_LOAD(rawA, vrA, 0);
    if (nch > 1) AP_LOAD(rawB, vrB, 1);
    const LAS bf16_t* pBt = img + (l15 >> 2) * IS + 128 + (l15 & 3) * 16 + quad * 8;
    const LAS float* pW = (const LAS float*)(img + (l15 >> 2) * IS + 288) + (l15 & 3);
#define AP_CHUNK(raw, vraw, CC) do { const int c = (CC); \
        AP_STAGE(raw); \
        u32x4v vw = {0u, 0u, 0u, 0u}; \
        if (quad < 2) { vw.x = (unsigned)vraw[0] | ((unsigned)vraw[1] << 16); vw.y = (unsigned)vraw[2] | ((unsigned)vraw[3] << 16); vw.z = (unsigned)vraw[4] | ((unsigned)vraw[5] << 16); vw.w = (unsigned)vraw[6] | ((unsigned)vraw[7] << 16); } \
        asm volatile("" : "+v"(vw)); \
        if (c + 2 < nch) AP_LOAD(raw, vraw, c + 2); \
        ap_compute(c, vw); } while (0)
    auto ap_compute = [&](int c, u32x4v vw) {
        const bf16x8 va = __builtin_bit_cast(bf16x8, vw);
#pragma unroll
        for (int tn = 0; tn < 4; ++tn) { const unsigned w01 = pk2(S[tn][0], S[tn][1]), w23 = pk2(S[tn][2], S[tn][3]); LAS bf16_t* ds = sS + (quad * 4) * 72 + 16 * tn + l15;
            ds[0] = (bf16_t)(w01 & 0xffff); ds[72] = (bf16_t)(w01 >> 16); ds[144] = (bf16_t)(w23 & 0xffff); ds[216] = (bf16_t)(w23 >> 16); }
        LDS_FENCE();
        f32x4 cm = {0.f, 0.f, 0.f, 0.f}, yy = {0.f, 0.f, 0.f, 0.f};
#pragma unroll
        for (int ks = 0; ks < 2; ++ks) { const bf16x8 fs = frag(sS, 0, 72, 32 * ks, lane); cm = MFMA16(fs, frag(img, 0, IS, 32 * ks, lane), cm); yy = MFMA16(fs, frag(img + 64, 0, IS, 32 * ks, lane), yy); }
        cm = MFMA16(va, frag16(img + 256, 0, IS, lane), cm); yy = MFMA16(va, frag16(img + 272, 0, IS, lane), yy);
#pragma unroll
        for (int j = 0; j < 4; ++j) { yd[step * 512 * (16 * c + l15) + quad * 4 + j] = yy[j]; sCm[(quad * 4 + j) * 24 + l15] = f2bf_sw(cm[j]); }
        LDS_FENCE();
        const bf16x8 fc = frag16(sCm, 0, 24, lane);
#pragma unroll
        for (int tn = 0; tn < 4; ++tn) { f32x4 ab = {0.f, 0.f, 0.f, 0.f}, ag = ab;
            bf16x8 fb = {0, 0, 0, 0, 0, 0, 0, 0}, fg = fb;
            if (quad < 2) { fb = *(const LAS bf16x8*)(pBt + tn * 4 * IS); fg = *(const LAS bf16x8*)(pBt + tn * 4 * IS + 64); }
            ab = MFMA16(fc, fb, ab); ag = MFMA16(va, fg, ag);
            const float w16 = pW[tn * 2 * IS];
#pragma unroll
            for (int j = 0; j < 4; ++j) S[tn][j] = (S[tn][j] - ab[j] + ag[j]) * w16; }
        LDS_FENCE();
    };
    for (int c2 = 0; c2 < nch; c2 += 2) { AP_CHUNK(rawA, vrA, c2); AP_CHUNK(rawB, vrB, c2 + 1); }
#undef AP_CHUNK
#undef AP_LOAD
#undef AP_STAGE
    if (s < 32) { float* so = p.out + O_RW + ((((size_t)(s * 2 + l) * 2 + d) * 8 + h) * 64 + 16 * rt) * 64;
#pragma unroll
        for (int tn = 0; tn < 4; ++tn)
#pragma unroll
            for (int j = 0; j < 4; ++j) so[(quad * 4 + j) * 64 + 16 * tn + l15] = S[tn][j]; }
}
constexpr int AP_LDS = (16 * 72 * 2 + 64 * 24 * 2 + 16 * 24 * 2) * 2 + 64 * 4 + (16 * 72 + 16 * 24) * 2;

typedef float f32x2 __attribute__((ext_vector_type(2)));
__device__ __forceinline__ void m2_phase(const Params& p, int l, int rep, LAS unsigned char* lds, const XcdBarrier& xbar) {
    const int tid_ = opaque_tid(); const int lane = tid_ & 63, wave = tid_ >> 6;
    LAS unsigned char* wl = lds + wave * 16384;
    const int G = gridDim.x, b = blockIdx.x, slot = b * 8 + wave, NW = G * 8;
    for (int t = slot; t < 2048; t += NW) cp_task(p, 8192 + t, lane, wl);
    xcd_barrier(xbar);
    const bool chain_wave = wave == 0 && b < 128;
    if (chain_wave) { for (int t = b; t < 128; t += G) ap_task(p, l, t, lane, wl); }
    else { const int nchain = G < 128 ? G : 128;
        const int idx = b < nchain ? b * 7 + (wave - 1) : nchain * 7 + (b - nchain) * 8 + wave;
        for (int t = idx; t < 8192; t += NW - nchain) cp_task(p, t, lane, wl); }
    xcd_barrier(xbar);
    for (int t = slot; t < 2048; t += NW) ap_task(p, l, 128 + t, lane, wl);
}

__device__ __forceinline__ void m3_phase(const Params& p, int l) {
    const int tid_ = opaque_tid(); const int lane = tid_ & 63, gw = blockIdx.x * 8 + (tid_ >> 6), NGW = gridDim.x * 8;
    const bf16_t* proj = (const bf16_t*)(p.ws + WS_PROJ);
    bf16_t* mixed = (bf16_t*)(p.ws + WS_UM);
    const int c = lane * 8;
    for (int tok = gw; tok < NTOK; tok += NGW) {
        const size_t o = (size_t)tok * 512 + c;
        {
            float y0[8], y1[8], g[8], bb[8], bn[8], gt[8], out[8];
            ld8f((const float*)(p.ws + WS_YD) + o, y0); ld8f((const float*)(p.ws + WS_YD) + (size_t)NTOK * 512 + o, y1);
            float s = 0.f;
#pragma unroll
            for (int e = 0; e < 8; ++e) { y0[e] += y1[e]; s += y0[e]; }
            s += __shfl_xor(s, 1); s += __shfl_xor(s, 2); s += __shfl_xor(s, 4);
            const float mu = s * (1.0f / 64.0f); float q = 0.f;
#pragma unroll
            for (int e = 0; e < 8; ++e) { y0[e] -= mu; q += y0[e] * y0[e]; }
            q += __shfl_xor(q, 1); q += __shfl_xor(q, 2); q += __shfl_xor(q, 4);
            const float rs = rsqrtf(q * (1.0f / 64.0f) + 64e-5f);
            ld8f(p.in[I_RGG] + l * 512 + c, g); ld8f(p.in[I_RGB] + l * 512 + c, bb);
            unpack8(*(const u32x4v*)((const bf16_t*)(p.ws + WS_SCBON) + o), bn);
            unpack8(*(const u32x4v*)(proj + (size_t)tok * NP + A_GATE + c), gt);
#pragma unroll
            for (int e = 0; e < 8; ++e) out[e] = (y0[e] * rs * g[e] + bb[e] + bn[e]) * siluf_(gt[e]);
            *(u32x4v*)(mixed + (size_t)tok * DM + c) = pack8(out);
        }
        {
            float h0[8], h1[8], g[8], bb[8], og[8], gt[8], out[8];
            ld8f((const float*)(p.ws + WS_HD) + o, h0); ld8f((const float*)(p.ws + WS_HD) + (size_t)NTOK * 512 + o, h1);
            unpack8(*(const u32x4v*)(proj + (size_t)tok * NP + B_O + c), og);
            float s = 0.f;
#pragma unroll
            for (int e = 0; e < 8; ++e) { h0[e] = (h0[e] + h1[e]) * sigmoidf_(og[e]); s += h0[e]; }
            s += __shfl_xor(s, 1); s += __shfl_xor(s, 2); s += __shfl_xor(s, 4); s += __shfl_xor(s, 8);
            const float mu = s * (1.0f / 128.0f); float q = 0.f;
#pragma unroll
            for (int e = 0; e < 8; ++e) { h0[e] -= mu; q += h0[e] * h0[e]; }
            q += __shfl_xor(q, 1); q += __shfl_xor(q, 2); q += __shfl_xor(q, 4); q += __shfl_xor(q, 8);
            const float rs = rsqrtf(q * (1.0f / 128.0f) + 1e-5f);
            ld8f(p.in[I_MGG] + l * 512 + c, g); ld8f(p.in[I_MGB] + l * 512 + c, bb);
            unpack8(*(const u32x4v*)(proj + (size_t)tok * NP + B_GATE + c), gt);
#pragma unroll
            for (int e = 0; e < 8; ++e) out[e] = (h0[e] * rs * g[e] + bb[e]) * siluf_(gt[e]);
            *(u32x4v*)(mixed + (size_t)tok * DM + 512 + c) = pack8(out);
        }
    }
}

__device__ __forceinline__ void ln_phase(const Params& p, int l) {
    const int tid_ = opaque_tid(); const int lane = tid_ & 63, gw = blockIdx.x * 8 + (tid_ >> 6), NGW = gridDim.x * 8;
    for (int tok0 = gw; tok0 < NTOK; tok0 += 2 * NGW) {
        const int tok1 = tok0 + NGW; const bool has1 = tok1 < NTOK;
        float* zr0 = p.out + O_Y + (size_t)tok0 * DM; float* zr1 = p.out + O_Y + (size_t)(has1 ? tok1 : tok0) * DM;
        float v0[4][8], v1[4][8]; float s0 = 0.f, s1 = 0.f;
#pragma unroll
        for (int j = 0; j < 4; ++j) { ld8f(zr0 + j * 512 + lane * 8, v0[j]); ld8f(zr1 + j * 512 + lane * 8, v1[j]); }
#pragma unroll
        for (int j = 0; j < 4; ++j)
#pragma unroll
            for (int e = 0; e < 8; ++e) { s0 += v0[j][e]; s1 += v1[j][e]; }
#pragma unroll
        for (int o = 1; o < 64; o <<= 1) { s0 += __shfl_xor(s0, o); s1 += __shfl_xor(s1, o); }
        const float mu0 = s0 * (1.0f / 2048.0f), mu1 = s1 * (1.0f / 2048.0f); float q0 = 0.f, q1 = 0.f;
#pragma unroll
        for (int j = 0; j < 4; ++j)
#pragma unroll
            for (int e = 0; e < 8; ++e) { v0[j][e] -= mu0; q0 += v0[j][e] * v0[j][e]; v1[j][e] -= mu1; q1 += v1[j][e] * v1[j][e]; }
#pragma unroll
        for (int o = 1; o < 64; o <<= 1) { q0 += __shfl_xor(q0, o); q1 += __shfl_xor(q1, o); }
        const float rs0 = rsqrtf(q0 * (1.0f / 2048.0f) + 1e-5f), rs1 = rsqrtf(q1 * (1.0f / 2048.0f) + 1e-5f);
        const float* mod0 = (const float*)(p.ws + WS_MOD) + (size_t)(3 + mod_row(tok0)) * 6144;
        const float* mod1 = (const float*)(p.ws + WS_MOD) + (size_t)(3 + mod_row(has1 ? tok1 : tok0)) * 6144;
        bf16_t* ur0 = (bf16_t*)(p.ws + WS_UM) + (size_t)tok0 * DM; bf16_t* ur1 = (bf16_t*)(p.ws + WS_UM) + (size_t)(has1 ? tok1 : tok0) * DM;
#pragma unroll
        for (int j = 0; j < 4; ++j) { const int c = j * 512 + lane * 8; float g[8], bb[8], y0[8], y1[8];
            ld8f(p.in[I_LNG] + l * DM + c, g); ld8f(p.in[I_LNB] + l * DM + c, bb);
#pragma unroll
            for (int e = 0; e < 8; ++e) { y0[e] = v0[j][e] * rs0 * g[e] + bb[e]; y1[e] = v1[j][e] * rs1 * g[e] + bb[e]; }
            *(float4*)(zr0 + c) = make_float4(y0[0], y0[1], y0[2], y0[3]); *(float4*)(zr0 + c + 4) = make_float4(y0[4], y0[5], y0[6], y0[7]);
            if (has1) { *(float4*)(zr1 + c) = make_float4(y1[0], y1[1], y1[2], y1[3]); *(float4*)(zr1 + c + 4) = make_float4(y1[4], y1[5], y1[6], y1[7]); }
            if (l == 0) { float sh[8], sc[8], o[8]; ld8f(mod0 + c, sh); ld8f(mod0 + 2048 + c, sc);
#pragma unroll
                for (int e = 0; e < 8; ++e) o[e] = y0[e] * (1.0f + sc[e]) + sh[e];
                *(u32x4v*)(ur0 + c) = pack8(o);
                if (has1) { ld8f(mod1 + c, sh); ld8f(mod1 + 2048 + c, sc);
#pragma unroll
                    for (int e = 0; e < 8; ++e) o[e] = y1[e] * (1.0f + sc[e]) + sh[e];
                    *(u32x4v*)(ur1 + c) = pack8(o); } } }
    }
}

#ifndef G2_ALIGN
#define G2_ALIGN true
#endif
#ifndef GEMM_ALIGN
#define GEMM_ALIGN true
#endif
#ifndef GEMM_SP2
#define GEMM_SP2 true
#endif
#ifndef DUP_P0B
#define DUP_P0B 0
#endif
#ifndef DUP_SYNC
#define DUP_SYNC 0
#endif
#ifndef DUP_M3
#define DUP_M3 0
#endif
#ifndef DUP_G2
#define DUP_G2 0
#endif
#ifndef DUP_P0
#define DUP_P0 0
#endif
#ifndef DUP_M1
#define DUP_M1 0
#endif
#ifndef DUP_M2
#define DUP_M2 0
#endif
#ifndef DUP_G1
#define DUP_G1 0
#endif
#ifndef DUP_MASK
#define DUP_MASK 7
#endif
#ifndef PH_ALL
#define PH_ALL 1
#endif
#ifndef PH_P0
#define PH_P0 PH_ALL
#endif
#ifndef PH_G1
#define PH_G1 PH_ALL
#endif
#ifndef PH_M1
#define PH_M1 PH_ALL
#endif
#ifndef PH_M2
#define PH_M2 PH_ALL
#endif
#ifndef PH_M3
#define PH_M3 PH_ALL
#endif
#ifndef PH_G2
#define PH_G2 PH_ALL
#endif
#ifndef PH_LN
#define PH_LN PH_ALL
#endif
__global__ void __launch_bounds__(NTHREADS) hybrid_fwd(Params p) {
    extern __shared__ __attribute__((aligned(16))) unsigned char smem[];
    LAS unsigned char* lds = (LAS unsigned char*)smem;
    cg::grid_group grid = cg::this_grid();
    volatile LAS unsigned* xst = (volatile LAS unsigned*)(lds + LDS_SLOT + 16);
    if (threadIdx.x == 0) { xst[0] = 0u; xst[1] = 0u; }
    __syncthreads();
    const XcdBarrier xbar = xcd_barrier_post((unsigned*)(p.ws + WS_BAR), xst);
#define GSYNC() xcd_barrier(xbar)
#if PH_P0
    for (int rep = 0; rep < 1 + DUP_P0; ++rep) { p0_phase(p, lds, rep); if (rep < DUP_P0) GSYNC(); }
#endif
    if (p.ws == nullptr) grid.sync();
    GSYNC();
#if PH_P0
    for (int rep = 0; rep < 1 + DUP_P0B; ++rep) p0b_phase(p);
#endif
    GSYNC();
    for (int i = 0; i < DUP_SYNC; ++i) GSYNC();
    for (int l = 0; l < 2; ++l) {
#if PH_G1
        for (int rep = 0; rep < 1 + DUP_G1; ++rep) {
            pg8::Gemm g; g.A = (const bf16_t*)(p.ws + WS_UM); g.Bt = (const bf16_t*)(p.ws + WS_WIN) + (size_t)l * NP * DM; g.M = NTOK; g.N = NP; g.K = DM;
            pg8::StaticOrder S; S.init(NTOK, NP, gridDim.x, blockIdx.x);
            EpiIn E; E.proj = (bf16_t*)(p.ws + WS_PROJ); E.gates = (float*)(p.ws + WS_GATES); E.newk = p.out + O_NK; E.newv = p.out + O_NV; E.rope = (const float*)(p.ws + WS_ROPE); E.layer = l;
            pg8::gemm_phase<EpiIn, pg8::StaticOrder, GEMM_ALIGN, GEMM_SP2>(lds, g, S, E);
            if (l == 0 && rep == 0) tr_tail_phase(p, lds);
            if (rep < DUP_G1) GSYNC();
        }
#endif
        GSYNC();
#if PH_M1
        for (int rep = 0; rep < 1 + DUP_M1; ++rep) { m1_phase(p, l, lds, rep, rep == 0 ? 7 : DUP_MASK); if (rep < DUP_M1) GSYNC(); }
#endif
        GSYNC();
#if PH_M2
        for (int rep = 0; rep < 1 + DUP_M2; ++rep) { m2_phase(p, l, rep, lds, xbar); if (rep < DUP_M2) GSYNC(); }
#endif
        GSYNC();
#if PH_M3
        for (int rep = 0; rep < 1 + DUP_M3; ++rep) m3_phase(p, l);
#endif
        GSYNC();
#if PH_G2
        for (int rep = 0; rep < 1 + (l == 0 ? DUP_G2 : 0); ++rep) {
            pg8::Gemm g; g.A = (const bf16_t*)(p.ws + WS_UM); g.Bt = (const bf16_t*)(p.ws + WS_WOUT) + (size_t)l * DM * DM; g.M = NTOK; g.N = DM; g.K = DM;
            pg8::StaticOrder S; S.init(NTOK, DM, gridDim.x, blockIdx.x);
            EpiOut E; E.xp = p.in[I_XP]; E.xs = p.in[I_XS]; E.mod = (const float*)(p.ws + WS_MOD) + (size_t)l * 3 * 6144; E.y = p.out + O_Y; E.layer = l;
            pg8::gemm_phase<EpiOut, pg8::StaticOrder, G2_ALIGN, GEMM_SP2>(lds, g, S, E);
            if (rep < (l == 0 ? DUP_G2 : 0)) GSYNC();
        }
#endif
        GSYNC();
#if PH_LN
        ln_phase(p, l);
#endif
        if (l == 0) GSYNC();
    }
}

extern "C" void kernel_launch(void* const* d_in, const int* in_sizes, int n_in, void* d_out, int out_size, void* d_ws, size_t ws_size, hipStream_t stream) {
    static int grid_blocks = 0;
    if (grid_blocks == 0) {
        if (n_in != 38 || ws_size < WS_END) { fprintf(stderr, "kernel_launch: unexpected n_in %d / ws_size %zu (need %zu)\n", n_in, ws_size, (size_t)WS_END); grid_blocks = -1; return; }
        int dev = 0, cus = 0, per_cu = 0;
        hipGetDevice(&dev);
        hipDeviceGetAttribute(&cus, hipDeviceAttributeMultiprocessorCount, dev);
        hipFuncSetAttribute((const void*)hybrid_fwd, hipFuncAttributeMaxDynamicSharedMemorySize, LDS_BYTES);
        hipOccupancyMaxActiveBlocksPerMultiprocessor(&per_cu, (const void*)hybrid_fwd, NTHREADS, LDS_BYTES);
        if (per_cu < 1) { fprintf(stderr, "kernel_launch: occupancy query gives %d blocks per CU\n", per_cu); per_cu = 1; }
        grid_blocks = cus * per_cu;
    }
    if (grid_blocks < 0) return;
    Params p{};
    for (int i = 0; i < 38; ++i) p.in[i] = (const float*)d_in[i];
    p.out = (float*)d_out; p.ws = (unsigned char*)d_ws;
    hipMemsetAsync(d_ws, 0, 32768, stream);
    void* args[] = {&p};
    hipError_t e = hipLaunchCooperativeKernel((const void*)hybrid_fwd, dim3(grid_blocks), dim3(NTHREADS), args, LDS_BYTES, stream);
    if (e != hipSuccess) fprintf(stderr, "cooperative launch failed: %s (grid %d)\n", hipGetErrorString(e), grid_blocks);
}
```

```cpp
#include <hip/hip_runtime.h>
#include <hip/hip_cooperative_groups.h>
#include <cstdio>
#include <cstdint>
namespace cg = cooperative_groups;
namespace pg8 {
#define PG8_LAS __attribute__((address_space(3)))
typedef unsigned short bf16_t;
typedef short bf16x8 __attribute__((ext_vector_type(8)));
typedef float f32x4 __attribute__((ext_vector_type(4)));
typedef unsigned u32x4 __attribute__((ext_vector_type(4)));
constexpr int BM = 256, BK = 64, HALF = 128, HTB = HALF * BK * 2  , STAGE_BYTES = 8 * HTB, NXCD = 8, WGM = 8;

__host__ __device__ __forceinline__ int lds_byte(int r, int c) { const int st = (r >> 4) * 2 + (c >> 5), rr = r & 15, cc = c & 31, ob = rr * 64 + cc * 2; return st * 1024 + (ob ^ (((ob >> 9) & 1) << 5)); }
__host__ __device__ __forceinline__ void stage_rc(int b, int& R, int& C) { const int st = b / 1024, sb = b % 1024, swz = sb ^ (((sb >> 9) & 1) << 5); R = (st >> 1) * 16 + swz / 64; C = (st & 1) * 32 + (swz % 64) / 2; }
__host__ __device__ __forceinline__ int perm32(int rho) { const int n = rho >> 4, i = rho & 15; return 8 * (i >> 2) + 4 * n + (i & 3); }

struct Unit { int pm, pn; };
struct Gemm { const bf16_t* A; const bf16_t* Bt; int M, N, K; };

struct StaticOrder {
    int nM, nN, nwg, G, c;
    __host__ __device__ void init(int M, int N, int G_, int c_) { nM = M / BM; nN = N / BM; nwg = nM * nN; G = G_; c = c_; }
    __host__ __device__ bool next(int i, Unit& u) const {
        const long L = (long)i * G + c; if (L >= nwg) return false;
        int wgid = (int)L; { const int q = nwg / NXCD, r = nwg % NXCD, xcd = wgid % NXCD, off = wgid / NXCD; wgid = (xcd < r ? xcd * (q + 1) : r * (q + 1) + (xcd - r) * q) + off; }
        const int nig = WGM * nN, gid = wgid / nig, fm = gid * WGM, gsz = (nM - fm) < WGM ? (nM - fm) : WGM;
        u.pm = fm + ((wgid % nig) % gsz); u.pn = (wgid % nig) / gsz; return true;
    }
    __device__ __forceinline__ void a_ready(const Unit&) const {}
    __device__ __forceinline__ void done(const Unit&) const {}
};
__device__ __forceinline__ unsigned cvt_pk_bf16(float lo, float hi) { unsigned r; asm volatile("v_cvt_pk_bf16_f32 %0, %1, %2" : "=v"(r) : "v"(lo), "v"(hi)); return r; }

template <class Epi, class Sched, bool ALIGN_EPI = false, bool SP2 = false>
__device__ __forceinline__ void gemm_phase(PG8_LAS unsigned char* lds, const Gemm g, const Sched& S, const Epi& E) {
    int tid = threadIdx.x; asm volatile("" : "+v"(tid)); const int wid = __builtin_amdgcn_readfirstlane(tid >> 6), lane = tid & 63, wr = wid >> 2, wc = wid & 3, fr = lane & 15, fq = lane >> 4;
    const int K = g.K, nt = K / BK;
    unsigned voffA[2], voffB[2];
#pragma unroll
    for (int i = 0; i < 2; ++i) { int R, C; stage_rc(tid * 16 + i * 8192, R, C); const int Rb = Epi::PERM ? ((R & ~31) + perm32(R & 31)) : R;
        voffA[i] = (unsigned)(R * K + C) * 2u; voffB[i] = (unsigned)(Rb * K + C) * 2u; }
    const size_t kstep = (size_t)(BK * 2);
    const size_t hstep = (size_t)HALF * K * 2;
    const size_t tstep = 2 * hstep;
    const unsigned ldsw = (unsigned)wid * 1024u;
    const int aoff = lds_byte(wr * 64 + fr, fq * 8), boff = lds_byte(wc * 32 + fr, fq * 8);
#define PG8_SA(b, h) (((b) * 2 + (h)) * HTB)
#define PG8_SB(b, h) ((4 + (b) * 2 + (h)) * HTB)
#define PG8_STAGE(bufoff, gbase, voff) do { _Pragma("unroll") for (int _i = 0; _i < 2; ++_i) \
        __builtin_amdgcn_global_load_lds((const unsigned*)((const char*)(gbase) + (voff)[_i]), (PG8_LAS unsigned*)(lds + (bufoff) + ldsw + _i * 8192), 16, 0, 0); } while (0)
#define PG8_LDA(dst, b, h) do { _Pragma("unroll") for (int m = 0; m < 4; ++m) _Pragma("unroll") for (int k = 0; k < 2; ++k) dst[m][k] = *(const PG8_LAS bf16x8*)(lds + PG8_SA(b, h) + aoff + m * 2048 + k * 1024); } while (0)
#define PG8_LDB(dst, b, h) do { _Pragma("unroll") for (int n = 0; n < 2; ++n) _Pragma("unroll") for (int k = 0; k < 2; ++k) dst[n][k] = *(const PG8_LAS bf16x8*)(lds + PG8_SB(b, h) + boff + n * 2048 + k * 1024); } while (0)
#define PG8_MMA(ai, bj, At, Bt) do { __builtin_amdgcn_s_setprio(1); _Pragma("unroll") for (int m = 0; m < 4; ++m) _Pragma("unroll") for (int n = 0; n < 2; ++n) _Pragma("unroll") for (int k = 0; k < 2; ++k) \
        acc[ai][bj][m][n] = __builtin_amdgcn_mfma_f32_16x16x32_bf16(Bt[n][k], At[m][k], acc[ai][bj][m][n], 0, 0, 0); __builtin_amdgcn_s_setprio(0); } while (0)
#define PG8_WAIT_V(n) asm volatile("s_waitcnt vmcnt(" #n ")" ::: "memory")
#define PG8_WAIT_L(n) asm volatile("s_waitcnt lgkmcnt(" #n ")" ::: "memory")
#define PG8_BAR __builtin_amdgcn_s_barrier()
#define PG8_SCHED __builtin_amdgcn_sched_barrier(0)
    Unit cur, nxt; int ui = 0;
    if (!S.next(0, cur)) return;
    f32x4 acc[2][2][4][2];
#pragma unroll
    for (int a = 0; a < 2; ++a)
#pragma unroll
        for (int b = 0; b < 2; ++b)
#pragma unroll
            for (int m = 0; m < 4; ++m)
#pragma unroll
                for (int n = 0; n < 2; ++n) acc[a][b][m][n] = (f32x4){0.f, 0.f, 0.f, 0.f};
    bf16x8 At[4][2], B0[2][2], B1[2][2];
    const char* cA = (const char*)g.A + (size_t)cur.pm * tstep; const char* cB = (const char*)g.Bt + (size_t)cur.pn * tstep;
    S.a_ready(cur);
    if constexpr (SP2) {
        PG8_STAGE(PG8_SB(0, 0), cB, voffB); PG8_STAGE(PG8_SB(0, 1), cB + hstep, voffB); PG8_STAGE(PG8_SA(0, 0), cA, voffA); PG8_STAGE(PG8_SA(0, 1), cA + hstep, voffA);
        if (wr == 1) PG8_BAR;
        PG8_WAIT_V(2); PG8_BAR;
        PG8_STAGE(PG8_SB(1, 0), cB + kstep, voffB); PG8_STAGE(PG8_SA(1, 0), cA + kstep, voffA); PG8_STAGE(PG8_SB(1, 1), cB + hstep + kstep, voffB);
        PG8_WAIT_V(6); PG8_BAR;
    } else {
        PG8_STAGE(PG8_SB(0, 0), cB, voffB); PG8_STAGE(PG8_SA(0, 0), cA, voffA); PG8_STAGE(PG8_SB(0, 1), cB + hstep, voffB); PG8_STAGE(PG8_SA(0, 1), cA + hstep, voffA);
        if (wr == 1) PG8_BAR;
        PG8_WAIT_V(4); PG8_BAR;
        PG8_STAGE(PG8_SB(1, 0), cB + kstep, voffB); PG8_STAGE(PG8_SA(1, 0), cA + kstep, voffA); PG8_STAGE(PG8_SB(1, 1), cB + hstep + kstep, voffB);
        PG8_WAIT_V(6); PG8_BAR;
    }
    for (;;) {
        const bool has_next = S.next(ui + 1, nxt);
        const char* nA = has_next ? (const char*)g.A + (size_t)nxt.pm * tstep : cA; const char* nB = has_next ? (const char*)g.Bt + (size_t)nxt.pn * tstep : cB;
        for (int t = 0; t < nt; t += 2) {
            const bool last = (t == nt - 2);
            const char* a1 = cA + (size_t)(t + 1) * kstep;
            const char* a2 = last ? nA : cA + (size_t)(t + 2) * kstep; const char* b2 = last ? nB : cB + (size_t)(t + 2) * kstep;
            const char* a3 = a2 + kstep; const char* b3 = b2 + kstep;
            if (last && has_next) S.a_ready(nxt);
            if constexpr (SP2) {
            PG8_LDB(B0, 0, 0); PG8_LDB(B1, 0, 1); PG8_SCHED; PG8_LDA(At, 0, 0); PG8_STAGE(PG8_SA(1, 1), a1 + hstep, voffA);
            PG8_WAIT_V(8); PG8_WAIT_L(0); PG8_BAR; PG8_MMA(0, 0, At, B0); PG8_MMA(0, 1, At, B1); PG8_BAR; PG8_SCHED;
            PG8_LDA(At, 0, 1); PG8_STAGE(PG8_SB(0, 0), b2, voffB); PG8_STAGE(PG8_SB(0, 1), b2 + hstep, voffB); PG8_STAGE(PG8_SA(0, 0), a2, voffA);
            PG8_WAIT_V(8); PG8_WAIT_L(0); PG8_BAR; PG8_MMA(1, 0, At, B0); PG8_MMA(1, 1, At, B1); PG8_BAR; PG8_SCHED;
            PG8_LDB(B0, 1, 0); PG8_LDB(B1, 1, 1); PG8_SCHED; PG8_LDA(At, 1, 0); PG8_STAGE(PG8_SA(0, 1), a2 + hstep, voffA);
            PG8_WAIT_V(8); PG8_WAIT_L(0); PG8_BAR; PG8_MMA(0, 0, At, B0); PG8_MMA(0, 1, At, B1); PG8_BAR; PG8_SCHED;
            PG8_LDA(At, 1, 1); PG8_STAGE(PG8_SB(1, 0), b3, voffB); PG8_STAGE(PG8_SB(1, 1), b3 + hstep, voffB); PG8_STAGE(PG8_SA(1, 0), a3, voffA);
            PG8_WAIT_V(8); PG8_WAIT_L(0); PG8_BAR; PG8_MMA(1, 0, At, B0); PG8_MMA(1, 1, At, B1); PG8_BAR; PG8_SCHED;
            } else {
            PG8_LDB(B0, 0, 0); PG8_SCHED; PG8_LDA(At, 0, 0); PG8_STAGE(PG8_SA(1, 1), a1 + hstep, voffA);
            PG8_WAIT_L(8); PG8_BAR; PG8_WAIT_L(0); PG8_MMA(0, 0, At, B0); PG8_BAR; PG8_SCHED;
            PG8_LDB(B1, 0, 1); PG8_STAGE(PG8_SB(0, 0), b2, voffB);
            PG8_BAR; PG8_WAIT_L(0); PG8_MMA(0, 1, At, B1); PG8_BAR;
            PG8_LDA(At, 0, 1); PG8_STAGE(PG8_SA(0, 0), a2, voffA);
            PG8_BAR; PG8_WAIT_L(0); PG8_MMA(1, 0, At, B0); PG8_BAR; PG8_SCHED;
            PG8_STAGE(PG8_SB(0, 1), b2 + hstep, voffB);
            PG8_WAIT_V(6); PG8_BAR; PG8_MMA(1, 1, At, B1); PG8_BAR;
            PG8_LDB(B0, 1, 0); PG8_SCHED; PG8_LDA(At, 1, 0); PG8_STAGE(PG8_SA(0, 1), a2 + hstep, voffA);
            PG8_WAIT_L(8); PG8_BAR; PG8_WAIT_L(0); PG8_MMA(0, 0, At, B0); PG8_BAR; PG8_SCHED;
            PG8_LDB(B1, 1, 1); PG8_STAGE(PG8_SB(1, 0), b3, voffB);
            PG8_BAR; PG8_WAIT_L(0); PG8_MMA(0, 1, At, B1); PG8_BAR;
            PG8_LDA(At, 1, 1); PG8_STAGE(PG8_SA(1, 0), a3, voffA);
            PG8_BAR; PG8_WAIT_L(0); PG8_MMA(1, 0, At, B0); PG8_BAR; PG8_SCHED;
            PG8_STAGE(PG8_SB(1, 1), b3 + hstep, voffB);
            PG8_WAIT_V(6); PG8_BAR; PG8_MMA(1, 1, At, B1); PG8_BAR;
            }
        }
        if constexpr (ALIGN_EPI) { if (wr == 0) PG8_BAR; }
        if constexpr (!Epi::AFTER_DRAIN) { E(acc, cur, wr, wc, fr, fq); S.done(cur); }
        if (!has_next) break;
#pragma unroll
        for (int a = 0; a < 2; ++a)
#pragma unroll
            for (int b = 0; b < 2; ++b)
#pragma unroll
                for (int m = 0; m < 4; ++m)
#pragma unroll
                    for (int n = 0; n < 2; ++n) acc[a][b][m][n] = (f32x4){0.f, 0.f, 0.f, 0.f};
        cur = nxt; cA = nA; cB = nB; ++ui;
        if constexpr (ALIGN_EPI) { if (wr == 1) PG8_BAR; }
    }
    PG8_WAIT_V(0);
    if constexpr (!ALIGN_EPI) { if (wr == 0) PG8_BAR; }
    PG8_BAR;
    if constexpr (Epi::AFTER_DRAIN) { E.fused(acc, cur, wr, wc, fr, fq, lds, wid, lane); S.done(cur); }
#undef PG8_SA
#undef PG8_SB
#undef PG8_STAGE
#undef PG8_LDA
#undef PG8_LDB
#undef PG8_MMA
#undef PG8_WAIT_V
#undef PG8_WAIT_L
#undef PG8_BAR
#undef PG8_SCHED
}
}

#define LAS __attribute__((address_space(3)))
#ifndef DUP_M2MASK
#define DUP_M2MASK 3
#endif
typedef unsigned short bf16_t;
typedef short bf16x8 __attribute__((ext_vector_type(8)));
typedef float f32x4 __attribute__((ext_vector_type(4)));
typedef unsigned u32x4v __attribute__((ext_vector_type(4)));
typedef unsigned u32x2v __attribute__((ext_vector_type(2)));

constexpr int NTOK = 10240, NPT = 8192, DM = 2048, NP = 9216, PIN = 8976;
constexpr int C_Q = 4864, C_K = 5888, C_V = 6912, C_G = 7936, C_IF = 8960;
constexpr int A_WD = 1536, A_AD = 1664, A_GATE = 1792;
constexpr int B_Q = 2304, B_V = 3328, B_O = 3840, B_GATE = 4352;
constexpr int NTHREADS = 512;
constexpr int LDS_SLOT = 131072, LDS_BYTES = 131072 + 1024;

constexpr size_t WS_CTL = 0;
constexpr size_t WS_BAR = 8192;
constexpr size_t WS_MOD = 32768;
constexpr size_t WS_ROPE = WS_MOD + 147456;
constexpr size_t WS_LAM = WS_ROPE + 8192;
constexpr size_t WS_WIN = WS_LAM + 256;
constexpr size_t WS_WOUT = WS_WIN + 2ull * NP * DM * 2;
constexpr size_t WS_UM = WS_WOUT + 2ull * DM * DM * 2;
constexpr size_t WS_PROJ = WS_UM + (size_t)NTOK * DM * 2;
constexpr size_t WS_GATES = WS_PROJ + (size_t)NTOK * NP * 2;
constexpr size_t SZ16 = (size_t)NTOK * 512 * 2, SZ32 = (size_t)NTOK * 512 * 4;
constexpr size_t WS_SCV = WS_GATES + (size_t)NTOK * 16 * 4;
constexpr size_t WS_SCBON = WS_SCV + SZ16;
constexpr size_t WS_PK = WS_SCBON + SZ16;
constexpr size_t SZPK = (size_t)NTOK * 8 * 320 * 2;
constexpr size_t WS_YD = WS_PK + 2 * SZPK;
constexpr size_t WS_HD = WS_YD + 2 * SZ32;
constexpr size_t WS_KC = WS_HD + 2 * SZ32;
constexpr size_t WS_VTC = WS_KC + 4194304;
constexpr size_t WS_WUPT = WS_VTC + 4194304;
constexpr size_t WS_END = WS_WUPT + 524288;

constexpr size_t O_Y = 0, O_NK = 20971520, O_NV = 37748736, O_RW = 54525952, O_MC = 58720256, O_MN = 67108864, O_MM = 67174400;

struct Params { const float* in[38]; float* out; unsigned char* ws; };
enum { I_XP = 0, I_XS, I_CK, I_CV, I_SRW, I_SMC, I_SMN, I_SMM, I_C, I_CCTX, I_WADA, I_BADA, I_WIN, I_CAW, I_CAB, I_W0, I_WUP, I_A0, I_AUP, I_KK, I_KA, I_RK,
       I_RGG, I_RGB, I_CBW, I_CBB, I_BI, I_BF, I_MGG, I_MGB, I_LQ1, I_LK1, I_LQ2, I_LK2, I_SUBG, I_WOUT, I_LNG, I_LNB };

__device__ __forceinline__ float bf2f(bf16_t v) { return __uint_as_float(((unsigned)v) << 16); }
__device__ __forceinline__ float bflo(unsigned w) { return __uint_as_float(w << 16); }
__device__ __forceinline__ float bfhi(unsigned w) { return __uint_as_float(w & 0xffff0000u); }
__device__ __forceinline__ unsigned pk2(float lo, float hi) { return pg8::cvt_pk_bf16(lo, hi); }
__device__ __forceinline__ bf16_t f2bf(float f) { return (bf16_t)(pk2(f, 0.f) & 0xffffu); }
__device__ __forceinline__ void unpack8(const u32x4v w, float (&o)[8]) { o[0] = bflo(w.x); o[1] = bfhi(w.x); o[2] = bflo(w.y); o[3] = bfhi(w.y); o[4] = bflo(w.z); o[5] = bfhi(w.z); o[6] = bflo(w.w); o[7] = bfhi(w.w); }
__device__ __forceinline__ u32x4v pack8(const float (&o)[8]) { u32x4v w; w.x = pk2(o[0], o[1]); w.y = pk2(o[2], o[3]); w.z = pk2(o[4], o[5]); w.w = pk2(o[6], o[7]); return w; }
__device__ __forceinline__ void ld8f(const float* p, float (&o)[8]) { const float4 a = *(const float4*)p, b = *(const float4*)(p + 4); o[0] = a.x; o[1] = a.y; o[2] = a.z; o[3] = a.w; o[4] = b.x; o[5] = b.y; o[6] = b.z; o[7] = b.w; }
__device__ __forceinline__ float sigmoidf_(float x) { return __builtin_amdgcn_rcpf(1.0f + __expf(-x)); }
__device__ __forceinline__ float siluf_(float x) { return x * __builtin_amdgcn_rcpf(1.0f + __expf(-x)); }
__device__ __forceinline__ float tanhf_(float x) { return 1.0f - 2.0f * __builtin_amdgcn_rcpf(1.0f + __expf(2.0f * x)); }
__device__ __forceinline__ bf16x8 frag(const LAS bf16_t* base, int row0, int ld, int k0, int lane) { return *(const LAS bf16x8*)(base + (row0 + (lane & 15)) * ld + k0 + (lane >> 4) * 8); }
__device__ __forceinline__ bf16x8 fragsw(const LAS bf16_t* base, int row0, int k0, int lane) { const int r = row0 + (lane & 15), m = (k0 >> 3) + (lane >> 4); return *(const LAS bf16x8*)(base + r * 72 + 8 * (m ^ ((r >> 3) & 7))); }
#define MFMA16(a, b, c) __builtin_amdgcn_mfma_f32_16x16x32_bf16((a), (b), (c), 0, 0, 0)
#define LDS_FENCE() asm volatile("s_waitcnt lgkmcnt(0)" ::: "memory")
template <int CTRL> __device__ __forceinline__ float dppf(float x) { return __builtin_bit_cast(float, __builtin_amdgcn_mov_dpp(__builtin_bit_cast(int, x), CTRL, 0xf, 0xf, true)); }
__device__ __forceinline__ float red16_sum(float x) { x += dppf<0xB1>(x); x += dppf<0x4E>(x); x += dppf<0x124>(x); x += dppf<0x128>(x); return x; }
__device__ __forceinline__ float red4_sum(float x) { x += dppf<0xB1>(x); x += dppf<0x4E>(x); return x; }
__device__ __forceinline__ float red16_max(float x) { x = fmaxf(x, dppf<0xB1>(x)); x = fmaxf(x, dppf<0x4E>(x)); x = fmaxf(x, dppf<0x124>(x)); x = fmaxf(x, dppf<0x128>(x)); return x; }

__device__ __forceinline__ int opaque_tid() { int t = threadIdx.x; asm volatile("" : "+v"(t)); return t; }
__device__ __forceinline__ int next_task(unsigned* ctr, LAS int* slot) {
    __syncthreads();
    if (threadIdx.x == 0) *slot = (int)atomicAdd(ctr, 1u);
    __syncthreads();
    return *slot;
}
#define QNEXT_BEGIN(ctr) unsigned qn_ = 0u; if (threadIdx.x == 0) qn_ = atomicAdd((ctr), 1u)
#define QNEXT_END(slot, t) do { __syncthreads(); if (threadIdx.x == 0) *(slot) = (int)qn_; __syncthreads(); (t) = *(slot); } while (0)
__device__ __forceinline__ int win_src_col(int n) { return n < 4352 ? n : (n < 8960 ? n + 16 : (n < 8976 ? n - 8960 + 4352 : -1)); }
__device__ __forceinline__ int mod_row(int tok) { return tok < NPT ? 0 : 1 + ((tok - NPT) >> 10); }

__device__ __forceinline__ void p0_mod_item(const Params& p, int item, LAS unsigned char* lds) {
    const int tid = opaque_tid(), lane = tid & 63, wave = tid >> 6, kq = lane >> 4, cq = lane & 15;
    const int l = item / 96, cb = item % 96;
    LAS float* sS = (LAS float*)lds;
    LAS float* sRed = sS + 3 * 2048;
    for (int e = tid; e < 3 * 2048; e += NTHREADS) { const int r = e >> 11, k = e & 2047; const float cv = r == 0 ? p.in[I_CCTX][k] : p.in[I_C][(r - 1) * 2048 + k]; sS[e] = siluf_(cv); }
    __syncthreads();
    const float* W = p.in[I_WADA] + (size_t)l * 2048 * 6144 + cb * 64 + 4 * cq;
    float4 a0 = {0, 0, 0, 0}, a1 = a0, a2 = a0;
#pragma unroll 16
    for (int i = 0; i < 64; ++i) { const int k = wave * 256 + i * 4 + kq; const float4 w = *(const float4*)(W + (size_t)k * 6144);
        const float s0 = sS[k], s1 = sS[2048 + k], s2 = sS[4096 + k];
        a0.x += s0 * w.x; a0.y += s0 * w.y; a0.z += s0 * w.z; a0.w += s0 * w.w;
        a1.x += s1 * w.x; a1.y += s1 * w.y; a1.z += s1 * w.z; a1.w += s1 * w.w;
        a2.x += s2 * w.x; a2.y += s2 * w.y; a2.z += s2 * w.z; a2.w += s2 * w.w; }
    float v[12] = {a0.x, a0.y, a0.z, a0.w, a1.x, a1.y, a1.z, a1.w, a2.x, a2.y, a2.z, a2.w};
#pragma unroll
    for (int i = 0; i < 12; ++i) { v[i] += __shfl_xor(v[i], 16); v[i] += __shfl_xor(v[i], 32); }
    if (kq == 0) {
#pragma unroll
        for (int r = 0; r < 3; ++r)
#pragma unroll
            for (int e = 0; e < 4; ++e) sRed[(wave * 3 + r) * 64 + 4 * cq + e] = v[r * 4 + e];
    }
    __syncthreads();
    if (tid < 192) { const int r = tid >> 6, c = tid & 63; float s = 0.f;
#pragma unroll
        for (int w = 0; w < 8; ++w) s += sRed[(w * 3 + r) * 64 + c];
        ((float*)(p.ws + WS_MOD))[(l * 3 + r) * 6144 + cb * 64 + c] = s + p.in[I_BADA][l * 6144 + cb * 64 + c]; }
}
template <bool MAPCOL> __device__ __forceinline__ void p0_transpose_item(const float* W, int N, int nblk, bf16_t* WT, LAS float* scr, int item, int lane) {
    const int kb = item / nblk, nb = item % nblk, k0 = 64 * kb, n0 = 32 * nb;
    const int n = n0 + (lane & 31); const int oc = MAPCOL ? win_src_col(n) : n;
    float tv[32];
    const float* wp = W + (size_t)(k0 + (lane >> 5)) * N + (oc >= 0 ? oc : 0);
#pragma unroll
    for (int i = 0; i < 32; ++i) tv[i] = wp[(size_t)(2 * i) * N];
#pragma unroll
    for (int i = 0; i < 32; ++i) scr[(2 * i + (lane >> 5)) * 33 + (lane & 31)] = oc >= 0 ? tv[i] : 0.f;
    LDS_FENCE();
    const int c = lane & 7;
#pragma unroll
    for (int j = 0; j < 4; ++j) { const int nn = (lane >> 3) + 8 * j; const LAS float* s = scr + (8 * c) * 33 + nn;
        u32x4v o; o.x = pk2(s[0 * 33], s[1 * 33]); o.y = pk2(s[2 * 33], s[3 * 33]); o.z = pk2(s[4 * 33], s[5 * 33]); o.w = pk2(s[6 * 33], s[7 * 33]);
        *(u32x4v*)(WT + (size_t)(n0 + nn) * 2048 + k0 + 8 * c) = o; }
    LDS_FENCE();
}
__device__ __forceinline__ void p0_phase(const Params& p, LAS unsigned char* lds, int rep) {
    const int tid = opaque_tid(), lane = tid & 63, wave = tid >> 6;
    unsigned* ctr = (unsigned*)(p.ws + WS_CTL) + 64 * 15 * rep;
    LAS int* slot = (LAS int*)(lds + LDS_SLOT);
    constexpr int NT_MOD = 96  , NT_TR = 1408  , NT_A = NT_MOD + 1 + NT_TR, NT_KC = 512, NT_VT = 512, NT_WU = 64, NT = NT_A + NT_KC + NT_VT + NT_WU;
    for (;;) {
        const int t = next_task(ctr, slot);
        if (t >= NT) break;
        if (t < NT_MOD) { p0_mod_item(p, t, lds); continue; }
        if (t == NT_MOD) {
            float* rope = (float*)(p.ws + WS_ROPE);
            for (int e = tid; e < 1024; e += NTHREADS) { const int pos = e >> 4, i = e & 15; const float inv = 1.0f / powf(10000.0f, (float)(2 * i) / 32.0f); const float ang = (float)pos * inv;
                rope[pos * 32 + i] = cosf(ang); rope[pos * 32 + 16 + i] = sinf(ang); }
            if (tid < 2) { const int l = tid; float d1 = 0.f, d2 = 0.f;
                for (int i = 0; i < 64; ++i) { d1 += p.in[I_LQ1][l * 64 + i] * p.in[I_LK1][l * 64 + i]; d2 += p.in[I_LQ2][l * 64 + i] * p.in[I_LK2][l * 64 + i]; }
                const float lam_init = 0.8f - 0.6f * expf(-0.3f * (float)l);
                ((float*)(p.ws + WS_LAM))[l] = expf(d1) - expf(d2) + lam_init; }
            continue;
        }
        if (t >= NT_A) {
            int u = t - NT_A;
            if (u < NT_KC) { const size_t o = ((size_t)u * 512 + tid) * 8; float x[8]; ld8f(p.in[I_CK] + o, x); *(u32x4v*)((bf16_t*)(p.ws + WS_KC) + o) = pack8(x); continue; }
            u -= NT_KC;
            if (u < NT_VT) { const int idx = u * 512 + tid, dv = idx & 127, m = (idx >> 7) & 63, bh = idx >> 13; float x[8];
#pragma unroll
                for (int e = 0; e < 8; ++e) x[e] = p.in[I_CV][((size_t)bh * 512 + 8 * m + e) * 128 + dv];
                *(u32x4v*)((bf16_t*)(p.ws + WS_VTC) + ((size_t)bh * 128 + dv) * 512 + 8 * m) = pack8(x); continue; }
            u -= NT_VT;
#pragma unroll
            for (int e = 0; e < 8; ++e) { const int f = u * 4096 + e * 512 + tid, c = f & 63, j = (f >> 6) & 63, h = (f >> 12) & 7, which = (f >> 15) & 1, ld = f >> 16;
                const float v = (which ? p.in[I_AUP] : p.in[I_WUP])[((size_t)ld * 64 + j) * 512 + h * 64 + c];
                ((bf16_t*)(p.ws + WS_WUPT))[(f & ~4095) + c * 64 + j] = f2bf(v); }
            continue;
        }
        int it = (t - NT_MOD - 1) * 8 + wave;
        LAS float* scr = (LAS float*)(lds + wave * 8704);
        const int l = it / 11264; it -= l * 11264;
        if (it < 9216) p0_transpose_item<true>(p.in[I_WIN] + (size_t)l * 2048 * PIN, PIN, 288, (bf16_t*)(p.ws + WS_WIN) + (size_t)l * NP * 2048, scr, it, lane);
        else p0_transpose_item<false>(p.in[I_WOUT] + (size_t)l * 2048 * 2048, 2048, 64, (bf16_t*)(p.ws + WS_WOUT) + (size_t)l * 2048 * 2048, scr, it - 9216, lane);
    }
}
__device__ __forceinline__ void mod_tail_phase(const Params& p, LAS unsigned char* lds) {
    unsigned* ctr = (unsigned*)(p.ws + WS_CTL) + 64 * 13;
    LAS int* slot = (LAS int*)(lds + LDS_SLOT);
    for (;;) { const int t = next_task(ctr, slot); if (t >= 96) break; p0_mod_item(p, 96 + t, lds); }
}
__device__ __forceinline__ void tr_tail_phase(const Params& p, LAS unsigned char* lds) {
    const int tid = opaque_tid(), lane = tid & 63, wave = tid >> 6;
    unsigned* ctr = (unsigned*)(p.ws + WS_CTL) + 64 * 12;
    LAS int* slot = (LAS int*)(lds + LDS_SLOT);
    for (;;) {
        const int t = next_task(ctr, slot);
        if (t >= 1408) break;
        int it = t * 8 + wave;
        LAS float* scr = (LAS float*)(lds + wave * 8704);
        if (it < 9216) p0_transpose_item<true>(p.in[I_WIN] + (size_t)2048 * PIN, PIN, 288, (bf16_t*)(p.ws + WS_WIN) + (size_t)NP * 2048, scr, it, lane);
        else p0_transpose_item<false>(p.in[I_WOUT] + (size_t)2048 * 2048, 2048, 64, (bf16_t*)(p.ws + WS_WOUT) + (size_t)2048 * 2048, scr, it - 9216, lane);
    }
}
__device__ __forceinline__ void modulate_row(const float* xrow, const float* mod, bf16_t* urow, int lane) {
#pragma unroll
    for (int j = 0; j < 4; ++j) { const int c = j * 512 + lane * 8; float x[8], sh[8], sc[8], o[8]; ld8f(xrow + c, x); ld8f(mod + c, sh); ld8f(mod + 2048 + c, sc);
#pragma unroll
        for (int e = 0; e < 8; ++e) o[e] = x[e] * (1.0f + sc[e]) + sh[e];
        *(u32x4v*)(urow + c) = pack8(o); }
}
__device__ __forceinline__ void p0b_phase(const Params& p) {
    const int tid_ = opaque_tid(); const int lane = tid_ & 63, gw = blockIdx.x * 8 + (tid_ >> 6), NGW = gridDim.x * 8;
    for (int tok = gw; tok < NTOK; tok += NGW) {
        const float* xrow = tok < NPT ? p.in[I_XP] + (size_t)tok * DM : p.in[I_XS] + (size_t)(tok - NPT) * DM;
        modulate_row(xrow, (const float*)(p.ws + WS_MOD) + mod_row(tok) * 6144, (bf16_t*)(p.ws + WS_UM) + (size_t)tok * DM, lane);
    }
}

struct EpiIn {
    static constexpr bool PERM = true, AFTER_DRAIN = false;
    bf16_t* proj; float* gates; float* newk; float* newv; const float* rope; int layer;
    __device__ __forceinline__ void operator()(const f32x4 (&acc)[2][2][4][2], const pg8::Unit& u, int wr, int wc, int fr, int fq) const {
        const int row0 = u.pm * 256 + wr * 64 + fr, col0 = u.pn * 256 + wc * 32 + 8 * fq;
        const bool samp = u.pm >= 32;
        const bool is_rope = samp && u.pn >= 19 && u.pn < 27;
        const bool is_k = !samp && u.pn >= 23 && u.pn < 27, is_v = !samp && u.pn >= 27 && u.pn < 31, is_g = u.pn == 35;
#pragma unroll
        for (int ai = 0; ai < 2; ++ai)
#pragma unroll
            for (int m = 0; m < 4; ++m) {
                const int row = row0 + ai * 128 + m * 16;
                float cs[8], sn[8];
                if (is_rope) { const int pos = (row - NPT) & 1023; const int pp = (wc & 1) ? (pos & 63) : (pos >> 6); const float* rp = rope + pp * 32 + 8 * (fq & 1); ld8f(rp, cs); ld8f(rp + 16, sn); }
#pragma unroll
                for (int bj = 0; bj < 2; ++bj) {
                    f32x4 v0 = acc[ai][bj][m][0], v1 = acc[ai][bj][m][1];
                    if (is_rope) {
                        const float sg = (fq & 2) ? 1.0f : -1.0f;
#pragma unroll
                        for (int e = 0; e < 4; ++e) { const float p0 = __shfl_xor(v0[e], 32), p1 = __shfl_xor(v1[e], 32);
                            v0[e] = v0[e] * cs[e] + sg * p0 * sn[e]; v1[e] = v1[e] * cs[4 + e] + sg * p1 * sn[4 + e]; }
                    }
                    const int col = col0 + bj * 128;
                    u32x4v w; w.x = pk2(v0[0], v0[1]); w.y = pk2(v0[2], v0[3]); w.z = pk2(v1[0], v1[1]); w.w = pk2(v1[2], v1[3]);
                    *(u32x4v*)(proj + (size_t)row * NP + col) = w;
                    if (is_k || is_v) { const int ck = col - (is_k ? C_K : C_V), h = ck >> 7, j = ck & 127, b = row >> 8, t = row & 255;
                        float* dst = (is_k ? newk : newv) + ((((size_t)(b * 2 + layer) * 8 + h) * 256 + t) * 128 + j);
                        *(f32x4*)dst = v0; *(f32x4*)(dst + 4) = v1; }
                    if (is_g && bj == 0 && wc == 0 && fq < 2) { float* dst = gates + (size_t)row * 16 + 8 * fq; *(f32x4*)dst = v0; *(f32x4*)(dst + 4) = v1; }
                }
            }
    }
};
struct EpiOut {
    static constexpr bool PERM = false, AFTER_DRAIN = false;
    const float* xp; const float* xs; const float* mod; float* y; int layer;
    __device__ __forceinline__ void operator()(const f32x4 (&acc)[2][2][4][2], const pg8::Unit& u, int wr, int wc, int fr, int fq) const {
        const int row0 = u.pm * 256 + wr * 64 + fr, col0 = u.pn * 256 + wc * 32 + 4 * fq;
#pragma unroll
        for (int ai = 0; ai < 2; ++ai)
#pragma unroll
            for (int m = 0; m < 4; ++m) {
                const int row = row0 + ai * 128 + m * 16;
                const float* xrow = layer == 0 ? (row < NPT ? xp + (size_t)row * DM : xs + (size_t)(row - NPT) * DM) : y + (size_t)row * DM;
                const float* g = mod + mod_row(row) * 6144 + 4096;
#pragma unroll
                for (int bj = 0; bj < 2; ++bj)
#pragma unroll
                    for (int n = 0; n < 2; ++n) { const int c = col0 + bj * 128 + n * 16;
                        const f32x4 xv = *(const f32x4*)(xrow + c), gv = *(const f32x4*)(g + c);
                        *(f32x4*)(y + (size_t)row * DM + c) = 1.41421356237f * xv + gv * acc[ai][bj][m][n]; }
            }
    }
};

#define XB_TMO      128
#define XB_XCNT(j)  (256  + 64 * (j))
#define XB_XSUB(j)  (1280 + 64 * (j))
#define XB_XGEN(j)  (2304 + 64 * (j))
#define XB_TOP      3328
#define XB_TOPGEN   3392
#define XCD_BAR_WORDS 3456
#define XB_SPIN_CAP (1u << 18)

__device__ __forceinline__ unsigned xb_ld(unsigned* p)              { return __hip_atomic_load(p, __ATOMIC_RELAXED, __HIP_MEMORY_SCOPE_AGENT); }
__device__ __forceinline__ unsigned xb_add(unsigned* p, unsigned v) { return __hip_atomic_fetch_add(p, v, __ATOMIC_RELAXED, __HIP_MEMORY_SCOPE_AGENT); }
__device__ __forceinline__ unsigned xb_xcc_id() { return (unsigned)__builtin_amdgcn_s_getreg((3 << 11) | 20) & 0xFu; }
#define XB_SPIN(cond, bar) do { unsigned _sp = 0; while (cond) { __builtin_amdgcn_s_sleep(1); \
    if ((++_sp & 255u) == 0u) { if (xb_ld(&(bar)[XB_TMO])) break; if (_sp > XB_SPIN_CAP) { atomicAdd(&(bar)[XB_TMO], 1u); break; } } } } while (0)

struct XcdBarrier {
    unsigned* bar; unsigned x;
    volatile LAS unsigned* st;
};

__device__ __forceinline__ XcdBarrier xcd_barrier_post(unsigned* bar, volatile LAS unsigned* st) {
    XcdBarrier b; b.bar = bar; b.x = xb_xcc_id(); b.st = st;
    if (threadIdx.x == 0) (void)xb_add(&bar[XB_XCNT(b.x)], 1u);
    return b;
}
__device__ __forceinline__ void xcd_barrier_complete(unsigned* bar, unsigned x, unsigned& nloc, unsigned& nx) {
    const unsigned G = gridDim.x * gridDim.y * gridDim.z;
    unsigned sum, cnt, mine, sp = 0u;
    for (;;) {
        sum = 0u; cnt = 0u; mine = 0u;
#pragma unroll
        for (unsigned j = 0; j < 16; ++j) { const unsigned c = xb_ld(&bar[XB_XCNT(j)]); sum += c; cnt += (c > 0u) ? 1u : 0u; mine = (j == x) ? c : mine; }
        if (sum == G) break;
        __builtin_amdgcn_s_sleep(1);
        if ((++sp & 255u) == 0u) { if (xb_ld(&bar[XB_TMO])) break; if (sp > XB_SPIN_CAP) { atomicAdd(&bar[XB_TMO], 1u); break; } }
    }
    nloc = mine > 0u ? mine : 1u; nx = cnt > 0u ? cnt : 1u;
}

__device__ __forceinline__ unsigned xb_xcc_id_v() { unsigned r; asm volatile("s_getreg_b32 %0, hwreg(20, 0, 4)" : "=s"(r)); return r & 0xFu; }
__device__ __forceinline__ void xcd_barrier(const XcdBarrier& b) {
    asm volatile("s_waitcnt vmcnt(0)" ::: "memory");
    __syncthreads();
    if (threadIdx.x == 0) {
        unsigned* bar = b.bar; const unsigned bx = xb_xcc_id_v();
        __builtin_amdgcn_s_waitcnt(0);
        unsigned nloc = b.st[0], nx = b.st[1];
        if (nloc == 0u) { xcd_barrier_complete(bar, bx, nloc, nx); b.st[0] = nloc; b.st[1] = nx; }
        const unsigned old = xb_add(&bar[XB_XSUB(bx)], 1u);
        const unsigned gen = old / nloc;
        if (old + 1u == (gen + 1u) * nloc) {
            __builtin_amdgcn_fence(__ATOMIC_RELEASE, "agent");
            asm volatile("s_waitcnt vmcnt(0)" ::: "memory");
            const unsigned og = xb_add(&bar[XB_TOP], 1u);
            const unsigned tg = og / nx;
            if (og + 1u == (tg + 1u) * nx) xb_add(&bar[XB_TOPGEN], 1u);
            else XB_SPIN(xb_ld(&bar[XB_TOPGEN]) == tg, bar);
            __builtin_amdgcn_fence(__ATOMIC_ACQUIRE, "agent");
            xb_add(&bar[XB_XGEN(bx)], 1u);
            asm volatile("s_waitcnt vmcnt(0)" ::: "memory");
        } else {
            XB_SPIN(xb_ld(&bar[XB_XGEN(bx)]) == gen, bar);
            __builtin_amdgcn_fence(__ATOMIC_ACQUIRE, "agent");
            asm volatile("s_waitcnt vmcnt(0)" ::: "memory");
        }
    }
    __syncthreads();
}


__device__ __forceinline__ void mlstm_task(const Params& p, int l, int s, int d, int h, LAS unsigned char* lds) {
    const int tid = opaque_tid(), lane = tid & 63, wave = tid >> 6, quad = lane >> 4, l15 = lane & 15;
    const int T = s < 32 ? 256 : 1024, tok0 = s < 32 ? s * 256 : NPT + (s - 32) * 1024, nch = T / 64;
    LAS bf16_t* sQ = (LAS bf16_t*)lds;
    LAS bf16_t* sK = sQ + 64 * 136;
    LAS bf16_t* sKt = sK + 64 * 136;
    LAS bf16_t* sVt = sKt + 128 * 72;
    LAS bf16_t* sP = sVt + 128 * 72;
    LAS bf16_t* sC = sP + 64 * 72;
    LAS float* sf = (LAS float*)(sC + 128 * 136);
    LAS float *sA = sf, *sB = sf + 64, *sPm = sf + 128, *sN = sf + 192, *sNq = sf + 320, *sPs = sf + 384;
    const bf16_t* proj = (const bf16_t*)(p.ws + WS_PROJ);
    const float* gates = (const float*)(p.ws + WS_GATES);
    float* hd = (float*)(p.ws + WS_HD) + (size_t)d * NTOK * 512;
    const float bi = p.in[I_BI][l * 8 + d * 4 + h], bfb = p.in[I_BF][l * 8 + d * 4 + h];
    f32x4 cacc[8];
    float m;
    float cw0[8], cw1[8], cw2[8], cbb[8];
    { const int g = tid & 31, ch = ((g >> 4) ? 512 : 0) + h * 128 + (g & 15) * 8; const float* cw = p.in[I_CBW] + (size_t)l * 3 * 1024 + ch;
        ld8f(cw, cw0); ld8f(cw + 1024, cw1); ld8f(cw + 2048, cw2); ld8f(p.in[I_CBB] + l * 1024 + ch, cbb); }
    __syncthreads();
    if (s >= 32) {
        const size_t sb = (((size_t)((s - 32) * 2 + l) * 2 + d) * 4 + h);
        const float* C0 = p.in[I_SMC] + sb * 128 * 128;
#pragma unroll
        for (int tn = 0; tn < 8; ++tn)
#pragma unroll
            for (int j = 0; j < 4; ++j) cacc[tn][j] = C0[(16 * wave + quad * 4 + j) * 128 + 16 * tn + l15];
        if (tid < 128) sN[tid] = p.in[I_SMN][sb * 128 + tid];
        m = p.in[I_SMM][sb];
    } else {
#pragma unroll
        for (int tn = 0; tn < 8; ++tn) cacc[tn] = (f32x4){0.f, 0.f, 0.f, 0.f};
        if (tid < 128) sN[tid] = 0.f;
        m = 0.f;
    }
#pragma unroll
    for (int tn = 0; tn < 8; ++tn)
#pragma unroll
        for (int j = 0; j < 4; ++j) sC[(16 * wave + quad * 4 + j) * 136 + 16 * tn + l15] = f2bf(cacc[tn][j]);

    u32x4v px1[4], pvv[2];
#define ML_PREFETCH(CC) do { _Pragma("unroll") for (int it = 0; it < 4; ++it) { const int idx = tid + 512 * it, i = idx >> 5, g = idx & 31, ch = ((g >> 4) ? 512 : 0) + h * 128 + (g & 15) * 8; \
            const int ii = 64 * (CC) + i, pos = d == 0 ? ii : T - 1 - ii; px1[it] = *(const u32x4v*)(proj + (size_t)(tok0 + pos) * NP + B_Q + ch); } \
        _Pragma("unroll") for (int it = 0; it < 2; ++it) { const int idx = tid + 512 * it, i = idx >> 4, g = idx & 15; const int ii = 64 * (CC) + i, tk = d == 0 ? tok0 + ii : tok0 + T - 1 - ii; \
            pvv[it] = *(const u32x4v*)(proj + (size_t)tk * NP + B_V + h * 128 + 8 * g); } } while (0)
    ML_PREFETCH(0);
    float gi_n = 0.f, gf_n = 0.f;
    if (wave == 0) { const int tk = d == 0 ? tok0 + lane : tok0 + T - 1 - lane; gi_n = gates[(size_t)tk * 16 + d * 4 + h]; gf_n = gates[(size_t)tk * 16 + 8 + d * 4 + h]; }
    for (int c = 0; c < nch; ++c) {
        __syncthreads();
        if (wave == 0) {
            const float gi = gi_n + bi, gf = gf_n + bfb;
            if (c + 1 < nch) { const int ii = 64 * (c + 1) + lane; const int tk = d == 0 ? tok0 + ii : tok0 + T - 1 - ii; gi_n = gates[(size_t)tk * 16 + d * 4 + h]; gf_n = gates[(size_t)tk * 16 + 8 + d * 4 + h]; }
            const float lf = fminf(gf, 0.f) - log1pf(__expf(-fabsf(gf)));
            float b = lf;
#pragma unroll
            for (int off = 1; off < 64; off <<= 1) { const float t = __shfl_up(b, off); if (lane >= off) b += t; }
            const float a = gi - b; float pm = a;
#pragma unroll
            for (int off = 1; off < 64; off <<= 1) { const float t = __shfl_up(pm, off); if (lane >= off) pm = fmaxf(pm, t); }
            sB[lane] = b; sA[lane] = a; sPm[lane] = pm;
        }
        __syncthreads();
        const float mx = fmaxf(m, sPm[63]), bL = sB[63];
#pragma unroll
        for (int it = 0; it < 4; ++it) {
            const int idx = tid + 512 * it, i = idx >> 5, g = idx & 31, isK = g >> 4, j0 = (g & 15) * 8, ch = (isK ? 512 : 0) + h * 128 + j0;
            const int ii = 64 * c + i, pos = d == 0 ? ii : T - 1 - ii, tk = tok0 + pos;
            const bf16_t* src = proj + (size_t)tk * NP + B_Q + ch;
            float x0[8], x1[8], x2[8], y[8];
            unpack8(px1[it], x1);
            unpack8(*(const u32x4v*)(pos > 0 ? src - NP : src), x0); unpack8(*(const u32x4v*)(pos < T - 1 ? src + NP : src), x2);
            const float m0 = pos > 0 ? 1.f : 0.f, m2 = pos < T - 1 ? 1.f : 0.f;
#pragma unroll
            for (int e = 0; e < 8; ++e) y[e] = siluf_(m0 * x0[e] * cw0[e] + x1[e] * cw1[e] + m2 * x2[e] * cw2[e] + cbb[e]);
            if (!isK) { *(LAS u32x4v*)(sQ + i * 136 + j0) = pack8(y); }
            else {
                const float wgi = __expf(sA[i] - mx);
#pragma unroll
                for (int e = 0; e < 8; ++e) y[e] *= 0.08838834764831845f;
                *(LAS u32x4v*)(sK + i * 136 + j0) = pack8(y);
#pragma unroll
                for (int e = 0; e < 8; ++e) sKt[(j0 + e) * 72 + (i ^ (8 * ((j0 >> 3) & 7)))] = f2bf(y[e] * wgi);
            }
        }
#pragma unroll
        for (int it = 0; it < 2; ++it) {
            const int idx = tid + 512 * it, i = idx >> 4, g = idx & 15;
            const int ii = 64 * c + i, tk = d == 0 ? tok0 + ii : tok0 + T - 1 - ii;
            const u32x4v w = pvv[it];
            LAS bf16_t* dst = sVt + (8 * g) * 72 + (i ^ (8 * (g & 7)));
            dst[0] = (bf16_t)(w.x & 0xffff); dst[72] = (bf16_t)(w.x >> 16); dst[144] = (bf16_t)(w.y & 0xffff); dst[216] = (bf16_t)(w.y >> 16);
            dst[288] = (bf16_t)(w.z & 0xffff); dst[360] = (bf16_t)(w.z >> 16); dst[432] = (bf16_t)(w.w & 0xffff); dst[504] = (bf16_t)(w.w >> 16);
        }
        if (c + 1 < nch) ML_PREFETCH(c + 1);
        __syncthreads();
        const int tm = wave >> 1;
        {
            const int tn0 = (wave & 1) * 2;
#pragma unroll
            for (int tt = 0; tt < 2; ++tt) {
                f32x4 acc = {0.f, 0.f, 0.f, 0.f};
#pragma unroll
                for (int ks = 0; ks < 4; ++ks) acc = MFMA16(frag(sQ, 16 * tm, 136, 32 * ks, lane), frag(sK, 16 * (tn0 + tt), 136, 32 * ks, lane), acc);
                const int scol = 16 * (tn0 + tt) + l15; const float as = sA[scol];
#pragma unroll
                for (int j = 0; j < 4; ++j) { const int t = 16 * tm + quad * 4 + j;
                    float pv = scol <= t ? __expf(as - fmaxf(m, sPm[t])) * acc[j] : 0.f;
                    sP[t * 72 + scol] = f2bf(pv);
                    pv = red16_sum(pv);
                    if (l15 == 0) sPs[t * 4 + tn0 + tt] = pv; }
            }
        }
        const int tnb = (wave & 1) * 4;
        f32x4 accq[4];
#pragma unroll
        for (int tt = 0; tt < 4; ++tt) { accq[tt] = (f32x4){0.f, 0.f, 0.f, 0.f};
#pragma unroll
            for (int ks = 0; ks < 4; ++ks) accq[tt] = MFMA16(frag(sQ, 16 * tm, 136, 32 * ks, lane), frag(sC, 16 * (tnb + tt), 136, 32 * ks, lane), accq[tt]); }
        { const int t = tid >> 3, part = tid & 7; float sacc = 0.f;
#pragma unroll
            for (int e = 0; e < 16; ++e) sacc += sN[16 * part + e] * bf2f(sQ[t * 136 + 16 * part + e]);
            sacc += __shfl_xor(sacc, 1); sacc += __shfl_xor(sacc, 2); sacc += __shfl_xor(sacc, 4);
            if (part == 0) sNq[t] = sacc; }
        __syncthreads();
        {
            f32x4 accp[4];
#pragma unroll
            for (int tt = 0; tt < 4; ++tt) { accp[tt] = (f32x4){0.f, 0.f, 0.f, 0.f};
#pragma unroll
                for (int ks = 0; ks < 2; ++ks) accp[tt] = MFMA16(frag(sP, 16 * tm, 72, 32 * ks, lane), fragsw(sVt, 16 * (tnb + tt), 32 * ks, lane), accp[tt]); }
#pragma unroll
            for (int j = 0; j < 4; ++j) { const int t = 16 * tm + quad * 4 + j;
                const float mtm = fmaxf(m, sPm[t]), wi = __expf(m - mtm);
                const float den = wi * sNq[t] + ((sPs[t * 4] + sPs[t * 4 + 1]) + (sPs[t * 4 + 2] + sPs[t * 4 + 3]));
                const float mt = sB[t] + mtm; const float inv = 1.0f / fmaxf(fabsf(den), __expf(-mt));
                const int ii = 64 * c + t, tk = d == 0 ? tok0 + ii : tok0 + T - 1 - ii;
                float* dst = hd + (size_t)tk * 512 + h * 128 + 16 * tnb + l15;
#pragma unroll
                for (int tt = 0; tt < 4; ++tt) dst[16 * tt] = (wi * accq[tt][j] + accp[tt][j]) * inv; }
        }
        const float sc = __expf(m - mx);
        if (tid < 128) { float ns = 0.f;
#pragma unroll 8
            for (int e = 0; e < 64; ++e) ns += bf2f(sKt[tid * 72 + e]);
            sN[tid] = sc * sN[tid] + ns; }
#pragma unroll
        for (int tn = 0; tn < 8; ++tn) { f32x4 dc = {0.f, 0.f, 0.f, 0.f};
#pragma unroll
            for (int ks = 0; ks < 2; ++ks) dc = MFMA16(fragsw(sVt, 16 * wave, 32 * ks, lane), fragsw(sKt, 16 * tn, 32 * ks, lane), dc);
            cacc[tn] = sc * cacc[tn] + dc;
#pragma unroll
            for (int j = 0; j < 4; ++j) sC[(16 * wave + quad * 4 + j) * 136 + 16 * tn + l15] = f2bf(cacc[tn][j]); }
        m = bL + mx;
    }
    __syncthreads();
    if (s < 32) {
        const size_t sb = (((size_t)(s * 2 + l) * 2 + d) * 4 + h);
        float* Co = p.out + O_MC + sb * 128 * 128;
#pragma unroll
        for (int tn = 0; tn < 8; ++tn)
#pragma unroll
            for (int j = 0; j < 4; ++j) Co[(16 * wave + quad * 4 + j) * 128 + 16 * tn + l15] = cacc[tn][j];
        if (tid < 128) p.out[O_MN + sb * 128 + tid] = sN[tid];
        if (tid == 0) p.out[O_MM + sb] = m;
    }
}

#undef ML_PREFETCH
__device__ __forceinline__ void attn_task(const Params& p, int l, int task, LAS unsigned char* lds) {
    const int tid = opaque_tid(), lane = tid & 63, wave = tid >> 6, quad = lane >> 4, l15 = lane & 15;
    const bool samp = task < 128;
    int b, h, qb;
    if (samp) { b = task >> 6; h = (task >> 3) & 7; qb = task & 7; } else { const int t2 = task - 128; b = t2 >> 4; h = (t2 >> 1) & 7; qb = t2 & 1; }
    const int tok0 = samp ? NPT + b * 1024 : b * 256, nkt = samp ? 24 : 4, nct = samp ? 8 : 0;
    LAS bf16_t* sK = (LAS bf16_t*)lds;
    LAS bf16_t* sVt = sK + 64 * 136;
    LAS bf16_t* sPw = sVt + 128 * 72 + wave * (16 * 72);
    const bf16_t* proj = (const bf16_t*)(p.ws + WS_PROJ);
    const bf16_t* ck = (const bf16_t*)(p.ws + WS_KC) + (((unsigned)(b * 2 + l) * 8 + h) * 512) * 128;
    const bf16_t* cv = (const bf16_t*)(p.ws + WS_VTC) + (((unsigned)(b * 2 + l) * 8 + h) * 128) * 512;
    const float lam = ((const float*)(p.ws + WS_LAM))[l];
    const float lam_init = 0.8f - 0.6f * expf(-0.3f * (float)l);
    const int q0 = 128 * qb + 16 * wave;
    bf16x8 aq1[2], aq2[2];
    { const bf16_t* qp = proj + (unsigned)(tok0 + q0 + l15) * NP + C_Q + h * 128 + quad * 8;
        aq1[0] = *(const bf16x8*)qp; aq1[1] = *(const bf16x8*)(qp + 32); aq2[0] = *(const bf16x8*)(qp + 64); aq2[1] = *(const bf16x8*)(qp + 96); }
    LAS bf16_t* sQw = sVt + 128 * 72 + wave * (16 * 136);
    { LAS bf16_t* qd = sQw + l15 * 136 + quad * 8;
        *(LAS bf16x8*)qd = aq1[0]; *(LAS bf16x8*)(qd + 32) = aq1[1]; *(LAS bf16x8*)(qd + 64) = aq2[0]; *(LAS bf16x8*)(qd + 96) = aq2[1]; }
    LDS_FENCE();
    float mx1 = -INFINITY, mx2 = -INFINITY, sm1 = 0.f, sm2 = 0.f, mc1 = 0.f, mc2 = 0.f;
    constexpr float CS = 0.125f * 1.4426950408889634f;
    f32x4 o1[8], o2[8];
#pragma unroll
    for (int tn = 0; tn < 8; ++tn) { o1[tn] = (f32x4){0.f, 0.f, 0.f, 0.f}; o2[tn] = o1[tn]; }
    u32x4v kreg[2], vreg[2];
#define ATT_LOAD(KT, PASS) do { int ktv = (KT); asm volatile("" : "+v"(ktv));     \
    _Pragma("unroll") for (int it = 0; it < 2; ++it) { const int idx = tid + 512 * it, i = idx >> 4, g = idx & 15; \
        if ((KT) < nct) { kreg[it] = *(const u32x4v*)(ck + (unsigned)((64 * ktv + i) * 128 + 8 * g)); \
            if ((PASS) == 1) { const int dv = idx >> 3, mm = idx & 7; vreg[it] = *(const u32x4v*)(cv + (unsigned)(dv * 512 + 64 * ktv + 8 * mm)); } } \
        else { kreg[it] = *(const u32x4v*)(proj + (unsigned)((tok0 + 64 * (ktv - nct) + i) * NP + C_K + h * 128 + 8 * g)); \
            if ((PASS) == 1) vreg[it] = *(const u32x4v*)(proj + (unsigned)((tok0 + 64 * (ktv - nct) + (idx & 63)) * NP + C_V + h * 128 + 8 * (idx >> 6))); } } } while (0)
#define ATT_LOADK(BUF, KT) do { int ktv = (KT); asm volatile("" : "+v"(ktv)); _Pragma("unroll") for (int it = 0; it < 2; ++it) { const int idx = tid + 512 * it, i = idx >> 4, g = idx & 15; \
        if ((KT) < nct) BUF[it] = *(const u32x4v*)(ck + (unsigned)((64 * ktv + i) * 128 + 8 * g)); \
        else BUF[it] = *(const u32x4v*)(proj + (unsigned)((tok0 + 64 * (ktv - nct) + i) * NP + C_K + h * 128 + 8 * g)); } } while (0)
#define ATT_P0TILE(BUF, KT) do { __syncthreads(); \
        _Pragma("unroll") for (int it = 0; it < 2; ++it) { const int idx = tid + 512 * it, i = idx >> 4, g = idx & 15; *(LAS u32x4v*)(sK + i * 136 + 8 * g) = BUF[it]; } \
        if ((KT) + 2 < nkt) ATT_LOADK(BUF, (KT) + 2); \
        __syncthreads(); \
        _Pragma("unroll") for (int tn = 0; tn < 4; ++tn) { f32x4 a_ = {0.f, 0.f, 0.f, 0.f}, b_ = a_; \
            _Pragma("unroll") for (int ks = 0; ks < 2; ++ks) { a_ = MFMA16(frag(sK, 16 * tn, 136, 32 * ks, lane), aq1[ks], a_); b_ = MFMA16(frag(sK, 16 * tn, 136, 64 + 32 * ks, lane), aq2[ks], b_); } \
            _Pragma("unroll") for (int j = 0; j < 4; ++j) { mx1 = fmaxf(mx1, a_[j]); mx2 = fmaxf(mx2, b_[j]); } } } while (0)
    ATT_LOADK(kreg, 0); ATT_LOADK(vreg, 1);
    for (int kt = 0; kt < nkt; kt += 2) { ATT_P0TILE(kreg, kt); ATT_P0TILE(vreg, kt + 1); }
#undef ATT_LOADK
#undef ATT_P0TILE
    mx1 = fmaxf(mx1, __shfl_xor(mx1, 16)); mx1 = fmaxf(mx1, __shfl_xor(mx1, 32)); mx2 = fmaxf(mx2, __shfl_xor(mx2, 16)); mx2 = fmaxf(mx2, __shfl_xor(mx2, 32)); mc1 = mx1 * CS; mc2 = mx2 * CS;
    u32x4v kreg2[2], vreg2[2];
#define ATT_LOADKV(KB, VB, KT) do { int ktv = (KT); asm volatile("" : "+v"(ktv)); _Pragma("unroll") for (int it = 0; it < 2; ++it) { const int idx = tid + 512 * it, i = idx >> 4, g = idx & 15; \
        if ((KT) < nct) { KB[it] = *(const u32x4v*)(ck + (unsigned)((64 * ktv + i) * 128 + 8 * g)); const int dv = idx >> 3, mm = idx & 7; VB[it] = *(const u32x4v*)(cv + (unsigned)(dv * 512 + 64 * ktv + 8 * mm)); } \
        else { KB[it] = *(const u32x4v*)(proj + (unsigned)((tok0 + 64 * (ktv - nct) + i) * NP + C_K + h * 128 + 8 * g)); \
            VB[it] = *(const u32x4v*)(proj + (unsigned)((tok0 + 64 * (ktv - nct) + (idx & 63)) * NP + C_V + h * 128 + 8 * (idx >> 6))); } } } while (0)
#define ATT_STAGEKV(KB, VB, KT) do { _Pragma("unroll") for (int it = 0; it < 2; ++it) { const int idx = tid + 512 * it, i = idx >> 4, g = idx & 15; \
        *(LAS u32x4v*)(sK + i * 136 + 8 * g) = KB[it]; \
        if ((KT) < nct) { const int dv = idx >> 3, mm = idx & 7; *(LAS u32x4v*)(sVt + dv * 72 + 8 * mm) = VB[it]; } \
        else { const u32x4v w = VB[it]; LAS bf16_t* dst = sVt + (8 * (idx >> 6)) * 72 + (idx & 63); \
            dst[0] = (bf16_t)(w.x & 0xffff); dst[72] = (bf16_t)(w.x >> 16); dst[144] = (bf16_t)(w.y & 0xffff); dst[216] = (bf16_t)(w.y >> 16); \
            dst[288] = (bf16_t)(w.z & 0xffff); dst[360] = (bf16_t)(w.z >> 16); dst[432] = (bf16_t)(w.w & 0xffff); dst[504] = (bf16_t)(w.w >> 16); } } } while (0)
    auto p1_compute = [&]() {
#pragma unroll
            for (int bb = 0; bb < 2; ++bb) {
                f32x4 s1[2], s2[2];
#pragma unroll
                for (int t = 0; t < 2; ++t) { s1[t] = (f32x4){0.f, 0.f, 0.f, 0.f}; s2[t] = s1[t];
#pragma unroll
                    for (int ks = 0; ks < 2; ++ks) { s1[t] = MFMA16(frag(sK, 32 * bb + 16 * t, 136, 32 * ks, lane), aq1[ks], s1[t]); s2[t] = MFMA16(frag(sK, 32 * bb + 16 * t, 136, 64 + 32 * ks, lane), aq2[ks], s2[t]); } }
                {
                    bf16x8 pa1, pa2;
                    { float p1[8];
#pragma unroll
                        for (int jj = 0; jj < 8; ++jj) { p1[jj] = __builtin_amdgcn_exp2f(s1[jj >> 2][jj & 3] * CS - mc1); sm1 += p1[jj]; }
                        pa1 = __builtin_bit_cast(bf16x8, pack8(p1)); }
                    { float p2[8];
#pragma unroll
                        for (int jj = 0; jj < 8; ++jj) { p2[jj] = __builtin_amdgcn_exp2f(s2[jj >> 2][jj & 3] * CS - mc2); sm2 += p2[jj]; }
                        pa2 = __builtin_bit_cast(bf16x8, pack8(p2)); }
#pragma unroll
                    for (int tn2 = 0; tn2 < 8; ++tn2) { const LAS bf16_t* vrow = sVt + (16 * tn2 + l15) * 72 + 32 * bb + quad * 4;
                        const u32x2v lo = *(const LAS u32x2v*)vrow, hi = *(const LAS u32x2v*)(vrow + 16);
                        u32x4v vw; vw.x = lo.x; vw.y = lo.y; vw.z = hi.x; vw.w = hi.y;
                        const bf16x8 vb = __builtin_bit_cast(bf16x8, vw);
                        o1[tn2] = MFMA16(pa1, vb, o1[tn2]); o2[tn2] = MFMA16(pa2, vb, o2[tn2]); }
                }
                asm volatile("" ::: "memory");
            }
    };
#define ATT_P1TILE(KB, VB, KT) do { __syncthreads(); ATT_STAGEKV(KB, VB, KT); if ((KT) + 2 < nkt) ATT_LOADKV(KB, VB, (KT) + 2); __syncthreads(); p1_compute(); } while (0)
    ATT_LOADKV(kreg, vreg, 0); ATT_LOADKV(kreg2, vreg2, 1);
    for (int kt = 0; kt < nkt; kt += 2) { ATT_P1TILE(kreg, vreg, kt); ATT_P1TILE(kreg2, vreg2, kt + 1); }
#undef ATT_LOADKV
#undef ATT_STAGEKV
#undef ATT_P1TILE
    sm1 += __shfl_xor(sm1, 16); sm1 += __shfl_xor(sm1, 32); sm2 += __shfl_xor(sm2, 16); sm2 += __shfl_xor(sm2, 32);
    const float il1 = 1.0f / sm1, il2 = lam / sm2;
    float f1[4], f2[4];
#pragma unroll
    for (int j = 0; j < 4; ++j) { f1[j] = __shfl(il1, quad * 4 + j); f2[j] = __shfl(il2, quad * 4 + j); }
#pragma unroll
    for (int tn = 0; tn < 8; ++tn)
#pragma unroll
        for (int j = 0; j < 4; ++j) o1[tn][j] = o1[tn][j] * f1[j] - o2[tn][j] * f2[j];
    asm volatile("" ::: "memory");
#define oacc o1
#undef ATT_LOAD
    bf16_t* mixed = (bf16_t*)(p.ws + WS_UM);
    const float* sg = p.in[I_SUBG] + l * 128;
#pragma unroll
    for (int j = 0; j < 4; ++j) {
        float ss = 0.f;
#pragma unroll
        for (int tn = 0; tn < 8; ++tn) ss += oacc[tn][j] * oacc[tn][j];
        ss = red16_sum(ss);
        const float r = rsqrtf(ss * (1.0f / 128.0f) + 1e-5f) * (1.0f - lam_init);
        const int tq = tok0 + q0 + quad * 4 + j;
#pragma unroll
        for (int tn = 0; tn < 8; ++tn) { const int dv = 16 * tn + l15;
            const float gt = bf2f(proj[(unsigned)tq * NP + C_G + h * 128 + dv]);
            mixed[(unsigned)tq * DM + 1024 + h * 128 + dv] = f2bf(oacc[tn][j] * r * sg[dv] * siluf_(gt)); }
    }
}

#undef oacc
__device__ __forceinline__ void rwkv_prep_task(const Params& p, int l, int task, LAS unsigned char* lds) {
    const int tid = opaque_tid(), lane = tid & 63, wave = tid >> 6, quad = lane >> 4, l15 = lane & 15;
    const int tile = task >> 3, h = task & 7, tb = 64 * tile;
    const int T = tb < NPT ? 256 : 1024, seq0 = tb < NPT ? (tb & ~255) : NPT + ((tb - NPT) & ~1023);
    LAS bf16_t* sTW = (LAS bf16_t*)lds;
    LAS bf16_t* sAD = sTW + 2 * 64 * 72;
    LAS bf16_t* sWup = sAD + 2 * 64 * 72;
    LAS bf16_t* sAup = sWup + 2 * 64 * 72;
    LAS float* sR = (LAS float*)(sAup + 2 * 64 * 72);
    LAS float* sKf = sR + 4096; LAS float* sVf = sKf + 4096; LAS float* sNrm = sVf + 4096; LAS float* sRK = sNrm + 64;
    const bf16_t* proj = (const bf16_t*)(p.ws + WS_PROJ);
    __syncthreads();
#pragma unroll
    for (int it = 0; it < 4; ++it) {
        const int idx = tid + 512 * it, arr = idx >> 9, i = (idx >> 3) & 63, g = idx & 7;
        const u32x4v w = *(const u32x4v*)(proj + (size_t)(tb + i) * NP + A_WD + 64 * arr + 8 * g);
        if (arr < 2) { float x[8]; unpack8(w, x);
#pragma unroll
            for (int e = 0; e < 8; ++e) x[e] = tanhf_(x[e]);
            *(LAS u32x4v*)(sTW + (arr * 64 + i) * 72 + 8 * g) = pack8(x); }
        else *(LAS u32x4v*)(sAD + ((arr - 2) * 64 + i) * 72 + 8 * g) = w;
    }
#pragma unroll
    for (int it = 0; it < 4; ++it) {
        const int dd2 = it >> 1, which = it & 1, c = tid >> 3, jg = tid & 7;
        const bf16_t* src = (const bf16_t*)(p.ws + WS_WUPT) + ((((size_t)(l * 2 + dd2) * 2 + which) * 8 + h) * 4096) + c * 64 + 8 * jg;
        *(LAS u32x4v*)((which ? sAup : sWup) + (dd2 * 64 + c) * 72 + 8 * jg) = *(const u32x4v*)src;
    }
#pragma unroll
    for (int it = 0; it < 3; ++it) {
        const int idx = tid + 512 * it, which = idx >> 9, i = (idx >> 3) & 63, g = idx & 7, ch = which * 512 + h * 64 + 8 * g;
        const int tk = tb + i, pos = tk - seq0;
        const bf16_t* src = proj + (size_t)tk * NP + ch;
        float x0[8], x1[8], x2[8], w0[8], w1[8], w2[8], bb[8];
        unpack8(*(const u32x4v*)src, x1);
        unpack8(*(const u32x4v*)(pos > 0 ? src - NP : src), x0); unpack8(*(const u32x4v*)(pos < T - 1 ? src + NP : src), x2);
        const float m0 = pos > 0 ? 1.f : 0.f, m2 = pos < T - 1 ? 1.f : 0.f;
        const float* cw = p.in[I_CAW] + (size_t)l * 3 * 1536 + ch;
        ld8f(cw, w0); ld8f(cw + 1536, w1); ld8f(cw + 3072, w2); ld8f(p.in[I_CAB] + l * 1536 + ch, bb);
        LAS float* dst = (which == 0 ? sR : (which == 1 ? sKf : sVf)) + i * 64 + 8 * g;
#pragma unroll
        for (int e = 0; e < 8; ++e) dst[e] = m0 * x0[e] * w0[e] + x1[e] * w1[e] + m2 * x2[e] * w2[e] + bb[e];
    }
    __syncthreads();
    { const int t = tid >> 3, part = tid & 7; float ss = 0.f;
#pragma unroll
        for (int e = 0; e < 8; ++e) { const float v = sKf[t * 64 + 8 * part + e] * p.in[I_KK][l * 512 + h * 64 + 8 * part + e]; ss += v * v; }
        ss += __shfl_xor(ss, 1); ss += __shfl_xor(ss, 2); ss += __shfl_xor(ss, 4);
        if (part == 0) sNrm[t] = rsqrtf(ss + 1e-12f); }
    const int dd = wave >> 2, tm = wave & 3;
    f32x4 aw[4], aa[4];
#pragma unroll
    for (int tn = 0; tn < 4; ++tn) { aw[tn] = (f32x4){0.f, 0.f, 0.f, 0.f}; aa[tn] = aw[tn];
#pragma unroll
        for (int ks = 0; ks < 2; ++ks) { aw[tn] = MFMA16(frag(sTW + dd * 64 * 72, 16 * tm, 72, 32 * ks, lane), frag(sWup + dd * 64 * 72, 16 * tn, 72, 32 * ks, lane), aw[tn]);
            aa[tn] = MFMA16(frag(sAD + dd * 64 * 72, 16 * tm, 72, 32 * ks, lane), frag(sAup + dd * 64 * 72, 16 * tn, 72, 32 * ks, lane), aa[tn]); } }
    __syncthreads();
    {
        LAS bf16_t* so = sTW + dd * (3 * 4096);
        float rk[4] = {0.f, 0.f, 0.f, 0.f};
#pragma unroll
        for (int tn = 0; tn < 4; ++tn) { const int c = 16 * tn + l15, ch = h * 64 + c;
            const float w0v = p.in[I_W0][(l * 2 + dd) * 512 + ch], a0v = p.in[I_A0][(l * 2 + dd) * 512 + ch], kav = p.in[I_KA][l * 512 + ch], kkv = p.in[I_KK][l * 512 + ch], rkv = p.in[I_RK][l * 512 + ch];
#pragma unroll
            for (int j = 0; j < 4; ++j) { const int t = 16 * tm + quad * 4 + j; const int o = t * 64 + c;
                const float z = w0v + aw[tn][j]; const float dec = __expf(-0.6065306597126334f * sigmoidf_(z));
                const float av = sigmoidf_(a0v + aa[tn][j]); const float kv = sKf[t * 64 + c];
                const float ktv = kv * (1.0f + (av - 1.0f) * kav); const float kk = kv * kkv * sNrm[t];
                so[o] = f2bf(ktv); so[4096 + o] = f2bf(kk * av); so[8192 + o] = f2bf(dec - 1.0f);
                rk[j] += sR[t * 64 + c] * ktv * rkv; } }
#pragma unroll
        for (int j = 0; j < 4; ++j) { const float s = red16_sum(rk[j]); if (l15 == 0) sRK[dd * 64 + 16 * tm + quad * 4 + j] = s; }
    }
    __syncthreads();
    { const int i = tid >> 3, g = tid & 7; const size_t o = (size_t)(tb + i) * 512 + h * 64 + 8 * g;
        float r[8], k[8], v[8], bn[8]; const float nr = sNrm[i], rks = sRK[i] + sRK[64 + i];
#pragma unroll
        for (int e = 0; e < 8; ++e) { r[e] = sR[i * 64 + 8 * g + e]; k[e] = sKf[i * 64 + 8 * g + e] * p.in[I_KK][l * 512 + h * 64 + 8 * g + e] * nr; v[e] = sVf[i * 64 + 8 * g + e]; bn[e] = rks * v[e]; }
        const size_t o2 = ((size_t)(tb + i) * 8 + h) * 320 + 8 * g; bf16_t* pk = (bf16_t*)(p.ws + WS_PK);
#pragma unroll
        for (int dd2 = 0; dd2 < 2; ++dd2)
#pragma unroll
            for (int ar = 0; ar < 3; ++ar) *(u32x4v*)(pk + (size_t)dd2 * NTOK * 2560 + o2 + 128 + 64 * ar) = *(const LAS u32x4v*)(sTW + dd2 * (3 * 4096) + ar * 4096 + i * 64 + 8 * g);
        const u32x4v rr = pack8(r), kk8 = pack8(k);
        *(u32x4v*)(pk + o2) = rr; *(u32x4v*)(pk + o2 + 64) = kk8; *(u32x4v*)(pk + (size_t)NTOK * 2560 + o2) = rr; *(u32x4v*)(pk + (size_t)NTOK * 2560 + o2 + 64) = kk8;
        *(u32x4v*)((bf16_t*)(p.ws + WS_SCV) + o) = pack8(v); *(u32x4v*)((bf16_t*)(p.ws + WS_SCBON) + o) = pack8(bn); }
}

__device__ __forceinline__ void m1_phase(const Params& p, int l, LAS unsigned char* lds, int rep, int mask) {
    unsigned* ctr = (unsigned*)(p.ws + WS_CTL) + 64 * (1 + 4 * l + 8 * rep);
    LAS int* slot = (LAS int*)(lds + LDS_SLOT);
#ifndef NO_MLSTM
    if (mask & 1) for (;;) { const int t = next_task(ctr, slot); if (t >= 272) break; const int u = t < 16 ? t + 256 : t - 16; mlstm_task(p, l, u >> 3, (u >> 2) & 1, u & 3, lds); }
#endif
#ifndef NO_ATTN
    if (mask & 2) for (;;) { const int t = next_task(ctr + 64, slot); if (t >= 640) break; attn_task(p, l, t, lds); }
#endif
#ifndef NO_PREP
    if (mask & 4) for (;;) { const int t = next_task(ctr + 128, slot); if (t >= 1280) break; rwkv_prep_task(p, l, t, lds); }
#endif
}

#ifdef EXP_LITE
#if EXP_LITE == 1
#define EXPY(v) (bf2f(sBt[(quad * 4 + j) * 24 + l15]) + bf2f(sGt[(16 + quad * 4 + j) * 24 + l15]) + sW[l15 + 16 * quad])
#elif EXP_LITE == 2
#define EXPY(v) (bf2f(sAt[(quad * 4 + j) * 72 + l15]) + bf2f(sX2[(quad * 4 + j) * 24 + l15]))
#else
#define EXPY(v) (bf2f(sPy[(quad * 4 + j) * 72 + 16 + l15]) + bf2f(sQy[(quad * 4 + j) * 24 + l15]))
#endif
#define EXPS(v) 0.f
#else
#define EXPY(v) (v)
#define EXPS(v) (v)
#endif
__device__ __forceinline__ bf16_t f2bf_sw(float f) { unsigned u = __float_as_uint(f); u += 0x7FFFu + ((u >> 16) & 1u); return (bf16_t)(u >> 16); }
__device__ __forceinline__ bf16x8 frag16(const LAS bf16_t* base, int row0, int ld, int lane) {
    bf16x8 z = {0, 0, 0, 0, 0, 0, 0, 0};
    if ((lane >> 4) < 2) z = *(const LAS bf16x8*)(base + (row0 + (lane & 15)) * ld + (lane >> 4) * 8);
    return z;
}
__device__ __forceinline__ void cp_task(const Params& p, int task, int lane, LAS unsigned char* wl) {
    int s, d, h, c, T;
    if (task < 8192) { s = task >> 8; d = (task >> 7) & 1; h = (task >> 4) & 7; c = task & 15; T = 256; }
    else { const int u = task - 8192; s = 32 + (u >> 10); d = (u >> 9) & 1; h = (u >> 6) & 7; c = u & 63; T = 1024; }
    const int tok0 = s < 32 ? s * 256 : NPT + (s - 32) * 1024, quad = lane >> 4, l15 = lane & 15;
    const long step = d == 0 ? 1 : -1; const int tfirst = d == 0 ? tok0 + 16 * c : tok0 + T - 1 - 16 * c;
    bf16_t* pk = (bf16_t*)(p.ws + WS_PK) + (size_t)d * NTOK * 2560 + ((size_t)tfirst * 8 + h) * 320;
    LAS bf16_t* sA = (LAS bf16_t*)wl;
    LAS bf16_t* sB = sA + 16 * 72, *sG = sB + 16 * 72, *sR = sG + 16 * 72;
    LAS float* mL1 = (LAS float*)(sR + 16 * 72);
    LAS bf16_t* sL2 = (LAS bf16_t*)(mL1 + 16 * 17);
    LAS bf16_t* sM1t = sL2 + 16 * 24;
    LAS bf16_t* sTt = sM1t + 16 * 24;
    LAS bf16_t* sAtil = sTt + 16 * 24;
    LAS bf16_t* sX2 = sTt;
    LAS bf16_t* oAt = sB;
    LAS bf16_t* oPy = sG;
    LAS bf16_t* oX2 = (LAS bf16_t*)mL1;
    LAS bf16_t* oQy = sL2;
    float bt[16], gt[16], W = 1.0f;
    { const int k = lane;
        float rr[16], kk[16], kt[16], ka[16], wm[16];
#pragma unroll
        for (int i = 0; i < 16; ++i) { const bf16_t* rec = pk + step * 2560 * i + k; rr[i] = bf2f(rec[0]); kk[i] = bf2f(rec[64]); kt[i] = bf2f(rec[128]); ka[i] = bf2f(rec[192]); wm[i] = bf2f(rec[256]); }
#pragma unroll
        for (int i = 0; i < 16; ++i) { const float Wp = W; W = W + W * wm[i]; const float iw = __builtin_amdgcn_rcpf(W);
            sA[i * 72 + k] = f2bf(Wp * kk[i]); bt[i] = ka[i] * iw; gt[i] = kt[i] * iw; sB[i * 72 + k] = f2bf(bt[i]); sG[i * 72 + k] = f2bf(gt[i]); sR[i * 72 + k] = f2bf(W * rr[i]); } }
    LDS_FENCE();
    f32x4 m2acc;
    { f32x4 a1 = {0.f, 0.f, 0.f, 0.f}, a2 = a1, a3 = a1, a4 = a1;
#pragma unroll
        for (int ks = 0; ks < 2; ++ks) { const bf16x8 fb = frag(sB, 0, 72, 32 * ks, lane), fg = frag(sG, 0, 72, 32 * ks, lane), fa = frag(sA, 0, 72, 32 * ks, lane), fr = frag(sR, 0, 72, 32 * ks, lane);
            a1 = MFMA16(fb, fa, a1); a2 = MFMA16(fg, fa, a2); a3 = MFMA16(fb, fr, a3); a4 = MFMA16(fg, fr, a4); }
#pragma unroll
        for (int j = 0; j < 4; ++j) { const int i = quad * 4 + j, t = l15;
            mL1[i * 17 + t] = i < t ? a1[j] : 0.f; sL2[i * 24 + t] = f2bf(i < t ? a2[j] : 0.f); sM1t[t * 24 + i] = f2bf(i <= t ? a3[j] : 0.f); m2acc[j] = i <= t ? a4[j] : 0.f; } }
    LDS_FENCE();
    { float Tr[16];
#pragma unroll
        for (int t = 0; t < 16; ++t) { float acc = (l15 == t) ? 1.0f : 0.0f;
#pragma unroll
            for (int i = 0; i < t; ++i) acc -= Tr[i] * mL1[i * 17 + t];
            Tr[t] = acc; }
        if (quad == 0) {
#pragma unroll
            for (int t = 0; t < 16; ++t) sTt[t * 24 + l15] = f2bf(Tr[t]); } }
    LDS_FENCE();
    const bf16x8 ftt = frag16(sTt, 0, 24, lane);
#pragma unroll
    for (int kt2 = 0; kt2 < 4; ++kt2) {
        u32x4v aw = {0u, 0u, 0u, 0u};
        if (quad < 2) { const LAS bf16_t* col = sA + (quad * 8) * 72 + 16 * kt2 + l15;
            aw.x = (unsigned)col[0] | ((unsigned)col[72] << 16); aw.y = (unsigned)col[144] | ((unsigned)col[216] << 16); aw.z = (unsigned)col[288] | ((unsigned)col[360] << 16); aw.w = (unsigned)col[432] | ((unsigned)col[504] << 16); }
        f32x4 acc = {0.f, 0.f, 0.f, 0.f};
        acc = MFMA16(__builtin_bit_cast(bf16x8, aw), ftt, acc);
#pragma unroll
        for (int j = 0; j < 4; ++j) { const int k = 16 * kt2 + quad * 4 + j; const bf16_t v = f2bf_sw(acc[j]); sAtil[k * 24 + l15] = v; oAt[l15 * 72 + k] = v; }
    }
    { f32x4 acc = {0.f, 0.f, 0.f, 0.f};
        acc = MFMA16(frag16(sL2, 0, 24, lane), ftt, acc);
#pragma unroll
        for (int j = 0; j < 4; ++j) { const bf16_t v = f2bf_sw(acc[j]); sX2[(quad * 4 + j) * 24 + l15] = v; oX2[l15 * 24 + quad * 4 + j] = v; } }
    LDS_FENCE();
    const bf16x8 fm1 = frag16(sM1t, 0, 24, lane);
#pragma unroll
    for (int kt2 = 0; kt2 < 4; ++kt2) { f32x4 acc = {0.f, 0.f, 0.f, 0.f};
        acc = MFMA16(frag16(sAtil, 16 * kt2, 24, lane), fm1, acc);
#pragma unroll
        for (int j = 0; j < 4; ++j) { const int k = 16 * kt2 + quad * 4 + j; oPy[l15 * 72 + k] = f2bf(bf2f(sR[l15 * 72 + k]) - acc[j]); } }
    { f32x4 acc = {0.f, 0.f, 0.f, 0.f};
        acc = MFMA16(frag16(sX2, 0, 24, lane), fm1, acc);
#pragma unroll
        for (int j = 0; j < 4; ++j) oQy[l15 * 24 + quad * 4 + j] = f2bf(m2acc[j] - acc[j]); }
    LDS_FENCE();
    { float bb8[8]; const int k = lane; bf16_t* rec = pk + step * 2560 * (k >> 2);
#pragma unroll
        for (int hh = 0; hh < 2; ++hh) {
#pragma unroll
            for (int e = 0; e < 8; ++e) bb8[e] = bt[8 * hh + e];
            *(u32x4v*)(rec + 128 + (k & 3) * 16 + 8 * hh) = pack8(bb8);
#pragma unroll
            for (int e = 0; e < 8; ++e) bb8[e] = gt[8 * hh + e];
            *(u32x4v*)(rec + 192 + (k & 3) * 16 + 8 * hh) = pack8(bb8); }
        ((float*)(rec + 288))[k & 3] = W; }
#pragma unroll
    for (int it = 0; it < 2; ++it) { const int f = lane + 64 * it, t = f >> 3, q = f & 7; bf16_t* rec = pk + step * 2560 * t;
        *(u32x4v*)(rec + 8 * q) = *(const LAS u32x4v*)(oAt + t * 72 + 8 * q); *(u32x4v*)(rec + 64 + 8 * q) = *(const LAS u32x4v*)(oPy + t * 72 + 8 * q); }
    if (lane < 32) { const int t = lane >> 1, q = lane & 1; bf16_t* rec = pk + step * 2560 * t;
        *(u32x4v*)(rec + 256 + 8 * q) = *(const LAS u32x4v*)(oX2 + t * 24 + 8 * q); *(u32x4v*)(rec + 272 + 8 * q) = *(const LAS u32x4v*)(oQy + t * 24 + 8 * q); }
    LDS_FENCE();
}
constexpr int CP_LDS = 16 * 72 * 2 * 4 + 16 * 17 * 4 + (16 * 24 * 3 + 64 * 24 + 16 * 24) * 2 + 16 * 72 * 2 * 2 + 16 * 24 * 2 * 2;

__device__ __forceinline__ void ap_task(const Params& p, int l, int task, int lane, LAS unsigned char* wl) {
    int s, d, h, rt;
    if (task < 128) { s = 32 + (task >> 6); d = (task >> 5) & 1; h = (task >> 2) & 7; rt = task & 3; }
    else { const int u = task - 128; s = u >> 6; d = (u >> 5) & 1; h = (u >> 2) & 7; rt = u & 3; }
    const int T = s < 32 ? 256 : 1024, nch = T / 16, tok0 = s < 32 ? s * 256 : NPT + (s - 32) * 1024, quad = lane >> 4, l15 = lane & 15;
    const long step = d == 0 ? 1 : -1; const int tstart = d == 0 ? tok0 : tok0 + T - 1;
    const bf16_t* pk = (const bf16_t*)(p.ws + WS_PK) + (size_t)d * NTOK * 2560 + ((size_t)tstart * 8 + h) * 320;
    const bf16_t* pv = (const bf16_t*)(p.ws + WS_SCV) + (size_t)tstart * 512 + h * 64 + 16 * rt;
    float* yd = (float*)(p.ws + WS_YD) + (size_t)d * NTOK * 512 + (size_t)tstart * 512 + h * 64 + 16 * rt;
    constexpr int IS = 328;
    LAS bf16_t* img = (LAS bf16_t*)wl;
    LAS bf16_t* sS = img + 16 * IS;
    LAS bf16_t* sCm = sS + 16 * 72;
    f32x4 S[4];
    if (s >= 32) { const float* s0 = p.in[I_SRW] + ((((size_t)((s - 32) * 2 + l) * 2 + d) * 8 + h) * 64 + 16 * rt) * 64;
#pragma unroll
        for (int tn = 0; tn < 4; ++tn)
#pragma unroll
            for (int j = 0; j < 4; ++j) S[tn][j] = s0[(quad * 4 + j) * 64 + 16 * tn + l15]; }
    else {
#pragma unroll
        for (int tn = 0; tn < 4; ++tn) S[tn] = (f32x4){0.f, 0.f, 0.f, 0.f}; }
    const bf16_t* gsrc = pk + step * 2560 * (lane >> 2) + 8 * (lane & 3);
    LAS bf16_t* ldst = img + (lane >> 2) * IS + 8 * (lane & 3);
    u32x4v rawA[10], rawB[10]; bf16_t vrA[8], vrB[8];
#define AP_LOAD(raw, vraw, CH) do { int chv = (CH); asm volatile("" : "+v"(chv)); const bf16_t* cb = gsrc + step * 2560 * (16 * chv); \
        _Pragma("unroll") for (int jj = 0; jj < 10; ++jj) raw[jj] = *(const u32x4v*)(cb + 32 * jj); \
        if (quad < 2) { _Pragma("unroll") for (int e = 0; e < 8; ++e) vraw[e] = pv[step * 512 * (16 * chv + quad * 8 + e) + l15]; } } while (0)
#define AP_STAGE(raw) do { _Pragma("unroll") for (int jj = 0; jj < 10; ++jj) *(LAS u32x4v*)(ldst + 32 * jj) = raw[jj]; } while (0)
    AP_LOAD(rawA, vrA, 0);
    if (nch > 1) AP_LOAD(rawB, vrB, 1);
    const LAS bf16_t* pBt = img + (l15 >> 2) * IS + 128 + (l15 & 3) * 16 + quad * 8;
    const LAS float* pW = (const LAS float*)(img + (l15 >> 2) * IS + 288) + (l15 & 3);
#define AP_CHUNK(raw, vraw, CC) do { const int c = (CC); \
        AP_STAGE(raw); \
        u32x4v vw = {0u, 0u, 0u, 0u}; \
        if (quad < 2) { vw.x = (unsigned)vraw[0] | ((unsigned)vraw[1] << 16); vw.y = (unsigned)vraw[2] | ((unsigned)vraw[3] << 16); vw.z = (unsigned)vraw[4] | ((unsigned)vraw[5] << 16); vw.w = (unsigned)vraw[6] | ((unsigned)vraw[7] << 16); } \
        asm volatile("" : "+v"(vw)); \
        if (c + 2 < nch) AP_LOAD(raw, vraw, c + 2); \
        ap_compute(c, vw); } while (0)
    auto ap_compute = [&](int c, u32x4v vw) {
        const bf16x8 va = __builtin_bit_cast(bf16x8, vw);
#pragma unroll
        for (int tn = 0; tn < 4; ++tn) { const unsigned w01 = pk2(S[tn][0], S[tn][1]), w23 = pk2(S[tn][2], S[tn][3]); LAS bf16_t* ds = sS + (quad * 4) * 72 + 16 * tn + l15;
            ds[0] = (bf16_t)(w01 & 0xffff); ds[72] = (bf16_t)(w01 >> 16); ds[144] = (bf16_t)(w23 & 0xffff); ds[216] = (bf16_t)(w23 >> 16); }
        LDS_FENCE();
        f32x4 cm = {0.f, 0.f, 0.f, 0.f}, yy = {0.f, 0.f, 0.f, 0.f};
#pragma unroll
        for (int ks = 0; ks < 2; ++ks) { const bf16x8 fs = frag(sS, 0, 72, 32 * ks, lane); cm = MFMA16(fs, frag(img, 0, IS, 32 * ks, lane), cm); yy = MFMA16(fs, frag(img + 64, 0, IS, 32 * ks, lane), yy); }
        cm = MFMA16(va, frag16(img + 256, 0, IS, lane), cm); yy = MFMA16(va, frag16(img + 272, 0, IS, lane), yy);
#pragma unroll
        for (int j = 0; j < 4; ++j) { yd[step * 512 * (16 * c + l15) + quad * 4 + j] = yy[j]; sCm[(quad * 4 + j) * 24 + l15] = f2bf_sw(cm[j]); }
        LDS_FENCE();
        const bf16x8 fc = frag16(sCm, 0, 24, lane);
#pragma unroll
        for (int tn = 0; tn < 4; ++tn) { f32x4 ab = {0.f, 0.f, 0.f, 0.f}, ag = ab;
            bf16x8 fb = {0, 0, 0, 0, 0, 0, 0, 0}, fg = fb;
            if (quad < 2) { fb = *(const LAS bf16x8*)(pBt + tn * 4 * IS); fg = *(const LAS bf16x8*)(pBt + tn * 4 * IS + 64); }
            ab = MFMA16(fc, fb, ab); ag = MFMA16(va, fg, ag);
            const float w16 = pW[tn * 2 * IS];
#pragma unroll
            for (int j = 0; j < 4; ++j) S[tn][j] = (S[tn][j] - ab[j] + ag[j]) * w16; }
        LDS_FENCE();
    };
    for (int c2 = 0; c2 < nch; c2 += 2) { AP_CHUNK(rawA, vrA, c2); AP_CHUNK(rawB, vrB, c2 + 1); }
#undef AP_CHUNK
#undef AP_LOAD
#undef AP_STAGE
    if (s < 32) { float* so = p.out + O_RW + ((((size_t)(s * 2 + l) * 2 + d) * 8 + h) * 64 + 16 * rt) * 64;
#pragma unroll
        for (int tn = 0; tn < 4; ++tn)
#pragma unroll
            for (int j = 0; j < 4; ++j) so[(quad * 4 + j) * 64 + 16 * tn + l15] = S[tn][j]; }
}
constexpr int AP_LDS = (16 * 72 * 2 + 64 * 24 * 2 + 16 * 24 * 2) * 2 + 64 * 4 + (16 * 72 + 16 * 24) * 2;

typedef float f32x2 __attribute__((ext_vector_type(2)));
__device__ __forceinline__ void m2_phase(const Params& p, int l, int rep, LAS unsigned char* lds, const XcdBarrier& xbar) {
    const int tid_ = opaque_tid(); const int lane = tid_ & 63, wave = tid_ >> 6;
    LAS unsigned char* wl = lds + wave * 16384;
    const int G = gridDim.x, b = blockIdx.x, slot = b * 8 + wave, NW = G * 8;
    for (int t = slot; t < 2048; t += NW) cp_task(p, 8192 + t, lane, wl);
    xcd_barrier(xbar);
    const bool chain_wave = wave == 0 && b < 128;
    if (chain_wave) { for (int t = b; t < 128; t += G) ap_task(p, l, t, lane, wl); }
    else { const int nchain = G < 128 ? G : 128;
        const int idx = b < nchain ? b * 7 + (wave - 1) : nchain * 7 + (b - nchain) * 8 + wave;
        for (int t = idx; t < 8192; t += NW - nchain) cp_task(p, t, lane, wl); }
    xcd_barrier(xbar);
    for (int t = slot; t < 2048; t += NW) ap_task(p, l, 128 + t, lane, wl);
}

__device__ __forceinline__ void m3_phase(const Params& p, int l) {
    const int tid_ = opaque_tid(); const int lane = tid_ & 63, gw = blockIdx.x * 8 + (tid_ >> 6), NGW = gridDim.x * 8;
    const bf16_t* proj = (const bf16_t*)(p.ws + WS_PROJ);
    bf16_t* mixed = (bf16_t*)(p.ws + WS_UM);
    const int c = lane * 8;
    for (int tok = gw; tok < NTOK; tok += NGW) {
        const size_t o = (size_t)tok * 512 + c;
        {
            float y0[8], y1[8], g[8], bb[8], bn[8], gt[8], out[8];
            ld8f((const float*)(p.ws + WS_YD) + o, y0); ld8f((const float*)(p.ws + WS_YD) + (size_t)NTOK * 512 + o, y1);
            float s = 0.f;
#pragma unroll
            for (int e = 0; e < 8; ++e) { y0[e] += y1[e]; s += y0[e]; }
            s += __shfl_xor(s, 1); s += __shfl_xor(s, 2); s += __shfl_xor(s, 4);
            const float mu = s * (1.0f / 64.0f); float q = 0.f;
#pragma unroll
            for (int e = 0; e < 8; ++e) { y0[e] -= mu; q += y0[e] * y0[e]; }
            q += __shfl_xor(q, 1); q += __shfl_xor(q, 2); q += __shfl_xor(q, 4);
            const float rs = rsqrtf(q * (1.0f / 64.0f) + 64e-5f);
            ld8f(p.in[I_RGG] + l * 512 + c, g); ld8f(p.in[I_RGB] + l * 512 + c, bb);
            unpack8(*(const u32x4v*)((const bf16_t*)(p.ws + WS_SCBON) + o), bn);
            unpack8(*(const u32x4v*)(proj + (size_t)tok * NP + A_GATE + c), gt);
#pragma unroll
            for (int e = 0; e < 8; ++e) out[e] = (y0[e] * rs * g[e] + bb[e] + bn[e]) * siluf_(gt[e]);
            *(u32x4v*)(mixed + (size_t)tok * DM + c) = pack8(out);
        }
        {
            float h0[8], h1[8], g[8], bb[8], og[8], gt[8], out[8];
            ld8f((const float*)(p.ws + WS_HD) + o, h0); ld8f((const float*)(p.ws + WS_HD) + (size_t)NTOK * 512 + o, h1);
            unpack8(*(const u32x4v*)(proj + (size_t)tok * NP + B_O + c), og);
            float s = 0.f;
#pragma unroll
            for (int e = 0; e < 8; ++e) { h0[e] = (h0[e] + h1[e]) * sigmoidf_(og[e]); s += h0[e]; }
            s += __shfl_xor(s, 1); s += __shfl_xor(s, 2); s += __shfl_xor(s, 4); s += __shfl_xor(s, 8);
            const float mu = s * (1.0f / 128.0f); float q = 0.f;
#pragma unroll
            for (int e = 0; e < 8; ++e) { h0[e] -= mu; q += h0[e] * h0[e]; }
            q += __shfl_xor(q, 1); q += __shfl_xor(q, 2); q += __shfl_xor(q, 4); q += __shfl_xor(q, 8);
            const float rs = rsqrtf(q * (1.0f / 128.0f) + 1e-5f);
            ld8f(p.in[I_MGG] + l * 512 + c, g); ld8f(p.in[I_MGB] + l * 512 + c, bb);
            unpack8(*(const u32x4v*)(proj + (size_t)tok * NP + B_GATE + c), gt);
#pragma unroll
            for (int e = 0; e < 8; ++e) out[e] = (h0[e] * rs * g[e] + bb[e]) * siluf_(gt[e]);
            *(u32x4v*)(mixed + (size_t)tok * DM + 512 + c) = pack8(out);
        }
    }
}

__device__ __forceinline__ void ln_phase(const Params& p, int l) {
    const int tid_ = opaque_tid(); const int lane = tid_ & 63, gw = blockIdx.x * 8 + (tid_ >> 6), NGW = gridDim.x * 8;
    for (int tok0 = gw; tok0 < NTOK; tok0 += 2 * NGW) {
        const int tok1 = tok0 + NGW; const bool has1 = tok1 < NTOK;
        float* zr0 = p.out + O_Y + (size_t)tok0 * DM; float* zr1 = p.out + O_Y + (size_t)(has1 ? tok1 : tok0) * DM;
        float v0[4][8], v1[4][8]; float s0 = 0.f, s1 = 0.f;
#pragma unroll
        for (int j = 0; j < 4; ++j) { ld8f(zr0 + j * 512 + lane * 8, v0[j]); ld8f(zr1 + j * 512 + lane * 8, v1[j]); }
#pragma unroll
        for (int j = 0; j < 4; ++j)
#pragma unroll
            for (int e = 0; e < 8; ++e) { s0 += v0[j][e]; s1 += v1[j][e]; }
#pragma unroll
        for (int o = 1; o < 64; o <<= 1) { s0 += __shfl_xor(s0, o); s1 += __shfl_xor(s1, o); }
        const float mu0 = s0 * (1.0f / 2048.0f), mu1 = s1 * (1.0f / 2048.0f); float q0 = 0.f, q1 = 0.f;
#pragma unroll
        for (int j = 0; j < 4; ++j)
#pragma unroll
            for (int e = 0; e < 8; ++e) { v0[j][e] -= mu0; q0 += v0[j][e] * v0[j][e]; v1[j][e] -= mu1; q1 += v1[j][e] * v1[j][e]; }
#pragma unroll
        for (int o = 1; o < 64; o <<= 1) { q0 += __shfl_xor(q0, o); q1 += __shfl_xor(q1, o); }
        const float rs0 = rsqrtf(q0 * (1.0f / 2048.0f) + 1e-5f), rs1 = rsqrtf(q1 * (1.0f / 2048.0f) + 1e-5f);
        const float* mod0 = (const float*)(p.ws + WS_MOD) + (size_t)(3 + mod_row(tok0)) * 6144;
        const float* mod1 = (const float*)(p.ws + WS_MOD) + (size_t)(3 + mod_row(has1 ? tok1 : tok0)) * 6144;
        bf16_t* ur0 = (bf16_t*)(p.ws + WS_UM) + (size_t)tok0 * DM; bf16_t* ur1 = (bf16_t*)(p.ws + WS_UM) + (size_t)(has1 ? tok1 : tok0) * DM;
#pragma unroll
        for (int j = 0; j < 4; ++j) { const int c = j * 512 + lane * 8; float g[8], bb[8], y0[8], y1[8];
            ld8f(p.in[I_LNG] + l * DM + c, g); ld8f(p.in[I_LNB] + l * DM + c, bb);
#pragma unroll
            for (int e = 0; e < 8; ++e) { y0[e] = v0[j][e] * rs0 * g[e] + bb[e]; y1[e] = v1[j][e] * rs1 * g[e] + bb[e]; }
            *(float4*)(zr0 + c) = make_float4(y0[0], y0[1], y0[2], y0[3]); *(float4*)(zr0 + c + 4) = make_float4(y0[4], y0[5], y0[6], y0[7]);
            if (has1) { *(float4*)(zr1 + c) = make_float4(y1[0], y1[1], y1[2], y1[3]); *(float4*)(zr1 + c + 4) = make_float4(y1[4], y1[5], y1[6], y1[7]); }
            if (l == 0) { float sh[8], sc[8], o[8]; ld8f(mod0 + c, sh); ld8f(mod0 + 2048 + c, sc);
#pragma unroll
                for (int e = 0; e < 8; ++e) o[e] = y0[e] * (1.0f + sc[e]) + sh[e];
                *(u32x4v*)(ur0 + c) = pack8(o);
                if (has1) { ld8f(mod1 + c, sh); ld8f(mod1 + 2048 + c, sc);
#pragma unroll
                    for (int e = 0; e < 8; ++e) o[e] = y1[e] * (1.0f + sc[e]) + sh[e];
                    *(u32x4v*)(ur1 + c) = pack8(o); } } }
    }
}

#ifndef G2_ALIGN
#define G2_ALIGN true
#endif
#ifndef GEMM_ALIGN
#define GEMM_ALIGN true
#endif
#ifndef GEMM_SP2
#define GEMM_SP2 true
#endif
#ifndef DUP_P0B
#define DUP_P0B 0
#endif
#ifndef DUP_SYNC
#define DUP_SYNC 0
#endif
#ifndef DUP_M3
#define DUP_M3 0
#endif
#ifndef DUP_G2
#define DUP_G2 0
#endif
#ifndef DUP_P0
#define DUP_P0 0
#endif
#ifndef DUP_M1
#define DUP_M1 0
#endif
#ifndef DUP_M2
#define DUP_M2 0
#endif
#ifndef DUP_G1
#define DUP_G1 0
#endif
#ifndef DUP_MASK
#define DUP_MASK 7
#endif
#ifndef PH_ALL
#define PH_ALL 1
#endif
#ifndef PH_P0
#define PH_P0 PH_ALL
#endif
#ifndef PH_G1
#define PH_G1 PH_ALL
#endif
#ifndef PH_M1
#define PH_M1 PH_ALL
#endif
#ifndef PH_M2
#define PH_M2 PH_ALL
#endif
#ifndef PH_M3
#define PH_M3 PH_ALL
#endif
#ifndef PH_G2
#define PH_G2 PH_ALL
#endif
#ifndef PH_LN
#define PH_LN PH_ALL
#endif
__global__ void __launch_bounds__(NTHREADS) hybrid_fwd(Params p) {
    extern __shared__ __attribute__((aligned(16))) unsigned char smem[];
    LAS unsigned char* lds = (LAS unsigned char*)smem;
    cg::grid_group grid = cg::this_grid();
    volatile LAS unsigned* xst = (volatile LAS unsigned*)(lds + LDS_SLOT + 16);
    if (threadIdx.x == 0) { xst[0] = 0u; xst[1] = 0u; }
    __syncthreads();
    const XcdBarrier xbar = xcd_barrier_post((unsigned*)(p.ws + WS_BAR), xst);
#define GSYNC() xcd_barrier(xbar)
#if PH_P0
    for (int rep = 0; rep < 1 + DUP_P0; ++rep) { p0_phase(p, lds, rep); if (rep < DUP_P0) GSYNC(); }
#endif
    if (p.ws == nullptr) grid.sync();
    GSYNC();
#if PH_P0
    for (int rep = 0; rep < 1 + DUP_P0B; ++rep) p0b_phase(p);
#endif
    GSYNC();
    for (int i = 0; i < DUP_SYNC; ++i) GSYNC();
    for (int l = 0; l < 2; ++l) {
#if PH_G1
        for (int rep = 0; rep < 1 + DUP_G1; ++rep) {
            pg8::Gemm g; g.A = (const bf16_t*)(p.ws + WS_UM); g.Bt = (const bf16_t*)(p.ws + WS_WIN) + (size_t)l * NP * DM; g.M = NTOK; g.N = NP; g.K = DM;
            pg8::StaticOrder S; S.init(NTOK, NP, gridDim.x, blockIdx.x);
            EpiIn E; E.proj = (bf16_t*)(p.ws + WS_PROJ); E.gates = (float*)(p.ws + WS_GATES); E.newk = p.out + O_NK; E.newv = p.out + O_NV; E.rope = (const float*)(p.ws + WS_ROPE); E.layer = l;
            pg8::gemm_phase<EpiIn, pg8::StaticOrder, GEMM_ALIGN, GEMM_SP2>(lds, g, S, E);
            if (l == 0 && rep == 0) tr_tail_phase(p, lds);
            if (rep < DUP_G1) GSYNC();
        }
#endif
        GSYNC();
#if PH_M1
        for (int rep = 0; rep < 1 + DUP_M1; ++rep) { m1_phase(p, l, lds, rep, rep == 0 ? 7 : DUP_MASK); if (rep < DUP_M1) GSYNC(); }
#endif
        GSYNC();
#if PH_M2
        for (int rep = 0; rep < 1 + DUP_M2; ++rep) { m2_phase(p, l, rep, lds, xbar); if (rep < DUP_M2) GSYNC(); }
#endif
        GSYNC();
#if PH_M3
        for (int rep = 0; rep < 1 + DUP_M3; ++rep) m3_phase(p, l);
#endif
        GSYNC();
#if PH_G2
        for (int rep = 0; rep < 1 + (l == 0 ? DUP_G2 : 0); ++rep) {
            pg8::Gemm g; g.A = (const bf16_t*)(p.ws + WS_UM); g.Bt = (const bf16_t*)(p.ws + WS_WOUT) + (size_t)l * DM * DM; g.M = NTOK; g.N = DM; g.K = DM;
            pg8::StaticOrder S; S.init(NTOK, DM, gridDim.x, blockIdx.x);
            EpiOut E; E.xp = p.in[I_XP]; E.xs = p.in[I_XS]; E.mod = (const float*)(p.ws + WS_MOD) + (size_t)l * 3 * 6144; E.y = p.out + O_Y; E.layer = l;
            pg8::gemm_phase<EpiOut, pg8::StaticOrder, G2_ALIGN, GEMM_SP2>(lds, g, S, E);
            if (l == 0 && rep == 0) mod_tail_phase(p, lds);
            if (rep < (l == 0 ? DUP_G2 : 0)) GSYNC();
        }
#endif
        GSYNC();
#if PH_LN
        ln_phase(p, l);
#endif
        if (l == 0) GSYNC();
    }
}

extern "C" void kernel_launch(void* const* d_in, const int* in_sizes, int n_in, void* d_out, int out_size, void* d_ws, size_t ws_size, hipStream_t stream) {
    static int grid_blocks = 0;
    if (grid_blocks == 0) {
        if (n_in != 38 || ws_size < WS_END) { fprintf(stderr, "kernel_launch: unexpected n_in %d / ws_size %zu (need %zu)\n", n_in, ws_size, (size_t)WS_END); grid_blocks = -1; return; }
        int dev = 0, cus = 0, per_cu = 0;
        hipGetDevice(&dev);
        hipDeviceGetAttribute(&cus, hipDeviceAttributeMultiprocessorCount, dev);
        hipFuncSetAttribute((const void*)hybrid_fwd, hipFuncAttributeMaxDynamicSharedMemorySize, LDS_BYTES);
        hipOccupancyMaxActiveBlocksPerMultiprocessor(&per_cu, (const void*)hybrid_fwd, NTHREADS, LDS_BYTES);
        if (per_cu < 1) { fprintf(stderr, "kernel_launch: occupancy query gives %d blocks per CU\n", per_cu); per_cu = 1; }
        grid_blocks = cus * per_cu;
    }
    if (grid_blocks < 0) return;
    Params p{};
    for (int i = 0; i < 38; ++i) p.in[i] = (const float*)d_in[i];
    p.out = (float*)d_out; p.ws = (unsigned char*)d_ws;
    hipMemsetAsync(d_ws, 0, 32768, stream);
    void* args[] = {&p};
    hipError_t e = hipLaunchCooperativeKernel((const void*)hybrid_fwd, dim3(grid_blocks), dim3(NTHREADS), args, LDS_BYTES, stream);
    if (e != hipSuccess) fprintf(stderr, "cooperative launch failed: %s (grid %d)\n", hipGetErrorString(e), grid_blocks);
}
```

```cpp
#include <hip/hip_runtime.h>
#include <hip/hip_cooperative_groups.h>
#include <cstdio>
#include <cstdint>
namespace cg = cooperative_groups;
namespace pg8 {
#define PG8_LAS __attribute__((address_space(3)))
typedef unsigned short bf16_t;
typedef short bf16x8 __attribute__((ext_vector_type(8)));
typedef float f32x4 __attribute__((ext_vector_type(4)));
typedef unsigned u32x4 __attribute__((ext_vector_type(4)));
constexpr int BM = 256, BK = 64, HALF = 128, HTB = HALF * BK * 2  , STAGE_BYTES = 8 * HTB, NXCD = 8, WGM = 8;

__host__ __device__ __forceinline__ int lds_byte(int r, int c) { const int st = (r >> 4) * 2 + (c >> 5), rr = r & 15, cc = c & 31, ob = rr * 64 + cc * 2; return st * 1024 + (ob ^ (((ob >> 9) & 1) << 5)); }
__host__ __device__ __forceinline__ void stage_rc(int b, int& R, int& C) { const int st = b / 1024, sb = b % 1024, swz = sb ^ (((sb >> 9) & 1) << 5); R = (st >> 1) * 16 + swz / 64; C = (st & 1) * 32 + (swz % 64) / 2; }
__host__ __device__ __forceinline__ int perm32(int rho) { const int n = rho >> 4, i = rho & 15; return 8 * (i >> 2) + 4 * n + (i & 3); }

struct Unit { int pm, pn; };
struct Gemm { const bf16_t* A; const bf16_t* Bt; int M, N, K; };

struct StaticOrder {
    int nM, nN, nwg, G, c;
    __host__ __device__ void init(int M, int N, int G_, int c_) { nM = M / BM; nN = N / BM; nwg = nM * nN; G = G_; c = c_; }
    __host__ __device__ bool next(int i, Unit& u) const {
        const long L = (long)i * G + c; if (L >= nwg) return false;
        int wgid = (int)L; { const int q = nwg / NXCD, r = nwg % NXCD, xcd = wgid % NXCD, off = wgid / NXCD; wgid = (xcd < r ? xcd * (q + 1) : r * (q + 1) + (xcd - r) * q) + off; }
        const int nig = WGM * nN, gid = wgid / nig, fm = gid * WGM, gsz = (nM - fm) < WGM ? (nM - fm) : WGM;
        u.pm = fm + ((wgid % nig) % gsz); u.pn = (wgid % nig) / gsz; return true;
    }
    __device__ __forceinline__ void a_ready(const Unit&) const {}
    __device__ __forceinline__ void done(const Unit&) const {}
};
__device__ __forceinline__ unsigned cvt_pk_bf16(float lo, float hi) { unsigned r; asm volatile("v_cvt_pk_bf16_f32 %0, %1, %2" : "=v"(r) : "v"(lo), "v"(hi)); return r; }

template <class Epi, class Sched, bool ALIGN_EPI = false, bool SP2 = false>
__device__ __forceinline__ void gemm_phase(PG8_LAS unsigned char* lds, const Gemm g, const Sched& S, const Epi& E) {
    int tid = threadIdx.x; asm volatile("" : "+v"(tid)); const int wid = __builtin_amdgcn_readfirstlane(tid >> 6), lane = tid & 63, wr = wid >> 2, wc = wid & 3, fr = lane & 15, fq = lane >> 4;
    const int K = g.K, nt = K / BK;
    unsigned voffA[2], voffB[2];
#pragma unroll
    for (int i = 0; i < 2; ++i) { int R, C; stage_rc(tid * 16 + i * 8192, R, C); const int Rb = Epi::PERM ? ((R & ~31) + perm32(R & 31)) : R;
        voffA[i] = (unsigned)(R * K + C) * 2u; voffB[i] = (unsigned)(Rb * K + C) * 2u; }
    const size_t kstep = (size_t)(BK * 2);
    const size_t hstep = (size_t)HALF * K * 2;
    const size_t tstep = 2 * hstep;
    const unsigned ldsw = (unsigned)wid * 1024u;
    const int aoff = lds_byte(wr * 64 + fr, fq * 8), boff = lds_byte(wc * 32 + fr, fq * 8);
#define PG8_SA(b, h) (((b) * 2 + (h)) * HTB)
#define PG8_SB(b, h) ((4 + (b) * 2 + (h)) * HTB)
#define PG8_STAGE(bufoff, gbase, voff) do { _Pragma("unroll") for (int _i = 0; _i < 2; ++_i) \
        __builtin_amdgcn_global_load_lds((const unsigned*)((const char*)(gbase) + (voff)[_i]), (PG8_LAS unsigned*)(lds + (bufoff) + ldsw + _i * 8192), 16, 0, 0); } while (0)
#define PG8_LDA(dst, b, h) do { _Pragma("unroll") for (int m = 0; m < 4; ++m) _Pragma("unroll") for (int k = 0; k < 2; ++k) dst[m][k] = *(const PG8_LAS bf16x8*)(lds + PG8_SA(b, h) + aoff + m * 2048 + k * 1024); } while (0)
#define PG8_LDB(dst, b, h) do { _Pragma("unroll") for (int n = 0; n < 2; ++n) _Pragma("unroll") for (int k = 0; k < 2; ++k) dst[n][k] = *(const PG8_LAS bf16x8*)(lds + PG8_SB(b, h) + boff + n * 2048 + k * 1024); } while (0)
#define PG8_MMA(ai, bj, At, Bt) do { __builtin_amdgcn_s_setprio(1); _Pragma("unroll") for (int m = 0; m < 4; ++m) _Pragma("unroll") for (int n = 0; n < 2; ++n) _Pragma("unroll") for (int k = 0; k < 2; ++k) \
        acc[ai][bj][m][n] = __builtin_amdgcn_mfma_f32_16x16x32_bf16(Bt[n][k], At[m][k], acc[ai][bj][m][n], 0, 0, 0); __builtin_amdgcn_s_setprio(0); } while (0)
#define PG8_WAIT_V(n) asm volatile("s_waitcnt vmcnt(" #n ")" ::: "memory")
#define PG8_WAIT_L(n) asm volatile("s_waitcnt lgkmcnt(" #n ")" ::: "memory")
#define PG8_BAR __builtin_amdgcn_s_barrier()
#define PG8_SCHED __builtin_amdgcn_sched_barrier(0)
    Unit cur, nxt; int ui = 0;
    if (!S.next(0, cur)) return;
    f32x4 acc[2][2][4][2];
#pragma unroll
    for (int a = 0; a < 2; ++a)
#pragma unroll
        for (int b = 0; b < 2; ++b)
#pragma unroll
            for (int m = 0; m < 4; ++m)
#pragma unroll
                for (int n = 0; n < 2; ++n) acc[a][b][m][n] = (f32x4){0.f, 0.f, 0.f, 0.f};
    bf16x8 At[4][2], B0[2][2], B1[2][2];
    const char* cA = (const char*)g.A + (size_t)cur.pm * tstep; const char* cB = (const char*)g.Bt + (size_t)cur.pn * tstep;
    S.a_ready(cur);
    if constexpr (SP2) {
        PG8_STAGE(PG8_SB(0, 0), cB, voffB); PG8_STAGE(PG8_SB(0, 1), cB + hstep, voffB); PG8_STAGE(PG8_SA(0, 0), cA, voffA); PG8_STAGE(PG8_SA(0, 1), cA + hstep, voffA);
        if (wr == 1) PG8_BAR;
        PG8_WAIT_V(2); PG8_BAR;
        PG8_STAGE(PG8_SB(1, 0), cB + kstep, voffB); PG8_STAGE(PG8_SA(1, 0), cA + kstep, voffA); PG8_STAGE(PG8_SB(1, 1), cB + hstep + kstep, voffB);
        PG8_WAIT_V(6); PG8_BAR;
    } else {
        PG8_STAGE(PG8_SB(0, 0), cB, voffB); PG8_STAGE(PG8_SA(0, 0), cA, voffA); PG8_STAGE(PG8_SB(0, 1), cB + hstep, voffB); PG8_STAGE(PG8_SA(0, 1), cA + hstep, voffA);
        if (wr == 1) PG8_BAR;
        PG8_WAIT_V(4); PG8_BAR;
        PG8_STAGE(PG8_SB(1, 0), cB + kstep, voffB); PG8_STAGE(PG8_SA(1, 0), cA + kstep, voffA); PG8_STAGE(PG8_SB(1, 1), cB + hstep + kstep, voffB);
        PG8_WAIT_V(6); PG8_BAR;
    }
    for (;;) {
        const bool has_next = S.next(ui + 1, nxt);
        const char* nA = has_next ? (const char*)g.A + (size_t)nxt.pm * tstep : cA; const char* nB = has_next ? (const char*)g.Bt + (size_t)nxt.pn * tstep : cB;
        for (int t = 0; t < nt; t += 2) {
            const bool last = (t == nt - 2);
            const char* a1 = cA + (size_t)(t + 1) * kstep;
            const char* a2 = last ? nA : cA + (size_t)(t + 2) * kstep; const char* b2 = last ? nB : cB + (size_t)(t + 2) * kstep;
            const char* a3 = a2 + kstep; const char* b3 = b2 + kstep;
            if (last && has_next) S.a_ready(nxt);
            if constexpr (SP2) {
            PG8_LDB(B0, 0, 0); PG8_LDB(B1, 0, 1); PG8_SCHED; PG8_LDA(At, 0, 0); PG8_STAGE(PG8_SA(1, 1), a1 + hstep, voffA);
            PG8_WAIT_V(8); PG8_WAIT_L(0); PG8_BAR; PG8_MMA(0, 0, At, B0); PG8_MMA(0, 1, At, B1); PG8_BAR; PG8_SCHED;
            PG8_LDA(At, 0, 1); PG8_STAGE(PG8_SB(0, 0), b2, voffB); PG8_STAGE(PG8_SB(0, 1), b2 + hstep, voffB); PG8_STAGE(PG8_SA(0, 0), a2, voffA);
            PG8_WAIT_V(8); PG8_WAIT_L(0); PG8_BAR; PG8_MMA(1, 0, At, B0); PG8_MMA(1, 1, At, B1); PG8_BAR; PG8_SCHED;
            PG8_LDB(B0, 1, 0); PG8_LDB(B1, 1, 1); PG8_SCHED; PG8_LDA(At, 1, 0); PG8_STAGE(PG8_SA(0, 1), a2 + hstep, voffA);
            PG8_WAIT_V(8); PG8_WAIT_L(0); PG8_BAR; PG8_MMA(0, 0, At, B0); PG8_MMA(0, 1, At, B1); PG8_BAR; PG8_SCHED;
            PG8_LDA(At, 1, 1); PG8_STAGE(PG8_SB(1, 0), b3, voffB); PG8_STAGE(PG8_SB(1, 1), b3 + hstep, voffB); PG8_STAGE(PG8_SA(1, 0), a3, voffA);
            PG8_WAIT_V(8); PG8_WAIT_L(0); PG8_BAR; PG8_MMA(1, 0, At, B0); PG8_MMA(1, 1, At, B1); PG8_BAR; PG8_SCHED;
            } else {
            PG8_LDB(B0, 0, 0); PG8_SCHED; PG8_LDA(At, 0, 0); PG8_STAGE(PG8_SA(1, 1), a1 + hstep, voffA);
            PG8_WAIT_L(8); PG8_BAR; PG8_WAIT_L(0); PG8_MMA(0, 0, At, B0); PG8_BAR; PG8_SCHED;
            PG8_LDB(B1, 0, 1); PG8_STAGE(PG8_SB(0, 0), b2, voffB);
            PG8_BAR; PG8_WAIT_L(0); PG8_MMA(0, 1, At, B1); PG8_BAR;
            PG8_LDA(At, 0, 1); PG8_STAGE(PG8_SA(0, 0), a2, voffA);
            PG8_BAR; PG8_WAIT_L(0); PG8_MMA(1, 0, At, B0); PG8_BAR; PG8_SCHED;
            PG8_STAGE(PG8_SB(0, 1), b2 + hstep, voffB);
            PG8_WAIT_V(6); PG8_BAR; PG8_MMA(1, 1, At, B1); PG8_BAR;
            PG8_LDB(B0, 1, 0); PG8_SCHED; PG8_LDA(At, 1, 0); PG8_STAGE(PG8_SA(0, 1), a2 + hstep, voffA);
            PG8_WAIT_L(8); PG8_BAR; PG8_WAIT_L(0); PG8_MMA(0, 0, At, B0); PG8_BAR; PG8_SCHED;
            PG8_LDB(B1, 1, 1); PG8_STAGE(PG8_SB(1, 0), b3, voffB);
            PG8_BAR; PG8_WAIT_L(0); PG8_MMA(0, 1, At, B1); PG8_BAR;
            PG8_LDA(At, 1, 1); PG8_STAGE(PG8_SA(1, 0), a3, voffA);
            PG8_BAR; PG8_WAIT_L(0); PG8_MMA(1, 0, At, B0); PG8_BAR; PG8_SCHED;
            PG8_STAGE(PG8_SB(1, 1), b3 + hstep, voffB);
            PG8_WAIT_V(6); PG8_BAR; PG8_MMA(1, 1, At, B1); PG8_BAR;
            }
        }
        if constexpr (ALIGN_EPI) { if (wr == 0) PG8_BAR; }
        if constexpr (!Epi::AFTER_DRAIN) { E(acc, cur, wr, wc, fr, fq); S.done(cur); }
        if (!has_next) break;
#pragma unroll
        for (int a = 0; a < 2; ++a)
#pragma unroll
            for (int b = 0; b < 2; ++b)
#pragma unroll
                for (int m = 0; m < 4; ++m)
#pragma unroll
                    for (int n = 0; n < 2; ++n) acc[a][b][m][n] = (f32x4){0.f, 0.f, 0.f, 0.f};
        cur = nxt; cA = nA; cB = nB; ++ui;
        if constexpr (ALIGN_EPI) { if (wr == 1) PG8_BAR; }
    }
    PG8_WAIT_V(0);
    if constexpr (!ALIGN_EPI) { if (wr == 0) PG8_BAR; }
    PG8_BAR;
    if constexpr (Epi::AFTER_DRAIN) { E.fused(acc, cur, wr, wc, fr, fq, lds, wid, lane); S.done(cur); }
#undef PG8_SA
#undef PG8_SB
#undef PG8_STAGE
#undef PG8_LDA
#undef PG8_LDB
#undef PG8_MMA
#undef PG8_WAIT_V
#undef PG8_WAIT_L
#undef PG8_BAR
#undef PG8_SCHED
}
}

#define LAS __attribute__((address_space(3)))
#ifndef DUP_M2MASK
#define DUP_M2MASK 3
#endif
typedef unsigned short bf16_t;
typedef short bf16x8 __attribute__((ext_vector_type(8)));
typedef float f32x4 __attribute__((ext_vector_type(4)));
typedef unsigned u32x4v __attribute__((ext_vector_type(4)));
typedef unsigned u32x2v __attribute__((ext_vector_type(2)));

constexpr int NTOK = 10240, NPT = 8192, DM = 2048, NP = 9216, PIN = 8976;
constexpr int C_Q = 4864, C_K = 5888, C_V = 6912, C_G = 7936, C_IF = 8960;
constexpr int A_WD = 1536, A_AD = 1664, A_GATE = 1792;
constexpr int B_Q = 2304, B_V = 3328, B_O = 3840, B_GATE = 4352;
constexpr int NTHREADS = 512;
constexpr int LDS_SLOT = 131072, LDS_BYTES = 131072 + 1024;

constexpr size_t WS_CTL = 0;
constexpr size_t WS_BAR = 8192;
constexpr size_t WS_MOD = 32768;
constexpr size_t WS_ROPE = WS_MOD + 147456;
constexpr size_t WS_LAM = WS_ROPE + 8192;
constexpr size_t WS_WIN = WS_LAM + 256;
constexpr size_t WS_WOUT = WS_WIN + 2ull * NP * DM * 2;
constexpr size_t WS_UM = WS_WOUT + 2ull * DM * DM * 2;
constexpr size_t WS_PROJ = WS_UM + (size_t)NTOK * DM * 2;
constexpr size_t WS_GATES = WS_PROJ + (size_t)NTOK * NP * 2;
constexpr size_t SZ16 = (size_t)NTOK * 512 * 2, SZ32 = (size_t)NTOK * 512 * 4;
constexpr size_t WS_SCV = WS_GATES + (size_t)NTOK * 16 * 4;
constexpr size_t WS_SCBON = WS_SCV + SZ16;
constexpr size_t WS_PK = WS_SCBON + SZ16;
constexpr size_t SZPK = (size_t)NTOK * 8 * 320 * 2;
constexpr size_t WS_YD = WS_PK + 2 * SZPK;
constexpr size_t WS_HD = WS_YD + 2 * SZ32;
constexpr size_t WS_KC = WS_HD + 2 * SZ32;
constexpr size_t WS_VTC = WS_KC + 4194304;
constexpr size_t WS_WUPT = WS_VTC + 4194304;
constexpr size_t WS_END = WS_WUPT + 524288;

constexpr size_t O_Y = 0, O_NK = 20971520, O_NV = 37748736, O_RW = 54525952, O_MC = 58720256, O_MN = 67108864, O_MM = 67174400;

struct Params { const float* in[38]; float* out; unsigned char* ws; };
enum { I_XP = 0, I_XS, I_CK, I_CV, I_SRW, I_SMC, I_SMN, I_SMM, I_C, I_CCTX, I_WADA, I_BADA, I_WIN, I_CAW, I_CAB, I_W0, I_WUP, I_A0, I_AUP, I_KK, I_KA, I_RK,
       I_RGG, I_RGB, I_CBW, I_CBB, I_BI, I_BF, I_MGG, I_MGB, I_LQ1, I_LK1, I_LQ2, I_LK2, I_SUBG, I_WOUT, I_LNG, I_LNB };

__device__ __forceinline__ float bf2f(bf16_t v) { return __uint_as_float(((unsigned)v) << 16); }
__device__ __forceinline__ float bflo(unsigned w) { return __uint_as_float(w << 16); }
__device__ __forceinline__ float bfhi(unsigned w) { return __uint_as_float(w & 0xffff0000u); }
__device__ __forceinline__ unsigned pk2(float lo, float hi) { return pg8::cvt_pk_bf16(lo, hi); }
__device__ __forceinline__ bf16_t f2bf(float f) { return (bf16_t)(pk2(f, 0.f) & 0xffffu); }
__device__ __forceinline__ void unpack8(const u32x4v w, float (&o)[8]) { o[0] = bflo(w.x); o[1] = bfhi(w.x); o[2] = bflo(w.y); o[3] = bfhi(w.y); o[4] = bflo(w.z); o[5] = bfhi(w.z); o[6] = bflo(w.w); o[7] = bfhi(w.w); }
__device__ __forceinline__ u32x4v pack8(const float (&o)[8]) { u32x4v w; w.x = pk2(o[0], o[1]); w.y = pk2(o[2], o[3]); w.z = pk2(o[4], o[5]); w.w = pk2(o[6], o[7]); return w; }
__device__ __forceinline__ void ld8f(const float* p, float (&o)[8]) { const float4 a = *(const float4*)p, b = *(const float4*)(p + 4); o[0] = a.x; o[1] = a.y; o[2] = a.z; o[3] = a.w; o[4] = b.x; o[5] = b.y; o[6] = b.z; o[7] = b.w; }
__device__ __forceinline__ float sigmoidf_(float x) { return __builtin_amdgcn_rcpf(1.0f + __expf(-x)); }
__device__ __forceinline__ float siluf_(float x) { return x * __builtin_amdgcn_rcpf(1.0f + __expf(-x)); }
__device__ __forceinline__ float tanhf_(float x) { return 1.0f - 2.0f * __builtin_amdgcn_rcpf(1.0f + __expf(2.0f * x)); }
__device__ __forceinline__ bf16x8 frag(const LAS bf16_t* base, int row0, int ld, int k0, int lane) { return *(const LAS bf16x8*)(base + (row0 + (lane & 15)) * ld + k0 + (lane >> 4) * 8); }
__device__ __forceinline__ bf16x8 fragsw(const LAS bf16_t* base, int row0, int k0, int lane) { const int r = row0 + (lane & 15), m = (k0 >> 3) + (lane >> 4); return *(const LAS bf16x8*)(base + r * 72 + 8 * (m ^ ((r >> 3) & 7))); }
#define MFMA16(a, b, c) __builtin_amdgcn_mfma_f32_16x16x32_bf16((a), (b), (c), 0, 0, 0)
#define LDS_FENCE() asm volatile("s_waitcnt lgkmcnt(0)" ::: "memory")
template <int CTRL> __device__ __forceinline__ float dppf(float x) { return __builtin_bit_cast(float, __builtin_amdgcn_mov_dpp(__builtin_bit_cast(int, x), CTRL, 0xf, 0xf, true)); }
__device__ __forceinline__ float red16_sum(float x) { x += dppf<0xB1>(x); x += dppf<0x4E>(x); x += dppf<0x124>(x); x += dppf<0x128>(x); return x; }
__device__ __forceinline__ float red4_sum(float x) { x += dppf<0xB1>(x); x += dppf<0x4E>(x); return x; }
__device__ __forceinline__ float red16_max(float x) { x = fmaxf(x, dppf<0xB1>(x)); x = fmaxf(x, dppf<0x4E>(x)); x = fmaxf(x, dppf<0x124>(x)); x = fmaxf(x, dppf<0x128>(x)); return x; }

__device__ __forceinline__ int opaque_tid() { int t = threadIdx.x; asm volatile("" : "+v"(t)); return t; }
__device__ __forceinline__ int next_task(unsigned* ctr, LAS int* slot) {
    __syncthreads();
    if (threadIdx.x == 0) *slot = (int)atomicAdd(ctr, 1u);
    __syncthreads();
    return *slot;
}
#define QNEXT_BEGIN(ctr) unsigned qn_ = 0u; if (threadIdx.x == 0) qn_ = atomicAdd((ctr), 1u)
#define QNEXT_END(slot, t) do { __syncthreads(); if (threadIdx.x == 0) *(slot) = (int)qn_; __syncthreads(); (t) = *(slot); } while (0)
__device__ __forceinline__ int win_src_col(int n) { return n < 4352 ? n : (n < 8960 ? n + 16 : (n < 8976 ? n - 8960 + 4352 : -1)); }
__device__ __forceinline__ int mod_row(int tok) { return tok < NPT ? 0 : 1 + ((tok - NPT) >> 10); }

__device__ __forceinline__ void p0_mod_item(const Params& p, int item, LAS unsigned char* lds) {
    const int tid = opaque_tid(), lane = tid & 63, wave = tid >> 6, kq = lane >> 4, cq = lane & 15;
    const int l = item / 96, cb = item % 96;
    LAS float* sS = (LAS float*)lds;
    LAS float* sRed = sS + 3 * 2048;
    for (int e = tid; e < 3 * 2048; e += NTHREADS) { const int r = e >> 11, k = e & 2047; const float cv = r == 0 ? p.in[I_CCTX][k] : p.in[I_C][(r - 1) * 2048 + k]; sS[e] = siluf_(cv); }
    __syncthreads();
    const float* W = p.in[I_WADA] + (size_t)l * 2048 * 6144 + cb * 64 + 4 * cq;
    float4 a0 = {0, 0, 0, 0}, a1 = a0, a2 = a0;
#pragma unroll 16
    for (int i = 0; i < 64; ++i) { const int k = wave * 256 + i * 4 + kq; const float4 w = *(const float4*)(W + (size_t)k * 6144);
        const float s0 = sS[k], s1 = sS[2048 + k], s2 = sS[4096 + k];
        a0.x += s0 * w.x; a0.y += s0 * w.y; a0.z += s0 * w.z; a0.w += s0 * w.w;
        a1.x += s1 * w.x; a1.y += s1 * w.y; a1.z += s1 * w.z; a1.w += s1 * w.w;
        a2.x += s2 * w.x; a2.y += s2 * w.y; a2.z += s2 * w.z; a2.w += s2 * w.w; }
    float v[12] = {a0.x, a0.y, a0.z, a0.w, a1.x, a1.y, a1.z, a1.w, a2.x, a2.y, a2.z, a2.w};
#pragma unroll
    for (int i = 0; i < 12; ++i) { v[i] += __shfl_xor(v[i], 16); v[i] += __shfl_xor(v[i], 32); }
    if (kq == 0) {
#pragma unroll
        for (int r = 0; r < 3; ++r)
#pragma unroll
            for (int e = 0; e < 4; ++e) sRed[(wave * 3 + r) * 64 + 4 * cq + e] = v[r * 4 + e];
    }
    __syncthreads();
    if (tid < 192) { const int r = tid >> 6, c = tid & 63; float s = 0.f;
#pragma unroll
        for (int w = 0; w < 8; ++w) s += sRed[(w * 3 + r) * 64 + c];
        ((float*)(p.ws + WS_MOD))[(l * 3 + r) * 6144 + cb * 64 + c] = s + p.in[I_BADA][l * 6144 + cb * 64 + c]; }
}
template <bool MAPCOL> __device__ __forceinline__ void p0_transpose_item(const float* W, int N, int nblk, bf16_t* WT, LAS float* scr, int item, int lane) {
    const int kb = item / nblk, nb = item % nblk, k0 = 64 * kb, n0 = 32 * nb;
    const int n = n0 + (lane & 31); const int oc = MAPCOL ? win_src_col(n) : n;
    float tv[32];
    const float* wp = W + (size_t)(k0 + (lane >> 5)) * N + (oc >= 0 ? oc : 0);
#pragma unroll
    for (int i = 0; i < 32; ++i) tv[i] = wp[(size_t)(2 * i) * N];
#pragma unroll
    for (int i = 0; i < 32; ++i) scr[(2 * i + (lane >> 5)) * 33 + (lane & 31)] = oc >= 0 ? tv[i] : 0.f;
    LDS_FENCE();
    const int c = lane & 7;
#pragma unroll
    for (int j = 0; j < 4; ++j) { const int nn = (lane >> 3) + 8 * j; const LAS float* s = scr + (8 * c) * 33 + nn;
        u32x4v o; o.x = pk2(s[0 * 33], s[1 * 33]); o.y = pk2(s[2 * 33], s[3 * 33]); o.z = pk2(s[4 * 33], s[5 * 33]); o.w = pk2(s[6 * 33], s[7 * 33]);
        *(u32x4v*)(WT + (size_t)(n0 + nn) * 2048 + k0 + 8 * c) = o; }
    LDS_FENCE();
}
__device__ __forceinline__ void p0_phase(const Params& p, LAS unsigned char* lds, int rep) {
    const int tid = opaque_tid(), lane = tid & 63, wave = tid >> 6;
    unsigned* ctr = (unsigned*)(p.ws + WS_CTL) + 64 * 15 * rep;
    LAS int* slot = (LAS int*)(lds + LDS_SLOT);
    constexpr int NT_MOD = 96  , NT_TR = 1408  , NT_A = NT_MOD + 1 + NT_TR, NT_KC = 512, NT_VT = 512, NT_WU = 64, NT = NT_A + NT_KC + NT_VT + NT_WU;
    for (;;) {
        const int t = next_task(ctr, slot);
        if (t >= NT) break;
        if (t < NT_MOD) { p0_mod_item(p, t, lds); continue; }
        if (t == NT_MOD) {
            float* rope = (float*)(p.ws + WS_ROPE);
            for (int e = tid; e < 1024; e += NTHREADS) { const int pos = e >> 4, i = e & 15; const float inv = 1.0f / powf(10000.0f, (float)(2 * i) / 32.0f); const float ang = (float)pos * inv;
                rope[pos * 32 + i] = cosf(ang); rope[pos * 32 + 16 + i] = sinf(ang); }
            if (tid < 2) { const int l = tid; float d1 = 0.f, d2 = 0.f;
                for (int i = 0; i < 64; ++i) { d1 += p.in[I_LQ1][l * 64 + i] * p.in[I_LK1][l * 64 + i]; d2 += p.in[I_LQ2][l * 64 + i] * p.in[I_LK2][l * 64 + i]; }
                const float lam_init = 0.8f - 0.6f * expf(-0.3f * (float)l);
                ((float*)(p.ws + WS_LAM))[l] = expf(d1) - expf(d2) + lam_init; }
            continue;
        }
        if (t >= NT_A) {
            int u = t - NT_A;
            if (u < NT_KC) { const size_t o = ((size_t)u * 512 + tid) * 8; float x[8]; ld8f(p.in[I_CK] + o, x); *(u32x4v*)((bf16_t*)(p.ws + WS_KC) + o) = pack8(x); continue; }
            u -= NT_KC;
            if (u < NT_VT) { const int idx = u * 512 + tid, dv = idx & 127, m = (idx >> 7) & 63, bh = idx >> 13; float x[8];
#pragma unroll
                for (int e = 0; e < 8; ++e) x[e] = p.in[I_CV][((size_t)bh * 512 + 8 * m + e) * 128 + dv];
                *(u32x4v*)((bf16_t*)(p.ws + WS_VTC) + ((size_t)bh * 128 + dv) * 512 + 8 * m) = pack8(x); continue; }
            u -= NT_VT;
#pragma unroll
            for (int e = 0; e < 8; ++e) { const int f = u * 4096 + e * 512 + tid, c = f & 63, j = (f >> 6) & 63, h = (f >> 12) & 7, which = (f >> 15) & 1, ld = f >> 16;
                const float v = (which ? p.in[I_AUP] : p.in[I_WUP])[((size_t)ld * 64 + j) * 512 + h * 64 + c];
                ((bf16_t*)(p.ws + WS_WUPT))[(f & ~4095) + c * 64 + j] = f2bf(v); }
            continue;
        }
        int it = (t - NT_MOD - 1) * 8 + wave;
        LAS float* scr = (LAS float*)(lds + wave * 8704);
        const int l = it / 11264; it -= l * 11264;
        if (it < 9216) p0_transpose_item<true>(p.in[I_WIN] + (size_t)l * 2048 * PIN, PIN, 288, (bf16_t*)(p.ws + WS_WIN) + (size_t)l * NP * 2048, scr, it, lane);
        else p0_transpose_item<false>(p.in[I_WOUT] + (size_t)l * 2048 * 2048, 2048, 64, (bf16_t*)(p.ws + WS_WOUT) + (size_t)l * 2048 * 2048, scr, it - 9216, lane);
    }
}
__device__ __forceinline__ void mod_tail_phase(const Params& p, LAS unsigned char* lds) {
    unsigned* ctr = (unsigned*)(p.ws + WS_CTL) + 64 * 13;
    LAS int* slot = (LAS int*)(lds + LDS_SLOT);
    for (;;) { const int t = next_task(ctr, slot); if (t >= 96) break; p0_mod_item(p, 96 + t, lds); }
}
__device__ __forceinline__ void tr_tail_phase(const Params& p, LAS unsigned char* lds, int lo, int hi, int cidx) {
    const int tid = opaque_tid(), lane = tid & 63, wave = tid >> 6;
    unsigned* ctr = (unsigned*)(p.ws + WS_CTL) + 64 * cidx;
    LAS int* slot = (LAS int*)(lds + LDS_SLOT);
    for (;;) {
        const int t = lo + next_task(ctr, slot);
        if (t >= hi) break;
        int it = t * 8 + wave;
        LAS float* scr = (LAS float*)(lds + wave * 8704);
        if (it < 9216) p0_transpose_item<true>(p.in[I_WIN] + (size_t)2048 * PIN, PIN, 288, (bf16_t*)(p.ws + WS_WIN) + (size_t)NP * 2048, scr, it, lane);
        else p0_transpose_item<false>(p.in[I_WOUT] + (size_t)2048 * 2048, 2048, 64, (bf16_t*)(p.ws + WS_WOUT) + (size_t)2048 * 2048, scr, it - 9216, lane);
    }
}
__device__ __forceinline__ void modulate_row(const float* xrow, const float* mod, bf16_t* urow, int lane) {
#pragma unroll
    for (int j = 0; j < 4; ++j) { const int c = j * 512 + lane * 8; float x[8], sh[8], sc[8], o[8]; ld8f(xrow + c, x); ld8f(mod + c, sh); ld8f(mod + 2048 + c, sc);
#pragma unroll
        for (int e = 0; e < 8; ++e) o[e] = x[e] * (1.0f + sc[e]) + sh[e];
        *(u32x4v*)(urow + c) = pack8(o); }
}
__device__ __forceinline__ void p0b_phase(const Params& p) {
    const int tid_ = opaque_tid(); const int lane = tid_ & 63, gw = blockIdx.x * 8 + (tid_ >> 6), NGW = gridDim.x * 8;
    for (int tok = gw; tok < NTOK; tok += NGW) {
        const float* xrow = tok < NPT ? p.in[I_XP] + (size_t)tok * DM : p.in[I_XS] + (size_t)(tok - NPT) * DM;
        modulate_row(xrow, (const float*)(p.ws + WS_MOD) + mod_row(tok) * 6144, (bf16_t*)(p.ws + WS_UM) + (size_t)tok * DM, lane);
    }
}

struct EpiIn {
    static constexpr bool PERM = true, AFTER_DRAIN = false;
    bf16_t* proj; float* gates; float* newk; float* newv; const float* rope; int layer;
    __device__ __forceinline__ void operator()(const f32x4 (&acc)[2][2][4][2], const pg8::Unit& u, int wr, int wc, int fr, int fq) const {
        const int row0 = u.pm * 256 + wr * 64 + fr, col0 = u.pn * 256 + wc * 32 + 8 * fq;
        const bool samp = u.pm >= 32;
        const bool is_rope = samp && u.pn >= 19 && u.pn < 27;
        const bool is_k = !samp && u.pn >= 23 && u.pn < 27, is_v = !samp && u.pn >= 27 && u.pn < 31, is_g = u.pn == 35;
#pragma unroll
        for (int ai = 0; ai < 2; ++ai)
#pragma unroll
            for (int m = 0; m < 4; ++m) {
                const int row = row0 + ai * 128 + m * 16;
                float cs[8], sn[8];
                if (is_rope) { const int pos = (row - NPT) & 1023; const int pp = (wc & 1) ? (pos & 63) : (pos >> 6); const float* rp = rope + pp * 32 + 8 * (fq & 1); ld8f(rp, cs); ld8f(rp + 16, sn); }
#pragma unroll
                for (int bj = 0; bj < 2; ++bj) {
                    f32x4 v0 = acc[ai][bj][m][0], v1 = acc[ai][bj][m][1];
                    if (is_rope) {
                        const float sg = (fq & 2) ? 1.0f : -1.0f;
#pragma unroll
                        for (int e = 0; e < 4; ++e) { const float p0 = __shfl_xor(v0[e], 32), p1 = __shfl_xor(v1[e], 32);
                            v0[e] = v0[e] * cs[e] + sg * p0 * sn[e]; v1[e] = v1[e] * cs[4 + e] + sg * p1 * sn[4 + e]; }
                    }
                    const int col = col0 + bj * 128;
                    u32x4v w; w.x = pk2(v0[0], v0[1]); w.y = pk2(v0[2], v0[3]); w.z = pk2(v1[0], v1[1]); w.w = pk2(v1[2], v1[3]);
                    *(u32x4v*)(proj + (size_t)row * NP + col) = w;
                    if (is_k || is_v) { const int ck = col - (is_k ? C_K : C_V), h = ck >> 7, j = ck & 127, b = row >> 8, t = row & 255;
                        float* dst = (is_k ? newk : newv) + ((((size_t)(b * 2 + layer) * 8 + h) * 256 + t) * 128 + j);
                        *(f32x4*)dst = v0; *(f32x4*)(dst + 4) = v1; }
                    if (is_g && bj == 0 && wc == 0 && fq < 2) { float* dst = gates + (size_t)row * 16 + 8 * fq; *(f32x4*)dst = v0; *(f32x4*)(dst + 4) = v1; }
                }
            }
    }
};
struct EpiOut {
    static constexpr bool PERM = false, AFTER_DRAIN = false;
    const float* xp; const float* xs; const float* mod; float* y; int layer;
    __device__ __forceinline__ void operator()(const f32x4 (&acc)[2][2][4][2], const pg8::Unit& u, int wr, int wc, int fr, int fq) const {
        const int row0 = u.pm * 256 + wr * 64 + fr, col0 = u.pn * 256 + wc * 32 + 4 * fq;
#pragma unroll
        for (int ai = 0; ai < 2; ++ai)
#pragma unroll
            for (int m = 0; m < 4; ++m) {
                const int row = row0 + ai * 128 + m * 16;
                const float* xrow = layer == 0 ? (row < NPT ? xp + (size_t)row * DM : xs + (size_t)(row - NPT) * DM) : y + (size_t)row * DM;
                const float* g = mod + mod_row(row) * 6144 + 4096;
#pragma unroll
                for (int bj = 0; bj < 2; ++bj)
#pragma unroll
                    for (int n = 0; n < 2; ++n) { const int c = col0 + bj * 128 + n * 16;
                        const f32x4 xv = *(const f32x4*)(xrow + c), gv = *(const f32x4*)(g + c);
                        *(f32x4*)(y + (size_t)row * DM + c) = 1.41421356237f * xv + gv * acc[ai][bj][m][n]; }
            }
    }
};

#define XB_TMO      128
#define XB_XCNT(j)  (256  + 64 * (j))
#define XB_XSUB(j)  (1280 + 64 * (j))
#define XB_XGEN(j)  (2304 + 64 * (j))
#define XB_TOP      3328
#define XB_TOPGEN   3392
#define XCD_BAR_WORDS 3456
#define XB_SPIN_CAP (1u << 18)

__device__ __forceinline__ unsigned xb_ld(unsigned* p)              { return __hip_atomic_load(p, __ATOMIC_RELAXED, __HIP_MEMORY_SCOPE_AGENT); }
__device__ __forceinline__ unsigned xb_add(unsigned* p, unsigned v) { return __hip_atomic_fetch_add(p, v, __ATOMIC_RELAXED, __HIP_MEMORY_SCOPE_AGENT); }
__device__ __forceinline__ unsigned xb_xcc_id() { return (unsigned)__builtin_amdgcn_s_getreg((3 << 11) | 20) & 0xFu; }
#define XB_SPIN(cond, bar) do { unsigned _sp = 0; while (cond) { __builtin_amdgcn_s_sleep(1); \
    if ((++_sp & 255u) == 0u) { if (xb_ld(&(bar)[XB_TMO])) break; if (_sp > XB_SPIN_CAP) { atomicAdd(&(bar)[XB_TMO], 1u); break; } } } } while (0)

struct XcdBarrier {
    unsigned* bar; unsigned x;
    volatile LAS unsigned* st;
};

__device__ __forceinline__ XcdBarrier xcd_barrier_post(unsigned* bar, volatile LAS unsigned* st) {
    XcdBarrier b; b.bar = bar; b.x = xb_xcc_id(); b.st = st;
    if (threadIdx.x == 0) (void)xb_add(&bar[XB_XCNT(b.x)], 1u);
    return b;
}
__device__ __forceinline__ void xcd_barrier_complete(unsigned* bar, unsigned x, unsigned& nloc, unsigned& nx) {
    const unsigned G = gridDim.x * gridDim.y * gridDim.z;
    unsigned sum, cnt, mine, sp = 0u;
    for (;;) {
        sum = 0u; cnt = 0u; mine = 0u;
#pragma unroll
        for (unsigned j = 0; j < 16; ++j) { const unsigned c = xb_ld(&bar[XB_XCNT(j)]); sum += c; cnt += (c > 0u) ? 1u : 0u; mine = (j == x) ? c : mine; }
        if (sum == G) break;
        __builtin_amdgcn_s_sleep(1);
        if ((++sp & 255u) == 0u) { if (xb_ld(&bar[XB_TMO])) break; if (sp > XB_SPIN_CAP) { atomicAdd(&bar[XB_TMO], 1u); break; } }
    }
    nloc = mine > 0u ? mine : 1u; nx = cnt > 0u ? cnt : 1u;
}

__device__ __forceinline__ unsigned xb_xcc_id_v() { unsigned r; asm volatile("s_getreg_b32 %0, hwreg(20, 0, 4)" : "=s"(r)); return r & 0xFu; }
__device__ __forceinline__ void xcd_barrier(const XcdBarrier& b) {
    asm volatile("s_waitcnt vmcnt(0)" ::: "memory");
    __syncthreads();
    if (threadIdx.x == 0) {
        unsigned* bar = b.bar; const unsigned bx = xb_xcc_id_v();
        __builtin_amdgcn_s_waitcnt(0);
        unsigned nloc = b.st[0], nx = b.st[1];
        if (nloc == 0u) { xcd_barrier_complete(bar, bx, nloc, nx); b.st[0] = nloc; b.st[1] = nx; }
        const unsigned old = xb_add(&bar[XB_XSUB(bx)], 1u);
        const unsigned gen = old / nloc;
        if (old + 1u == (gen + 1u) * nloc) {
            __builtin_amdgcn_fence(__ATOMIC_RELEASE, "agent");
            asm volatile("s_waitcnt vmcnt(0)" ::: "memory");
            const unsigned og = xb_add(&bar[XB_TOP], 1u);
            const unsigned tg = og / nx;
            if (og + 1u == (tg + 1u) * nx) xb_add(&bar[XB_TOPGEN], 1u);
            else XB_SPIN(xb_ld(&bar[XB_TOPGEN]) == tg, bar);
            __builtin_amdgcn_fence(__ATOMIC_ACQUIRE, "agent");
            xb_add(&bar[XB_XGEN(bx)], 1u);
            asm volatile("s_waitcnt vmcnt(0)" ::: "memory");
        } else {
            XB_SPIN(xb_ld(&bar[XB_XGEN(bx)]) == gen, bar);
            __builtin_amdgcn_fence(__ATOMIC_ACQUIRE, "agent");
            asm volatile("s_waitcnt vmcnt(0)" ::: "memory");
        }
    }
    __syncthreads();
}


__device__ __forceinline__ void mlstm_task(const Params& p, int l, int s, int d, int h, LAS unsigned char* lds) {
    const int tid = opaque_tid(), lane = tid & 63, wave = tid >> 6, quad = lane >> 4, l15 = lane & 15;
    const int T = s < 32 ? 256 : 1024, tok0 = s < 32 ? s * 256 : NPT + (s - 32) * 1024, nch = T / 64;
    LAS bf16_t* sQ = (LAS bf16_t*)lds;
    LAS bf16_t* sK = sQ + 64 * 136;
    LAS bf16_t* sKt = sK + 64 * 136;
    LAS bf16_t* sVt = sKt + 128 * 72;
    LAS bf16_t* sP = sVt + 128 * 72;
    LAS bf16_t* sC = sP + 64 * 72;
    LAS float* sf = (LAS float*)(sC + 128 * 136);
    LAS float *sA = sf, *sB = sf + 64, *sPm = sf + 128, *sN = sf + 192, *sNq = sf + 320, *sPs = sf + 384;
    const bf16_t* proj = (const bf16_t*)(p.ws + WS_PROJ);
    const float* gates = (const float*)(p.ws + WS_GATES);
    float* hd = (float*)(p.ws + WS_HD) + (size_t)d * NTOK * 512;
    const float bi = p.in[I_BI][l * 8 + d * 4 + h], bfb = p.in[I_BF][l * 8 + d * 4 + h];
    f32x4 cacc[8];
    float m;
    float cw0[8], cw1[8], cw2[8], cbb[8];
    { const int g = tid & 31, ch = ((g >> 4) ? 512 : 0) + h * 128 + (g & 15) * 8; const float* cw = p.in[I_CBW] + (size_t)l * 3 * 1024 + ch;
        ld8f(cw, cw0); ld8f(cw + 1024, cw1); ld8f(cw + 2048, cw2); ld8f(p.in[I_CBB] + l * 1024 + ch, cbb); }
    __syncthreads();
    if (s >= 32) {
        const size_t sb = (((size_t)((s - 32) * 2 + l) * 2 + d) * 4 + h);
        const float* C0 = p.in[I_SMC] + sb * 128 * 128;
#pragma unroll
        for (int tn = 0; tn < 8; ++tn)
#pragma unroll
            for (int j = 0; j < 4; ++j) cacc[tn][j] = C0[(16 * wave + quad * 4 + j) * 128 + 16 * tn + l15];
        if (tid < 128) sN[tid] = p.in[I_SMN][sb * 128 + tid];
        m = p.in[I_SMM][sb];
    } else {
#pragma unroll
        for (int tn = 0; tn < 8; ++tn) cacc[tn] = (f32x4){0.f, 0.f, 0.f, 0.f};
        if (tid < 128) sN[tid] = 0.f;
        m = 0.f;
    }
#pragma unroll
    for (int tn = 0; tn < 8; ++tn)
#pragma unroll
        for (int j = 0; j < 4; ++j) sC[(16 * wave + quad * 4 + j) * 136 + 16 * tn + l15] = f2bf(cacc[tn][j]);

    u32x4v px1[4], pvv[2];
#define ML_PREFETCH(CC) do { _Pragma("unroll") for (int it = 0; it < 4; ++it) { const int idx = tid + 512 * it, i = idx >> 5, g = idx & 31, ch = ((g >> 4) ? 512 : 0) + h * 128 + (g & 15) * 8; \
            const int ii = 64 * (CC) + i, pos = d == 0 ? ii : T - 1 - ii; px1[it] = *(const u32x4v*)(proj + (size_t)(tok0 + pos) * NP + B_Q + ch); } \
        _Pragma("unroll") for (int it = 0; it < 2; ++it) { const int idx = tid + 512 * it, i = idx >> 4, g = idx & 15; const int ii = 64 * (CC) + i, tk = d == 0 ? tok0 + ii : tok0 + T - 1 - ii; \
            pvv[it] = *(const u32x4v*)(proj + (size_t)tk * NP + B_V + h * 128 + 8 * g); } } while (0)
    ML_PREFETCH(0);
    float gi_n = 0.f, gf_n = 0.f;
    if (wave == 0) { const int tk = d == 0 ? tok0 + lane : tok0 + T - 1 - lane; gi_n = gates[(size_t)tk * 16 + d * 4 + h]; gf_n = gates[(size_t)tk * 16 + 8 + d * 4 + h]; }
    for (int c = 0; c < nch; ++c) {
        __syncthreads();
        if (wave == 0) {
            const float gi = gi_n + bi, gf = gf_n + bfb;
            if (c + 1 < nch) { const int ii = 64 * (c + 1) + lane; const int tk = d == 0 ? tok0 + ii : tok0 + T - 1 - ii; gi_n = gates[(size_t)tk * 16 + d * 4 + h]; gf_n = gates[(size_t)tk * 16 + 8 + d * 4 + h]; }
            const float lf = fminf(gf, 0.f) - log1pf(__expf(-fabsf(gf)));
            float b = lf;
#pragma unroll
            for (int off = 1; off < 64; off <<= 1) { const float t = __shfl_up(b, off); if (lane >= off) b += t; }
            const float a = gi - b; float pm = a;
#pragma unroll
            for (int off = 1; off < 64; off <<= 1) { const float t = __shfl_up(pm, off); if (lane >= off) pm = fmaxf(pm, t); }
            sB[lane] = b; sA[lane] = a; sPm[lane] = pm;
        }
        __syncthreads();
        const float mx = fmaxf(m, sPm[63]), bL = sB[63];
#pragma unroll
        for (int it = 0; it < 4; ++it) {
            const int idx = tid + 512 * it, i = idx >> 5, g = idx & 31, isK = g >> 4, j0 = (g & 15) * 8, ch = (isK ? 512 : 0) + h * 128 + j0;
            const int ii = 64 * c + i, pos = d == 0 ? ii : T - 1 - ii, tk = tok0 + pos;
            const bf16_t* src = proj + (size_t)tk * NP + B_Q + ch;
            float x0[8], x1[8], x2[8], y[8];
            unpack8(px1[it], x1);
            unpack8(*(const u32x4v*)(pos > 0 ? src - NP : src), x0); unpack8(*(const u32x4v*)(pos < T - 1 ? src + NP : src), x2);
            const float m0 = pos > 0 ? 1.f : 0.f, m2 = pos < T - 1 ? 1.f : 0.f;
#pragma unroll
            for (int e = 0; e < 8; ++e) y[e] = siluf_(m0 * x0[e] * cw0[e] + x1[e] * cw1[e] + m2 * x2[e] * cw2[e] + cbb[e]);
            if (!isK) { *(LAS u32x4v*)(sQ + i * 136 + j0) = pack8(y); }
            else {
                const float wgi = __expf(sA[i] - mx);
#pragma unroll
                for (int e = 0; e < 8; ++e) y[e] *= 0.08838834764831845f;
                *(LAS u32x4v*)(sK + i * 136 + j0) = pack8(y);
#pragma unroll
                for (int e = 0; e < 8; ++e) sKt[(j0 + e) * 72 + (i ^ (8 * ((j0 >> 3) & 7)))] = f2bf(y[e] * wgi);
            }
        }
#pragma unroll
        for (int it = 0; it < 2; ++it) {
            const int idx = tid + 512 * it, i = idx >> 4, g = idx & 15;
            const int ii = 64 * c + i, tk = d == 0 ? tok0 + ii : tok0 + T - 1 - ii;
            const u32x4v w = pvv[it];
            LAS bf16_t* dst = sVt + (8 * g) * 72 + (i ^ (8 * (g & 7)));
            dst[0] = (bf16_t)(w.x & 0xffff); dst[72] = (bf16_t)(w.x >> 16); dst[144] = (bf16_t)(w.y & 0xffff); dst[216] = (bf16_t)(w.y >> 16);
            dst[288] = (bf16_t)(w.z & 0xffff); dst[360] = (bf16_t)(w.z >> 16); dst[432] = (bf16_t)(w.w & 0xffff); dst[504] = (bf16_t)(w.w >> 16);
        }
        if (c + 1 < nch) ML_PREFETCH(c + 1);
        __syncthreads();
        const int tm = wave >> 1;
        {
            const int tn0 = (wave & 1) * 2;
#pragma unroll
            for (int tt = 0; tt < 2; ++tt) {
                f32x4 acc = {0.f, 0.f, 0.f, 0.f};
#pragma unroll
                for (int ks = 0; ks < 4; ++ks) acc = MFMA16(frag(sQ, 16 * tm, 136, 32 * ks, lane), frag(sK, 16 * (tn0 + tt), 136, 32 * ks, lane), acc);
                const int scol = 16 * (tn0 + tt) + l15; const float as = sA[scol];
#pragma unroll
                for (int j = 0; j < 4; ++j) { const int t = 16 * tm + quad * 4 + j;
                    float pv = scol <= t ? __expf(as - fmaxf(m, sPm[t])) * acc[j] : 0.f;
                    sP[t * 72 + scol] = f2bf(pv);
                    pv = red16_sum(pv);
                    if (l15 == 0) sPs[t * 4 + tn0 + tt] = pv; }
            }
        }
        const int tnb = (wave & 1) * 4;
        f32x4 accq[4];
#pragma unroll
        for (int tt = 0; tt < 4; ++tt) { accq[tt] = (f32x4){0.f, 0.f, 0.f, 0.f};
#pragma unroll
            for (int ks = 0; ks < 4; ++ks) accq[tt] = MFMA16(frag(sQ, 16 * tm, 136, 32 * ks, lane), frag(sC, 16 * (tnb + tt), 136, 32 * ks, lane), accq[tt]); }
        { const int t = tid >> 3, part = tid & 7; float sacc = 0.f;
#pragma unroll
            for (int e = 0; e < 16; ++e) sacc += sN[16 * part + e] * bf2f(sQ[t * 136 + 16 * part + e]);
            sacc += __shfl_xor(sacc, 1); sacc += __shfl_xor(sacc, 2); sacc += __shfl_xor(sacc, 4);
            if (part == 0) sNq[t] = sacc; }
        __syncthreads();
        {
            f32x4 accp[4];
#pragma unroll
            for (int tt = 0; tt < 4; ++tt) { accp[tt] = (f32x4){0.f, 0.f, 0.f, 0.f};
#pragma unroll
                for (int ks = 0; ks < 2; ++ks) accp[tt] = MFMA16(frag(sP, 16 * tm, 72, 32 * ks, lane), fragsw(sVt, 16 * (tnb + tt), 32 * ks, lane), accp[tt]); }
#pragma unroll
            for (int j = 0; j < 4; ++j) { const int t = 16 * tm + quad * 4 + j;
                const float mtm = fmaxf(m, sPm[t]), wi = __expf(m - mtm);
                const float den = wi * sNq[t] + ((sPs[t * 4] + sPs[t * 4 + 1]) + (sPs[t * 4 + 2] + sPs[t * 4 + 3]));
                const float mt = sB[t] + mtm; const float inv = 1.0f / fmaxf(fabsf(den), __expf(-mt));
                const int ii = 64 * c + t, tk = d == 0 ? tok0 + ii : tok0 + T - 1 - ii;
                float* dst = hd + (size_t)tk * 512 + h * 128 + 16 * tnb + l15;
#pragma unroll
                for (int tt = 0; tt < 4; ++tt) dst[16 * tt] = (wi * accq[tt][j] + accp[tt][j]) * inv; }
        }
        const float sc = __expf(m - mx);
        if (tid < 128) { float ns = 0.f;
#pragma unroll 8
            for (int e = 0; e < 64; ++e) ns += bf2f(sKt[tid * 72 + e]);
            sN[tid] = sc * sN[tid] + ns; }
#pragma unroll
        for (int tn = 0; tn < 8; ++tn) { f32x4 dc = {0.f, 0.f, 0.f, 0.f};
#pragma unroll
            for (int ks = 0; ks < 2; ++ks) dc = MFMA16(fragsw(sVt, 16 * wave, 32 * ks, lane), fragsw(sKt, 16 * tn, 32 * ks, lane), dc);
            cacc[tn] = sc * cacc[tn] + dc;
#pragma unroll
            for (int j = 0; j < 4; ++j) sC[(16 * wave + quad * 4 + j) * 136 + 16 * tn + l15] = f2bf(cacc[tn][j]); }
        m = bL + mx;
    }
    __syncthreads();
    if (s < 32) {
        const size_t sb = (((size_t)(s * 2 + l) * 2 + d) * 4 + h);
        float* Co = p.out + O_MC + sb * 128 * 128;
#pragma unroll
        for (int tn = 0; tn < 8; ++tn)
#pragma unroll
            for (int j = 0; j < 4; ++j) Co[(16 * wave + quad * 4 + j) * 128 + 16 * tn + l15] = cacc[tn][j];
        if (tid < 128) p.out[O_MN + sb * 128 + tid] = sN[tid];
        if (tid == 0) p.out[O_MM + sb] = m;
    }
}

#undef ML_PREFETCH
__device__ __forceinline__ void attn_task(const Params& p, int l, int task, LAS unsigned char* lds) {
    const int tid = opaque_tid(), lane = tid & 63, wave = tid >> 6, quad = lane >> 4, l15 = lane & 15;
    const bool samp = task < 128;
    int b, h, qb;
    if (samp) { b = task >> 6; h = (task >> 3) & 7; qb = task & 7; } else { const int t2 = task - 128; b = t2 >> 4; h = (t2 >> 1) & 7; qb = t2 & 1; }
    const int tok0 = samp ? NPT + b * 1024 : b * 256, nkt = samp ? 24 : 4, nct = samp ? 8 : 0;
    LAS bf16_t* sK = (LAS bf16_t*)lds;
    LAS bf16_t* sVt = sK + 64 * 136;
    LAS bf16_t* sPw = sVt + 128 * 72 + wave * (16 * 72);
    const bf16_t* proj = (const bf16_t*)(p.ws + WS_PROJ);
    const bf16_t* ck = (const bf16_t*)(p.ws + WS_KC) + (((unsigned)(b * 2 + l) * 8 + h) * 512) * 128;
    const bf16_t* cv = (const bf16_t*)(p.ws + WS_VTC) + (((unsigned)(b * 2 + l) * 8 + h) * 128) * 512;
    const float lam = ((const float*)(p.ws + WS_LAM))[l];
    const float lam_init = 0.8f - 0.6f * expf(-0.3f * (float)l);
    const int q0 = 128 * qb + 16 * wave;
    bf16x8 aq1[2], aq2[2];
    { const bf16_t* qp = proj + (unsigned)(tok0 + q0 + l15) * NP + C_Q + h * 128 + quad * 8;
        aq1[0] = *(const bf16x8*)qp; aq1[1] = *(const bf16x8*)(qp + 32); aq2[0] = *(const bf16x8*)(qp + 64); aq2[1] = *(const bf16x8*)(qp + 96); }
    LAS bf16_t* sQw = sVt + 128 * 72 + wave * (16 * 136);
    { LAS bf16_t* qd = sQw + l15 * 136 + quad * 8;
        *(LAS bf16x8*)qd = aq1[0]; *(LAS bf16x8*)(qd + 32) = aq1[1]; *(LAS bf16x8*)(qd + 64) = aq2[0]; *(LAS bf16x8*)(qd + 96) = aq2[1]; }
    LDS_FENCE();
    float mx1 = -INFINITY, mx2 = -INFINITY, sm1 = 0.f, sm2 = 0.f, mc1 = 0.f, mc2 = 0.f;
    constexpr float CS = 0.125f * 1.4426950408889634f;
    f32x4 o1[8], o2[8];
#pragma unroll
    for (int tn = 0; tn < 8; ++tn) { o1[tn] = (f32x4){0.f, 0.f, 0.f, 0.f}; o2[tn] = o1[tn]; }
    u32x4v kreg[2], vreg[2];
#define ATT_LOAD(KT, PASS) do { int ktv = (KT); asm volatile("" : "+v"(ktv));     \
    _Pragma("unroll") for (int it = 0; it < 2; ++it) { const int idx = tid + 512 * it, i = idx >> 4, g = idx & 15; \
        if ((KT) < nct) { kreg[it] = *(const u32x4v*)(ck + (unsigned)((64 * ktv + i) * 128 + 8 * g)); \
            if ((PASS) == 1) { const int dv = idx >> 3, mm = idx & 7; vreg[it] = *(const u32x4v*)(cv + (unsigned)(dv * 512 + 64 * ktv + 8 * mm)); } } \
        else { kreg[it] = *(const u32x4v*)(proj + (unsigned)((tok0 + 64 * (ktv - nct) + i) * NP + C_K + h * 128 + 8 * g)); \
            if ((PASS) == 1) vreg[it] = *(const u32x4v*)(proj + (unsigned)((tok0 + 64 * (ktv - nct) + (idx & 63)) * NP + C_V + h * 128 + 8 * (idx >> 6))); } } } while (0)
#define ATT_LOADK(BUF, KT) do { int ktv = (KT); asm volatile("" : "+v"(ktv)); _Pragma("unroll") for (int it = 0; it < 2; ++it) { const int idx = tid + 512 * it, i = idx >> 4, g = idx & 15; \
        if ((KT) < nct) BUF[it] = *(const u32x4v*)(ck + (unsigned)((64 * ktv + i) * 128 + 8 * g)); \
        else BUF[it] = *(const u32x4v*)(proj + (unsigned)((tok0 + 64 * (ktv - nct) + i) * NP + C_K + h * 128 + 8 * g)); } } while (0)
#define ATT_P0TILE(BUF, KT) do { __syncthreads(); \
        _Pragma("unroll") for (int it = 0; it < 2; ++it) { const int idx = tid + 512 * it, i = idx >> 4, g = idx & 15; *(LAS u32x4v*)(sK + i * 136 + 8 * g) = BUF[it]; } \
        if ((KT) + 2 < nkt) ATT_LOADK(BUF, (KT) + 2); \
        __syncthreads(); \
        _Pragma("unroll") for (int tn = 0; tn < 4; ++tn) { f32x4 a_ = {0.f, 0.f, 0.f, 0.f}, b_ = a_; \
            _Pragma("unroll") for (int ks = 0; ks < 2; ++ks) { a_ = MFMA16(frag(sK, 16 * tn, 136, 32 * ks, lane), aq1[ks], a_); b_ = MFMA16(frag(sK, 16 * tn, 136, 64 + 32 * ks, lane), aq2[ks], b_); } \
            _Pragma("unroll") for (int j = 0; j < 4; ++j) { mx1 = fmaxf(mx1, a_[j]); mx2 = fmaxf(mx2, b_[j]); } } } while (0)
    ATT_LOADK(kreg, 0); ATT_LOADK(vreg, 1);
    for (int kt = 0; kt < nkt; kt += 2) { ATT_P0TILE(kreg, kt); ATT_P0TILE(vreg, kt + 1); }
#undef ATT_LOADK
#undef ATT_P0TILE
    mx1 = fmaxf(mx1, __shfl_xor(mx1, 16)); mx1 = fmaxf(mx1, __shfl_xor(mx1, 32)); mx2 = fmaxf(mx2, __shfl_xor(mx2, 16)); mx2 = fmaxf(mx2, __shfl_xor(mx2, 32)); mc1 = mx1 * CS; mc2 = mx2 * CS;
    u32x4v kreg2[2], vreg2[2];
#define ATT_LOADKV(KB, VB, KT) do { int ktv = (KT); asm volatile("" : "+v"(ktv)); _Pragma("unroll") for (int it = 0; it < 2; ++it) { const int idx = tid + 512 * it, i = idx >> 4, g = idx & 15; \
        if ((KT) < nct) { KB[it] = *(const u32x4v*)(ck + (unsigned)((64 * ktv + i) * 128 + 8 * g)); const int dv = idx >> 3, mm = idx & 7; VB[it] = *(const u32x4v*)(cv + (unsigned)(dv * 512 + 64 * ktv + 8 * mm)); } \
        else { KB[it] = *(const u32x4v*)(proj + (unsigned)((tok0 + 64 * (ktv - nct) + i) * NP + C_K + h * 128 + 8 * g)); \
            VB[it] = *(const u32x4v*)(proj + (unsigned)((tok0 + 64 * (ktv - nct) + (idx & 63)) * NP + C_V + h * 128 + 8 * (idx >> 6))); } } } while (0)
#define ATT_STAGEKV(KB, VB, KT) do { _Pragma("unroll") for (int it = 0; it < 2; ++it) { const int idx = tid + 512 * it, i = idx >> 4, g = idx & 15; \
        *(LAS u32x4v*)(sK + i * 136 + 8 * g) = KB[it]; \
        if ((KT) < nct) { const int dv = idx >> 3, mm = idx & 7; *(LAS u32x4v*)(sVt + dv * 72 + 8 * mm) = VB[it]; } \
        else { const u32x4v w = VB[it]; LAS bf16_t* dst = sVt + (8 * (idx >> 6)) * 72 + (idx & 63); \
            dst[0] = (bf16_t)(w.x & 0xffff); dst[72] = (bf16_t)(w.x >> 16); dst[144] = (bf16_t)(w.y & 0xffff); dst[216] = (bf16_t)(w.y >> 16); \
            dst[288] = (bf16_t)(w.z & 0xffff); dst[360] = (bf16_t)(w.z >> 16); dst[432] = (bf16_t)(w.w & 0xffff); dst[504] = (bf16_t)(w.w >> 16); } } } while (0)
    auto p1_compute = [&]() {
#pragma unroll
            for (int bb = 0; bb < 2; ++bb) {
                f32x4 s1[2], s2[2];
#pragma unroll
                for (int t = 0; t < 2; ++t) { s1[t] = (f32x4){0.f, 0.f, 0.f, 0.f}; s2[t] = s1[t];
#pragma unroll
                    for (int ks = 0; ks < 2; ++ks) { s1[t] = MFMA16(frag(sK, 32 * bb + 16 * t, 136, 32 * ks, lane), aq1[ks], s1[t]); s2[t] = MFMA16(frag(sK, 32 * bb + 16 * t, 136, 64 + 32 * ks, lane), aq2[ks], s2[t]); } }
                {
                    bf16x8 pa1, pa2;
                    { float p1[8];
#pragma unroll
                        for (int jj = 0; jj < 8; ++jj) { p1[jj] = __builtin_amdgcn_exp2f(s1[jj >> 2][jj & 3] * CS - mc1); sm1 += p1[jj]; }
                        pa1 = __builtin_bit_cast(bf16x8, pack8(p1)); }
                    { float p2[8];
#pragma unroll
                        for (int jj = 0; jj < 8; ++jj) { p2[jj] = __builtin_amdgcn_exp2f(s2[jj >> 2][jj & 3] * CS - mc2); sm2 += p2[jj]; }
                        pa2 = __builtin_bit_cast(bf16x8, pack8(p2)); }
#pragma unroll
                    for (int tn2 = 0; tn2 < 8; ++tn2) { const LAS bf16_t* vrow = sVt + (16 * tn2 + l15) * 72 + 32 * bb + quad * 4;
                        const u32x2v lo = *(const LAS u32x2v*)vrow, hi = *(const LAS u32x2v*)(vrow + 16);
                        u32x4v vw; vw.x = lo.x; vw.y = lo.y; vw.z = hi.x; vw.w = hi.y;
                        const bf16x8 vb = __builtin_bit_cast(bf16x8, vw);
                        o1[tn2] = MFMA16(pa1, vb, o1[tn2]); o2[tn2] = MFMA16(pa2, vb, o2[tn2]); }
                }
                asm volatile("" ::: "memory");
            }
    };
#define ATT_P1TILE(KB, VB, KT) do { __syncthreads(); ATT_STAGEKV(KB, VB, KT); if ((KT) + 2 < nkt) ATT_LOADKV(KB, VB, (KT) + 2); __syncthreads(); p1_compute(); } while (0)
    ATT_LOADKV(kreg, vreg, 0); ATT_LOADKV(kreg2, vreg2, 1);
    for (int kt = 0; kt < nkt; kt += 2) { ATT_P1TILE(kreg, vreg, kt); ATT_P1TILE(kreg2, vreg2, kt + 1); }
#undef ATT_LOADKV
#undef ATT_STAGEKV
#undef ATT_P1TILE
    sm1 += __shfl_xor(sm1, 16); sm1 += __shfl_xor(sm1, 32); sm2 += __shfl_xor(sm2, 16); sm2 += __shfl_xor(sm2, 32);
    const float il1 = 1.0f / sm1, il2 = lam / sm2;
    float f1[4], f2[4];
#pragma unroll
    for (int j = 0; j < 4; ++j) { f1[j] = __shfl(il1, quad * 4 + j); f2[j] = __shfl(il2, quad * 4 + j); }
#pragma unroll
    for (int tn = 0; tn < 8; ++tn)
#pragma unroll
        for (int j = 0; j < 4; ++j) o1[tn][j] = o1[tn][j] * f1[j] - o2[tn][j] * f2[j];
    asm volatile("" ::: "memory");
#define oacc o1
#undef ATT_LOAD
    bf16_t* mixed = (bf16_t*)(p.ws + WS_UM);
    const float* sg = p.in[I_SUBG] + l * 128;
#pragma unroll
    for (int j = 0; j < 4; ++j) {
        float ss = 0.f;
#pragma unroll
        for (int tn = 0; tn < 8; ++tn) ss += oacc[tn][j] * oacc[tn][j];
        ss = red16_sum(ss);
        const float r = rsqrtf(ss * (1.0f / 128.0f) + 1e-5f) * (1.0f - lam_init);
        const int tq = tok0 + q0 + quad * 4 + j;
#pragma unroll
        for (int tn = 0; tn < 8; ++tn) { const int dv = 16 * tn + l15;
            const float gt = bf2f(proj[(unsigned)tq * NP + C_G + h * 128 + dv]);
            mixed[(unsigned)tq * DM + 1024 + h * 128 + dv] = f2bf(oacc[tn][j] * r * sg[dv] * siluf_(gt)); }
    }
}

#undef oacc
__device__ __forceinline__ void rwkv_prep_task(const Params& p, int l, int task, LAS unsigned char* lds) {
    const int tid = opaque_tid(), lane = tid & 63, wave = tid >> 6, quad = lane >> 4, l15 = lane & 15;
    const int tile = task >> 3, h = task & 7, tb = 64 * tile;
    const int T = tb < NPT ? 256 : 1024, seq0 = tb < NPT ? (tb & ~255) : NPT + ((tb - NPT) & ~1023);
    LAS bf16_t* sTW = (LAS bf16_t*)lds;
    LAS bf16_t* sAD = sTW + 2 * 64 * 72;
    LAS bf16_t* sWup = sAD + 2 * 64 * 72;
    LAS bf16_t* sAup = sWup + 2 * 64 * 72;
    LAS float* sR = (LAS float*)(sAup + 2 * 64 * 72);
    LAS float* sKf = sR + 4096; LAS float* sVf = sKf + 4096; LAS float* sNrm = sVf + 4096; LAS float* sRK = sNrm + 64;
    const bf16_t* proj = (const bf16_t*)(p.ws + WS_PROJ);
    __syncthreads();
#pragma unroll
    for (int it = 0; it < 4; ++it) {
        const int idx = tid + 512 * it, arr = idx >> 9, i = (idx >> 3) & 63, g = idx & 7;
        const u32x4v w = *(const u32x4v*)(proj + (size_t)(tb + i) * NP + A_WD + 64 * arr + 8 * g);
        if (arr < 2) { float x[8]; unpack8(w, x);
#pragma unroll
            for (int e = 0; e < 8; ++e) x[e] = tanhf_(x[e]);
            *(LAS u32x4v*)(sTW + (arr * 64 + i) * 72 + 8 * g) = pack8(x); }
        else *(LAS u32x4v*)(sAD + ((arr - 2) * 64 + i) * 72 + 8 * g) = w;
    }
#pragma unroll
    for (int it = 0; it < 4; ++it) {
        const int dd2 = it >> 1, which = it & 1, c = tid >> 3, jg = tid & 7;
        const bf16_t* src = (const bf16_t*)(p.ws + WS_WUPT) + ((((size_t)(l * 2 + dd2) * 2 + which) * 8 + h) * 4096) + c * 64 + 8 * jg;
        *(LAS u32x4v*)((which ? sAup : sWup) + (dd2 * 64 + c) * 72 + 8 * jg) = *(const u32x4v*)src;
    }
#pragma unroll
    for (int it = 0; it < 3; ++it) {
        const int idx = tid + 512 * it, which = idx >> 9, i = (idx >> 3) & 63, g = idx & 7, ch = which * 512 + h * 64 + 8 * g;
        const int tk = tb + i, pos = tk - seq0;
        const bf16_t* src = proj + (size_t)tk * NP + ch;
        float x0[8], x1[8], x2[8], w0[8], w1[8], w2[8], bb[8];
        unpack8(*(const u32x4v*)src, x1);
        unpack8(*(const u32x4v*)(pos > 0 ? src - NP : src), x0); unpack8(*(const u32x4v*)(pos < T - 1 ? src + NP : src), x2);
        const float m0 = pos > 0 ? 1.f : 0.f, m2 = pos < T - 1 ? 1.f : 0.f;
        const float* cw = p.in[I_CAW] + (size_t)l * 3 * 1536 + ch;
        ld8f(cw, w0); ld8f(cw + 1536, w1); ld8f(cw + 3072, w2); ld8f(p.in[I_CAB] + l * 1536 + ch, bb);
        LAS float* dst = (which == 0 ? sR : (which == 1 ? sKf : sVf)) + i * 64 + 8 * g;
#pragma unroll
        for (int e = 0; e < 8; ++e) dst[e] = m0 * x0[e] * w0[e] + x1[e] * w1[e] + m2 * x2[e] * w2[e] + bb[e];
    }
    __syncthreads();
    { const int t = tid >> 3, part = tid & 7; float ss = 0.f;
#pragma unroll
        for (int e = 0; e < 8; ++e) { const float v = sKf[t * 64 + 8 * part + e] * p.in[I_KK][l * 512 + h * 64 + 8 * part + e]; ss += v * v; }
        ss += __shfl_xor(ss, 1); ss += __shfl_xor(ss, 2); ss += __shfl_xor(ss, 4);
        if (part == 0) sNrm[t] = rsqrtf(ss + 1e-12f); }
    const int dd = wave >> 2, tm = wave & 3;
    f32x4 aw[4], aa[4];
#pragma unroll
    for (int tn = 0; tn < 4; ++tn) { aw[tn] = (f32x4){0.f, 0.f, 0.f, 0.f}; aa[tn] = aw[tn];
#pragma unroll
        for (int ks = 0; ks < 2; ++ks) { aw[tn] = MFMA16(frag(sTW + dd * 64 * 72, 16 * tm, 72, 32 * ks, lane), frag(sWup + dd * 64 * 72, 16 * tn, 72, 32 * ks, lane), aw[tn]);
            aa[tn] = MFMA16(frag(sAD + dd * 64 * 72, 16 * tm, 72, 32 * ks, lane), frag(sAup + dd * 64 * 72, 16 * tn, 72, 32 * ks, lane), aa[tn]); } }
    __syncthreads();
    {
        LAS bf16_t* so = sTW + dd * (3 * 4096);
        float rk[4] = {0.f, 0.f, 0.f, 0.f};
#pragma unroll
        for (int tn = 0; tn < 4; ++tn) { const int c = 16 * tn + l15, ch = h * 64 + c;
            const float w0v = p.in[I_W0][(l * 2 + dd) * 512 + ch], a0v = p.in[I_A0][(l * 2 + dd) * 512 + ch], kav = p.in[I_KA][l * 512 + ch], kkv = p.in[I_KK][l * 512 + ch], rkv = p.in[I_RK][l * 512 + ch];
#pragma unroll
            for (int j = 0; j < 4; ++j) { const int t = 16 * tm + quad * 4 + j; const int o = t * 64 + c;
                const float z = w0v + aw[tn][j]; const float dec = __expf(-0.6065306597126334f * sigmoidf_(z));
                const float av = sigmoidf_(a0v + aa[tn][j]); const float kv = sKf[t * 64 + c];
                const float ktv = kv * (1.0f + (av - 1.0f) * kav); const float kk = kv * kkv * sNrm[t];
                so[o] = f2bf(ktv); so[4096 + o] = f2bf(kk * av); so[8192 + o] = f2bf(dec - 1.0f);
                rk[j] += sR[t * 64 + c] * ktv * rkv; } }
#pragma unroll
        for (int j = 0; j < 4; ++j) { const float s = red16_sum(rk[j]); if (l15 == 0) sRK[dd * 64 + 16 * tm + quad * 4 + j] = s; }
    }
    __syncthreads();
    { const int i = tid >> 3, g = tid & 7; const size_t o = (size_t)(tb + i) * 512 + h * 64 + 8 * g;
        float r[8], k[8], v[8], bn[8]; const float nr = sNrm[i], rks = sRK[i] + sRK[64 + i];
#pragma unroll
        for (int e = 0; e < 8; ++e) { r[e] = sR[i * 64 + 8 * g + e]; k[e] = sKf[i * 64 + 8 * g + e] * p.in[I_KK][l * 512 + h * 64 + 8 * g + e] * nr; v[e] = sVf[i * 64 + 8 * g + e]; bn[e] = rks * v[e]; }
        const size_t o2 = ((size_t)(tb + i) * 8 + h) * 320 + 8 * g; bf16_t* pk = (bf16_t*)(p.ws + WS_PK);
#pragma unroll
        for (int dd2 = 0; dd2 < 2; ++dd2)
#pragma unroll
            for (int ar = 0; ar < 3; ++ar) *(u32x4v*)(pk + (size_t)dd2 * NTOK * 2560 + o2 + 128 + 64 * ar) = *(const LAS u32x4v*)(sTW + dd2 * (3 * 4096) + ar * 4096 + i * 64 + 8 * g);
        const u32x4v rr = pack8(r), kk8 = pack8(k);
        *(u32x4v*)(pk + o2) = rr; *(u32x4v*)(pk + o2 + 64) = kk8; *(u32x4v*)(pk + (size_t)NTOK * 2560 + o2) = rr; *(u32x4v*)(pk + (size_t)NTOK * 2560 + o2 + 64) = kk8;
        *(u32x4v*)((bf16_t*)(p.ws + WS_SCV) + o) = pack8(v); *(u32x4v*)((bf16_t*)(p.ws + WS_SCBON) + o) = pack8(bn); }
}

__device__ __forceinline__ void m1_phase(const Params& p, int l, LAS unsigned char* lds, int rep, int mask) {
    unsigned* ctr = (unsigned*)(p.ws + WS_CTL) + 64 * (1 + 4 * l + 8 * rep);
    LAS int* slot = (LAS int*)(lds + LDS_SLOT);
#ifndef NO_MLSTM
    if (mask & 1) for (;;) { const int t = next_task(ctr, slot); if (t >= 272) break; const int u = t < 16 ? t + 256 : t - 16; mlstm_task(p, l, u >> 3, (u >> 2) & 1, u & 3, lds); }
#endif
#ifndef NO_ATTN
    if (mask & 2) for (;;) { const int t = next_task(ctr + 64, slot); if (t >= 640) break; attn_task(p, l, t, lds); }
#endif
#ifndef NO_PREP
    if (mask & 4) for (;;) { const int t = next_task(ctr + 128, slot); if (t >= 1280) break; rwkv_prep_task(p, l, t, lds); }
#endif
}

#ifdef EXP_LITE
#if EXP_LITE == 1
#define EXPY(v) (bf2f(sBt[(quad * 4 + j) * 24 + l15]) + bf2f(sGt[(16 + quad * 4 + j) * 24 + l15]) + sW[l15 + 16 * quad])
#elif EXP_LITE == 2
#define EXPY(v) (bf2f(sAt[(quad * 4 + j) * 72 + l15]) + bf2f(sX2[(quad * 4 + j) * 24 + l15]))
#else
#define EXPY(v) (bf2f(sPy[(quad * 4 + j) * 72 + 16 + l15]) + bf2f(sQy[(quad * 4 + j) * 24 + l15]))
#endif
#define EXPS(v) 0.f
#else
#define EXPY(v) (v)
#define EXPS(v) (v)
#endif
__device__ __forceinline__ bf16_t f2bf_sw(float f) { unsigned u = __float_as_uint(f); u += 0x7FFFu + ((u >> 16) & 1u); return (bf16_t)(u >> 16); }
__device__ __forceinline__ bf16x8 frag16(const LAS bf16_t* base, int row0, int ld, int lane) {
    bf16x8 z = {0, 0, 0, 0, 0, 0, 0, 0};
    if ((lane >> 4) < 2) z = *(const LAS bf16x8*)(base + (row0 + (lane & 15)) * ld + (lane >> 4) * 8);
    return z;
}
__device__ __forceinline__ void cp_task(const Params& p, int task, int lane, LAS unsigned char* wl) {
    int s, d, h, c, T;
    if (task < 8192) { s = task >> 8; d = (task >> 7) & 1; h = (task >> 4) & 7; c = task & 15; T = 256; }
    else { const int u = task - 8192; s = 32 + (u >> 10); d = (u >> 9) & 1; h = (u >> 6) & 7; c = u & 63; T = 1024; }
    const int tok0 = s < 32 ? s * 256 : NPT + (s - 32) * 1024, quad = lane >> 4, l15 = lane & 15;
    const long step = d == 0 ? 1 : -1; const int tfirst = d == 0 ? tok0 + 16 * c : tok0 + T - 1 - 16 * c;
    bf16_t* pk = (bf16_t*)(p.ws + WS_PK) + (size_t)d * NTOK * 2560 + ((size_t)tfirst * 8 + h) * 320;
    LAS bf16_t* sA = (LAS bf16_t*)wl;
    LAS bf16_t* sB = sA + 16 * 72, *sG = sB + 16 * 72, *sR = sG + 16 * 72;
    LAS float* mL1 = (LAS float*)(sR + 16 * 72);
    LAS bf16_t* sL2 = (LAS bf16_t*)(mL1 + 16 * 17);
    LAS bf16_t* sM1t = sL2 + 16 * 24;
    LAS bf16_t* sTt = sM1t + 16 * 24;
    LAS bf16_t* sAtil = sTt + 16 * 24;
    LAS bf16_t* sX2 = sTt;
    LAS bf16_t* oAt = sB;
    LAS bf16_t* oPy = sG;
    LAS bf16_t* oX2 = (LAS bf16_t*)mL1;
    LAS bf16_t* oQy = sL2;
    float bt[16], gt[16], W = 1.0f;
    { const int k = lane;
        float rr[16], kk[16], kt[16], ka[16], wm[16];
#pragma unroll
        for (int i = 0; i < 16; ++i) { const bf16_t* rec = pk + step * 2560 * i + k; rr[i] = bf2f(rec[0]); kk[i] = bf2f(rec[64]); kt[i] = bf2f(rec[128]); ka[i] = bf2f(rec[192]); wm[i] = bf2f(rec[256]); }
#pragma unroll
        for (int i = 0; i < 16; ++i) { const float Wp = W; W = W + W * wm[i]; const float iw = __builtin_amdgcn_rcpf(W);
            sA[i * 72 + k] = f2bf(Wp * kk[i]); bt[i] = ka[i] * iw; gt[i] = kt[i] * iw; sB[i * 72 + k] = f2bf(bt[i]); sG[i * 72 + k] = f2bf(gt[i]); sR[i * 72 + k] = f2bf(W * rr[i]); } }
    LDS_FENCE();
    f32x4 m2acc;
    { f32x4 a1 = {0.f, 0.f, 0.f, 0.f}, a2 = a1, a3 = a1, a4 = a1;
#pragma unroll
        for (int ks = 0; ks < 2; ++ks) { const bf16x8 fb = frag(sB, 0, 72, 32 * ks, lane), fg = frag(sG, 0, 72, 32 * ks, lane), fa = frag(sA, 0, 72, 32 * ks, lane), fr = frag(sR, 0, 72, 32 * ks, lane);
            a1 = MFMA16(fb, fa, a1); a2 = MFMA16(fg, fa, a2); a3 = MFMA16(fb, fr, a3); a4 = MFMA16(fg, fr, a4); }
#pragma unroll
        for (int j = 0; j < 4; ++j) { const int i = quad * 4 + j, t = l15;
            mL1[i * 17 + t] = i < t ? a1[j] : 0.f; sL2[i * 24 + t] = f2bf(i < t ? a2[j] : 0.f); sM1t[t * 24 + i] = f2bf(i <= t ? a3[j] : 0.f); m2acc[j] = i <= t ? a4[j] : 0.f; } }
    LDS_FENCE();
    { float Tr[16];
#pragma unroll
        for (int t = 0; t < 16; ++t) { float acc = (l15 == t) ? 1.0f : 0.0f;
#pragma unroll
            for (int i = 0; i < t; ++i) acc -= Tr[i] * mL1[i * 17 + t];
            Tr[t] = acc; }
        if (quad == 0) {
#pragma unroll
            for (int t = 0; t < 16; ++t) sTt[t * 24 + l15] = f2bf(Tr[t]); } }
    LDS_FENCE();
    const bf16x8 ftt = frag16(sTt, 0, 24, lane);
#pragma unroll
    for (int kt2 = 0; kt2 < 4; ++kt2) {
        u32x4v aw = {0u, 0u, 0u, 0u};
        if (quad < 2) { const LAS bf16_t* col = sA + (quad * 8) * 72 + 16 * kt2 + l15;
            aw.x = (unsigned)col[0] | ((unsigned)col[72] << 16); aw.y = (unsigned)col[144] | ((unsigned)col[216] << 16); aw.z = (unsigned)col[288] | ((unsigned)col[360] << 16); aw.w = (unsigned)col[432] | ((unsigned)col[504] << 16); }
        f32x4 acc = {0.f, 0.f, 0.f, 0.f};
        acc = MFMA16(__builtin_bit_cast(bf16x8, aw), ftt, acc);
#pragma unroll
        for (int j = 0; j < 4; ++j) { const int k = 16 * kt2 + quad * 4 + j; const bf16_t v = f2bf_sw(acc[j]); sAtil[k * 24 + l15] = v; oAt[l15 * 72 + k] = v; }
    }
    { f32x4 acc = {0.f, 0.f, 0.f, 0.f};
        acc = MFMA16(frag16(sL2, 0, 24, lane), ftt, acc);
#pragma unroll
        for (int j = 0; j < 4; ++j) { const bf16_t v = f2bf_sw(acc[j]); sX2[(quad * 4 + j) * 24 + l15] = v; oX2[l15 * 24 + quad * 4 + j] = v; } }
    LDS_FENCE();
    const bf16x8 fm1 = frag16(sM1t, 0, 24, lane);
#pragma unroll
    for (int kt2 = 0; kt2 < 4; ++kt2) { f32x4 acc = {0.f, 0.f, 0.f, 0.f};
        acc = MFMA16(frag16(sAtil, 16 * kt2, 24, lane), fm1, acc);
#pragma unroll
        for (int j = 0; j < 4; ++j) { const int k = 16 * kt2 + quad * 4 + j; oPy[l15 * 72 + k] = f2bf(bf2f(sR[l15 * 72 + k]) - acc[j]); } }
    { f32x4 acc = {0.f, 0.f, 0.f, 0.f};
        acc = MFMA16(frag16(sX2, 0, 24, lane), fm1, acc);
#pragma unroll
        for (int j = 0; j < 4; ++j) oQy[l15 * 24 + quad * 4 + j] = f2bf(m2acc[j] - acc[j]); }
    LDS_FENCE();
    { float bb8[8]; const int k = lane; bf16_t* rec = pk + step * 2560 * (k >> 2);
#pragma unroll
        for (int hh = 0; hh < 2; ++hh) {
#pragma unroll
            for (int e = 0; e < 8; ++e) bb8[e] = bt[8 * hh + e];
            *(u32x4v*)(rec + 128 + (k & 3) * 16 + 8 * hh) = pack8(bb8);
#pragma unroll
            for (int e = 0; e < 8; ++e) bb8[e] = gt[8 * hh + e];
            *(u32x4v*)(rec + 192 + (k & 3) * 16 + 8 * hh) = pack8(bb8); }
        ((float*)(rec + 288))[k & 3] = W; }
#pragma unroll
    for (int it = 0; it < 2; ++it) { const int f = lane + 64 * it, t = f >> 3, q = f & 7; bf16_t* rec = pk + step * 2560 * t;
        *(u32x4v*)(rec + 8 * q) = *(const LAS u32x4v*)(oAt + t * 72 + 8 * q); *(u32x4v*)(rec + 64 + 8 * q) = *(const LAS u32x4v*)(oPy + t * 72 + 8 * q); }
    if (lane < 32) { const int t = lane >> 1, q = lane & 1; bf16_t* rec = pk + step * 2560 * t;
        *(u32x4v*)(rec + 256 + 8 * q) = *(const LAS u32x4v*)(oX2 + t * 24 + 8 * q); *(u32x4v*)(rec + 272 + 8 * q) = *(const LAS u32x4v*)(oQy + t * 24 + 8 * q); }
    LDS_FENCE();
}
constexpr int CP_LDS = 16 * 72 * 2 * 4 + 16 * 17 * 4 + (16 * 24 * 3 + 64 * 24 + 16 * 24) * 2 + 16 * 72 * 2 * 2 + 16 * 24 * 2 * 2;

__device__ __forceinline__ void ap_task(const Params& p, int l, int task, int lane, LAS unsigned char* wl) {
    int s, d, h, rt;
    if (task < 128) { s = 32 + (task >> 6); d = (task >> 5) & 1; h = (task >> 2) & 7; rt = task & 3; }
    else { const int u = task - 128; s = u >> 6; d = (u >> 5) & 1; h = (u >> 2) & 7; rt = u & 3; }
    const int T = s < 32 ? 256 : 1024, nch = T / 16, tok0 = s < 32 ? s * 256 : NPT + (s - 32) * 1024, quad = lane >> 4, l15 = lane & 15;
    const long step = d == 0 ? 1 : -1; const int tstart = d == 0 ? tok0 : tok0 + T - 1;
    const bf16_t* pk = (const bf16_t*)(p.ws + WS_PK) + (size_t)d * NTOK * 2560 + ((size_t)tstart * 8 + h) * 320;
    const bf16_t* pv = (const bf16_t*)(p.ws + WS_SCV) + (size_t)tstart * 512 + h * 64 + 16 * rt;
    float* yd = (float*)(p.ws + WS_YD) + (size_t)d * NTOK * 512 + (size_t)tstart * 512 + h * 64 + 16 * rt;
    constexpr int IS = 328;
    LAS bf16_t* img = (LAS bf16_t*)wl;
    LAS bf16_t* sS = img + 16 * IS;
    LAS bf16_t* sCm = sS + 16 * 72;
    f32x4 S[4];
    if (s >= 32) { const float* s0 = p.in[I_SRW] + ((((size_t)((s - 32) * 2 + l) * 2 + d) * 8 + h) * 64 + 16 * rt) * 64;
#pragma unroll
        for (int tn = 0; tn < 4; ++tn)
#pragma unroll
            for (int j = 0; j < 4; ++j) S[tn][j] = s0[(quad * 4 + j) * 64 + 16 * tn + l15]; }
    else {
#pragma unroll
        for (int tn = 0; tn < 4; ++tn) S[tn] = (f32x4){0.f, 0.f, 0.f, 0.f}; }
    const bf16_t* gsrc = pk + step * 2560 * (lane >> 2) + 8 * (lane & 3);
    LAS bf16_t* ldst = img + (lane >> 2) * IS + 8 * (lane & 3);
    u32x4v rawA[10], rawB[10]; bf16_t vrA[8], vrB[8];
#define AP_LOAD(raw, vraw, CH) do { int chv = (CH); asm volatile("" : "+v"(chv)); const bf16_t* cb = gsrc + step * 2560 * (16 * chv); \
        _Pragma("unroll") for (int jj = 0; jj < 10; ++jj) raw[jj] = *(const u32x4v*)(cb + 32 * jj); \
        if (quad < 2) { _Pragma("unroll") for (int e = 0; e < 8; ++e) vraw[e] = pv[step * 512 * (16 * chv + quad * 8 + e) + l15]; } } while (0)
#define AP_STAGE(raw) do { _Pragma("unroll") for (int jj = 0; jj < 10; ++jj) *(LAS u32x4v*)(ldst + 32 * jj) = raw[jj]; } while (0)
    AP_LOAD(rawA, vrA, 0);
    if (nch > 1) AP_LOAD(rawB, vrB, 1);
    const LAS bf16_t* pBt = img + (l15 >> 2) * IS + 128 + (l15 & 3) * 16 + quad * 8;
    const LAS float* pW = (const LAS float*)(img + (l15 >> 2) * IS + 288) + (l15 & 3);
#define AP_CHUNK(raw, vraw, CC) do { const int c = (CC); \
        AP_STAGE(raw); \
        u32x4v vw = {0u, 0u, 0u, 0u}; \
        if (quad < 2) { vw.x = (unsigned)vraw[0] | ((unsigned)vraw[1] << 16); vw.y = (unsigned)vraw[2] | ((unsigned)vraw[3] << 16); vw.z = (unsigned)vraw[4] | ((unsigned)vraw[5] << 16); vw.w = (unsigned)vraw[6] | ((unsigned)vraw[7] << 16); } \
        asm volatile("" : "+v"(vw)); \
        if (c + 2 < nch) AP_LOAD(raw, vraw, c + 2); \
        ap_compute(c, vw); } while (0)
    auto ap_compute = [&](int c, u32x4v vw) {
        const bf16x8 va = __builtin_bit_cast(bf16x8, vw);
#pragma unroll
        for (int tn = 0; tn < 4; ++tn) { const unsigned w01 = pk2(S[tn][0], S[tn][1]), w23 = pk2(S[tn][2], S[tn][3]); LAS bf16_t* ds = sS + (quad * 4) * 72 + 16 * tn + l15;
            ds[0] = (bf16_t)(w01 & 0xffff); ds[72] = (bf16_t)(w01 >> 16); ds[144] = (bf16_t)(w23 & 0xffff); ds[216] = (bf16_t)(w23 >> 16); }
        LDS_FENCE();
        f32x4 cm = {0.f, 0.f, 0.f, 0.f}, yy = {0.f, 0.f, 0.f, 0.f};
#pragma unroll
        for (int ks = 0; ks < 2; ++ks) { const bf16x8 fs = frag(sS, 0, 72, 32 * ks, lane); cm = MFMA16(fs, frag(img, 0, IS, 32 * ks, lane), cm); yy = MFMA16(fs, frag(img + 64, 0, IS, 32 * ks, lane), yy); }
        cm = MFMA16(va, frag16(img + 256, 0, IS, lane), cm); yy = MFMA16(va, frag16(img + 272, 0, IS, lane), yy);
#pragma unroll
        for (int j = 0; j < 4; ++j) { yd[step * 512 * (16 * c + l15) + quad * 4 + j] = yy[j]; sCm[(quad * 4 + j) * 24 + l15] = f2bf_sw(cm[j]); }
        LDS_FENCE();
        const bf16x8 fc = frag16(sCm, 0, 24, lane);
#pragma unroll
        for (int tn = 0; tn < 4; ++tn) { f32x4 ab = {0.f, 0.f, 0.f, 0.f}, ag = ab;
            bf16x8 fb = {0, 0, 0, 0, 0, 0, 0, 0}, fg = fb;
            if (quad < 2) { fb = *(const LAS bf16x8*)(pBt + tn * 4 * IS); fg = *(const LAS bf16x8*)(pBt + tn * 4 * IS + 64); }
            ab = MFMA16(fc, fb, ab); ag = MFMA16(va, fg, ag);
            const float w16 = pW[tn * 2 * IS];
#pragma unroll
            for (int j = 0; j < 4; ++j) S[tn][j] = (S[tn][j] - ab[j] + ag[j]) * w16; }
        LDS_FENCE();
    };
    for (int c2 = 0; c2 < nch; c2 += 2) { AP_CHUNK(rawA, vrA, c2); AP_CHUNK(rawB, vrB, c2 + 1); }
#undef AP_CHUNK
#undef AP_LOAD
#undef AP_STAGE
    if (s < 32) { float* so = p.out + O_RW + ((((size_t)(s * 2 + l) * 2 + d) * 8 + h) * 64 + 16 * rt) * 64;
#pragma unroll
        for (int tn = 0; tn < 4; ++tn)
#pragma unroll
            for (int j = 0; j < 4; ++j) so[(quad * 4 + j) * 64 + 16 * tn + l15] = S[tn][j]; }
}
constexpr int AP_LDS = (16 * 72 * 2 + 64 * 24 * 2 + 16 * 24 * 2) * 2 + 64 * 4 + (16 * 72 + 16 * 24) * 2;

typedef float f32x2 __attribute__((ext_vector_type(2)));
__device__ __forceinline__ void m2_phase(const Params& p, int l, int rep, LAS unsigned char* lds, const XcdBarrier& xbar) {
    const int tid_ = opaque_tid(); const int lane = tid_ & 63, wave = tid_ >> 6;
    LAS unsigned char* wl = lds + wave * 16384;
    const int G = gridDim.x, b = blockIdx.x, slot = b * 8 + wave, NW = G * 8;
    for (int t = slot; t < 2048; t += NW) cp_task(p, 8192 + t, lane, wl);
    xcd_barrier(xbar);
    const bool chain_wave = wave == 0 && b < 128;
    if (chain_wave) { for (int t = b; t < 128; t += G) ap_task(p, l, t, lane, wl); }
    else { const int nchain = G < 128 ? G : 128;
        const int idx = b < nchain ? b * 7 + (wave - 1) : nchain * 7 + (b - nchain) * 8 + wave;
        for (int t = idx; t < 8192; t += NW - nchain) cp_task(p, t, lane, wl); }
    xcd_barrier(xbar);
    for (int t = slot; t < 2048; t += NW) ap_task(p, l, 128 + t, lane, wl);
}

__device__ __forceinline__ void m3_phase(const Params& p, int l) {
    const int tid_ = opaque_tid(); const int lane = tid_ & 63, gw = blockIdx.x * 8 + (tid_ >> 6), NGW = gridDim.x * 8;
    const bf16_t* proj = (const bf16_t*)(p.ws + WS_PROJ);
    bf16_t* mixed = (bf16_t*)(p.ws + WS_UM);
    const int c = lane * 8;
    for (int tok = gw; tok < NTOK; tok += NGW) {
        const size_t o = (size_t)tok * 512 + c;
        {
            float y0[8], y1[8], g[8], bb[8], bn[8], gt[8], out[8];
            ld8f((const float*)(p.ws + WS_YD) + o, y0); ld8f((const float*)(p.ws + WS_YD) + (size_t)NTOK * 512 + o, y1);
            float s = 0.f;
#pragma unroll
            for (int e = 0; e < 8; ++e) { y0[e] += y1[e]; s += y0[e]; }
            s += __shfl_xor(s, 1); s += __shfl_xor(s, 2); s += __shfl_xor(s, 4);
            const float mu = s * (1.0f / 64.0f); float q = 0.f;
#pragma unroll
            for (int e = 0; e < 8; ++e) { y0[e] -= mu; q += y0[e] * y0[e]; }
            q += __shfl_xor(q, 1); q += __shfl_xor(q, 2); q += __shfl_xor(q, 4);
            const float rs = rsqrtf(q * (1.0f / 64.0f) + 64e-5f);
            ld8f(p.in[I_RGG] + l * 512 + c, g); ld8f(p.in[I_RGB] + l * 512 + c, bb);
            unpack8(*(const u32x4v*)((const bf16_t*)(p.ws + WS_SCBON) + o), bn);
            unpack8(*(const u32x4v*)(proj + (size_t)tok * NP + A_GATE + c), gt);
#pragma unroll
            for (int e = 0; e < 8; ++e) out[e] = (y0[e] * rs * g[e] + bb[e] + bn[e]) * siluf_(gt[e]);
            *(u32x4v*)(mixed + (size_t)tok * DM + c) = pack8(out);
        }
        {
            float h0[8], h1[8], g[8], bb[8], og[8], gt[8], out[8];
            ld8f((const float*)(p.ws + WS_HD) + o, h0); ld8f((const float*)(p.ws + WS_HD) + (size_t)NTOK * 512 + o, h1);
            unpack8(*(const u32x4v*)(proj + (size_t)tok * NP + B_O + c), og);
            float s = 0.f;
#pragma unroll
            for (int e = 0; e < 8; ++e) { h0[e] = (h0[e] + h1[e]) * sigmoidf_(og[e]); s += h0[e]; }
            s += __shfl_xor(s, 1); s += __shfl_xor(s, 2); s += __shfl_xor(s, 4); s += __shfl_xor(s, 8);
            const float mu = s * (1.0f / 128.0f); float q = 0.f;
#pragma unroll
            for (int e = 0; e < 8; ++e) { h0[e] -= mu; q += h0[e] * h0[e]; }
            q += __shfl_xor(q, 1); q += __shfl_xor(q, 2); q += __shfl_xor(q, 4); q += __shfl_xor(q, 8);
            const float rs = rsqrtf(q * (1.0f / 128.0f) + 1e-5f);
            ld8f(p.in[I_MGG] + l * 512 + c, g); ld8f(p.in[I_MGB] + l * 512 + c, bb);
            unpack8(*(const u32x4v*)(proj + (size_t)tok * NP + B_GATE + c), gt);
#pragma unroll
            for (int e = 0; e < 8; ++e) out[e] = (h0[e] * rs * g[e] + bb[e]) * siluf_(gt[e]);
            *(u32x4v*)(mixed + (size_t)tok * DM + 512 + c) = pack8(out);
        }
    }
}

__device__ __forceinline__ void ln_phase(const Params& p, int l) {
    const int tid_ = opaque_tid(); const int lane = tid_ & 63, gw = blockIdx.x * 8 + (tid_ >> 6), NGW = gridDim.x * 8;
    for (int tok0 = gw; tok0 < NTOK; tok0 += 2 * NGW) {
        const int tok1 = tok0 + NGW; const bool has1 = tok1 < NTOK;
        float* zr0 = p.out + O_Y + (size_t)tok0 * DM; float* zr1 = p.out + O_Y + (size_t)(has1 ? tok1 : tok0) * DM;
        float v0[4][8], v1[4][8]; float s0 = 0.f, s1 = 0.f;
#pragma unroll
        for (int j = 0; j < 4; ++j) { ld8f(zr0 + j * 512 + lane * 8, v0[j]); ld8f(zr1 + j * 512 + lane * 8, v1[j]); }
#pragma unroll
        for (int j = 0; j < 4; ++j)
#pragma unroll
            for (int e = 0; e < 8; ++e) { s0 += v0[j][e]; s1 += v1[j][e]; }
#pragma unroll
        for (int o = 1; o < 64; o <<= 1) { s0 += __shfl_xor(s0, o); s1 += __shfl_xor(s1, o); }
        const float mu0 = s0 * (1.0f / 2048.0f), mu1 = s1 * (1.0f / 2048.0f); float q0 = 0.f, q1 = 0.f;
#pragma unroll
        for (int j = 0; j < 4; ++j)
#pragma unroll
            for (int e = 0; e < 8; ++e) { v0[j][e] -= mu0; q0 += v0[j][e] * v0[j][e]; v1[j][e] -= mu1; q1 += v1[j][e] * v1[j][e]; }
#pragma unroll
        for (int o = 1; o < 64; o <<= 1) { q0 += __shfl_xor(q0, o); q1 += __shfl_xor(q1, o); }
        const float rs0 = rsqrtf(q0 * (1.0f / 2048.0f) + 1e-5f), rs1 = rsqrtf(q1 * (1.0f / 2048.0f) + 1e-5f);
        const float* mod0 = (const float*)(p.ws + WS_MOD) + (size_t)(3 + mod_row(tok0)) * 6144;
        const float* mod1 = (const float*)(p.ws + WS_MOD) + (size_t)(3 + mod_row(has1 ? tok1 : tok0)) * 6144;
        bf16_t* ur0 = (bf16_t*)(p.ws + WS_UM) + (size_t)tok0 * DM; bf16_t* ur1 = (bf16_t*)(p.ws + WS_UM) + (size_t)(has1 ? tok1 : tok0) * DM;
#pragma unroll
        for (int j = 0; j < 4; ++j) { const int c = j * 512 + lane * 8; float g[8], bb[8], y0[8], y1[8];
            ld8f(p.in[I_LNG] + l * DM + c, g); ld8f(p.in[I_LNB] + l * DM + c, bb);
#pragma unroll
            for (int e = 0; e < 8; ++e) { y0[e] = v0[j][e] * rs0 * g[e] + bb[e]; y1[e] = v1[j][e] * rs1 * g[e] + bb[e]; }
            *(float4*)(zr0 + c) = make_float4(y0[0], y0[1], y0[2], y0[3]); *(float4*)(zr0 + c + 4) = make_float4(y0[4], y0[5], y0[6], y0[7]);
            if (has1) { *(float4*)(zr1 + c) = make_float4(y1[0], y1[1], y1[2], y1[3]); *(float4*)(zr1 + c + 4) = make_float4(y1[4], y1[5], y1[6], y1[7]); }
            if (l == 0) { float sh[8], sc[8], o[8]; ld8f(mod0 + c, sh); ld8f(mod0 + 2048 + c, sc);
#pragma unroll
                for (int e = 0; e < 8; ++e) o[e] = y0[e] * (1.0f + sc[e]) + sh[e];
                *(u32x4v*)(ur0 + c) = pack8(o);
                if (has1) { ld8f(mod1 + c, sh); ld8f(mod1 + 2048 + c, sc);
#pragma unroll
                    for (int e = 0; e < 8; ++e) o[e] = y1[e] * (1.0f + sc[e]) + sh[e];
                    *(u32x4v*)(ur1 + c) = pack8(o); } } }
    }
}

#ifndef G2_ALIGN
#define G2_ALIGN true
#endif
#ifndef GEMM_ALIGN
#define GEMM_ALIGN true
#endif
#ifndef GEMM_SP2
#define GEMM_SP2 true
#endif
#ifndef DUP_P0B
#define DUP_P0B 0
#endif
#ifndef DUP_SYNC
#define DUP_SYNC 0
#endif
#ifndef DUP_M3
#define DUP_M3 0
#endif
#ifndef DUP_G2
#define DUP_G2 0
#endif
#ifndef DUP_P0
#define DUP_P0 0
#endif
#ifndef DUP_M1
#define DUP_M1 0
#endif
#ifndef DUP_M2
#define DUP_M2 0
#endif
#ifndef DUP_G1
#define DUP_G1 0
#endif
#ifndef DUP_MASK
#define DUP_MASK 7
#endif
#ifndef PH_ALL
#define PH_ALL 1
#endif
#ifndef PH_P0
#define PH_P0 PH_ALL
#endif
#ifndef PH_G1
#define PH_G1 PH_ALL
#endif
#ifndef PH_M1
#define PH_M1 PH_ALL
#endif
#ifndef PH_M2
#define PH_M2 PH_ALL
#endif
#ifndef PH_M3
#define PH_M3 PH_ALL
#endif
#ifndef PH_G2
#define PH_G2 PH_ALL
#endif
#ifndef PH_LN
#define PH_LN PH_ALL
#endif
__global__ void __launch_bounds__(NTHREADS) hybrid_fwd(Params p) {
    extern __shared__ __attribute__((aligned(16))) unsigned char smem[];
    LAS unsigned char* lds = (LAS unsigned char*)smem;
    cg::grid_group grid = cg::this_grid();
    volatile LAS unsigned* xst = (volatile LAS unsigned*)(lds + LDS_SLOT + 16);
    if (threadIdx.x == 0) { xst[0] = 0u; xst[1] = 0u; }
    __syncthreads();
    const XcdBarrier xbar = xcd_barrier_post((unsigned*)(p.ws + WS_BAR), xst);
#define GSYNC() xcd_barrier(xbar)
#if PH_P0
    for (int rep = 0; rep < 1 + DUP_P0; ++rep) { p0_phase(p, lds, rep); if (rep < DUP_P0) GSYNC(); }
#endif
    if (p.ws == nullptr) grid.sync();
    GSYNC();
#if PH_P0
    for (int rep = 0; rep < 1 + DUP_P0B; ++rep) p0b_phase(p);
#endif
    GSYNC();
    for (int i = 0; i < DUP_SYNC; ++i) GSYNC();
    for (int l = 0; l < 2; ++l) {
#if PH_G1
        for (int rep = 0; rep < 1 + DUP_G1; ++rep) {
            pg8::Gemm g; g.A = (const bf16_t*)(p.ws + WS_UM); g.Bt = (const bf16_t*)(p.ws + WS_WIN) + (size_t)l * NP * DM; g.M = NTOK; g.N = NP; g.K = DM;
            pg8::StaticOrder S; S.init(NTOK, NP, gridDim.x, blockIdx.x);
            EpiIn E; E.proj = (bf16_t*)(p.ws + WS_PROJ); E.gates = (float*)(p.ws + WS_GATES); E.newk = p.out + O_NK; E.newv = p.out + O_NV; E.rope = (const float*)(p.ws + WS_ROPE); E.layer = l;
            pg8::gemm_phase<EpiIn, pg8::StaticOrder, GEMM_ALIGN, GEMM_SP2>(lds, g, S, E);
            if (l == 0 && rep == 0) tr_tail_phase(p, lds, 0, 704, 12);
            if (rep < DUP_G1) GSYNC();
        }
#endif
        GSYNC();
#if PH_M1
        for (int rep = 0; rep < 1 + DUP_M1; ++rep) { m1_phase(p, l, lds, rep, rep == 0 ? 7 : DUP_MASK); if (rep < DUP_M1) GSYNC(); }
#endif
        GSYNC();
#if PH_M2
        for (int rep = 0; rep < 1 + DUP_M2; ++rep) { m2_phase(p, l, rep, lds, xbar); if (rep < DUP_M2) GSYNC(); }
#endif
        GSYNC();
#if PH_M3
        for (int rep = 0; rep < 1 + DUP_M3; ++rep) m3_phase(p, l);
#endif
        GSYNC();
#if PH_G2
        for (int rep = 0; rep < 1 + (l == 0 ? DUP_G2 : 0); ++rep) {
            pg8::Gemm g; g.A = (const bf16_t*)(p.ws + WS_UM); g.Bt = (const bf16_t*)(p.ws + WS_WOUT) + (size_t)l * DM * DM; g.M = NTOK; g.N = DM; g.K = DM;
            pg8::StaticOrder S; S.init(NTOK, DM, gridDim.x, blockIdx.x);
            EpiOut E; E.xp = p.in[I_XP]; E.xs = p.in[I_XS]; E.mod = (const float*)(p.ws + WS_MOD) + (size_t)l * 3 * 6144; E.y = p.out + O_Y; E.layer = l;
            pg8::gemm_phase<EpiOut, pg8::StaticOrder, G2_ALIGN, GEMM_SP2>(lds, g, S, E);
            if (l == 0 && rep == 0) { mod_tail_phase(p, lds); tr_tail_phase(p, lds, 704, 1408, 14); }
            if (rep < (l == 0 ? DUP_G2 : 0)) GSYNC();
        }
#endif
        GSYNC();
#if PH_LN
        ln_phase(p, l);
#endif
        if (l == 0) GSYNC();
    }
}

extern "C" void kernel_launch(void* const* d_in, const int* in_sizes, int n_in, void* d_out, int out_size, void* d_ws, size_t ws_size, hipStream_t stream) {
    static int grid_blocks = 0;
    if (grid_blocks == 0) {
        if (n_in != 38 || ws_size < WS_END) { fprintf(stderr, "kernel_launch: unexpected n_in %d / ws_size %zu (need %zu)\n", n_in, ws_size, (size_t)WS_END); grid_blocks = -1; return; }
        int dev = 0, cus = 0, per_cu = 0;
        hipGetDevice(&dev);
        hipDeviceGetAttribute(&cus, hipDeviceAttributeMultiprocessorCount, dev);
        hipFuncSetAttribute((const void*)hybrid_fwd, hipFuncAttributeMaxDynamicSharedMemorySize, LDS_BYTES);
        hipOccupancyMaxActiveBlocksPerMultiprocessor(&per_cu, (const void*)hybrid_fwd, NTHREADS, LDS_BYTES);
        if (per_cu < 1) { fprintf(stderr, "kernel_launch: occupancy query gives %d blocks per CU\n", per_cu); per_cu = 1; }
        grid_blocks = cus * per_cu;
    }
    if (grid_blocks < 0) return;
    Params p{};
    for (int i = 0; i < 38; ++i) p.in[i] = (const float*)d_in[i];
    p.out = (float*)d_out; p.ws = (unsigned char*)d_ws;
    hipMemsetAsync(d_ws, 0, 32768, stream);
    void* args[] = {&p};
    hipError_t e = hipLaunchCooperativeKernel((const void*)hybrid_fwd, dim3(grid_blocks), dim3(NTHREADS), args, LDS_BYTES, stream);
    if (e != hipSuccess) fprintf(stderr, "cooperative launch failed: %s (grid %d)\n", hipGetErrorString(e), grid_blocks);
}
```
